# Optimizing an MI355X kernel written in HIP

```python
import jax, jax.numpy as jnp
from jax import lax
import numpy as np

D_MODEL = 1024
BATCH = 8
SEQ = 2048
DEPTH = 2

CTX_LEN = 256
GRID_W = 64
MLA_HEADS = 4
QK_NOPE = 128
QK_ROPE = 64
V_DIM = 128
Q_LORA = 384
KV_LORA = 256
MLA_W = MLA_HEADS * V_DIM
FNET_GROUPS = 4
FNET_W = 256
CONV_GROUPS = 4
CONV_W = 256
D_MIX = MLA_W + FNET_W + CONV_W
MLA_IN = Q_LORA + KV_LORA + QK_ROPE
D_IN = MLA_IN + FNET_W + 3 * CONV_W
D_FF = 2816
ROPE_THETA = 10000.0
Q_BLOCK = 128
EPS = 1e-6
SM_SCALE = (QK_NOPE + QK_ROPE) ** -0.5

kernel_name = "hymba_style_mla_fnet_shortconv_dit_block"


def rmsnorm(x, g):
    xf = x.astype(jnp.float32)
    y = xf * lax.rsqrt(jnp.mean(xf * xf, axis=-1, keepdims=True) + EPS)
    return (y * g.astype(jnp.float32)).astype(x.dtype)


def modulate(h, shift, scale):
    return h * (1 + scale) + shift


def dwconv3(x, w, b):
    xp = jnp.pad(x, ((0, 0), (1, 1), (0, 0)))
    return xp[:, :-2] * w[0] + xp[:, 1:-1] * w[1] + xp[:, 2:] * w[2] + b


def axial_rope_tables(n_tokens):
    rows = n_tokens // GRID_W
    r = jnp.repeat(jnp.arange(rows), GRID_W).astype(jnp.float32)
    cidx = jnp.tile(jnp.arange(GRID_W), rows).astype(jnp.float32)
    half = QK_ROPE // 2
    inv = ROPE_THETA ** (-jnp.arange(0, half, 2, dtype=jnp.float32) / half)
    ang = jnp.stack([r[:, None] * inv, cidx[:, None] * inv], axis=1)
    return jnp.cos(ang), jnp.sin(ang)


def apply_axial_rope(x, cos, sin):
    shp = x.shape
    xf = x.astype(jnp.float32).reshape(shp[:-1] + (2, 2, QK_ROPE // 4))
    x1, x2 = xf[..., 0, :], xf[..., 1, :]
    out = jnp.stack([x1 * cos - x2 * sin, x1 * sin + x2 * cos], axis=-2)
    return out.reshape(shp).astype(x.dtype)


def mla_project(p, w_uq, q_norm_g, w_ukv, kv_norm_g, rope):
    cq = rmsnorm(p[..., :Q_LORA], q_norm_g)
    ckv = rmsnorm(p[..., Q_LORA:Q_LORA + KV_LORA], kv_norm_g)
    k_rope = p[..., Q_LORA + KV_LORA:]
    q = jnp.einsum('blr,rhd->blhd', cq, w_uq)
    kv = jnp.einsum('blr,rhd->blhd', ckv, w_ukv)
    q_nope, q_rope = q[..., :QK_NOPE], q[..., QK_NOPE:]
    k_nope, v = kv[..., :QK_NOPE], kv[..., QK_NOPE:]
    if rope is not None:
        cos, sin = rope
        q_rope = apply_axial_rope(q_rope, cos[:, None], sin[:, None])
        k_rope = apply_axial_rope(k_rope, cos, sin)
    return q_nope, q_rope, k_nope, k_rope, v


def mla_attend(q_n, q_r, k_n, k_r, v):
    s = (jnp.einsum('bqhd,bkhd->bhqk', q_n, k_n)
         + jnp.einsum('bqhr,bkr->bhqk', q_r, k_r)).astype(jnp.float32) * SM_SCALE
    p = jax.nn.softmax(s, axis=-1).astype(v.dtype)
    return jnp.einsum('bhqk,bkhd->bqhd', p, v)


def mla_attend_blocked(q_n, q_r, k_n, k_r, v):
    B, L, H, _ = q_n.shape
    nb = L // Q_BLOCK
    qn_b = jnp.moveaxis(q_n.reshape(B, nb, Q_BLOCK, H, QK_NOPE), 1, 0)
    qr_b = jnp.moveaxis(q_r.reshape(B, nb, Q_BLOCK, H, QK_ROPE), 1, 0)
    out = lax.map(lambda qs: mla_attend(qs[0], qs[1], k_n, k_r, v), (qn_b, qr_b))
    return jnp.moveaxis(out, 0, 1).reshape(B, L, H * V_DIM)


def fourier_mix(u):
    B, L, _ = u.shape
    ug = u.astype(jnp.float32).reshape(B, L, FNET_GROUPS, FNET_W // FNET_GROUPS)
    y = jnp.fft.fft2(ug, axes=(1, 3), norm='ortho').real
    return y.reshape(B, L, FNET_W).astype(u.dtype)


def short_gated_conv(p, w, b):
    bg, cg, xv = p[..., :CONV_W], p[..., CONV_W:2 * CONV_W], p[..., 2 * CONV_W:]
    return bg * dwconv3(cg * xv, w, b)


def merge_groups(att, p_rest, sconv_w, sconv_b, out_norm_g, w_out):
    y_f = fourier_mix(p_rest[..., :FNET_W])
    y_c = short_gated_conv(p_rest[..., FNET_W:], sconv_w, sconv_b)
    y = jnp.concatenate([rmsnorm(att, out_norm_g[:MLA_W]),
                         rmsnorm(y_f, out_norm_g[MLA_W:MLA_W + FNET_W]),
                         rmsnorm(y_c, out_norm_g[MLA_W + FNET_W:])], axis=-1)
    return y @ w_out


def conv_ffn(x, shift, scale, g, w_up, cw, cb, w_down):
    h = modulate(rmsnorm(x, g), shift, scale)
    u = h @ w_up
    gate = dwconv3(u[..., :D_FF], cw, cb)
    return (jax.nn.silu(gate) * u[..., D_FF:]) @ w_down


def setup_inputs(seed: int = 0) -> dict:
    key = jax.random.key(seed)
    ks = jax.random.split(key, 24)
    f32 = jnp.float32
    nrm = lambda k, shp, s: jax.random.normal(k, shp, f32) * s
    L = DEPTH
    return {
        "x": nrm(ks[0], (BATCH, SEQ, D_MODEL), 1.0),
        "c": nrm(ks[1], (BATCH, D_MODEL), 1.0),
        "ctx": nrm(ks[2], (BATCH, CTX_LEN, D_MODEL), 1.0),
        "c_ctx": nrm(ks[3], (D_MODEL,), 1.0),
        "ada_w": nrm(ks[4], (L, D_MODEL, 6 * D_MODEL), D_MODEL ** -0.5),
        "ada_b": nrm(ks[5], (L, 6 * D_MODEL), 0.02),
        "norm1_g": 1.0 + nrm(ks[6], (L, D_MODEL), 0.02),
        "w_in": nrm(ks[7], (L, D_MODEL, D_IN), D_MODEL ** -0.5),
        "q_norm_g": 1.0 + nrm(ks[8], (L, Q_LORA), 0.02),
        "kv_norm_g": 1.0 + nrm(ks[9], (L, KV_LORA), 0.02),
        "w_uq": nrm(ks[10], (L, Q_LORA, MLA_HEADS, QK_NOPE + QK_ROPE), Q_LORA ** -0.5),
        "w_ukv": nrm(ks[11], (L, KV_LORA, MLA_HEADS, QK_NOPE + V_DIM), KV_LORA ** -0.5),
        "sconv_w": nrm(ks[12], (L, 3, CONV_W), 3 ** -0.5),
        "sconv_b": nrm(ks[13], (L, CONV_W), 0.02),
        "out_norm_g": 1.0 + nrm(ks[14], (L, D_MIX), 0.02),
        "w_out": nrm(ks[15], (L, D_MIX, D_MODEL), D_MIX ** -0.5),
        "norm2_g": 1.0 + nrm(ks[16], (L, D_MODEL), 0.02),
        "w_up": nrm(ks[17], (L, D_MODEL, 2 * D_FF), D_MODEL ** -0.5),
        "ffconv_w": nrm(ks[18], (L, 3, D_FF), 3 ** -0.5),
        "ffconv_b": nrm(ks[19], (L, D_FF), 0.02),
        "w_down": nrm(ks[20], (L, D_FF, D_MODEL), D_FF ** -0.5),
        "final_g": 1.0 + nrm(ks[21], (D_MODEL,), 0.02),
    }


def reference(x, c, ctx, c_ctx, ada_w, ada_b, norm1_g, w_in, q_norm_g, kv_norm_g, w_uq, w_ukv,
              sconv_w, sconv_b, out_norm_g, w_out, norm2_g, w_up, ffconv_w, ffconv_b, w_down,
              final_g):
    B, S, _ = x.shape
    rope = axial_rope_tables(S)
    x_lat, x_ctx = x, ctx
    for l in range(DEPTH):
        last = l == DEPTH - 1
        mod_l = (jax.nn.silu(c) @ ada_w[l] + ada_b[l])[:, None, :]
        mod_c = (jax.nn.silu(c_ctx) @ ada_w[l] + ada_b[l])[None, None, :]
        sh1, sc1, ga1, sh2, sc2, ga2 = jnp.split(mod_l, 6, axis=-1)
        csh1, csc1, cga1, csh2, csc2, cga2 = jnp.split(mod_c, 6, axis=-1)

        p_lat = modulate(rmsnorm(x_lat, norm1_g[l]), sh1, sc1) @ w_in[l]
        p_ctx = modulate(rmsnorm(x_ctx, norm1_g[l]), csh1, csc1) @ w_in[l]
        ql_n, ql_r, kl_n, kl_r, vl = mla_project(p_lat[..., :MLA_IN], w_uq[l], q_norm_g[l],
                                                 w_ukv[l], kv_norm_g[l], rope)
        qc_n, qc_r, kc_n, kc_r, vc = mla_project(p_ctx[..., :MLA_IN], w_uq[l], q_norm_g[l],
                                                 w_ukv[l], kv_norm_g[l], None)
        k_n = jnp.concatenate([kc_n, kl_n], axis=1)
        k_r = jnp.concatenate([kc_r, kl_r], axis=1)
        v = jnp.concatenate([vc, vl], axis=1)
        att_lat = mla_attend_blocked(ql_n, ql_r, k_n, k_r, v)
        y_lat = merge_groups(att_lat, p_lat[..., MLA_IN:], sconv_w[l], sconv_b[l],
                             out_norm_g[l], w_out[l])
        x_lat_new = x_lat + ga1 * y_lat
        if not last:
            att_ctx = mla_attend(qc_n, qc_r, kc_n, kc_r, vc).reshape(B, -1, MLA_W)
            y_ctx = merge_groups(att_ctx, p_ctx[..., MLA_IN:], sconv_w[l], sconv_b[l],
                                 out_norm_g[l], w_out[l])
            x_ctx = x_ctx + cga1 * y_ctx
        x_lat = x_lat_new

        x_lat = x_lat + ga2 * conv_ffn(x_lat, sh2, sc2, norm2_g[l], w_up[l], ffconv_w[l],
                                       ffconv_b[l], w_down[l])
        if not last:
            x_ctx = x_ctx + cga2 * conv_ffn(x_ctx, csh2, csc2, norm2_g[l], w_up[l], ffconv_w[l],
                                            ffconv_b[l], w_down[l])
    return rmsnorm(x_lat, final_g)
```

```cpp
#define MK_SPLIT 1
#include <hip/hip_runtime.h>
#include <hip/hip_bf16.h>
#include <cstdio>
#include <cstdint>
#include <cmath>
namespace pg8 {
#define PG8_LAS __attribute__((address_space(3)))
typedef unsigned short bf16_t;
typedef short bf16x8 __attribute__((ext_vector_type(8)));
typedef float f32x4 __attribute__((ext_vector_type(4)));
typedef float f32x2 __attribute__((ext_vector_type(2)));
typedef unsigned u32x4 __attribute__((ext_vector_type(4)));
typedef unsigned u32x2 __attribute__((ext_vector_type(2)));
constexpr int BM = 256, BK = 64, HALF = 128, HTB = HALF * BK * 2  , STAGE_BYTES = 8 * HTB, NXCD = 8, WGM = 8;

__host__ __device__ __forceinline__ int lds_byte(int r, int c) { const int st = (r >> 4) * 2 + (c >> 5), rr = r & 15, cc = c & 31, ob = rr * 64 + cc * 2; return st * 1024 + (ob ^ (((ob >> 9) & 1) << 5)); }
__host__ __device__ __forceinline__ void stage_rc(int b, int& R, int& C) { const int st = b / 1024, sb = b % 1024, swz = sb ^ (((sb >> 9) & 1) << 5); R = (st >> 1) * 16 + swz / 64; C = (st & 1) * 32 + (swz % 64) / 2; }
__host__ __device__ __forceinline__ int perm32(int rho) { const int n = rho >> 4, i = rho & 15; return 8 * (i >> 2) + 4 * n + (i & 3); }

struct Unit { int pm, pn, arow; };
struct Gemm { const bf16_t* A; const bf16_t* Bt; int nM, nN, K, lda; };

struct StaticOrder {
    int nM, nN, nwg, G, c;
    __device__ __forceinline__ void init(int nM_, int nN_, int G_, int c_) { nM = nM_; nN = nN_; nwg = nM * nN; G = G_; c = c_; }
    __device__ __forceinline__ bool next_mn(int i, int& pm, int& pn) const {
        const long L = (long)i * G + c; if (L >= nwg) return false;
        int wgid = (int)L; { const int q = nwg / NXCD, r = nwg % NXCD, xcd = wgid % NXCD, off = wgid / NXCD; wgid = (xcd < r ? xcd * (q + 1) : r * (q + 1) + (xcd - r) * q) + off; }
        const int nig = WGM * nN, gid = wgid / nig, fm = gid * WGM, gsz = (nM - fm) < WGM ? (nM - fm) : WGM;
        pm = fm + ((wgid % nig) % gsz); pn = (wgid % nig) / gsz; return true;
    }
    typedef Unit UnitT;
    __device__ __forceinline__ bool next(int i, Unit& u) const { if (!next_mn(i, u.pm, u.pn)) return false; u.arow = u.pm * BM; return true; }
};

__device__ __forceinline__ unsigned cvt_pk_bf16(float lo, float hi) { unsigned r; asm volatile("v_cvt_pk_bf16_f32 %0, %1, %2" : "=v"(r) : "v"(lo), "v"(hi)); return r; }

template <class Epi, class Sched>
__device__ __forceinline__ void gemm_phase(PG8_LAS unsigned char* lds, const Gemm g, const Sched& S, const Epi& E) {
    int tid = threadIdx.x; asm volatile("" : "+v"(tid));
    const int wid = __builtin_amdgcn_readfirstlane(tid >> 6), lane = tid & 63, wr = wid >> 2, wc = wid & 3, fr = lane & 15, fq = lane >> 4;
    const int K = g.K, nt = K / BK, lda = g.lda;
    unsigned voffA[2], voffB[2];
#pragma unroll
    for (int i = 0; i < 2; ++i) { int R, C; stage_rc(tid * 16 + i * 8192, R, C); const int Rb = Epi::PERM ? ((R & ~31) + perm32(R & 31)) : R;
        voffA[i] = (unsigned)(R * lda + C) * 2u; voffB[i] = (unsigned)(Rb * K + C) * 2u; }
    const size_t kstep = (size_t)(BK * 2);
    const size_t hstepA = (size_t)HALF * lda * 2, hstepB = (size_t)HALF * K * 2;
    const size_t tstepB = 2 * hstepB;
    const unsigned ldsw = (unsigned)wid * 1024u;
    const int aoff = lds_byte(wr * 64 + fr, fq * 8), boff = lds_byte(wc * 32 + fr, fq * 8);
#define PG8_SA(b, h) (((b) * 2 + (h)) * HTB)
#define PG8_SB(b, h) ((4 + (b) * 2 + (h)) * HTB)
#define PG8_STAGE(bufoff, gbase, voff) do { _Pragma("unroll") for (int _i = 0; _i < 2; ++_i) \
        __builtin_amdgcn_global_load_lds((const unsigned*)((const char*)(gbase) + (voff)[_i]), (PG8_LAS unsigned*)(lds + (bufoff) + ldsw + _i * 8192), 16, 0, 0); } while (0)
#define PG8_LDA(dst, b, h) do { _Pragma("unroll") for (int m = 0; m < 4; ++m) _Pragma("unroll") for (int k = 0; k < 2; ++k) dst[m][k] = *(const PG8_LAS bf16x8*)(lds + PG8_SA(b, h) + aoff + m * 2048 + k * 1024); } while (0)
#define PG8_LDB(dst, b, h) do { _Pragma("unroll") for (int n = 0; n < 2; ++n) _Pragma("unroll") for (int k = 0; k < 2; ++k) dst[n][k] = *(const PG8_LAS bf16x8*)(lds + PG8_SB(b, h) + boff + n * 2048 + k * 1024); } while (0)
#define PG8_MMA(ai, bj, At, Bt) do { __builtin_amdgcn_s_setprio(1); _Pragma("unroll") for (int m = 0; m < 4; ++m) _Pragma("unroll") for (int n = 0; n < 2; ++n) _Pragma("unroll") for (int k = 0; k < 2; ++k) \
        acc[ai][bj][m][n] = __builtin_amdgcn_mfma_f32_16x16x32_bf16(Bt[n][k], At[m][k], acc[ai][bj][m][n], 0, 0, 0); __builtin_amdgcn_s_setprio(0); } while (0)
#define PG8_WAIT_V(n) asm volatile("s_waitcnt vmcnt(" #n ")" ::: "memory")
#define PG8_WAIT_L(n) asm volatile("s_waitcnt lgkmcnt(" #n ")" ::: "memory")
#define PG8_BAR __builtin_amdgcn_s_barrier()
#define PG8_SCHED __builtin_amdgcn_sched_barrier(0)
    typename Sched::UnitT cur, nxt; int ui = 0;
    if (!S.next(0, cur)) return;
    f32x4 acc[2][2][4][2];
#pragma unroll
    for (int a = 0; a < 2; ++a)
#pragma unroll
        for (int b = 0; b < 2; ++b)
#pragma unroll
            for (int m = 0; m < 4; ++m)
#pragma unroll
                for (int n = 0; n < 2; ++n) acc[a][b][m][n] = (f32x4){0.f, 0.f, 0.f, 0.f};
    bf16x8 At[4][2], B0[2][2], B1[2][2];
    const char* cA = (const char*)g.A + (ptrdiff_t)cur.arow * (ptrdiff_t)(lda * 2); const char* cB = (const char*)g.Bt + (size_t)cur.pn * tstepB;
    PG8_STAGE(PG8_SB(0, 0), cB, voffB); PG8_STAGE(PG8_SB(0, 1), cB + hstepB, voffB); PG8_STAGE(PG8_SA(0, 0), cA, voffA); PG8_STAGE(PG8_SA(0, 1), cA + hstepA, voffA);
    if (wr == 1) PG8_BAR;
    PG8_WAIT_V(2); PG8_BAR;
    PG8_STAGE(PG8_SB(1, 0), cB + kstep, voffB); PG8_STAGE(PG8_SA(1, 0), cA + kstep, voffA); PG8_STAGE(PG8_SB(1, 1), cB + hstepB + kstep, voffB);
    PG8_WAIT_V(6); PG8_BAR;
    for (;;) {
        const bool has_next = S.next(ui + 1, nxt);
        const char* nA = has_next ? (const char*)g.A + (ptrdiff_t)nxt.arow * (ptrdiff_t)(lda * 2) : cA; const char* nB = has_next ? (const char*)g.Bt + (size_t)nxt.pn * tstepB : cB;
        for (int t = 0; t < nt; t += 2) {
            const bool last = (t == nt - 2);
            const char* a1 = cA + (size_t)(t + 1) * kstep;
            const char* a2 = last ? nA : cA + (size_t)(t + 2) * kstep; const char* b2 = last ? nB : cB + (size_t)(t + 2) * kstep;
            const char* a3 = a2 + kstep; const char* b3 = b2 + kstep;
            PG8_LDB(B0, 0, 0); PG8_LDB(B1, 0, 1); PG8_SCHED; PG8_LDA(At, 0, 0); PG8_STAGE(PG8_SA(1, 1), a1 + hstepA, voffA);
            PG8_WAIT_V(8); PG8_WAIT_L(0); PG8_BAR; PG8_MMA(0, 0, At, B0); PG8_MMA(0, 1, At, B1); PG8_BAR; PG8_SCHED;
            PG8_LDA(At, 0, 1); PG8_STAGE(PG8_SB(0, 0), b2, voffB); PG8_STAGE(PG8_SB(0, 1), b2 + hstepB, voffB); PG8_STAGE(PG8_SA(0, 0), a2, voffA);
            PG8_WAIT_V(8); PG8_WAIT_L(0); PG8_BAR; PG8_MMA(1, 0, At, B0); PG8_MMA(1, 1, At, B1); PG8_BAR; PG8_SCHED;
            PG8_LDB(B0, 1, 0); PG8_LDB(B1, 1, 1); PG8_SCHED; PG8_LDA(At, 1, 0); PG8_STAGE(PG8_SA(0, 1), a2 + hstepA, voffA);
            PG8_WAIT_V(8); PG8_WAIT_L(0); PG8_BAR; PG8_MMA(0, 0, At, B0); PG8_MMA(0, 1, At, B1); PG8_BAR; PG8_SCHED;
            PG8_LDA(At, 1, 1); PG8_STAGE(PG8_SB(1, 0), b3, voffB); PG8_STAGE(PG8_SB(1, 1), b3 + hstepB, voffB); PG8_STAGE(PG8_SA(1, 0), a3, voffA);
            PG8_WAIT_V(8); PG8_WAIT_L(0); PG8_BAR; PG8_MMA(1, 0, At, B0); PG8_MMA(1, 1, At, B1); PG8_BAR; PG8_SCHED;
        }
        if (wr == 0) PG8_BAR;
        E(acc, cur, wr, wc, fr, fq);
        if (!has_next) break;
#pragma unroll
        for (int a = 0; a < 2; ++a)
#pragma unroll
            for (int b = 0; b < 2; ++b)
#pragma unroll
                for (int m = 0; m < 4; ++m)
#pragma unroll
                    for (int n = 0; n < 2; ++n) acc[a][b][m][n] = (f32x4){0.f, 0.f, 0.f, 0.f};
        cur = nxt; cA = nA; cB = nB; ++ui;
        if (wr == 1) PG8_BAR;
    }
    PG8_WAIT_V(0);
    PG8_BAR;
#undef PG8_SA
#undef PG8_SB
#undef PG8_STAGE
#undef PG8_LDA
#undef PG8_LDB
#undef PG8_MMA
#undef PG8_WAIT_V
#undef PG8_WAIT_L
#undef PG8_BAR
#undef PG8_SCHED
}
}
namespace pg8 {
constexpr float RMS_EPS = 1e-6f;
template <class T> __device__ __forceinline__ T gld(const void* base, unsigned boff) { return *(const T*)((const char*)base + boff); }
template <class T> __device__ __forceinline__ void gst(void* base, unsigned boff, T v) { *(T*)((char*)base + boff) = v; }

struct EpiWin {
    static constexpr bool PERM = true;
    bf16_t* O; int ldc; float* ssq;
    __device__ __forceinline__ void operator()(const f32x4 (&acc)[2][2][4][2], const Unit& u, int wr, int wc, int fr_in, int fq_in) const {
        int t_ = threadIdx.x; asm volatile("" : "+v"(t_)); const int fr = t_ & 15, fq = (t_ >> 4) & 3; (void)fr_in; (void)fq_in;
        const int row0 = u.pm * BM + wr * 64 + fr; const int col0 = u.pn * BM + wc * 32 + 8 * fq;
#pragma unroll
        for (int ai = 0; ai < 2; ++ai)
#pragma unroll
            for (int m = 0; m < 4; ++m) { const int row = row0 + ai * HALF + m * 16; const unsigned ob = ((unsigned)row * (unsigned)ldc + (unsigned)col0) * 2u;
#pragma unroll
                for (int bj = 0; bj < 2; ++bj) { const f32x4 v0 = acc[ai][bj][m][0], v1 = acc[ai][bj][m][1];
                    u32x4 w; w.x = cvt_pk_bf16(v0[0], v0[1]); w.y = cvt_pk_bf16(v0[2], v0[3]); w.z = cvt_pk_bf16(v1[0], v1[1]); w.w = cvt_pk_bf16(v1[2], v1[3]);
                    gst<u32x4>(O, ob + bj * HALF * 2, w);
                    const int hf = 2 * u.pn + bj;
                    if (hf < 5) {
                        float s = (v0[0] * v0[0] + v0[1] * v0[1]) + (v0[2] * v0[2] + v0[3] * v0[3]) + (v1[0] * v1[0] + v1[1] * v1[1]) + (v1[2] * v1[2] + v1[3] * v1[3]);
                        s += __shfl_xor(s, 16); s += __shfl_xor(s, 32);
                        if (fq == 0) gst<float>(ssq, ((unsigned)row * 20u + hf * 4 + wc) * 4u, s);
                    } } }
    }
};

struct EpiQ {
    static constexpr bool PERM = false;
    bf16_t* Q; const float* ssq; const float* ropec; const float* ropes;
    __device__ __forceinline__ void operator()(const f32x4 (&acc)[2][2][4][2], const Unit& u, int wr, int wc, int fr_in, int fq_in) const {
        int t_ = threadIdx.x; asm volatile("" : "+v"(t_)); const int fr = t_ & 15, fq = (t_ >> 4) & 3; (void)fr_in; (void)fq_in;
        const int row0 = u.pm * BM + wr * 64 + fr; const bool lat = u.pm < 64;
#pragma unroll
        for (int ai = 0; ai < 2; ++ai)
#pragma unroll
            for (int m = 0; m < 4; ++m) { const int row = row0 + ai * HALF + m * 16;
                const unsigned sb = ((unsigned)row * 20u + 3u * fq) * 4u; float ss = (gld<float>(ssq, sb) + gld<float>(ssq, sb + 4)) + gld<float>(ssq, sb + 8);
                ss += __shfl_xor(ss, 16); ss += __shfl_xor(ss, 32);
                const float rs = __builtin_amdgcn_rsqf(ss * (1.0f / 384.0f) + RMS_EPS);
                const int t = row & 2047;
#pragma unroll
                for (int bj = 0; bj < 2; ++bj) { const int gcol = u.pn * BM + bj * HALF + wc * 32;
                    const int w = gcol % 192; f32x4 x1 = acc[ai][bj][m][0] * rs, x2 = acc[ai][bj][m][1] * rs;
                    if (lat && w >= 128) { const int pos = (w >= 160) ? (t & 63) : (t >> 6);
                        const unsigned rb = (unsigned)(pos * 16 + 4 * fq) * 4u; const f32x4 c = gld<f32x4>(ropec, rb), s = gld<f32x4>(ropes, rb);
                        const f32x4 y1 = x1 * c - x2 * s, y2 = x1 * s + x2 * c; x1 = y1; x2 = y2; }
                    const unsigned qb = ((unsigned)row * 768u + (unsigned)(gcol + 4 * fq)) * 2u;
                    u32x2 a; a.x = cvt_pk_bf16(x1[0], x1[1]); a.y = cvt_pk_bf16(x1[2], x1[3]); gst<u32x2>(Q, qb, a);
                    u32x2 b; b.x = cvt_pk_bf16(x2[0], x2[1]); b.y = cvt_pk_bf16(x2[2], x2[3]); gst<u32x2>(Q, qb + 32, b); }
                if (m & 1) asm volatile("" ::: "memory"); }
    }
};

struct EpiKV {
    static constexpr bool PERM = true;
    bf16_t* Kb; bf16_t* Vb; const float* ssq;
    __device__ __forceinline__ void operator()(const f32x4 (&acc)[2][2][4][2], const Unit& u, int wr, int wc, int fr_in, int fq_in) const {
        int t_ = threadIdx.x; asm volatile("" : "+v"(t_)); const int fr = t_ & 15, fq = (t_ >> 4) & 3; (void)fr_in; (void)fq_in;
        const int row0 = u.pm * BM + wr * 64 + fr; const int cw = wc * 32 + 8 * fq;
#pragma unroll
        for (int ai = 0; ai < 2; ++ai)
#pragma unroll
            for (int m = 0; m < 4; ++m) { const int row = row0 + ai * HALF + m * 16;
                const unsigned sb = ((unsigned)row * 20u + 12u + 2u * fq) * 4u; float ss = gld<float>(ssq, sb) + gld<float>(ssq, sb + 4);
                ss += __shfl_xor(ss, 16); ss += __shfl_xor(ss, 32);
                const float rs = __builtin_amdgcn_rsqf(ss * (1.0f / 256.0f) + RMS_EPS);
#pragma unroll
                for (int bj = 0; bj < 2; ++bj) { const f32x4 v0 = acc[ai][bj][m][0] * rs, v1 = acc[ai][bj][m][1] * rs;
                    u32x4 w; w.x = cvt_pk_bf16(v0[0], v0[1]); w.y = cvt_pk_bf16(v0[2], v0[3]); w.z = cvt_pk_bf16(v1[0], v1[1]); w.w = cvt_pk_bf16(v1[2], v1[3]);
                    if (bj == 0) gst<u32x4>(Kb, ((unsigned)row * 768u + (unsigned)(192 * u.pn + cw)) * 2u, w);
                    else gst<u32x4>(Vb, ((unsigned)row * 512u + (unsigned)(128 * u.pn + cw)) * 2u, w); }
                if (m & 1) asm volatile("" ::: "memory"); }
    }
};

struct EpiFnet {
    static constexpr bool PERM = true;
    bf16_t* Y; int rowbase, seqlen; float scale;
    __device__ __forceinline__ void operator()(const f32x4 (&acc)[2][2][4][2], const Unit& u, int wr, int wc, int fr_in, int fq_in) const {
        int t_ = threadIdx.x; asm volatile("" : "+v"(t_)); const int fr = t_ & 15, fq = (t_ >> 4) & 3; (void)fr_in; (void)fq_in;
        const int k0 = u.pm * BM + wr * 64 + fr; const int cw = wc * 32 + 8 * fq;
#pragma unroll
        for (int ai = 0; ai < 2; ++ai)
#pragma unroll
            for (int m = 0; m < 4; ++m) { const int row = rowbase + u.pn * seqlen + k0 + ai * HALF + m * 16; const unsigned yb = ((unsigned)row * 1024u + 512u + (unsigned)cw) * 2u;
#pragma unroll
                for (int bj = 0; bj < 2; ++bj) { const f32x4 v0 = acc[ai][bj][m][0] * scale, v1 = acc[ai][bj][m][1] * scale;
                    u32x4 w; w.x = cvt_pk_bf16(v0[0], v0[1]); w.y = cvt_pk_bf16(v0[2], v0[3]); w.z = cvt_pk_bf16(v1[0], v1[1]); w.w = cvt_pk_bf16(v1[2], v1[3]);
                    gst<u32x4>(Y, yb + bj * HALF * 2, w); } }
    }
};

struct EpiRes {
    static constexpr bool PERM = false;
    const float* base_lat; const float* base_ctx; float* out_lat; float* out_ctx; const float* mod; int gofs;
    __device__ __forceinline__ void operator()(const f32x4 (&acc)[2][2][4][2], const Unit& u, int wr, int wc, int fr_in, int fq_in) const {
        int t_ = threadIdx.x; asm volatile("" : "+v"(t_)); const int fr = t_ & 15, fq = (t_ >> 4) & 3; (void)fr_in; (void)fq_in;
        const bool lat = u.pm < 64; const int r = lat ? (u.pm >> 3) : 8;
        const float* base = lat ? base_lat : base_ctx; float* out = lat ? out_lat : out_ctx;
        const float* gate = mod + r * 6144 + gofs;
        const int row0 = (lat ? u.pm : u.pm - 64) * BM + wr * 64 + fr; const int col0 = u.pn * BM + wc * 32 + 4 * fq;
        f32x4 gv[2][2];
#pragma unroll
        for (int bj = 0; bj < 2; ++bj)
#pragma unroll
            for (int n = 0; n < 2; ++n) gv[bj][n] = gld<f32x4>(gate, (unsigned)(col0 + bj * HALF + n * 16) * 4u);
#pragma unroll
        for (int ai = 0; ai < 2; ++ai)
#pragma unroll
            for (int m = 0; m < 4; ++m) { const unsigned off = ((unsigned)(row0 + ai * HALF + m * 16) * 1024u + (unsigned)col0) * 4u;
#pragma unroll
                for (int bj = 0; bj < 2; ++bj)
#pragma unroll
                    for (int n = 0; n < 2; ++n) { const unsigned o2 = off + (unsigned)(bj * HALF + n * 16) * 4u; const f32x4 bs = gld<f32x4>(base, o2);
                        gst<f32x4>(out, o2, bs + gv[bj][n] * acc[ai][bj][m][n]); }
                if (m & 1) asm volatile("" ::: "memory"); }
    }
};

struct UnitUp : Unit { int seq0, seq1, olo, ohi; };
struct EpiUp {
    static constexpr bool PERM = true;
    bf16_t* act; const float* cw; const float* cb; PG8_LAS float* xb;
    __device__ __forceinline__ void operator()(f32x4 (&acc)[2][2][4][2], const UnitUp& u, int wr, int wc, int fr_in, int fq_in) const {
        int t_ = threadIdx.x; asm volatile("" : "+v"(t_)); const int fr = t_ & 15, fq = (t_ >> 4) & 3; (void)fr_in; (void)fq_in;
        const int lane = fq * 16 + fr;
        const int ccol = wc * 32 + 8 * fq;
        const int gc = u.pn * HALF + ccol;
        PG8_LAS float* CW = xb + 1024;
        const float cwld = (t_ < 384) ? gld<float>(cw, (unsigned)((t_ >> 7) * 2816 + u.pn * HALF + (t_ & 127)) * 4u) : gld<float>(cb, (unsigned)(u.pn * HALF + (t_ & 127)) * 4u);
#pragma unroll
        for (int ai = 0; ai < 2; ++ai)
#pragma unroll
            for (int m = 0; m < 4; ++m) { const int g = u.arow + ai * HALF + wr * 64 + m * 16 + fr; const bool ok = (g >= u.seq0) && (g < u.seq1);
#pragma unroll
                for (int n = 0; n < 2; ++n) { f32x4 v = acc[ai][0][m][n]; v[0] = ok ? v[0] : 0.f; v[1] = ok ? v[1] : 0.f; v[2] = ok ? v[2] : 0.f; v[3] = ok ? v[3] : 0.f; acc[ai][0][m][n] = v; } }
        PG8_LAS float* XF = xb; PG8_LAS float* XL = xb + 512;
        const bool isF = (fr == 0), isL = (fr == 15);
#pragma unroll
        for (int ai = 0; ai < 2; ++ai) { const int blk = 2 * ai + wr;
            f32x4 s0, s1;
#pragma unroll
            for (int e = 0; e < 4; ++e) { s0[e] = isF ? acc[ai][0][0][0][e] : acc[ai][0][3][0][e]; s1[e] = isF ? acc[ai][0][0][1][e] : acc[ai][0][3][1][e]; }
            PG8_LAS float* dst = xb + (isF ? 0 : 512) + blk * 128 + ccol;
            if (isF || isL) { *(PG8_LAS f32x4*)dst = s0; *(PG8_LAS f32x4*)(dst + 4) = s1; } }
        CW[t_] = cwld;
        asm volatile("s_waitcnt lgkmcnt(0)" ::: "memory"); __builtin_amdgcn_s_barrier(); asm volatile("" ::: "memory");
        const int lup = (lane & 48) | ((lane - 1) & 15), ldn = (lane & 48) | ((lane + 1) & 15);
#pragma unroll
        for (int ai = 0; ai < 2; ++ai) { const int blk = 2 * ai + wr;
#pragma unroll
            for (int n = 0; n < 2; ++n) {
                const f32x4 w0 = *(const PG8_LAS f32x4*)(CW + ccol + 4 * n), w1 = *(const PG8_LAS f32x4*)(CW + 128 + ccol + 4 * n), w2 = *(const PG8_LAS f32x4*)(CW + 256 + ccol + 4 * n), bb = *(const PG8_LAS f32x4*)(CW + 384 + ccol + 4 * n);
                f32x4 xprev = (f32x4){0.f, 0.f, 0.f, 0.f}, xnext = (f32x4){0.f, 0.f, 0.f, 0.f};
                if (blk > 0) xprev = *(const PG8_LAS f32x4*)(XL + (blk - 1) * 128 + ccol + 4 * n);
                if (blk < 3) xnext = *(const PG8_LAS f32x4*)(XF + (blk + 1) * 128 + ccol + 4 * n);
#pragma unroll
                for (int e = 0; e < 4; ++e) {
                    float cur[4], up[4], dn[4];
#pragma unroll
                    for (int m = 0; m < 4; ++m) cur[m] = acc[ai][0][m][n][e];
#pragma unroll
                    for (int m = 0; m < 4; ++m) {
                        const float tu = isL ? (m > 0 ? cur[m > 0 ? m - 1 : 0] : xprev[e]) : cur[m];
                        const float td = isF ? (m < 3 ? cur[m < 3 ? m + 1 : 3] : xnext[e]) : cur[m];
                        up[m] = __shfl(tu, lup); dn[m] = __shfl(td, ldn); }
                    float rr[4];
#pragma unroll
                    for (int m = 0; m < 4; ++m) { const float cv = w0[e] * up[m] + w1[e] * cur[m] + w2[e] * dn[m] + bb[e];
                        const float sg = cv * __builtin_amdgcn_rcpf(1.0f + __expf(-cv));
                        rr[m] = sg * acc[ai][1][m][n][e]; }
                    asm volatile("" : "+v"(rr[0]), "+v"(rr[1]), "+v"(rr[2]), "+v"(rr[3]));
#pragma unroll
                    for (int m = 0; m < 4; ++m) acc[ai][0][m][n][e] = rr[m];
                }
            }
#pragma unroll
            for (int m = 0; m < 4; ++m) { const int tr = ai * HALF + wr * 64 + m * 16 + fr; const int g = u.arow + tr;
                if (tr >= u.olo && tr <= u.ohi && g < u.seq1) { const f32x4 v0 = acc[ai][0][m][0], v1 = acc[ai][0][m][1];
                    u32x4 w; w.x = cvt_pk_bf16(v0[0], v0[1]); w.y = cvt_pk_bf16(v0[2], v0[3]); w.z = cvt_pk_bf16(v1[0], v1[1]); w.w = cvt_pk_bf16(v1[2], v1[3]);
                    gst<u32x4>(act, ((unsigned)g * 2816u + (unsigned)gc) * 2u, w); } }
            asm volatile("" ::: "memory");
        }
        asm volatile("s_waitcnt lgkmcnt(0)" ::: "memory"); __builtin_amdgcn_s_barrier(); asm volatile("" ::: "memory");
    }
};
}
namespace att {
using bf16x8 = __attribute__((ext_vector_type(8))) short;
using s16x4  = __attribute__((ext_vector_type(4))) short;
using f32x16 = __attribute__((ext_vector_type(16))) float;
using u32x4  = __attribute__((ext_vector_type(4))) unsigned;
typedef unsigned short bf16_t;
constexpr int NW = 8, QBLK = 32, KVBLK = 64;
constexpr int LDQ = 768, LDK = 768, LDV = 512, LDO = 1024;
constexpr float SCALE = 0.07216878364870322f;
constexpr float THR = 8.f;
constexpr int SHM_V = KVBLK * 128 * 2, SHM_K = KVBLK * 192 * 2;
constexpr int OFF_V = 0, OFF_K = 2 * SHM_V, OFF_WS = 2 * SHM_V + 2 * SHM_K, OFF_QR = OFF_WS + NW * 64 * 4, SHM_ATTN = OFF_QR + NW * 4096;
#define KSWZ(row, colB) ((row) * 384 + ((colB) ^ (((row) & 7) << 4)))
#define SBAR() __builtin_amdgcn_sched_barrier(0)
__device__ __forceinline__ int crow(int r, int hi) { return (r & 3) + 8 * (r >> 2) + 4 * hi; }
__device__ __forceinline__ unsigned cvtpk(float lo, float hi) { unsigned r; asm volatile("v_cvt_pk_bf16_f32 %0, %1, %2" : "=v"(r) : "v"(lo), "v"(hi)); return r; }

__device__ __forceinline__ void partialSM(f32x16& p0, f32x16& p1, float& m_reg, float& mn, float& alpha) {
  constexpr float C = SCALE * 1.4426950408889634f;
  float pmax = p0[0];
#pragma unroll
  for (int r = 1; r < 16; ++r) pmax = fmaxf(pmax, p0[r]);
#pragma unroll
  for (int r = 0; r < 16; ++r) pmax = fmaxf(pmax, p1[r]);
  { auto rr = __builtin_amdgcn_permlane32_swap(__float_as_uint(pmax), __float_as_uint(pmax), false, false);
    pmax = fmaxf(__uint_as_float(rr[0]), __uint_as_float(rr[1])); }
  if (__builtin_expect(__all(pmax - m_reg <= THR / SCALE), 1)) { mn = m_reg; alpha = 1.f; }
  else { mn = fmaxf(m_reg, pmax); alpha = __builtin_amdgcn_exp2f((m_reg - mn) * C); m_reg = mn; }
  float mnC = -mn * C;
#pragma unroll
  for (int r = 0; r < 16; ++r) p0[r] = fmaf(p0[r], C, mnC);
#pragma unroll
  for (int r = 0; r < 16; ++r) p1[r] = fmaf(p1[r], C, mnC);
#pragma unroll
  for (int r = 0; r < 16; ++r) p0[r] = __builtin_amdgcn_exp2f(p0[r]);
}
__device__ __forceinline__ void finishSM(f32x16& p0, f32x16& p1, float alpha, float& l_reg, bf16x8& pa0, bf16x8& pa1, bf16x8& pa2, bf16x8& pa3) {
#pragma unroll
  for (int r = 0; r < 16; ++r) p1[r] = __builtin_amdgcn_exp2f(p1[r]);
  float ps = 0;
#pragma unroll
  for (int r = 0; r < 16; ++r) ps += p0[r];
#pragma unroll
  for (int r = 0; r < 16; ++r) ps += p1[r];
  { auto rr = __builtin_amdgcn_permlane32_swap(__float_as_uint(ps), __float_as_uint(ps), false, false);
    ps = __uint_as_float(rr[0]) + __uint_as_float(rr[1]); }
  l_reg = l_reg * alpha + ps;
#define PK4(P, BASE, OUT) do { unsigned a0 = cvtpk(P[BASE + 0], P[BASE + 1]), a1 = cvtpk(P[BASE + 2], P[BASE + 3]);   \
    unsigned b0 = cvtpk(P[BASE + 4], P[BASE + 5]), b1 = cvtpk(P[BASE + 6], P[BASE + 7]);                              \
    auto r0 = __builtin_amdgcn_permlane32_swap(a0, b0, false, false); auto r1 = __builtin_amdgcn_permlane32_swap(a1, b1, false, false); \
    u32x4 w = {r0[0], r1[0], r0[1], r1[1]}; OUT = *reinterpret_cast<bf16x8*>(&w); } while (0)
  PK4(p0, 0, pa0); PK4(p0, 8, pa1); PK4(p1, 0, pa2); PK4(p1, 8, pa3);
#undef PK4
}
__device__ __forceinline__ void qkt(f32x16& p0, f32x16& p1, const char* Ks, const bf16x8* qr, const char* Qr, int r32, int hi) {
  p0 = f32x16{}; p1 = f32x16{};
#pragma unroll
  for (int d0 = 0; d0 < 12; ++d0) { int cb = (d0 * 16 + hi * 8) * 2;
    bf16x8 b0 = *reinterpret_cast<const bf16x8*>(Ks + KSWZ(r32, cb));
    bf16x8 b1 = *reinterpret_cast<const bf16x8*>(Ks + KSWZ(32 + r32, cb));
    bf16x8 q;
    if (d0 < 8) q = qr[d0];
    else q = *reinterpret_cast<const bf16x8*>(Qr + r32 * 128 + ((((d0 - 8) * 16 + hi * 8) * 2) ^ ((r32 & 7) << 4)));
    p0 = __builtin_amdgcn_mfma_f32_32x32x16_bf16(b0, q, p0, 0, 0, 0);
    p1 = __builtin_amdgcn_mfma_f32_32x32x16_bf16(b1, q, p1, 0, 0, 0); }
}
__device__ __forceinline__ int v_st(int k, int c) { const int kk = (k & ~0xC) | ((k & 4) << 1) | ((k & 8) >> 1); return ((kk >> 3) * 4 + (c >> 5)) * 512 + ((kk & 7) * 32 + (c & 31)) * 2; }
__device__ __forceinline__ int v_rd_base(int lane) { return ((lane & 3) << 3) | (((lane >> 2) & 3) << 6) | (((lane >> 4) & 1) << 5) | (((lane >> 5) & 1) << 8); }
constexpr int v_rd_off(int d0, int ks, int half) { return d0 * 512 + ks * 4096 + half * 2048; }
template <int OFF> __device__ __forceinline__ s16x4 tr_read(int vb) {
  s16x4 r; asm volatile("ds_read_b64_tr_b16 %0, %1 offset:%2" : "=&v"(r) : "v"(vb), "i"(OFF) : "memory"); return r;
}
template <int D0> __device__ __forceinline__ void pv_one(f32x16& od, int vb, bf16x8 pa0, bf16x8 pa1, bf16x8 pa2, bf16x8 pa3) {
  const s16x4 l0 = tr_read<v_rd_off(D0, 0, 0)>(vb), h0 = tr_read<v_rd_off(D0, 0, 1)>(vb), l1 = tr_read<v_rd_off(D0, 1, 0)>(vb), h1 = tr_read<v_rd_off(D0, 1, 1)>(vb);
  const s16x4 l2 = tr_read<v_rd_off(D0, 2, 0)>(vb), h2 = tr_read<v_rd_off(D0, 2, 1)>(vb), l3 = tr_read<v_rd_off(D0, 3, 0)>(vb), h3 = tr_read<v_rd_off(D0, 3, 1)>(vb);
  asm volatile("s_waitcnt lgkmcnt(0)" ::: "memory"); SBAR();
#define PK(L, H) (bf16x8){L[0], L[1], L[2], L[3], H[0], H[1], H[2], H[3]}
  od = __builtin_amdgcn_mfma_f32_32x32x16_bf16(pa0, PK(l0, h0), od, 0, 0, 0);
  od = __builtin_amdgcn_mfma_f32_32x32x16_bf16(pa1, PK(l1, h1), od, 0, 0, 0);
  od = __builtin_amdgcn_mfma_f32_32x32x16_bf16(pa2, PK(l2, h2), od, 0, 0, 0);
  od = __builtin_amdgcn_mfma_f32_32x32x16_bf16(pa3, PK(l3, h3), od, 0, 0, 0);
#undef PK
}
__device__ __forceinline__ void pv_d0(f32x16* o, int vb, bf16x8 pa0, bf16x8 pa1, bf16x8 pa2, bf16x8 pa3) {
  pv_one<0>(o[0], vb, pa0, pa1, pa2, pa3); pv_one<1>(o[1], vb, pa0, pa1, pa2, pa3); pv_one<2>(o[2], vb, pa0, pa1, pa2, pa3); pv_one<3>(o[3], vb, pa0, pa1, pa2, pa3);
}

__device__ __forceinline__ void attn_unit(const bf16_t* __restrict__ Qb, const bf16_t* __restrict__ Kg, const bf16_t* __restrict__ Vg, bf16_t* __restrict__ Ob,
                                          int r0, int n0, int r1, int NT, char* lds) {
  int tid = threadIdx.x; asm volatile("" : "+v"(tid));
  const int wid = tid >> 6, lane = tid & 63, r32 = lane & 31, hi = lane >> 5;
  char* V_lds = lds + OFF_V; char* K_lds = lds + OFF_K;
  float* ws = (float*)(lds + OFF_WS) + wid * 64; float* li_l = ws; float* al_l = ws + 32;
  float m_reg = -1e30f, l_reg = 0; f32x16 o[4] = {}; bf16x8 qr[8];
  const bf16_t* Qw = Qb + (long)(wid * QBLK + r32) * LDQ + hi * 8;
  char* Qr = lds + OFF_QR + wid * 4096;
#pragma unroll
  for (int d0 = 0; d0 < 8; ++d0) qr[d0] = *reinterpret_cast<const bf16x8*>(Qw + d0 * 16);
#pragma unroll
  for (int d0 = 8; d0 < 12; ++d0) { const bf16x8 q = *reinterpret_cast<const bf16x8*>(Qw + d0 * 16);
    *reinterpret_cast<bf16x8*>(Qr + r32 * 128 + ((((d0 - 8) * 16 + hi * 8) * 2) ^ ((r32 & 7) << 4))) = q; }
  const int sr = tid >> 4, sc = (tid & 15) * 8, vst0 = v_st(sr, sc), vst1 = v_st(32 + sr, sc);
  unsigned kgo[3], kst[3];
#pragma unroll
  for (int i = 0; i < 3; ++i) { const int id = tid + 512 * i, kr_ = id / 24, kc_ = id % 24; kgo[i] = (unsigned)(kr_ * LDK + kc_ * 8) * 2u; kst[i] = (unsigned)KSWZ(kr_, kc_ * 16); }
  const unsigned vgo0 = (unsigned)(sr * LDV + sc) * 2u, vgo1 = vgo0 + 32u * LDV * 2u;
  const int vb0 = (int)(uintptr_t)V_lds + v_rd_base(lane);
  bf16x8 vs0, vs1, ks0, ks1, ks2;
#define TROW(j) ((j) < n0 ? r0 + 64 * (j) : r1 + 64 * ((j) - n0))
#define SLOAD(j) do { const long tr_ = TROW(j); const char* Vt = (const char*)(Vg + tr_ * LDV); const char* Kt = (const char*)(Kg + tr_ * LDK);     \
    vs0 = *reinterpret_cast<const bf16x8*>(Vt + vgo0); vs1 = *reinterpret_cast<const bf16x8*>(Vt + vgo1); \
    ks0 = *reinterpret_cast<const bf16x8*>(Kt + kgo[0]); ks1 = *reinterpret_cast<const bf16x8*>(Kt + kgo[1]); ks2 = *reinterpret_cast<const bf16x8*>(Kt + kgo[2]); } while (0)
#define SWRITE(b) do { *(bf16x8*)(V_lds + (b) * SHM_V + vst0) = vs0; *(bf16x8*)(V_lds + (b) * SHM_V + vst1) = vs1; \
    *(bf16x8*)(K_lds + (b) * SHM_K + kst[0]) = ks0; *(bf16x8*)(K_lds + (b) * SHM_K + kst[1]) = ks1; *(bf16x8*)(K_lds + (b) * SHM_K + kst[2]) = ks2; } while (0)
#define RESC(a) do { if (__any((a) < 1.f)) { if (hi == 0) al_l[r32] = (a); asm volatile("s_waitcnt lgkmcnt(0)" ::: "memory"); \
    _Pragma("unroll") for (int d = 0; d < 4; ++d) _Pragma("unroll") for (int r = 0; r < 16; ++r) o[d][r] *= al_l[crow(r, hi)]; } } while (0)
  f32x16 pA0, pA1, pB0, pB1; float mnA, mnB, alA, alB; bf16x8 pa0, pa1, pa2, pa3;
  SLOAD(0); asm volatile("s_waitcnt vmcnt(0)" ::: "memory"); SWRITE(0); __syncthreads();
  qkt(pA0, pA1, K_lds, qr, Qr, r32, hi); partialSM(pA0, pA1, m_reg, mnA, alA);
  SLOAD(1);
  asm volatile("s_waitcnt vmcnt(0)" ::: "memory"); SWRITE(1); __syncthreads();
  for (int j = 1; j + 1 < NT; j += 2) {
    SBAR(); qkt(pB0, pB1, K_lds + SHM_K, qr, Qr, r32, hi);
    finishSM(pA0, pA1, alA, l_reg, pa0, pa1, pa2, pa3); SBAR();
    SLOAD(j + 1); SBAR();
    pv_d0(o, vb0, pa0, pa1, pa2, pa3); partialSM(pB0, pB1, m_reg, mnB, alB);
    __syncthreads(); asm volatile("s_waitcnt vmcnt(0)" ::: "memory"); SWRITE(0);
    RESC(alB); __syncthreads();
    SBAR(); qkt(pA0, pA1, K_lds, qr, Qr, r32, hi);
    finishSM(pB0, pB1, alB, l_reg, pa0, pa1, pa2, pa3); SBAR();
    SLOAD(j + 2); SBAR();
    pv_d0(o, vb0 + SHM_V, pa0, pa1, pa2, pa3); partialSM(pA0, pA1, m_reg, mnA, alA);
    __syncthreads(); asm volatile("s_waitcnt vmcnt(0)" ::: "memory"); SWRITE(1);
    RESC(alA); __syncthreads();
  }
  SBAR(); qkt(pB0, pB1, K_lds + SHM_K, qr, Qr, r32, hi);
  finishSM(pA0, pA1, alA, l_reg, pa0, pa1, pa2, pa3); SBAR();
  pv_d0(o, vb0, pa0, pa1, pa2, pa3); partialSM(pB0, pB1, m_reg, mnB, alB);
  __syncthreads(); RESC(alB);
  finishSM(pB0, pB1, alB, l_reg, pa0, pa1, pa2, pa3); SBAR();
  pv_d0(o, vb0 + SHM_V, pa0, pa1, pa2, pa3);
  if (hi == 0) li_l[r32] = l_reg; asm volatile("s_waitcnt lgkmcnt(0)" ::: "memory");
  float rli[16];
#pragma unroll
  for (int r = 0; r < 16; ++r) rli[r] = __builtin_amdgcn_rcpf(li_l[crow(r, hi)]);
  __syncthreads();
  { bf16_t* stg = (bf16_t*)(lds + wid * 8192);
#pragma unroll
    for (int r = 0; r < 16; ++r) { const int orow = crow(r, hi);
#pragma unroll
      for (int d0 = 0; d0 < 4; ++d0) { const unsigned pk = cvtpk(o[d0][r] * rli[r], 0.f); stg[orow * 128 + d0 * 32 + r32] = (bf16_t)(pk & 0xffffu); } }
    asm volatile("s_waitcnt lgkmcnt(0)" ::: "memory");
    bf16_t* Ow = Ob + (long)(wid * QBLK) * LDO;
#pragma unroll
    for (int i = 0; i < 8; ++i) { const int row = i * 4 + (lane >> 4), ch = lane & 15; const u32x4 v = *(const u32x4*)(stg + row * 128 + ch * 8); *(u32x4*)(Ow + (long)row * LDO + ch * 8) = v; } }
  __syncthreads();
#undef TROW
#undef SLOAD
#undef SWRITE
#undef RESC
}
#undef KSWZ
#undef SBAR
}
constexpr int NWAVES = 8;
#ifndef MK_SPLIT
#define MK_SPLIT 0
#endif

constexpr int DM = 1024, NB = 8, SL = 2048, CL = 256, MLAT = NB * SL, MCTX = NB * CL, MT = MLAT + MCTX;
constexpr int NIN = 2048;
constexpr int FF = 2816, NUP = 2 * FF;
constexpr int NPH = 20;
constexpr float EPS = 1e-6f;

constexpr size_t MiB = 1u << 20;
constexpr size_t WS_CTL = 0, CTL_ZERO_BYTES = 64 * 1024;
constexpr size_t WS_MOD = 1 * MiB;
constexpr size_t WS_ROPE = 1 * MiB + 512 * 1024;
constexpr size_t WS_SSQ = 2 * MiB;
constexpr size_t WS_WIN = 4 * MiB, WIN_STRIDE = (size_t)NIN * DM * 2;
constexpr size_t WS_WUQ = 12 * MiB, WUQ_STRIDE = (size_t)768 * 384 * 2;
constexpr size_t WS_WUKV = 13 * MiB + 256 * 1024, WUKV_STRIDE = (size_t)1024 * 256 * 2;
constexpr size_t WS_WOUT = 14 * MiB + 512 * 1024, WOUT_STRIDE = (size_t)DM * DM * 2;
constexpr size_t WS_WUP = 19 * MiB, WUP_STRIDE = (size_t)NUP * DM * 2;
constexpr size_t WS_WDOWN = 41 * MiB, WDOWN_STRIDE = (size_t)DM * FF * 2;
constexpr size_t WS_DFT = 52 * MiB;
constexpr size_t WS_DFTC = 68 * MiB;
constexpr size_t WS_XCTX = 69 * MiB;
constexpr size_t WS_XN = 77 * MiB;
constexpr size_t WS_Q = WS_XN, WS_YC = WS_XN + 27 * MiB;
constexpr size_t WS_P = 113 * MiB;
constexpr size_t WS_YCAT = WS_P, WS_ACT = WS_P;
constexpr size_t WS_K = 185 * MiB;
constexpr size_t WS_V = 212 * MiB;
constexpr size_t WS_ZT = 230 * MiB;
constexpr size_t WS_ZTC = WS_ZT + 16 * MiB, WS_END = 248 * MiB;
static_assert(WS_WUQ + 2 * WUQ_STRIDE <= WS_WUKV && WS_WUKV + 2 * WUKV_STRIDE <= WS_WOUT && WS_WOUT + 2 * WOUT_STRIDE <= WS_WUP && WS_WUP + 2 * WUP_STRIDE <= WS_WDOWN && WS_WDOWN + 2 * WDOWN_STRIDE <= WS_DFT, "weights map");
static_assert(WS_SSQ + (size_t)MT * 80 <= WS_WIN && WS_XN + (size_t)MT * DM * 2 <= WS_P && WS_P + (size_t)MT * NIN * 2 <= WS_K && WS_K + (size_t)MT * 768 * 2 <= WS_V && WS_V + (size_t)MT * 512 * 2 <= WS_ZT, "activation map");
static_assert(WS_ACT + (size_t)MT * FF * 2 <= WS_V && WS_YC + (size_t)MT * 256 * 2 <= WS_P, "overlay map");
constexpr int CW_BAR = 4096;

constexpr int RING_OFF = 0, RING_BYTES = 131072;
constexpr int LDSCTL_OFF = RING_BYTES, MISC_OFF = LDSCTL_OFF + 320, PTR_OFF = LDSCTL_OFF + 512, EPIX_OFF = LDSCTL_OFF + 1024;
constexpr int LDS_BYTES = 147456;
static_assert(EPIX_OFF + 4096 <= LDS_BYTES, "LDS map");

#define GAS __attribute__((address_space(1)))
#define LAS __attribute__((address_space(3)))
typedef unsigned short bf16;
typedef unsigned v4u __attribute__((ext_vector_type(4)));
typedef unsigned v2u __attribute__((ext_vector_type(2)));
typedef float f32x4 __attribute__((ext_vector_type(4)));
typedef GAS unsigned gu32;
#define RLX_AGENT __ATOMIC_RELAXED, __HIP_MEMORY_SCOPE_AGENT
#define LDS_WAIT() asm volatile("s_waitcnt lgkmcnt(0)" ::: "memory")
#define VM_WAIT() asm volatile("s_waitcnt vmcnt(0)" ::: "memory")
__device__ __forceinline__ unsigned f2bf(float f) { unsigned u = __builtin_bit_cast(unsigned, f); return (u + 0x7fffu + ((u >> 16) & 1u)) >> 16; }
__device__ __forceinline__ unsigned pk2(float lo, float hi) { return f2bf(lo) | (f2bf(hi) << 16); }
__device__ __forceinline__ float bf2f(unsigned h) { return __builtin_bit_cast(float, h << 16); }

#define XB_TMO      128
#define XB_XCNT(j)  (256  + 64 * (j))
#define XB_XSUB(j)  (1280 + 64 * (j))
#define XB_XGEN(j)  (2304 + 64 * (j))
#define XB_TOP      3328
#define XB_TOPGEN   3392
#define XCD_BAR_WORDS 3456
#define XB_SPIN_CAP (1u << 20)
__device__ __forceinline__ unsigned xb_ld(unsigned* p)              { return __hip_atomic_load(p, __ATOMIC_RELAXED, __HIP_MEMORY_SCOPE_AGENT); }
__device__ __forceinline__ unsigned xb_add(unsigned* p, unsigned v) { return __hip_atomic_fetch_add(p, v, __ATOMIC_RELAXED, __HIP_MEMORY_SCOPE_AGENT); }
__device__ __forceinline__ unsigned xb_xcc_id() { return (unsigned)__builtin_amdgcn_s_getreg((3 << 11) | 20) & 0xFu; }
#define XB_SPIN(cond, bar) do { unsigned _sp = 0; while (cond) { __builtin_amdgcn_s_sleep(1); \
    if ((++_sp & 255u) == 0u) { if (xb_ld(&(bar)[XB_TMO])) break; if (_sp > XB_SPIN_CAP) { atomicAdd(&(bar)[XB_TMO], 1u); break; } } } } while (0)
struct XcdBarrier { unsigned* bar; unsigned x; volatile LAS unsigned* st; };
__device__ __forceinline__ XcdBarrier xcd_barrier_post(unsigned* bar, volatile LAS unsigned* st) {
    XcdBarrier b; b.bar = bar; b.x = xb_xcc_id(); b.st = st;
    if (threadIdx.x == 0) (void)xb_add(&bar[XB_XCNT(b.x)], 1u);
    return b;
}
__device__ __forceinline__ void xcd_barrier_complete(unsigned* bar, unsigned x, unsigned& nloc, unsigned& nx) {
    const unsigned G = gridDim.x * gridDim.y * gridDim.z;
    unsigned sum, cnt, mine, sp = 0u;
    for (;;) {
        sum = 0u; cnt = 0u; mine = 0u;
#pragma unroll
        for (unsigned j = 0; j < 16; ++j) { const unsigned c = xb_ld(&bar[XB_XCNT(j)]); sum += c; cnt += (c > 0u) ? 1u : 0u; mine = (j == x) ? c : mine; }
        if (sum == G) break;
        __builtin_amdgcn_s_sleep(1);
        if ((++sp & 255u) == 0u) { if (xb_ld(&bar[XB_TMO])) break; if (sp > XB_SPIN_CAP) { atomicAdd(&bar[XB_TMO], 1u); break; } }
    }
    nloc = mine > 0u ? mine : 1u; nx = cnt > 0u ? cnt : 1u;
}
__device__ __forceinline__ void xcd_barrier(const XcdBarrier& b) {
    asm volatile("s_waitcnt vmcnt(0)" ::: "memory");
    __syncthreads();
    if (threadIdx.x == 0) {
        unsigned* bar = b.bar;
        __builtin_amdgcn_s_waitcnt(0);
        unsigned nloc = b.st[0], nx = b.st[1];
        if (nloc == 0u) { xcd_barrier_complete(bar, b.x, nloc, nx); b.st[0] = nloc; b.st[1] = nx; }
        const unsigned old = xb_add(&bar[XB_XSUB(b.x)], 1u);
        const unsigned gen = old / nloc;
        if (old + 1u == (gen + 1u) * nloc) {
            __builtin_amdgcn_fence(__ATOMIC_RELEASE, "agent");
            asm volatile("s_waitcnt vmcnt(0)" ::: "memory");
            const unsigned og = xb_add(&bar[XB_TOP], 1u);
            const unsigned tg = og / nx;
            if (og + 1u == (tg + 1u) * nx) xb_add(&bar[XB_TOPGEN], 1u);
            else XB_SPIN(xb_ld(&bar[XB_TOPGEN]) == tg, bar);
            __builtin_amdgcn_fence(__ATOMIC_ACQUIRE, "agent");
            xb_add(&bar[XB_XGEN(b.x)], 1u);
            asm volatile("s_waitcnt vmcnt(0)" ::: "memory");
        } else {
            XB_SPIN(xb_ld(&bar[XB_XGEN(b.x)]) == gen, bar);
            __builtin_amdgcn_fence(__ATOMIC_ACQUIRE, "agent");
            asm volatile("s_waitcnt vmcnt(0)" ::: "memory");
        }
    }
    __syncthreads();
}

struct Args { const float* in[22]; float* out; unsigned char* ws; int ph_lo, ph_hi; };
enum { I_X = 0, I_C, I_CTX, I_CCTX, I_ADAW, I_ADAB, I_N1G, I_WIN, I_QNG, I_KVNG, I_WUQ, I_WUKV, I_SCW, I_SCB, I_ONG, I_WOUT, I_N2G, I_WUP, I_FCW, I_FCB, I_WDOWN, I_FING };

struct Frame {
    LAS unsigned char* lds; char* ldsg;
    volatile LAS unsigned* MISC;
    int tid, lane, wave, vcu, G, bx;
    unsigned char* ws; float* out;
};

__device__ __forceinline__ const float* inptr(const Frame& F, int i) {
    const LAS unsigned* T = (const LAS unsigned*)(F.lds + PTR_OFF) + 2 * i;
    const unsigned lo = __builtin_amdgcn_readfirstlane(T[0]), hi = __builtin_amdgcn_readfirstlane(T[1]);
    return (const float*)(const GAS float*)(((unsigned long long)hi << 32) | (unsigned long long)lo);
}
__device__ __forceinline__ float wave_sum(float v) {
#pragma unroll
    for (int o = 1; o < 64; o <<= 1) v += __shfl_xor(v, o);
    return v;
}

__device__ __forceinline__ void tr_item(const float* W, int ldw, int k0, int c0, bf16* WT, int ldt, int r0, const float* ks, LAS float* scr, int lane) {
#pragma unroll 8
    for (int i = 0; i < 32; ++i) { const int kk = 2 * i + (lane >> 5); float v = W[(size_t)(k0 + kk) * ldw + c0 + (lane & 31)]; if (ks) v *= ks[k0 + kk]; scr[kk * 33 + (lane & 31)] = v; }
    LDS_WAIT(); asm volatile("" ::: "memory");
    const int c = lane & 7;
#pragma unroll
    for (int j = 0; j < 4; ++j) { const int n = (lane >> 3) + 8 * j; const LAS float* s = scr + (8 * c) * 33 + n;
        v4u o; o.x = pk2(s[0 * 33], s[1 * 33]); o.y = pk2(s[2 * 33], s[3 * 33]); o.z = pk2(s[4 * 33], s[5 * 33]); o.w = pk2(s[6 * 33], s[7 * 33]);
        *(GAS v4u*)(WT + (size_t)(r0 + n) * ldt + k0 + 8 * c) = o; }
    LDS_WAIT(); asm volatile("" ::: "memory");
}
__device__ __forceinline__ void fold_item(const float* W  , int k0, int g, int oc, bf16* WT, LAS float* tb, int lane) {
    tb[lane] = cospif((float)lane * (1.0f / 32.0f)); tb[64 + lane] = sinpif((float)lane * (1.0f / 32.0f));
    f32x4 t[16]; const float* src = W + (size_t)(k0 + lane) * 1728 + 704 + 64 * g;
#pragma unroll
    for (int i = 0; i < 16; ++i) t[i] = *(const f32x4*)(src + 4 * i);
    LDS_WAIT(); asm volatile("" ::: "memory");
    for (int o = 0; o < 16; ++o) { const int oo = 16 * oc + o, k2 = oo & 63, sn = oo >> 6; float a = 0.f;
#pragma unroll
        for (int i = 0; i < 16; ++i)
#pragma unroll
            for (int e = 0; e < 4; ++e) a += t[i][e] * tb[sn * 64 + ((k2 * (4 * i + e)) & 63)];
        WT[(size_t)((sn ? 1024 : 768) + 64 * g + k2) * 1024 + k0 + lane] = (bf16)f2bf(a); }
    LDS_WAIT(); asm volatile("" ::: "memory");
}

__device__ __forceinline__ void p0_prologue(Frame& F) {
    unsigned char* ws = F.ws;
    float* MOD = (float*)(ws + WS_MOD);
    if (F.bx < 192) {
        const int l = F.bx / 96, cb = F.bx % 96;
        LAS float* S = (LAS float*)(F.lds + F.wave * 4608);
        const float* cin = inptr(F, I_C); const float* cctx = inptr(F, I_CCTX);
        for (int i = F.lane; i < 9 * 128; i += 64) { const int r = i >> 7, kk = i & 127, k = 128 * F.wave + kk; const float cv = (r < 8) ? cin[r * 1024 + k] : cctx[k]; S[i] = cv / (1.0f + __expf(-cv)); }
        LDS_WAIT(); asm volatile("" ::: "memory");
        f32x4 acc[9];
#pragma unroll
        for (int r = 0; r < 9; ++r) acc[r] = (f32x4){0.f, 0.f, 0.f, 0.f};
        const int kr = F.lane >> 4, cl = F.lane & 15;
        const float* W = inptr(F, I_ADAW) + (size_t)l * 1024 * 6144 + (size_t)(128 * F.wave) * 6144 + 64 * cb + 4 * cl;
#pragma unroll 4
        for (int i = 0; i < 32; ++i) { const int kk = 4 * i + kr; const f32x4 w = *(const f32x4*)(W + (size_t)kk * 6144);
#pragma unroll
            for (int r = 0; r < 9; ++r) acc[r] += w * S[r * 128 + kk]; }
        LAS float* RED = (LAS float*)(F.lds + 40960);
#pragma unroll
        for (int r = 0; r < 9; ++r)
#pragma unroll
            for (int e = 0; e < 4; ++e) { float v = acc[r][e]; v += __shfl_xor(v, 16); v += __shfl_xor(v, 32); if (kr == 0) RED[(F.wave * 9 + r) * 64 + 4 * cl + e] = v; }
        __syncthreads();
        for (int i = F.tid; i < 576; i += 512) { const int r = i >> 6, col = i & 63; float s = 0.f;
#pragma unroll
            for (int w = 0; w < 8; ++w) s += RED[(w * 9 + r) * 64 + col];
            MOD[(size_t)(l * 9 + r) * 6144 + 64 * cb + col] = s + inptr(F, I_ADAB)[l * 6144 + 64 * cb + col]; }
        __syncthreads();
    }
    if (F.bx == 255 % F.G) {
        float* RC = (float*)(ws + WS_ROPE); float* RS = RC + 1024;
        for (int idx = F.tid; idx < 1024; idx += 512) { const int pos = idx >> 4, i = idx & 15; const float inv = powf(10000.0f, -(float)(2 * i) / 32.0f); const float ang = (float)pos * inv; RC[idx] = cosf(ang); RS[idx] = sinf(ang); }
    }
    LAS float* scr = (LAS float*)(F.lds + F.wave * 16384);
    const int gw = F.vcu * NWAVES + F.wave, NGW = F.G * NWAVES;
    constexpr int I_WINA = 22 * 16, I_WINB = 24 * 16, I_PAD = 8, I_FOLD = 16 * 4 * 8, I_UQ = 6 * 24, I_UKV = 4 * 32, I_OUT = 16 * 32, I_UP = 16 * 176, I_DOWN = 44 * 32;
    constexpr int PER_LAYER = I_WINA + I_WINB + I_PAD + I_FOLD + I_UQ + I_UKV + I_OUT + I_UP + I_DOWN;
    constexpr int I_DFT = 2048, I_DFTC = 256;
    constexpr int NITEMS = 2 * PER_LAYER + I_DFT + I_DFTC;
    for (int it = gw; it < NITEMS; it += NGW) {
        int r = it;
        if (r < 2 * PER_LAYER) {
            const int l = r / PER_LAYER; r -= l * PER_LAYER;
            bf16* WinT = (bf16*)(ws + WS_WIN + l * WIN_STRIDE);
            const float* win = inptr(F, I_WIN) + (size_t)l * 1024 * 1728;
            if (r < I_WINA) { const int kb = r / 22, nb = r % 22; tr_item(win, 1728, 64 * kb, 32 * nb, WinT, 1024, 32 * nb, nullptr, scr, F.lane); continue; } r -= I_WINA;
            if (r < I_WINB) { const int kb = r / 24, nb = r % 24; tr_item(win, 1728, 64 * kb, 960 + 32 * nb, WinT, 1024, 1280 + 32 * nb, nullptr, scr, F.lane); continue; } r -= I_WINB;
            if (r < I_PAD) { const v4u z = {0u, 0u, 0u, 0u};
#pragma unroll
                for (int j = 0; j < 16; ++j) { const int q = j * 64 + F.lane; *(GAS v4u*)(WinT + (size_t)(704 + 8 * r + (q >> 7)) * 1024 + (q & 127) * 8) = z; } continue; } r -= I_PAD;
            if (r < I_FOLD) { const int kb = r >> 5, g = (r >> 3) & 3, oc = r & 7; fold_item(win, 64 * kb, g, oc, WinT, scr, F.lane); continue; } r -= I_FOLD;
            if (r < I_UQ) { const int kb = r / 24, nb = r % 24; tr_item(inptr(F, I_WUQ) + (size_t)l * 384 * 768, 768, 64 * kb, 32 * nb, (bf16*)(ws + WS_WUQ + l * WUQ_STRIDE), 384, 32 * nb, inptr(F, I_QNG) + l * 384, scr, F.lane); continue; } r -= I_UQ;
            if (r < I_UKV) { const int kb = r / 32, nb = r % 32; tr_item(inptr(F, I_WUKV) + (size_t)l * 256 * 1024, 1024, 64 * kb, 32 * nb, (bf16*)(ws + WS_WUKV + l * WUKV_STRIDE), 256, 32 * nb, inptr(F, I_KVNG) + l * 256, scr, F.lane); continue; } r -= I_UKV;
            if (r < I_OUT) { const int kb = r / 32, nb = r % 32; tr_item(inptr(F, I_WOUT) + (size_t)l * 1024 * 1024, 1024, 64 * kb, 32 * nb, (bf16*)(ws + WS_WOUT + l * WOUT_STRIDE), 1024, 32 * nb, inptr(F, I_ONG) + l * 1024, scr, F.lane); continue; } r -= I_OUT;
            if (r < I_UP) { const int kb = r / 176, nb = r % 176;
                const int j = nb >> 3, h = (nb >> 2) & 1, q = nb & 3;
                tr_item(inptr(F, I_WUP) + (size_t)l * 1024 * NUP, NUP, 64 * kb, h * FF + 128 * j + 32 * q, (bf16*)(ws + WS_WUP + l * WUP_STRIDE), 1024, 32 * nb, nullptr, scr, F.lane); continue; } r -= I_UP;
            { const int kb = r / 32, nb = r % 32; tr_item(inptr(F, I_WDOWN) + (size_t)l * FF * 1024, 1024, 64 * kb, 32 * nb, (bf16*)(ws + WS_WDOWN + l * WDOWN_STRIDE), FF, 32 * nb, nullptr, scr, F.lane); continue; }
        }
        r -= 2 * PER_LAYER;
        if (r < I_DFT) { const int k1 = r; bf16* D = (bf16*)(ws + WS_DFT) + (size_t)k1 * 4096;
#pragma unroll
            for (int j = 0; j < 8; ++j) { const int n0 = 512 * j + 8 * F.lane; float v[8];
#pragma unroll
                for (int e = 0; e < 8; ++e) { const int n = n0 + e, n1 = n & 2047; const float x = (float)((k1 * n1) & 2047) * (1.0f / 1024.0f); v[e] = (n < 2048) ? cospif(x) : -sinpif(x); }
                v4u o; o.x = pk2(v[0], v[1]); o.y = pk2(v[2], v[3]); o.z = pk2(v[4], v[5]); o.w = pk2(v[6], v[7]); *(GAS v4u*)(D + n0) = o; }
            continue; }
        r -= I_DFT;
        { const int k1 = r; bf16* D = (bf16*)(ws + WS_DFTC) + (size_t)k1 * 512; const int n0 = 8 * F.lane; float v[8];
#pragma unroll
            for (int e = 0; e < 8; ++e) { const int n = n0 + e, n1 = n & 255; const float x = (float)((k1 * n1) & 255) * (1.0f / 128.0f); v[e] = (n < 256) ? cospif(x) : -sinpif(x); }
            v4u o; o.x = pk2(v[0], v[1]); o.y = pk2(v[2], v[3]); o.z = pk2(v[4], v[5]); o.w = pk2(v[6], v[7]); *(GAS v4u*)(D + n0) = o; }
    }
}

__device__ __forceinline__ void norm_mod_phase(Frame& F, const float* src_lat, const float* src_ctx, int nrows, const float* g, const float* mod  , int shofs, int scofs) {
    bf16* XN = (bf16*)(F.ws + WS_XN);
    const int gw = F.vcu * NWAVES + F.wave, NGW = F.G * NWAVES;
    for (int row = gw; row < nrows; row += NGW) {
        const float* xr = row < MLAT ? src_lat + (size_t)row * DM : src_ctx + (size_t)(row - MLAT) * DM;
        const int r = row < MLAT ? (row >> 11) : 8;
        const float* sh = mod + r * 6144 + shofs; const float* sc = mod + r * 6144 + scofs;
        f32x4 v[4]; float ss = 0.f;
#pragma unroll
        for (int j = 0; j < 4; ++j) { v[j] = *(const f32x4*)(xr + 256 * j + 4 * F.lane); ss += (v[j][0] * v[j][0] + v[j][1] * v[j][1]) + (v[j][2] * v[j][2] + v[j][3] * v[j][3]); }
        const float rstd = 1.0f / sqrtf(wave_sum(ss) * (1.0f / DM) + EPS);
#pragma unroll
        for (int j = 0; j < 4; ++j) { const int c = 256 * j + 4 * F.lane; const f32x4 gg = *(const f32x4*)(g + c), s1 = *(const f32x4*)(sc + c), s0 = *(const f32x4*)(sh + c);
            const f32x4 h = (v[j] * rstd) * gg * (s1 + 1.0f) + s0;
            v2u o; o.x = pk2(h[0], h[1]); o.y = pk2(h[2], h[3]); *(GAS v2u*)(XN + (size_t)row * DM + c) = o; }
    }
}
__device__ __forceinline__ void qkv_rows_phase(Frame& F, int l) {
    const bf16* P = (const bf16*)(F.ws + WS_P); bf16* Kb = (bf16*)(F.ws + WS_K); bf16* YC = (bf16*)(F.ws + WS_YC);
    const float* RC = (const float*)(F.ws + WS_ROPE); const float* RS = RC + 1024;
    const float* scw = inptr(F, I_SCW) + l * 3 * 256; const float* scb = inptr(F, I_SCB) + l * 256;
    const int gw = F.vcu * NWAVES + F.wave, NGW = F.G * NWAVES;
    const int nrows_conv = (l == 0) ? MT : MLAT;
    for (int row = gw; row < MT; row += NGW) {
        const bool lat = row < MLAT; const int t = lat ? (row & 2047) : ((row - MLAT) & 255); const int L = lat ? SL : CL;
        const bf16* pr = P + (size_t)row * NIN;
        { const float v = bf2f(pr[640 + F.lane]); const float pv = __shfl_xor(v, 16); float o = v;
          if (lat) { const int j = F.lane, ax = j >> 5, i = j & 15, x2 = (j >> 4) & 1; const int pos = ax ? (t & 63) : (t >> 6); const float c = RC[pos * 16 + i], s = RS[pos * 16 + i];
              o = x2 ? (pv * s + v * c) : (v * c - pv * s); }
          const bf16 ob = (bf16)f2bf(o);
#pragma unroll
          for (int h = 0; h < 4; ++h) Kb[(size_t)row * 768 + 192 * h + 128 + F.lane] = ob; }
        if (row < nrows_conv) { const int c = 4 * F.lane;
            const v2u bgv = *(const GAS v2u*)(pr + 1280 + c);
            const v2u cg1 = *(const GAS v2u*)(pr + 1536 + c), xv1 = *(const GAS v2u*)(pr + 1792 + c);
            v2u cg0 = {0u, 0u}, xv0 = {0u, 0u}, cg2 = {0u, 0u}, xv2 = {0u, 0u};
            if (t > 0) { cg0 = *(const GAS v2u*)(pr - NIN + 1536 + c); xv0 = *(const GAS v2u*)(pr - NIN + 1792 + c); }
            if (t < L - 1) { cg2 = *(const GAS v2u*)(pr + NIN + 1536 + c); xv2 = *(const GAS v2u*)(pr + NIN + 1792 + c); }
            const f32x4 w0 = *(const f32x4*)(scw + c), w1 = *(const f32x4*)(scw + 256 + c), w2 = *(const f32x4*)(scw + 512 + c), bb = *(const f32x4*)(scb + c);
            float y[4];
#pragma unroll
            for (int e = 0; e < 4; ++e) { const unsigned sh = (e & 1) * 16; const unsigned m = 0xffffu;
                const unsigned b_ = ((e < 2 ? bgv.x : bgv.y) >> sh) & m;
                const unsigned c0_ = ((e < 2 ? cg0.x : cg0.y) >> sh) & m, x0_ = ((e < 2 ? xv0.x : xv0.y) >> sh) & m;
                const unsigned c1_ = ((e < 2 ? cg1.x : cg1.y) >> sh) & m, x1_ = ((e < 2 ? xv1.x : xv1.y) >> sh) & m;
                const unsigned c2_ = ((e < 2 ? cg2.x : cg2.y) >> sh) & m, x2_ = ((e < 2 ? xv2.x : xv2.y) >> sh) & m;
                const float u0 = bf2f(c0_) * bf2f(x0_), u1 = bf2f(c1_) * bf2f(x1_), u2 = bf2f(c2_) * bf2f(x2_);
                y[e] = bf2f(b_) * (w0[e] * u0 + w1[e] * u1 + w2[e] * u2 + bb[e]); }
            v2u o; o.x = pk2(y[0], y[1]); o.y = pk2(y[2], y[3]); *(GAS v2u*)(YC + (size_t)row * 256 + c) = o; }
    }
}
__device__ __forceinline__ void zt_phase(Frame& F, int l) {
    const bf16* P = (const bf16*)(F.ws + WS_P);
    LAS bf16* T = (LAS bf16*)(F.lds + F.wave * 16384);
    const int gw = F.vcu * NWAVES + F.wave, NGW = F.G * NWAVES;
    const int nitems = 2048 + (l == 0 ? 256 : 0);
    for (int it = gw; it < nitems; it += NGW) {
        const bool lat = it < 2048; const int r = lat ? it : it - 2048;
        const int pb = r >> 3, cb = r & 7;
        const int row0 = (lat ? 0 : MLAT) + 64 * pb; const int L = lat ? SL : CL;
        const int b = lat ? (pb >> 5) : (pb >> 2); const int n0 = (64 * pb) & (L - 1);
        bf16* ZT = lat ? (bf16*)(F.ws + WS_ZT) : (bf16*)(F.ws + WS_ZTC);
#pragma unroll
        for (int i = 0; i < 8; ++i) { const int pos = 8 * i + (F.lane >> 3), ch = F.lane & 7;
            const v4u v = *(const GAS v4u*)(P + (size_t)(row0 + pos) * NIN + 768 + 64 * cb + 8 * ch);
            LAS unsigned* d = (LAS unsigned*)(T + pos * 66 + 8 * ch); d[0] = v.x; d[1] = v.y; d[2] = v.z; d[3] = v.w; }
        LDS_WAIT(); asm volatile("" ::: "memory");
        const int sn = cb >> 2;
#pragma unroll
        for (int j = 0; j < 8; ++j) { const int chl = 8 * j + (F.lane >> 3), pc = F.lane & 7;
            unsigned e[8];
#pragma unroll
            for (int q = 0; q < 8; ++q) e[q] = T[(8 * pc + q) * 66 + chl];
            v4u o; o.x = e[0] | (e[1] << 16); o.y = e[2] | (e[3] << 16); o.z = e[4] | (e[5] << 16); o.w = e[6] | (e[7] << 16);
            const int chg = 64 * (cb & 3) + chl;
            *(GAS v4u*)(ZT + ((size_t)(b * 256 + chg) * 2 + sn) * L + n0 + 8 * pc) = o; }
        LDS_WAIT(); asm volatile("" ::: "memory");
    }
}
__device__ __forceinline__ void ycat_norm_phase(Frame& F, int nrows) {
    bf16* Y = (bf16*)(F.ws + WS_YCAT); const bf16* YC = (const bf16*)(F.ws + WS_YC);
    const int gw = F.vcu * NWAVES + F.wave, NGW = F.G * NWAVES;
    for (int row = gw; row < nrows; row += NGW) {
        bf16* yr = Y + (size_t)row * 1024;
        const v4u a = *(const GAS v4u*)(yr + 8 * F.lane); const v2u f = *(const GAS v2u*)(yr + 512 + 4 * F.lane); const v2u c = *(const GAS v2u*)(YC + (size_t)row * 256 + 4 * F.lane);
        float av[8], fv[4], cv[4];
        av[0] = bf2f(a.x & 0xffffu); av[1] = bf2f(a.x >> 16); av[2] = bf2f(a.y & 0xffffu); av[3] = bf2f(a.y >> 16); av[4] = bf2f(a.z & 0xffffu); av[5] = bf2f(a.z >> 16); av[6] = bf2f(a.w & 0xffffu); av[7] = bf2f(a.w >> 16);
        fv[0] = bf2f(f.x & 0xffffu); fv[1] = bf2f(f.x >> 16); fv[2] = bf2f(f.y & 0xffffu); fv[3] = bf2f(f.y >> 16);
        cv[0] = bf2f(c.x & 0xffffu); cv[1] = bf2f(c.x >> 16); cv[2] = bf2f(c.y & 0xffffu); cv[3] = bf2f(c.y >> 16);
        float sa = 0.f, sf = 0.f, sc = 0.f;
#pragma unroll
        for (int e = 0; e < 8; ++e) sa += av[e] * av[e];
#pragma unroll
        for (int e = 0; e < 4; ++e) { sf += fv[e] * fv[e]; sc += cv[e] * cv[e]; }
        const float ra = 1.0f / sqrtf(wave_sum(sa) * (1.0f / 512.0f) + EPS), rf = 1.0f / sqrtf(wave_sum(sf) * (1.0f / 256.0f) + EPS), rc = 1.0f / sqrtf(wave_sum(sc) * (1.0f / 256.0f) + EPS);
        v4u oa; oa.x = pk2(av[0] * ra, av[1] * ra); oa.y = pk2(av[2] * ra, av[3] * ra); oa.z = pk2(av[4] * ra, av[5] * ra); oa.w = pk2(av[6] * ra, av[7] * ra);
        v2u of; of.x = pk2(fv[0] * rf, fv[1] * rf); of.y = pk2(fv[2] * rf, fv[3] * rf);
        v2u oc; oc.x = pk2(cv[0] * rc, cv[1] * rc); oc.y = pk2(cv[2] * rc, cv[3] * rc);
        *(GAS v4u*)(yr + 8 * F.lane) = oa; *(GAS v2u*)(yr + 512 + 4 * F.lane) = of; *(GAS v2u*)(yr + 768 + 4 * F.lane) = oc;
    }
}
__device__ __forceinline__ void final_norm_phase(Frame& F, const float* g) {
    const int gw = F.vcu * NWAVES + F.wave, NGW = F.G * NWAVES;
    for (int row = gw; row < MLAT; row += NGW) {
        float* xr = F.out + (size_t)row * DM;
        f32x4 v[4]; float ss = 0.f;
#pragma unroll
        for (int j = 0; j < 4; ++j) { v[j] = *(const f32x4*)(xr + 256 * j + 4 * F.lane); ss += (v[j][0] * v[j][0] + v[j][1] * v[j][1]) + (v[j][2] * v[j][2] + v[j][3] * v[j][3]); }
        const float rstd = 1.0f / sqrtf(wave_sum(ss) * (1.0f / DM) + EPS);
#pragma unroll
        for (int j = 0; j < 4; ++j) { const int c = 256 * j + 4 * F.lane; const f32x4 gg = *(const f32x4*)(g + c); *(f32x4*)(xr + c) = (v[j] * rstd) * gg; }
    }
}
#ifndef PHMASK
#define PHMASK 0xFFFF
#endif
#define PHON(x) (((PHMASK) >> (x)) & 1)
#ifndef SUBMASK
#define SUBMASK 0xFF
#endif
#define SUBON(x) (((SUBMASK) >> (x)) & 1)
struct UpOrder : pg8::StaticOrder {
    typedef pg8::UnitUp UnitT;
    __device__ __forceinline__ bool next(int i, pg8::UnitUp& u) const {
        if (!next_mn(i, u.pm, u.pn)) return false;
        if (u.pm < 72) { const int b = u.pm / 9, j = u.pm % 9; u.arow = SL * b + 254 * j - 1; u.seq0 = SL * b; u.seq1 = SL * b + SL; u.olo = 1; u.ohi = 254; }
        else { const int b = u.pm - 72; u.arow = MLAT + CL * b; u.seq0 = u.arow; u.seq1 = u.arow + CL; u.olo = 0; u.ohi = 255; }
        return true;
    }
};

__global__ void __launch_bounds__(NWAVES * 64, 2) mk_fwd(Args args) {
    extern __shared__ __attribute__((aligned(16))) unsigned char lds[];
    Frame F;
    F.lds = (LAS unsigned char*)lds; F.ldsg = (char*)lds;
    F.MISC = (volatile LAS unsigned*)(F.lds + MISC_OFF);
    F.tid = threadIdx.x; F.lane = F.tid & 63; F.wave = __builtin_amdgcn_readfirstlane(F.tid >> 6);
    F.G = gridDim.x; F.bx = blockIdx.x; F.vcu = (F.G % 8 == 0) ? (F.bx % 8) * (F.G / 8) + F.bx / 8 : F.bx;
    F.ws = args.ws; F.out = args.out;
    for (int u = F.tid; u < (LDS_BYTES - LDSCTL_OFF) / 4; u += NWAVES * 64) ((LAS unsigned*)(F.lds + LDSCTL_OFF))[u] = 0u;
    __syncthreads();
    if (F.tid == 0) { LAS unsigned long long* T = (LAS unsigned long long*)(F.lds + PTR_OFF);
#pragma unroll
        for (int i = 0; i < 22; ++i) T[i] = (unsigned long long)args.in[i]; }
    __syncthreads();
    XcdBarrier bar; bar.bar = (unsigned*)(F.ws + WS_CTL) + CW_BAR; bar.x = 0; bar.st = nullptr;
    if (!MK_SPLIT) bar = xcd_barrier_post((unsigned*)(F.ws + WS_CTL) + CW_BAR, F.MISC + 8);

#define MOD ((float*)(ws + WS_MOD))
#define SSQ ((float*)(ws + WS_SSQ))
#define XN ((bf16*)(ws + WS_XN))
#define P ((bf16*)(ws + WS_P))
#define Qb ((bf16*)(ws + WS_Q))
#define Kb ((bf16*)(ws + WS_K))
#define Vb ((bf16*)(ws + WS_V))
#define YCAT ((bf16*)(ws + WS_YCAT))
#define ACT ((bf16*)(ws + WS_ACT))
#define XCTX ((float*)(ws + WS_XCTX))
    LAS unsigned char* ring = F.lds + RING_OFF;

    const int ph_lo = args.ph_lo, ph_hi = args.ph_hi;
#define PHASE(k) (ph_lo <= (k) && (k) < ph_hi)
#define SEAM(k) do { if (PHASE(k) && PHASE((k) + 1)) xcd_barrier(bar); } while (0)
#define RELANE() do { int t_ = threadIdx.x; asm volatile("" : "+v"(t_)); F.tid = t_; F.lane = t_ & 63; F.wave = __builtin_amdgcn_readfirstlane(t_ >> 6); } while (0)
    unsigned char* ws = F.ws;
    if (PHASE(0)) { RELANE(); if (PHON(0)) p0_prologue(F); }
    SEAM(0);
#pragma unroll
    for (int l = 0; l < 2; ++l) {
        const int pb = 1 + 9 * l;
        const int nMall = (l == 0) ? 72 : 64;
        if (PHASE(pb + 0)) { RELANE();
            if (PHON(1)) norm_mod_phase(F, l == 0 ? inptr(F, I_X) : F.out, l == 0 ? inptr(F, I_CTX) : XCTX, MT, inptr(F, I_N1G) + l * DM, MOD + (size_t)l * 9 * 6144, 0, 1024); }
        SEAM(pb + 0);
        if (PHASE(pb + 1)) { RELANE();
            if (PHON(2)) { pg8::Gemm g{XN, (const bf16*)(ws + WS_WIN + l * WIN_STRIDE), 72, 8, 1024, 1024}; pg8::StaticOrder S; S.init(72, 8, F.G, F.bx);
                pg8::EpiWin E{P, NIN, SSQ};
                pg8::gemm_phase(ring, g, S, E); } }
        SEAM(pb + 1);
        if (PHASE(pb + 2)) { RELANE();
            if (PHON(3)) {
                if (SUBON(0)) { pg8::Gemm g{P, (const bf16*)(ws + WS_WUQ + l * WUQ_STRIDE), nMall, 3, 384, NIN}; pg8::StaticOrder S; S.init(nMall, 3, F.G, F.bx);
                  pg8::EpiQ E{Qb, SSQ, (const float*)(ws + WS_ROPE), (const float*)(ws + WS_ROPE) + 1024};
                  pg8::gemm_phase(ring, g, S, E); }
                if (SUBON(1)) { pg8::Gemm g{P + 384, (const bf16*)(ws + WS_WUKV + l * WUKV_STRIDE), 72, 4, 256, NIN}; pg8::StaticOrder S; S.init(72, 4, F.G, F.G - 1 - F.bx);
                  pg8::EpiKV E{Kb, Vb, SSQ};
                  pg8::gemm_phase(ring, g, S, E); }
                if (SUBON(2)) qkv_rows_phase(F, l);
                if (SUBON(3)) zt_phase(F, l); } }
        SEAM(pb + 2);
        if (PHASE(pb + 3)) { RELANE();
            if (PHON(4)) {
                const int NU = 256 + (l == 0 ? 32 : 0);
                for (int u = F.vcu; u < NU; u += F.G) {
                    if (u < 256) { const int bh = u >> 3, qb = u & 7, b = bh >> 2, h = bh & 3; const long q0 = (long)b * SL + qb * 256;
                        att::attn_unit(Qb + q0 * 768 + 192 * h, Kb + 192 * h, Vb + 128 * h, YCAT + q0 * 1024 + 128 * h, MLAT + CL * b, 4, SL * b, 36, F.ldsg);
                    } else { const int cu = u - 256, b = cu >> 2, h = cu & 3; const long q0 = MLAT + (long)CL * b;
                        att::attn_unit(Qb + q0 * 768 + 192 * h, Kb + 192 * h, Vb + 128 * h, YCAT + q0 * 1024 + 128 * h, (int)q0, 4, 0, 4, F.ldsg); }
                }
                for (int v = 0; v < (l == 0 ? 2 : 1); ++v) {
                    pg8::Gemm g = v == 0 ? pg8::Gemm{(const bf16*)(ws + WS_DFT), (const bf16*)(ws + WS_ZT), 8, 8, 4096, 4096} : pg8::Gemm{(const bf16*)(ws + WS_DFTC), (const bf16*)(ws + WS_ZTC), 1, 8, 512, 512};
                    pg8::StaticOrder S; S.init(g.nM, g.nN, F.G, ((F.bx % 8 + (v == 0 ? 7 : 5)) % 8) * (F.G / 8) + F.bx / 8);
                    pg8::EpiFnet E{YCAT, v == 0 ? 0 : MLAT, v == 0 ? SL : CL, v == 0 ? 0.0027621358640099515f : 0.0078125f};
                    pg8::gemm_phase(ring, g, S, E);
                } } }
        SEAM(pb + 3);
        if (PHASE(pb + 4)) { RELANE();
            if (PHON(5)) ycat_norm_phase(F, nMall * 256); }
        SEAM(pb + 4);
        if (PHASE(pb + 5)) { RELANE();
            if (PHON(6)) { pg8::Gemm g{YCAT, (const bf16*)(ws + WS_WOUT + l * WOUT_STRIDE), nMall, 4, 1024, 1024}; pg8::StaticOrder S; S.init(nMall, 4, F.G, F.bx);
                pg8::EpiRes E{l == 0 ? inptr(F, I_X) : F.out, l == 0 ? inptr(F, I_CTX) : XCTX, F.out, XCTX, MOD + (size_t)l * 9 * 6144, 2048};
                pg8::gemm_phase(ring, g, S, E); } }
        SEAM(pb + 5);
        if (PHASE(pb + 6)) { RELANE();
            if (PHON(7)) norm_mod_phase(F, F.out, XCTX, nMall * 256, inptr(F, I_N2G) + l * DM, MOD + (size_t)l * 9 * 6144, 3072, 4096); }
        SEAM(pb + 6);
        if (PHASE(pb + 7)) { RELANE();
            if (PHON(8)) { const int nM = 72 + (l == 0 ? 8 : 0);
                pg8::Gemm g{XN, (const bf16*)(ws + WS_WUP + l * WUP_STRIDE), nM, 22, 1024, 1024}; UpOrder S; S.init(nM, 22, F.G, F.bx);
                pg8::EpiUp E{ACT, inptr(F, I_FCW) + (size_t)l * 3 * FF, inptr(F, I_FCB) + (size_t)l * FF, (LAS float*)(F.lds + EPIX_OFF)};
                pg8::gemm_phase(ring, g, S, E); } }
        SEAM(pb + 7);
        if (PHASE(pb + 8)) { RELANE();
            if (PHON(6)) { pg8::Gemm g{ACT, (const bf16*)(ws + WS_WDOWN + l * WDOWN_STRIDE), nMall, 4, FF, FF}; pg8::StaticOrder S; S.init(nMall, 4, F.G, F.bx);
                pg8::EpiRes E{F.out, XCTX, F.out, XCTX, MOD + (size_t)l * 9 * 6144, 5120};
                pg8::gemm_phase(ring, g, S, E); } }
        SEAM(pb + 8);
    }
    if (PHASE(NPH - 1)) { RELANE(); if (PHON(10)) final_norm_phase(F, inptr(F, I_FING)); }
#undef PHASE
#undef SEAM
#undef RELANE
#undef MOD
#undef SSQ
#undef XN
#undef P
#undef Qb
#undef Kb
#undef Vb
#undef YCAT
#undef ACT
#undef XCTX
}

extern "C" void kernel_launch(void* const* d_in, const int* in_sizes, int n_in, void* d_out, int out_size, void* d_ws, size_t ws_size, hipStream_t stream) {
    static int grid = 0;
    if (grid == 0) {
        if (n_in != 22 || out_size != MLAT * DM || ws_size < WS_END) { fprintf(stderr, "kernel_launch: unexpected shapes (n_in %d out %d ws %zu)\n", n_in, out_size, ws_size); grid = -1; return; }
        int dev = 0, cus = 0;
        if (hipGetDevice(&dev) != hipSuccess || hipDeviceGetAttribute(&cus, hipDeviceAttributeMultiprocessorCount, dev) != hipSuccess) { grid = -1; return; }
        if (hipFuncSetAttribute((const void*)mk_fwd, hipFuncAttributeMaxDynamicSharedMemorySize, LDS_BYTES) != hipSuccess) { fprintf(stderr, "kernel_launch: hipFuncSetAttribute failed\n"); grid = -1; return; }
        int per_cu = 0;
        if (hipOccupancyMaxActiveBlocksPerMultiprocessor(&per_cu, (const void*)mk_fwd, NWAVES * 64, LDS_BYTES) != hipSuccess || per_cu < 1) fprintf(stderr, "kernel_launch: occupancy query says %d\n", per_cu);
        (void)hipGetLastError();
        grid = cus;
    }
    if (grid < 0) return;
    if (hipMemsetAsync((char*)d_ws + WS_CTL, 0, CTL_ZERO_BYTES, stream) != hipSuccess) return;
    Args a{};
    for (int i = 0; i < 22; ++i) a.in[i] = (const float*)d_in[i];
    a.out = (float*)d_out; a.ws = (unsigned char*)d_ws;
#if MK_SPLIT
    for (int ph = 0; ph < NPH; ++ph) { a.ph_lo = ph; a.ph_hi = ph + 1; hipLaunchKernelGGL(mk_fwd, dim3(grid), dim3(NWAVES * 64), LDS_BYTES, stream, a); }
#else
    a.ph_lo = 0; a.ph_hi = NPH;
    hipLaunchKernelGGL(mk_fwd, dim3(grid), dim3(NWAVES * 64), LDS_BYTES, stream, a);
#endif
    const hipError_t le = hipPeekAtLastError();
    if (le != hipSuccess) fprintf(stderr, "kernel_launch: launch failed: %s\n", hipGetErrorName(le));
}
```

```cpp
#include <hip/hip_runtime.h>
#include <hip/hip_bf16.h>
#include <cstdio>
#include <cstdint>
#include <cmath>
namespace pg8 {
#define PG8_LAS __attribute__((address_space(3)))
typedef unsigned short bf16_t;
typedef short bf16x8 __attribute__((ext_vector_type(8)));
typedef float f32x4 __attribute__((ext_vector_type(4)));
typedef float f32x2 __attribute__((ext_vector_type(2)));
typedef unsigned u32x4 __attribute__((ext_vector_type(4)));
typedef unsigned u32x2 __attribute__((ext_vector_type(2)));
constexpr int BM = 256, BK = 64, HALF = 128, HTB = HALF * BK * 2  , STAGE_BYTES = 8 * HTB, NXCD = 8, WGM = 8;

__host__ __device__ __forceinline__ int lds_byte(int r, int c) { const int st = (r >> 4) * 2 + (c >> 5), rr = r & 15, cc = c & 31, ob = rr * 64 + cc * 2; return st * 1024 + (ob ^ (((ob >> 9) & 1) << 5)); }
__host__ __device__ __forceinline__ void stage_rc(int b, int& R, int& C) { const int st = b / 1024, sb = b % 1024, swz = sb ^ (((sb >> 9) & 1) << 5); R = (st >> 1) * 16 + swz / 64; C = (st & 1) * 32 + (swz % 64) / 2; }
__host__ __device__ __forceinline__ int perm32(int rho) { const int n = rho >> 4, i = rho & 15; return 8 * (i >> 2) + 4 * n + (i & 3); }

struct Unit { int pm, pn, arow, kofs, nt; };
struct Gemm { const bf16_t* A; const bf16_t* Bt; int nM, nN, K, lda; };

struct StaticOrder {
    int nM, nN, nwg, G, c, ntk;
    __device__ __forceinline__ void init(int nM_, int nN_, int G_, int c_, int K_) { nM = nM_; nN = nN_; nwg = nM * nN; G = G_; c = c_; ntk = K_ / BK; }
    __device__ __forceinline__ bool next_mn(int i, int& pm, int& pn) const {
        const long L = (long)i * G + c; if (L >= nwg) return false;
        int wgid = (int)L; { const int q = nwg / NXCD, r = nwg % NXCD, xcd = wgid % NXCD, off = wgid / NXCD; wgid = (xcd < r ? xcd * (q + 1) : r * (q + 1) + (xcd - r) * q) + off; }
        const int nig = WGM * nN, gid = wgid / nig, fm = gid * WGM, gsz = (nM - fm) < WGM ? (nM - fm) : WGM;
        pm = fm + ((wgid % nig) % gsz); pn = (wgid % nig) / gsz; return true;
    }
    typedef Unit UnitT;
    __device__ __forceinline__ bool next(int i, Unit& u) const { if (!next_mn(i, u.pm, u.pn)) return false; u.arow = u.pm * BM; u.kofs = 0; u.nt = ntk; return true; }
};

__device__ __forceinline__ unsigned cvt_pk_bf16(float lo, float hi) { unsigned r; asm volatile("v_cvt_pk_bf16_f32 %0, %1, %2" : "=v"(r) : "v"(lo), "v"(hi)); return r; }

template <class Epi, class Sched>
__device__ __forceinline__ void gemm_phase(PG8_LAS unsigned char* lds, const Gemm g, const Sched& S, const Epi& E) {
    int tid = threadIdx.x; asm volatile("" : "+v"(tid));
    const int wid = __builtin_amdgcn_readfirstlane(tid >> 6), lane = tid & 63, wr = wid >> 2, wc = wid & 3, fr = lane & 15, fq = lane >> 4;
    const int K = g.K, lda = g.lda;
    unsigned voffA[2], voffB[2];
#pragma unroll
    for (int i = 0; i < 2; ++i) { int R, C; stage_rc(tid * 16 + i * 8192, R, C); const int Rb = Epi::PERM ? ((R & ~31) + perm32(R & 31)) : R;
        voffA[i] = (unsigned)(R * lda + C) * 2u; voffB[i] = (unsigned)(Rb * K + C) * 2u; }
    const size_t kstep = (size_t)(BK * 2);
    const size_t hstepA = (size_t)HALF * lda * 2, hstepB = (size_t)HALF * K * 2;
    const size_t tstepB = 2 * hstepB;
    const unsigned ldsw = (unsigned)wid * 1024u;
    const int aoff = lds_byte(wr * 64 + fr, fq * 8), boff = lds_byte(wc * 32 + fr, fq * 8);
#define PG8_SA(b, h) (((b) * 2 + (h)) * HTB)
#define PG8_SB(b, h) ((4 + (b) * 2 + (h)) * HTB)
#define PG8_STAGE(bufoff, gbase, voff) do { _Pragma("unroll") for (int _i = 0; _i < 2; ++_i) \
        __builtin_amdgcn_global_load_lds((const unsigned*)((const char*)(gbase) + (voff)[_i]), (PG8_LAS unsigned*)(lds + (bufoff) + ldsw + _i * 8192), 16, 0, 0); } while (0)
#define PG8_LDA(dst, b, h) do { _Pragma("unroll") for (int m = 0; m < 4; ++m) _Pragma("unroll") for (int k = 0; k < 2; ++k) dst[m][k] = *(const PG8_LAS bf16x8*)(lds + PG8_SA(b, h) + aoff + m * 2048 + k * 1024); } while (0)
#define PG8_LDB(dst, b, h) do { _Pragma("unroll") for (int n = 0; n < 2; ++n) _Pragma("unroll") for (int k = 0; k < 2; ++k) dst[n][k] = *(const PG8_LAS bf16x8*)(lds + PG8_SB(b, h) + boff + n * 2048 + k * 1024); } while (0)
#define PG8_MMA(ai, bj, At, Bt) do { __builtin_amdgcn_s_setprio(1); _Pragma("unroll") for (int m = 0; m < 4; ++m) _Pragma("unroll") for (int n = 0; n < 2; ++n) _Pragma("unroll") for (int k = 0; k < 2; ++k) \
        acc[ai][bj][m][n] = __builtin_amdgcn_mfma_f32_16x16x32_bf16(Bt[n][k], At[m][k], acc[ai][bj][m][n], 0, 0, 0); __builtin_amdgcn_s_setprio(0); } while (0)
#define PG8_WAIT_V(n) asm volatile("s_waitcnt vmcnt(" #n ")" ::: "memory")
#define PG8_WAIT_L(n) asm volatile("s_waitcnt lgkmcnt(" #n ")" ::: "memory")
#define PG8_BAR __builtin_amdgcn_s_barrier()
#define PG8_SCHED __builtin_amdgcn_sched_barrier(0)
    typename Sched::UnitT cur, nxt; int ui = 0;
    if (!S.next(0, cur)) return;
    f32x4 acc[2][2][4][2];
#pragma unroll
    for (int a = 0; a < 2; ++a)
#pragma unroll
        for (int b = 0; b < 2; ++b)
#pragma unroll
            for (int m = 0; m < 4; ++m)
#pragma unroll
                for (int n = 0; n < 2; ++n) acc[a][b][m][n] = (f32x4){0.f, 0.f, 0.f, 0.f};
    bf16x8 At[4][2], B0[2][2], B1[2][2];
    const char* cA = (const char*)g.A + (ptrdiff_t)cur.arow * (ptrdiff_t)(lda * 2) + cur.kofs * 2; const char* cB = (const char*)g.Bt + (size_t)cur.pn * tstepB + cur.kofs * 2;
    PG8_STAGE(PG8_SB(0, 0), cB, voffB); PG8_STAGE(PG8_SB(0, 1), cB + hstepB, voffB); PG8_STAGE(PG8_SA(0, 0), cA, voffA); PG8_STAGE(PG8_SA(0, 1), cA + hstepA, voffA);
    if (wr == 1) PG8_BAR;
    PG8_WAIT_V(2); PG8_BAR;
    PG8_STAGE(PG8_SB(1, 0), cB + kstep, voffB); PG8_STAGE(PG8_SA(1, 0), cA + kstep, voffA); PG8_STAGE(PG8_SB(1, 1), cB + hstepB + kstep, voffB);
    PG8_WAIT_V(6); PG8_BAR;
    for (;;) {
        const bool has_next = S.next(ui + 1, nxt);
        const char* nA = has_next ? (const char*)g.A + (ptrdiff_t)nxt.arow * (ptrdiff_t)(lda * 2) + nxt.kofs * 2 : cA; const char* nB = has_next ? (const char*)g.Bt + (size_t)nxt.pn * tstepB + nxt.kofs * 2 : cB;
        const int nt = cur.nt;
        for (int t = 0; t < nt; t += 2) {
            const bool last = (t == nt - 2);
            const char* a1 = cA + (size_t)(t + 1) * kstep;
            const char* a2 = last ? nA : cA + (size_t)(t + 2) * kstep; const char* b2 = last ? nB : cB + (size_t)(t + 2) * kstep;
            const char* a3 = a2 + kstep; const char* b3 = b2 + kstep;
            PG8_LDB(B0, 0, 0); PG8_LDB(B1, 0, 1); PG8_SCHED; PG8_LDA(At, 0, 0); PG8_STAGE(PG8_SA(1, 1), a1 + hstepA, voffA);
            PG8_WAIT_V(8); PG8_WAIT_L(0); PG8_BAR; PG8_MMA(0, 0, At, B0); PG8_MMA(0, 1, At, B1); PG8_BAR; PG8_SCHED;
            PG8_LDA(At, 0, 1); PG8_STAGE(PG8_SB(0, 0), b2, voffB); PG8_STAGE(PG8_SB(0, 1), b2 + hstepB, voffB); PG8_STAGE(PG8_SA(0, 0), a2, voffA);
            PG8_WAIT_V(8); PG8_WAIT_L(0); PG8_BAR; PG8_MMA(1, 0, At, B0); PG8_MMA(1, 1, At, B1); PG8_BAR; PG8_SCHED;
            PG8_LDB(B0, 1, 0); PG8_LDB(B1, 1, 1); PG8_SCHED; PG8_LDA(At, 1, 0); PG8_STAGE(PG8_SA(0, 1), a2 + hstepA, voffA);
            PG8_WAIT_V(8); PG8_WAIT_L(0); PG8_BAR; PG8_MMA(0, 0, At, B0); PG8_MMA(0, 1, At, B1); PG8_BAR; PG8_SCHED;
            PG8_LDA(At, 1, 1); PG8_STAGE(PG8_SB(1, 0), b3, voffB); PG8_STAGE(PG8_SB(1, 1), b3 + hstepB, voffB); PG8_STAGE(PG8_SA(1, 0), a3, voffA);
            PG8_WAIT_V(8); PG8_WAIT_L(0); PG8_BAR; PG8_MMA(1, 0, At, B0); PG8_MMA(1, 1, At, B1); PG8_BAR; PG8_SCHED;
        }
        if (wr == 0) PG8_BAR;
        E(acc, cur, wr, wc, fr, fq);
        if (!has_next) break;
#pragma unroll
        for (int a = 0; a < 2; ++a)
#pragma unroll
            for (int b = 0; b < 2; ++b)
#pragma unroll
                for (int m = 0; m < 4; ++m)
#pragma unroll
                    for (int n = 0; n < 2; ++n) acc[a][b][m][n] = (f32x4){0.f, 0.f, 0.f, 0.f};
        cur = nxt; cA = nA; cB = nB; ++ui;
        if (wr == 1) PG8_BAR;
    }
    PG8_WAIT_V(0);
    PG8_BAR;
#undef PG8_SA
#undef PG8_SB
#undef PG8_STAGE
#undef PG8_LDA
#undef PG8_LDB
#undef PG8_MMA
#undef PG8_WAIT_V
#undef PG8_WAIT_L
#undef PG8_BAR
#undef PG8_SCHED
}
}
namespace pg8 {
constexpr float RMS_EPS = 1e-6f;
template <class T> __device__ __forceinline__ T gld(const void* base, unsigned boff) { return *(const T*)((const char*)base + boff); }
template <class T> __device__ __forceinline__ void gst(void* base, unsigned boff, T v) { *(T*)((char*)base + boff) = v; }

struct EpiWin {
    static constexpr bool PERM = true;
    bf16_t* O; int ldc; float* ssq;
    const float* ssx; const float* pb;
    __device__ __forceinline__ void operator()(const f32x4 (&acc)[2][2][4][2], const Unit& u, int wr, int wc, int fr_in, int fq_in) const {
        int t_ = threadIdx.x; asm volatile("" : "+v"(t_)); const int fr = t_ & 15, fq = (t_ >> 4) & 3; (void)fr_in; (void)fq_in;
        const int row0 = u.pm * BM + wr * 64 + fr; const int col0 = u.pn * BM + wc * 32 + 8 * fq;
        const bool fused = ssx != nullptr;
        f32x4 bv[2][2];
#pragma unroll
        for (int bj = 0; bj < 2; ++bj)
#pragma unroll
            for (int n = 0; n < 2; ++n) bv[bj][n] = fused ? gld<f32x4>(pb, (unsigned)((u.pm < 64 ? (u.pm >> 3) : 8) * 2048 + col0 + bj * HALF + 4 * n) * 4u) : (f32x4){0.f, 0.f, 0.f, 0.f};
#pragma unroll
        for (int ai = 0; ai < 2; ++ai)
#pragma unroll
            for (int m = 0; m < 4; ++m) { const int row = row0 + ai * HALF + m * 16; const unsigned ob = ((unsigned)row * (unsigned)ldc + (unsigned)col0) * 2u;
                float rs = 1.0f;
                if (fused) { const f32x4 s4 = gld<f32x4>(ssx, ((unsigned)row * 16u + 4u * fq) * 4u); float ss = (s4[0] + s4[1]) + (s4[2] + s4[3]); ss += __shfl_xor(ss, 16); ss += __shfl_xor(ss, 32);
                    rs = __builtin_amdgcn_rsqf(ss * (1.0f / 1024.0f) + RMS_EPS); }
#pragma unroll
                for (int bj = 0; bj < 2; ++bj) { const f32x4 v0 = acc[ai][bj][m][0] * rs + bv[bj][0], v1 = acc[ai][bj][m][1] * rs + bv[bj][1];
                    u32x4 w; w.x = cvt_pk_bf16(v0[0], v0[1]); w.y = cvt_pk_bf16(v0[2], v0[3]); w.z = cvt_pk_bf16(v1[0], v1[1]); w.w = cvt_pk_bf16(v1[2], v1[3]);
                    gst<u32x4>(O, ob + bj * HALF * 2, w);
                    const int hf = 2 * u.pn + bj;
                    if (hf < 5) {
                        float s = (v0[0] * v0[0] + v0[1] * v0[1]) + (v0[2] * v0[2] + v0[3] * v0[3]) + (v1[0] * v1[0] + v1[1] * v1[1]) + (v1[2] * v1[2] + v1[3] * v1[3]);
                        s += __shfl_xor(s, 16); s += __shfl_xor(s, 32);
                        if (fq == 0) gst<float>(ssq, ((unsigned)row * 20u + hf * 4 + wc) * 4u, s);
                    } }
                if (m & 1) asm volatile("" ::: "memory"); }
    }
};

struct EpiFold {
    static constexpr bool PERM = true;
    bf16_t* WinT; unsigned lstride;
    __device__ __forceinline__ void operator()(const f32x4 (&acc)[2][2][4][2], const Unit& u, int wr, int wc, int fr_in, int fq_in) const {
        int t_ = threadIdx.x; asm volatile("" : "+v"(t_)); const int fr = t_ & 15, fq = (t_ >> 4) & 3; (void)fr_in; (void)fq_in;
        bf16_t* O = WinT + (size_t)(u.pn >> 2) * lstride;
        const int row0 = 768 + u.pm * BM + wr * 64 + fr; const int col0 = (u.pn & 3) * BM + wc * 32 + 8 * fq;
#pragma unroll
        for (int ai = 0; ai < 2; ++ai)
#pragma unroll
            for (int m = 0; m < 4; ++m) { const unsigned ob = ((unsigned)(row0 + ai * HALF + m * 16) * 1024u + (unsigned)col0) * 2u;
#pragma unroll
                for (int bj = 0; bj < 2; ++bj) { const f32x4 v0 = acc[ai][bj][m][0], v1 = acc[ai][bj][m][1];
                    u32x4 w; w.x = cvt_pk_bf16(v0[0], v0[1]); w.y = cvt_pk_bf16(v0[2], v0[3]); w.z = cvt_pk_bf16(v1[0], v1[1]); w.w = cvt_pk_bf16(v1[2], v1[3]);
                    gst<u32x4>(O, ob + bj * HALF * 2, w); } }
    }
};

struct EpiQ {
    static constexpr bool PERM = false;
    bf16_t* Q; const float* ssq; const float* ropec; const float* ropes;
    __device__ __forceinline__ void operator()(const f32x4 (&acc)[2][2][4][2], const Unit& u, int wr, int wc, int fr_in, int fq_in) const {
        int t_ = threadIdx.x; asm volatile("" : "+v"(t_)); const int fr = t_ & 15, fq = (t_ >> 4) & 3; (void)fr_in; (void)fq_in;
        const int row0 = u.pm * BM + wr * 64 + fr; const bool lat = u.pm < 64;
#pragma unroll
        for (int ai = 0; ai < 2; ++ai)
#pragma unroll
            for (int m = 0; m < 4; ++m) { const int row = row0 + ai * HALF + m * 16;
                const unsigned sb = ((unsigned)row * 20u + 3u * fq) * 4u; float ss = (gld<float>(ssq, sb) + gld<float>(ssq, sb + 4)) + gld<float>(ssq, sb + 8);
                ss += __shfl_xor(ss, 16); ss += __shfl_xor(ss, 32);
                const float rs = __builtin_amdgcn_rsqf(ss * (1.0f / 384.0f) + RMS_EPS);
                const int t = row & 2047;
#pragma unroll
                for (int bj = 0; bj < 2; ++bj) { const int gcol = u.pn * BM + bj * HALF + wc * 32;
                    const int w = gcol % 192; f32x4 x1 = acc[ai][bj][m][0] * rs, x2 = acc[ai][bj][m][1] * rs;
                    if (lat && w >= 128) { const int pos = (w >= 160) ? (t & 63) : (t >> 6);
                        const unsigned rb = (unsigned)(pos * 16 + 4 * fq) * 4u; const f32x4 c = gld<f32x4>(ropec, rb), s = gld<f32x4>(ropes, rb);
                        const f32x4 y1 = x1 * c - x2 * s, y2 = x1 * s + x2 * c; x1 = y1; x2 = y2; }
                    const unsigned qb = ((unsigned)row * 768u + (unsigned)(gcol + 4 * fq)) * 2u;
                    u32x2 a; a.x = cvt_pk_bf16(x1[0], x1[1]); a.y = cvt_pk_bf16(x1[2], x1[3]); gst<u32x2>(Q, qb, a);
                    u32x2 b; b.x = cvt_pk_bf16(x2[0], x2[1]); b.y = cvt_pk_bf16(x2[2], x2[3]); gst<u32x2>(Q, qb + 32, b); }
                if (m & 1) asm volatile("" ::: "memory"); }
    }
};

struct EpiKV {
    static constexpr bool PERM = true;
    bf16_t* Kb; bf16_t* Vb; const float* ssq;
    __device__ __forceinline__ void operator()(const f32x4 (&acc)[2][2][4][2], const Unit& u, int wr, int wc, int fr_in, int fq_in) const {
        int t_ = threadIdx.x; asm volatile("" : "+v"(t_)); const int fr = t_ & 15, fq = (t_ >> 4) & 3; (void)fr_in; (void)fq_in;
        const int row0 = u.pm * BM + wr * 64 + fr; const int cw = wc * 32 + 8 * fq;
#pragma unroll
        for (int ai = 0; ai < 2; ++ai)
#pragma unroll
            for (int m = 0; m < 4; ++m) { const int row = row0 + ai * HALF + m * 16;
                const unsigned sb = ((unsigned)row * 20u + 12u + 2u * fq) * 4u; float ss = gld<float>(ssq, sb) + gld<float>(ssq, sb + 4);
                ss += __shfl_xor(ss, 16); ss += __shfl_xor(ss, 32);
                const float rs = __builtin_amdgcn_rsqf(ss * (1.0f / 256.0f) + RMS_EPS);
#pragma unroll
                for (int bj = 0; bj < 2; ++bj) { const f32x4 v0 = acc[ai][bj][m][0] * rs, v1 = acc[ai][bj][m][1] * rs;
                    u32x4 w; w.x = cvt_pk_bf16(v0[0], v0[1]); w.y = cvt_pk_bf16(v0[2], v0[3]); w.z = cvt_pk_bf16(v1[0], v1[1]); w.w = cvt_pk_bf16(v1[2], v1[3]);
                    if (bj == 0) gst<u32x4>(Kb, ((unsigned)row * 768u + (unsigned)(192 * u.pn + cw)) * 2u, w);
                    else gst<u32x4>(Vb, ((unsigned)row * 512u + (unsigned)(128 * u.pn + cw)) * 2u, w); }
                if (m & 1) asm volatile("" ::: "memory"); }
    }
};

struct EpiFnet {
    static constexpr bool PERM = true;
    bf16_t* Y; int rowbase, seqlen; float scale; unsigned slice_stride;
    __device__ __forceinline__ void operator()(const f32x4 (&acc)[2][2][4][2], const Unit& u, int wr, int wc, int fr_in, int fq_in) const {
        int t_ = threadIdx.x; asm volatile("" : "+v"(t_)); const int fr = t_ & 15, fq = (t_ >> 4) & 3; (void)fr_in; (void)fq_in;
        const int k0 = u.pm * BM + wr * 64 + fr; const int cw = wc * 32 + 8 * fq;
        bf16_t* Yb = Y + (size_t)(u.kofs >> 10) * slice_stride;
#pragma unroll
        for (int ai = 0; ai < 2; ++ai)
#pragma unroll
            for (int m = 0; m < 4; ++m) { const int row = rowbase + u.pn * seqlen + k0 + ai * HALF + m * 16; const unsigned yb = ((unsigned)row * 256u + (unsigned)cw) * 2u;
#pragma unroll
                for (int bj = 0; bj < 2; ++bj) { const f32x4 v0 = acc[ai][bj][m][0] * scale, v1 = acc[ai][bj][m][1] * scale;
                    u32x4 w; w.x = cvt_pk_bf16(v0[0], v0[1]); w.y = cvt_pk_bf16(v0[2], v0[3]); w.z = cvt_pk_bf16(v1[0], v1[1]); w.w = cvt_pk_bf16(v1[2], v1[3]);
                    gst<u32x4>(Yb, yb + bj * HALF * 2, w); } }
    }
};

struct EpiRes {
    static constexpr bool PERM = true;
    const bf16_t* base_lat; const bf16_t* base_ctx; bf16_t* out_lat; bf16_t* out_ctx; const float* mod; int gofs;
    bf16_t* xs; float* ssx; const float* ng; const float* scmod; int scofs;
    float gmul;
    __device__ __forceinline__ void operator()(const f32x4 (&acc)[2][2][4][2], const Unit& u, int wr, int wc, int fr_in, int fq_in) const {
        int t_ = threadIdx.x; asm volatile("" : "+v"(t_)); const int fr = t_ & 15, fq = (t_ >> 4) & 3; (void)fr_in; (void)fq_in;
        const bool lat = u.pm < 64; const int r = lat ? (u.pm >> 3) : 8;
        const bf16_t* base = lat ? base_lat : base_ctx; bf16_t* out = lat ? out_lat : out_ctx;
        const float* gate = mod + r * 6144 + gofs;
        const int row0 = (lat ? u.pm : u.pm - 64) * BM + wr * 64 + fr; const int col0 = u.pn * BM + wc * 32 + 8 * fq;
        const int grow0 = u.pm * BM + wr * 64 + fr;
        const bool prod = xs != nullptr;
        f32x4 gv[2][2], gs[2][2];
#pragma unroll
        for (int bj = 0; bj < 2; ++bj)
#pragma unroll
            for (int n = 0; n < 2; ++n) { const unsigned cb = (unsigned)(col0 + bj * HALF + n * 4) * 4u; gv[bj][n] = gld<f32x4>(gate, cb) * gmul;
                gs[bj][n] = prod ? gld<f32x4>(ng, cb) * (gld<f32x4>(scmod, (unsigned)(r * 6144 + scofs) * 4u + cb) + 1.0f) : (f32x4){0.f, 0.f, 0.f, 0.f}; }
#pragma unroll
        for (int ai = 0; ai < 2; ++ai)
#pragma unroll
            for (int m = 0; m < 4; ++m) { const unsigned off = ((unsigned)(row0 + ai * HALF + m * 16) * 1024u + (unsigned)col0) * 2u;
                const unsigned xoff = ((unsigned)(grow0 + ai * HALF + m * 16) * 1024u + (unsigned)col0) * 2u; float ss = 0.f;
#pragma unroll
                for (int bj = 0; bj < 2; ++bj) { const unsigned o2 = off + (unsigned)(bj * HALF) * 2u; const u32x4 bw = gld<u32x4>(base, o2);
                    f32x4 x0, x1;
                    x0[0] = __builtin_bit_cast(float, bw.x << 16); x0[1] = __builtin_bit_cast(float, bw.x & 0xffff0000u); x0[2] = __builtin_bit_cast(float, bw.y << 16); x0[3] = __builtin_bit_cast(float, bw.y & 0xffff0000u);
                    x1[0] = __builtin_bit_cast(float, bw.z << 16); x1[1] = __builtin_bit_cast(float, bw.z & 0xffff0000u); x1[2] = __builtin_bit_cast(float, bw.w << 16); x1[3] = __builtin_bit_cast(float, bw.w & 0xffff0000u);
                    x0 = x0 + gv[bj][0] * acc[ai][bj][m][0]; x1 = x1 + gv[bj][1] * acc[ai][bj][m][1];
                    u32x4 w; w.x = cvt_pk_bf16(x0[0], x0[1]); w.y = cvt_pk_bf16(x0[2], x0[3]); w.z = cvt_pk_bf16(x1[0], x1[1]); w.w = cvt_pk_bf16(x1[2], x1[3]);
                    gst<u32x4>(out, o2, w);
                    if (prod) { ss += ((x0[0] * x0[0] + x0[1] * x0[1]) + (x0[2] * x0[2] + x0[3] * x0[3])) + ((x1[0] * x1[0] + x1[1] * x1[1]) + (x1[2] * x1[2] + x1[3] * x1[3]));
                        const f32x4 h0 = x0 * gs[bj][0], h1 = x1 * gs[bj][1];
                        u32x4 hw; hw.x = cvt_pk_bf16(h0[0], h0[1]); hw.y = cvt_pk_bf16(h0[2], h0[3]); hw.z = cvt_pk_bf16(h1[0], h1[1]); hw.w = cvt_pk_bf16(h1[2], h1[3]);
                        gst<u32x4>(xs, xoff + (unsigned)(bj * HALF) * 2u, hw); } }
                if (prod) { ss += __shfl_xor(ss, 16); ss += __shfl_xor(ss, 32); if (fq == 0) gst<float>(ssx, ((unsigned)(grow0 + ai * HALF + m * 16) * 16u + (unsigned)(4 * u.pn + wc)) * 4u, ss); }
                if (m == 3) asm volatile("" ::: "memory"); }
    }
};

struct UnitUp : Unit { int seq0, seq1, olo, ohi; };
struct EpiUp {
    static constexpr bool PERM = true;
    bf16_t* act; const float* cw; const float* cb; PG8_LAS float* xb;
    const float* ssx; const float* ub;
    __device__ __forceinline__ void operator()(f32x4 (&acc)[2][2][4][2], const UnitUp& u, int wr, int wc, int fr_in, int fq_in) const {
        int t_ = threadIdx.x; asm volatile("" : "+v"(t_)); const int fr = t_ & 15, fq = (t_ >> 4) & 3; (void)fr_in; (void)fq_in;
        const int lane = fq * 16 + fr;
        const int ccol = wc * 32 + 8 * fq;
        const int gc = u.pn * HALF + ccol;
        PG8_LAS float* CW = xb + 1024;
        const float cwld = (t_ < 384) ? gld<float>(cw, (unsigned)((t_ >> 7) * 2816 + u.pn * HALF + (t_ & 127)) * 4u) : gld<float>(cb, (unsigned)(u.pn * HALF + (t_ & 127)) * 4u);
        { const int bidx = (u.pm < 72) ? (u.pm / 9) : 8; const unsigned ubb = (unsigned)(bidx * 5632 + u.pn * BM + ccol) * 4u;
          const f32x4 ug0 = gld<f32x4>(ub, ubb), ug1 = gld<f32x4>(ub, ubb + 16), uv0 = gld<f32x4>(ub, ubb + HALF * 4), uv1 = gld<f32x4>(ub, ubb + HALF * 4 + 16);
#pragma unroll
          for (int ai = 0; ai < 2; ++ai)
#pragma unroll
            for (int m = 0; m < 4; ++m) { const int g = u.arow + ai * HALF + wr * 64 + m * 16 + fr; const bool ok = (g >= u.seq0) && (g < u.seq1);
                const int gcl = g < 0 ? 0 : g;
                const f32x4 s4 = gld<f32x4>(ssx, ((unsigned)gcl * 16u + 4u * fq) * 4u); float ss = (s4[0] + s4[1]) + (s4[2] + s4[3]); ss += __shfl_xor(ss, 16); ss += __shfl_xor(ss, 32);
                const float rs = __builtin_amdgcn_rsqf(ss * (1.0f / 1024.0f) + RMS_EPS);
                f32x4 a0 = acc[ai][0][m][0] * rs + ug0, a1 = acc[ai][0][m][1] * rs + ug1;
#pragma unroll
                for (int e2 = 0; e2 < 4; ++e2) { a0[e2] = ok ? a0[e2] : 0.f; a1[e2] = ok ? a1[e2] : 0.f; }
                acc[ai][0][m][0] = a0; acc[ai][0][m][1] = a1;
                acc[ai][1][m][0] = acc[ai][1][m][0] * rs + uv0; acc[ai][1][m][1] = acc[ai][1][m][1] * rs + uv1;
                if (m & 1) asm volatile("" ::: "memory"); } }
        PG8_LAS float* XF = xb; PG8_LAS float* XL = xb + 512;
        const bool isF = (fr == 0), isL = (fr == 15);
#pragma unroll
        for (int ai = 0; ai < 2; ++ai) { const int blk = 2 * ai + wr;
            f32x4 s0, s1;
#pragma unroll
            for (int e = 0; e < 4; ++e) { s0[e] = isF ? acc[ai][0][0][0][e] : acc[ai][0][3][0][e]; s1[e] = isF ? acc[ai][0][0][1][e] : acc[ai][0][3][1][e]; }
            PG8_LAS float* dst = xb + (isF ? 0 : 512) + blk * 128 + ccol;
            if (isF || isL) { *(PG8_LAS f32x4*)dst = s0; *(PG8_LAS f32x4*)(dst + 4) = s1; } }
        CW[t_] = cwld;
        asm volatile("s_waitcnt lgkmcnt(0)" ::: "memory"); __builtin_amdgcn_s_barrier(); asm volatile("" ::: "memory");
        const int lup = (lane & 48) | ((lane - 1) & 15), ldn = (lane & 48) | ((lane + 1) & 15);
#pragma unroll
        for (int ai = 0; ai < 2; ++ai) { const int blk = 2 * ai + wr;
#pragma unroll
            for (int n = 0; n < 2; ++n) {
                const f32x4 w0 = *(const PG8_LAS f32x4*)(CW + ccol + 4 * n), w1 = *(const PG8_LAS f32x4*)(CW + 128 + ccol + 4 * n), w2 = *(const PG8_LAS f32x4*)(CW + 256 + ccol + 4 * n), bb = *(const PG8_LAS f32x4*)(CW + 384 + ccol + 4 * n);
                f32x4 xprev = (f32x4){0.f, 0.f, 0.f, 0.f}, xnext = (f32x4){0.f, 0.f, 0.f, 0.f};
                if (blk > 0) xprev = *(const PG8_LAS f32x4*)(XL + (blk - 1) * 128 + ccol + 4 * n);
                if (blk < 3) xnext = *(const PG8_LAS f32x4*)(XF + (blk + 1) * 128 + ccol + 4 * n);
#pragma unroll
                for (int e = 0; e < 4; ++e) {
                    float cur[4], up[4], dn[4];
#pragma unroll
                    for (int m = 0; m < 4; ++m) cur[m] = acc[ai][0][m][n][e];
#pragma unroll
                    for (int m = 0; m < 4; ++m) {
                        const float tu = isL ? (m > 0 ? cur[m > 0 ? m - 1 : 0] : xprev[e]) : cur[m];
                        const float td = isF ? (m < 3 ? cur[m < 3 ? m + 1 : 3] : xnext[e]) : cur[m];
                        up[m] = __shfl(tu, lup); dn[m] = __shfl(td, ldn); }
                    float rr[4];
#pragma unroll
                    for (int m = 0; m < 4; ++m) { const float cv = w0[e] * up[m] + w1[e] * cur[m] + w2[e] * dn[m] + bb[e];
                        const float sg = cv * __builtin_amdgcn_rcpf(1.0f + __expf(-cv));
                        rr[m] = sg * acc[ai][1][m][n][e]; }
                    asm volatile("" : "+v"(rr[0]), "+v"(rr[1]), "+v"(rr[2]), "+v"(rr[3]));
#pragma unroll
                    for (int m = 0; m < 4; ++m) acc[ai][0][m][n][e] = rr[m];
                }
            }
#pragma unroll
            for (int m = 0; m < 4; ++m) { const int tr = ai * HALF + wr * 64 + m * 16 + fr; const int g = u.arow + tr;
                if (tr >= u.olo && tr <= u.ohi && g < u.seq1) { const f32x4 v0 = acc[ai][0][m][0], v1 = acc[ai][0][m][1];
                    u32x4 w; w.x = cvt_pk_bf16(v0[0], v0[1]); w.y = cvt_pk_bf16(v0[2], v0[3]); w.z = cvt_pk_bf16(v1[0], v1[1]); w.w = cvt_pk_bf16(v1[2], v1[3]);
                    gst<u32x4>(act, ((unsigned)g * 2816u + (unsigned)gc) * 2u, w); } }
            asm volatile("" ::: "memory");
        }
        asm volatile("s_waitcnt lgkmcnt(0)" ::: "memory"); __builtin_amdgcn_s_barrier(); asm volatile("" ::: "memory");
    }
};
}
namespace att {
using bf16x8 = __attribute__((ext_vector_type(8))) short;
using s16x4  = __attribute__((ext_vector_type(4))) short;
using f32x16 = __attribute__((ext_vector_type(16))) float;
using u32x4  = __attribute__((ext_vector_type(4))) unsigned;
typedef unsigned short bf16_t;
constexpr int NW = 8, QBLK = 32, KVBLK = 64;
constexpr int LDQ = 768, LDK = 768, LDV = 512, LDO = 1024;
constexpr float SCALE = 0.07216878364870322f;
constexpr float THR = 8.f;
constexpr int SHM_V = KVBLK * 128 * 2, SHM_K = KVBLK * 192 * 2;
constexpr int OFF_V = 0, OFF_K = 2 * SHM_V, OFF_WS = 2 * SHM_V + 2 * SHM_K, OFF_QR = OFF_WS + NW * 64 * 4, SHM_ATTN = OFF_QR + NW * 4096;
#define KSWZ(row, colB) ((row) * 384 + ((colB) ^ (((row) & 7) << 4)))
#define SBAR() __builtin_amdgcn_sched_barrier(0)
__device__ __forceinline__ int crow(int r, int hi) { return (r & 3) + 8 * (r >> 2) + 4 * hi; }
__device__ __forceinline__ unsigned cvtpk(float lo, float hi) { unsigned r; asm volatile("v_cvt_pk_bf16_f32 %0, %1, %2" : "=v"(r) : "v"(lo), "v"(hi)); return r; }

__device__ __forceinline__ void partialSM(f32x16& p0, f32x16& p1, float& m_reg, float& mn, float& alpha) {
  constexpr float C = SCALE * 1.4426950408889634f;
  float pmax = p0[0];
#pragma unroll
  for (int r = 1; r < 16; ++r) pmax = fmaxf(pmax, p0[r]);
#pragma unroll
  for (int r = 0; r < 16; ++r) pmax = fmaxf(pmax, p1[r]);
  { auto rr = __builtin_amdgcn_permlane32_swap(__float_as_uint(pmax), __float_as_uint(pmax), false, false);
    pmax = fmaxf(__uint_as_float(rr[0]), __uint_as_float(rr[1])); }
  if (__builtin_expect(__all(pmax - m_reg <= THR / SCALE), 1)) { mn = m_reg; alpha = 1.f; }
  else { mn = fmaxf(m_reg, pmax); alpha = __builtin_amdgcn_exp2f((m_reg - mn) * C); m_reg = mn; }
  float mnC = -mn * C;
#pragma unroll
  for (int r = 0; r < 16; ++r) p0[r] = fmaf(p0[r], C, mnC);
#pragma unroll
  for (int r = 0; r < 16; ++r) p1[r] = fmaf(p1[r], C, mnC);
#pragma unroll
  for (int r = 0; r < 16; ++r) p0[r] = __builtin_amdgcn_exp2f(p0[r]);
}
__device__ __forceinline__ void finishSM(f32x16& p0, f32x16& p1, float alpha, float& l_reg, bf16x8& pa0, bf16x8& pa1, bf16x8& pa2, bf16x8& pa3) {
#pragma unroll
  for (int r = 0; r < 16; ++r) p1[r] = __builtin_amdgcn_exp2f(p1[r]);
  float ps = 0;
#pragma unroll
  for (int r = 0; r < 16; ++r) ps += p0[r];
#pragma unroll
  for (int r = 0; r < 16; ++r) ps += p1[r];
  { auto rr = __builtin_amdgcn_permlane32_swap(__float_as_uint(ps), __float_as_uint(ps), false, false);
    ps = __uint_as_float(rr[0]) + __uint_as_float(rr[1]); }
  l_reg = l_reg * alpha + ps;
#define PK4(P, BASE, OUT) do { unsigned a0 = cvtpk(P[BASE + 0], P[BASE + 1]), a1 = cvtpk(P[BASE + 2], P[BASE + 3]);   \
    unsigned b0 = cvtpk(P[BASE + 4], P[BASE + 5]), b1 = cvtpk(P[BASE + 6], P[BASE + 7]);                              \
    auto r0 = __builtin_amdgcn_permlane32_swap(a0, b0, false, false); auto r1 = __builtin_amdgcn_permlane32_swap(a1, b1, false, false); \
    u32x4 w = {r0[0], r1[0], r0[1], r1[1]}; OUT = *reinterpret_cast<bf16x8*>(&w); } while (0)
  PK4(p0, 0, pa0); PK4(p0, 8, pa1); PK4(p1, 0, pa2); PK4(p1, 8, pa3);
#undef PK4
}
__device__ __forceinline__ void qkt(f32x16& p0, f32x16& p1, const char* Ks, const bf16x8* qr, const char* Qr, int r32, int hi) {
  p0 = f32x16{}; p1 = f32x16{};
#pragma unroll
  for (int d0 = 0; d0 < 12; ++d0) { int cb = (d0 * 16 + hi * 8) * 2;
    bf16x8 b0 = *reinterpret_cast<const bf16x8*>(Ks + KSWZ(r32, cb));
    bf16x8 b1 = *reinterpret_cast<const bf16x8*>(Ks + KSWZ(32 + r32, cb));
    bf16x8 q;
    if (d0 < 8) q = qr[d0];
    else q = *reinterpret_cast<const bf16x8*>(Qr + r32 * 128 + ((((d0 - 8) * 16 + hi * 8) * 2) ^ ((r32 & 7) << 4)));
    p0 = __builtin_amdgcn_mfma_f32_32x32x16_bf16(b0, q, p0, 0, 0, 0);
    p1 = __builtin_amdgcn_mfma_f32_32x32x16_bf16(b1, q, p1, 0, 0, 0); }
}
__device__ __forceinline__ int v_st(int k, int c) { const int kk = (k & ~0xC) | ((k & 4) << 1) | ((k & 8) >> 1); return ((kk >> 3) * 4 + (c >> 5)) * 512 + ((kk & 7) * 32 + (c & 31)) * 2; }
__device__ __forceinline__ int v_rd_base(int lane) { return ((lane & 3) << 3) | (((lane >> 2) & 3) << 6) | (((lane >> 4) & 1) << 5) | (((lane >> 5) & 1) << 8); }
constexpr int v_rd_off(int d0, int ks, int half) { return d0 * 512 + ks * 4096 + half * 2048; }
template <int OFF> __device__ __forceinline__ s16x4 tr_read(int vb) {
  s16x4 r; asm volatile("ds_read_b64_tr_b16 %0, %1 offset:%2" : "=&v"(r) : "v"(vb), "i"(OFF) : "memory"); return r;
}
template <int D0> __device__ __forceinline__ void pv_one(f32x16& od, int vb, bf16x8 pa0, bf16x8 pa1, bf16x8 pa2, bf16x8 pa3) {
  const s16x4 l0 = tr_read<v_rd_off(D0, 0, 0)>(vb), h0 = tr_read<v_rd_off(D0, 0, 1)>(vb), l1 = tr_read<v_rd_off(D0, 1, 0)>(vb), h1 = tr_read<v_rd_off(D0, 1, 1)>(vb);
  const s16x4 l2 = tr_read<v_rd_off(D0, 2, 0)>(vb), h2 = tr_read<v_rd_off(D0, 2, 1)>(vb), l3 = tr_read<v_rd_off(D0, 3, 0)>(vb), h3 = tr_read<v_rd_off(D0, 3, 1)>(vb);
  asm volatile("s_waitcnt lgkmcnt(0)" ::: "memory"); SBAR();
#define PK(L, H) (bf16x8){L[0], L[1], L[2], L[3], H[0], H[1], H[2], H[3]}
  od = __builtin_amdgcn_mfma_f32_32x32x16_bf16(pa0, PK(l0, h0), od, 0, 0, 0);
  od = __builtin_amdgcn_mfma_f32_32x32x16_bf16(pa1, PK(l1, h1), od, 0, 0, 0);
  od = __builtin_amdgcn_mfma_f32_32x32x16_bf16(pa2, PK(l2, h2), od, 0, 0, 0);
  od = __builtin_amdgcn_mfma_f32_32x32x16_bf16(pa3, PK(l3, h3), od, 0, 0, 0);
#undef PK
}
__device__ __forceinline__ void pv_d0(f32x16* o, int vb, bf16x8 pa0, bf16x8 pa1, bf16x8 pa2, bf16x8 pa3) {
  pv_one<0>(o[0], vb, pa0, pa1, pa2, pa3); pv_one<1>(o[1], vb, pa0, pa1, pa2, pa3); pv_one<2>(o[2], vb, pa0, pa1, pa2, pa3); pv_one<3>(o[3], vb, pa0, pa1, pa2, pa3);
}

__device__ __forceinline__ void attn_unit(const bf16_t* __restrict__ Qb, const bf16_t* __restrict__ Kg, const bf16_t* __restrict__ Vg, bf16_t* __restrict__ Ob,
                                          int r0, int n0, int r1, int NT, char* lds) {
  int tid = threadIdx.x; asm volatile("" : "+v"(tid));
  const int wid = tid >> 6, lane = tid & 63, r32 = lane & 31, hi = lane >> 5;
  char* V_lds = lds + OFF_V; char* K_lds = lds + OFF_K;
  float* ws = (float*)(lds + OFF_WS) + wid * 64; float* li_l = ws; float* al_l = ws + 32;
  float m_reg = -1e30f, l_reg = 0; f32x16 o[4] = {}; bf16x8 qr[8];
  const bf16_t* Qw = Qb + (long)(wid * QBLK + r32) * LDQ + hi * 8;
  char* Qr = lds + OFF_QR + wid * 4096;
#pragma unroll
  for (int d0 = 0; d0 < 8; ++d0) qr[d0] = *reinterpret_cast<const bf16x8*>(Qw + d0 * 16);
#pragma unroll
  for (int d0 = 8; d0 < 12; ++d0) { const bf16x8 q = *reinterpret_cast<const bf16x8*>(Qw + d0 * 16);
    *reinterpret_cast<bf16x8*>(Qr + r32 * 128 + ((((d0 - 8) * 16 + hi * 8) * 2) ^ ((r32 & 7) << 4))) = q; }
  const int sr = tid >> 4, sc = (tid & 15) * 8, vst0 = v_st(sr, sc), vst1 = v_st(32 + sr, sc);
  unsigned kgo[3], kst[3];
#pragma unroll
  for (int i = 0; i < 3; ++i) { const int id = tid + 512 * i, kr_ = id / 24, kc_ = id % 24; kgo[i] = (unsigned)(kr_ * LDK + kc_ * 8) * 2u; kst[i] = (unsigned)KSWZ(kr_, kc_ * 16); }
  const unsigned vgo0 = (unsigned)(sr * LDV + sc) * 2u, vgo1 = vgo0 + 32u * LDV * 2u;
  const int vb0 = (int)(uintptr_t)V_lds + v_rd_base(lane);
  bf16x8 vs0, vs1, ks0, ks1, ks2;
#define TROW(j) ((j) < n0 ? r0 + 64 * (j) : r1 + 64 * ((j) - n0))
#define SLOAD(j) do { const long tr_ = TROW(j); const char* Vt = (const char*)(Vg + tr_ * LDV); const char* Kt = (const char*)(Kg + tr_ * LDK);     \
    vs0 = *reinterpret_cast<const bf16x8*>(Vt + vgo0); vs1 = *reinterpret_cast<const bf16x8*>(Vt + vgo1); \
    ks0 = *reinterpret_cast<const bf16x8*>(Kt + kgo[0]); ks1 = *reinterpret_cast<const bf16x8*>(Kt + kgo[1]); ks2 = *reinterpret_cast<const bf16x8*>(Kt + kgo[2]); } while (0)
#define SWRITE(b) do { *(bf16x8*)(V_lds + (b) * SHM_V + vst0) = vs0; *(bf16x8*)(V_lds + (b) * SHM_V + vst1) = vs1; \
    *(bf16x8*)(K_lds + (b) * SHM_K + kst[0]) = ks0; *(bf16x8*)(K_lds + (b) * SHM_K + kst[1]) = ks1; *(bf16x8*)(K_lds + (b) * SHM_K + kst[2]) = ks2; } while (0)
#define RESC(a) do { if (__any((a) < 1.f)) { if (hi == 0) al_l[r32] = (a); asm volatile("s_waitcnt lgkmcnt(0)" ::: "memory"); \
    _Pragma("unroll") for (int d = 0; d < 4; ++d) _Pragma("unroll") for (int r = 0; r < 16; ++r) o[d][r] *= al_l[crow(r, hi)]; } } while (0)
  f32x16 pA0, pA1, pB0, pB1; float mnA, mnB, alA, alB; bf16x8 pa0, pa1, pa2, pa3;
  SLOAD(0); asm volatile("s_waitcnt vmcnt(0)" ::: "memory"); SWRITE(0); __syncthreads();
  qkt(pA0, pA1, K_lds, qr, Qr, r32, hi); partialSM(pA0, pA1, m_reg, mnA, alA);
  SLOAD(1);
  asm volatile("s_waitcnt vmcnt(0)" ::: "memory"); SWRITE(1); __syncthreads();
  for (int j = 1; j + 1 < NT; j += 2) {
    SBAR(); qkt(pB0, pB1, K_lds + SHM_K, qr, Qr, r32, hi);
    finishSM(pA0, pA1, alA, l_reg, pa0, pa1, pa2, pa3); SBAR();
    SLOAD(j + 1); SBAR();
    pv_d0(o, vb0, pa0, pa1, pa2, pa3); partialSM(pB0, pB1, m_reg, mnB, alB);
    __syncthreads(); asm volatile("s_waitcnt vmcnt(0)" ::: "memory"); SWRITE(0);
    RESC(alB); __syncthreads();
    SBAR(); qkt(pA0, pA1, K_lds, qr, Qr, r32, hi);
    finishSM(pB0, pB1, alB, l_reg, pa0, pa1, pa2, pa3); SBAR();
    SLOAD(j + 2); SBAR();
    pv_d0(o, vb0 + SHM_V, pa0, pa1, pa2, pa3); partialSM(pA0, pA1, m_reg, mnA, alA);
    __syncthreads(); asm volatile("s_waitcnt vmcnt(0)" ::: "memory"); SWRITE(1);
    RESC(alA); __syncthreads();
  }
  SBAR(); qkt(pB0, pB1, K_lds + SHM_K, qr, Qr, r32, hi);
  finishSM(pA0, pA1, alA, l_reg, pa0, pa1, pa2, pa3); SBAR();
  pv_d0(o, vb0, pa0, pa1, pa2, pa3); partialSM(pB0, pB1, m_reg, mnB, alB);
  __syncthreads(); RESC(alB);
  finishSM(pB0, pB1, alB, l_reg, pa0, pa1, pa2, pa3); SBAR();
  pv_d0(o, vb0 + SHM_V, pa0, pa1, pa2, pa3);
  if (hi == 0) li_l[r32] = l_reg; asm volatile("s_waitcnt lgkmcnt(0)" ::: "memory");
  float rli[16];
#pragma unroll
  for (int r = 0; r < 16; ++r) rli[r] = __builtin_amdgcn_rcpf(li_l[crow(r, hi)]);
  __syncthreads();
  { bf16_t* stg = (bf16_t*)(lds + wid * 8192);
#pragma unroll
    for (int r = 0; r < 16; ++r) { const int orow = crow(r, hi);
#pragma unroll
      for (int d0 = 0; d0 < 4; ++d0) { const unsigned pk = cvtpk(o[d0][r] * rli[r], 0.f); stg[orow * 128 + d0 * 32 + r32] = (bf16_t)(pk & 0xffffu); } }
    asm volatile("s_waitcnt lgkmcnt(0)" ::: "memory");
    bf16_t* Ow = Ob + (long)(wid * QBLK) * LDO;
#pragma unroll
    for (int i = 0; i < 8; ++i) { const int row = i * 4 + (lane >> 4), ch = lane & 15; const u32x4 v = *(const u32x4*)(stg + row * 128 + ch * 8); *(u32x4*)(Ow + (long)row * LDO + ch * 8) = v; } }
  __syncthreads();
#undef TROW
#undef SLOAD
#undef SWRITE
#undef RESC
}
#undef KSWZ
#undef SBAR
}
constexpr int NWAVES = 8;
#ifndef MK_SPLIT
#define MK_SPLIT 0
#endif

constexpr int DM = 1024, NB = 8, SL = 2048, CL = 256, MLAT = NB * SL, MCTX = NB * CL, MT = MLAT + MCTX;
constexpr int NIN = 2048;
constexpr int FF = 2816, NUP = 2 * FF;
constexpr int NPH = 20;
constexpr float EPS = 1e-6f;

constexpr size_t MiB = 1u << 20;
constexpr size_t WS_CTL = 0, CTL_ZERO_BYTES = 64 * 1024;
constexpr size_t WS_MOD = 1 * MiB;
constexpr size_t WS_ROPE = 1 * MiB + 512 * 1024;
constexpr size_t WS_SSQ = 2 * MiB;
constexpr size_t WS_WIN = 4 * MiB, WIN_STRIDE = (size_t)NIN * DM * 2;
constexpr size_t WS_WUQ = 12 * MiB, WUQ_STRIDE = (size_t)768 * 384 * 2;
constexpr size_t WS_WUKV = 13 * MiB + 256 * 1024, WUKV_STRIDE = (size_t)1024 * 256 * 2;
constexpr size_t WS_WOUT = 14 * MiB + 512 * 1024, WOUT_STRIDE = (size_t)DM * DM * 2;
constexpr size_t WS_WUP = 19 * MiB, WUP_STRIDE = (size_t)NUP * DM * 2;
constexpr size_t WS_WDOWN = 41 * MiB, WDOWN_STRIDE = (size_t)DM * FF * 2;
constexpr size_t WS_DFT = 52 * MiB;
constexpr size_t WS_DFTC = 68 * MiB;
constexpr size_t WS_CST = 68 * MiB + 256 * 1024;
constexpr size_t WS_WF = 248 * MiB;
constexpr size_t WS_XCTX = 69 * MiB;
constexpr size_t WS_XN = 77 * MiB;
constexpr size_t WS_Q = WS_XN, WS_YC = WS_XN + 27 * MiB;
constexpr size_t WS_P = 113 * MiB;
constexpr size_t WS_YCAT = WS_P, WS_ACT = WS_P;
constexpr size_t WS_YFP = WS_P + 36 * MiB;
constexpr size_t WS_K = 185 * MiB;
constexpr size_t WS_V = 212 * MiB;
constexpr size_t WS_ZT = 230 * MiB;
constexpr size_t WS_ZTC = WS_ZT + 16 * MiB;
constexpr size_t WS_SSX = 250 * MiB;
constexpr size_t WS_PB = 252 * MiB;
constexpr size_t WS_UB = 253 * MiB;
constexpr size_t WS_END = 254 * MiB;
static_assert(WS_WUQ + 2 * WUQ_STRIDE <= WS_WUKV && WS_WUKV + 2 * WUKV_STRIDE <= WS_WOUT && WS_WOUT + 2 * WOUT_STRIDE <= WS_WUP && WS_WUP + 2 * WUP_STRIDE <= WS_WDOWN && WS_WDOWN + 2 * WDOWN_STRIDE <= WS_DFT, "weights map");
static_assert(WS_SSQ + (size_t)MT * 80 <= WS_WIN && WS_XN + (size_t)MT * DM * 2 <= WS_P && WS_P + (size_t)MT * NIN * 2 <= WS_K && WS_K + (size_t)MT * 768 * 2 <= WS_V && WS_V + (size_t)MT * 512 * 2 <= WS_ZT, "activation map");
static_assert(WS_ACT + (size_t)MT * FF * 2 <= WS_V && WS_YC + (size_t)MT * 256 * 2 <= WS_P, "overlay map");
constexpr int CW_BAR = 4096;

constexpr int RING_OFF = 0, RING_BYTES = 131072;
constexpr int LDSCTL_OFF = RING_BYTES, MISC_OFF = LDSCTL_OFF + 320, PTR_OFF = LDSCTL_OFF + 512, EPIX_OFF = LDSCTL_OFF + 1024;
constexpr int LDS_BYTES = 147456;
static_assert(EPIX_OFF + 4096 <= LDS_BYTES, "LDS map");

#define GAS __attribute__((address_space(1)))
#define LAS __attribute__((address_space(3)))
typedef unsigned short bf16;
typedef unsigned v4u __attribute__((ext_vector_type(4)));
typedef unsigned v2u __attribute__((ext_vector_type(2)));
typedef float f32x4 __attribute__((ext_vector_type(4)));
typedef GAS unsigned gu32;
#define RLX_AGENT __ATOMIC_RELAXED, __HIP_MEMORY_SCOPE_AGENT
#define LDS_WAIT() asm volatile("s_waitcnt lgkmcnt(0)" ::: "memory")
#define VM_WAIT() asm volatile("s_waitcnt vmcnt(0)" ::: "memory")
__device__ __forceinline__ unsigned f2bf(float f) { unsigned u = __builtin_bit_cast(unsigned, f); return (u + 0x7fffu + ((u >> 16) & 1u)) >> 16; }
__device__ __forceinline__ unsigned pk2(float lo, float hi) { return f2bf(lo) | (f2bf(hi) << 16); }
__device__ __forceinline__ float bf2f(unsigned h) { return __builtin_bit_cast(float, h << 16); }

#define XB_TMO      128
#define XB_XCNT(j)  (256  + 64 * (j))
#define XB_XSUB(j)  (1280 + 64 * (j))
#define XB_XGEN(j)  (2304 + 64 * (j))
#define XB_TOP      3328
#define XB_TOPGEN   3392
#define XCD_BAR_WORDS 3456
#define XB_SPIN_CAP (1u << 20)
__device__ __forceinline__ unsigned xb_ld(unsigned* p)              { return __hip_atomic_load(p, __ATOMIC_RELAXED, __HIP_MEMORY_SCOPE_AGENT); }
__device__ __forceinline__ unsigned xb_add(unsigned* p, unsigned v) { return __hip_atomic_fetch_add(p, v, __ATOMIC_RELAXED, __HIP_MEMORY_SCOPE_AGENT); }
__device__ __forceinline__ unsigned xb_xcc_id() { return (unsigned)__builtin_amdgcn_s_getreg((3 << 11) | 20) & 0xFu; }
#define XB_SPIN(cond, bar) do { unsigned _sp = 0; while (cond) { __builtin_amdgcn_s_sleep(1); \
    if ((++_sp & 255u) == 0u) { if (xb_ld(&(bar)[XB_TMO])) break; if (_sp > XB_SPIN_CAP) { atomicAdd(&(bar)[XB_TMO], 1u); break; } } } } while (0)
struct XcdBarrier { unsigned* bar; unsigned x; volatile LAS unsigned* st; };
__device__ __forceinline__ XcdBarrier xcd_barrier_post(unsigned* bar, volatile LAS unsigned* st) {
    XcdBarrier b; b.bar = bar; b.x = xb_xcc_id(); b.st = st;
    if (threadIdx.x == 0) (void)xb_add(&bar[XB_XCNT(b.x)], 1u);
    return b;
}
__device__ __forceinline__ void xcd_barrier_complete(unsigned* bar, unsigned x, unsigned& nloc, unsigned& nx) {
    const unsigned G = gridDim.x * gridDim.y * gridDim.z;
    unsigned sum, cnt, mine, sp = 0u;
    for (;;) {
        sum = 0u; cnt = 0u; mine = 0u;
#pragma unroll
        for (unsigned j = 0; j < 16; ++j) { const unsigned c = xb_ld(&bar[XB_XCNT(j)]); sum += c; cnt += (c > 0u) ? 1u : 0u; mine = (j == x) ? c : mine; }
        if (sum == G) break;
        __builtin_amdgcn_s_sleep(1);
        if ((++sp & 255u) == 0u) { if (xb_ld(&bar[XB_TMO])) break; if (sp > XB_SPIN_CAP) { atomicAdd(&bar[XB_TMO], 1u); break; } }
    }
    nloc = mine > 0u ? mine : 1u; nx = cnt > 0u ? cnt : 1u;
}
__device__ __forceinline__ void xcd_barrier(const XcdBarrier& b) {
    asm volatile("s_waitcnt vmcnt(0)" ::: "memory");
    __syncthreads();
    if (threadIdx.x == 0) {
        unsigned* bar = b.bar;
        __builtin_amdgcn_s_waitcnt(0);
        unsigned nloc = b.st[0], nx = b.st[1];
        if (nloc == 0u) { xcd_barrier_complete(bar, b.x, nloc, nx); b.st[0] = nloc; b.st[1] = nx; }
        const unsigned old = xb_add(&bar[XB_XSUB(b.x)], 1u);
        const unsigned gen = old / nloc;
        if (old + 1u == (gen + 1u) * nloc) {
            __builtin_amdgcn_fence(__ATOMIC_RELEASE, "agent");
            asm volatile("s_waitcnt vmcnt(0)" ::: "memory");
            const unsigned og = xb_add(&bar[XB_TOP], 1u);
            const unsigned tg = og / nx;
            if (og + 1u == (tg + 1u) * nx) xb_add(&bar[XB_TOPGEN], 1u);
            else XB_SPIN(xb_ld(&bar[XB_TOPGEN]) == tg, bar);
            __builtin_amdgcn_fence(__ATOMIC_ACQUIRE, "agent");
            xb_add(&bar[XB_XGEN(b.x)], 1u);
            asm volatile("s_waitcnt vmcnt(0)" ::: "memory");
        } else {
            XB_SPIN(xb_ld(&bar[XB_XGEN(b.x)]) == gen, bar);
            __builtin_amdgcn_fence(__ATOMIC_ACQUIRE, "agent");
            asm volatile("s_waitcnt vmcnt(0)" ::: "memory");
        }
    }
    __syncthreads();
}

struct Args { const float* in[22]; float* out; unsigned char* ws; int ph_lo, ph_hi; };
enum { I_X = 0, I_C, I_CTX, I_CCTX, I_ADAW, I_ADAB, I_N1G, I_WIN, I_QNG, I_KVNG, I_WUQ, I_WUKV, I_SCW, I_SCB, I_ONG, I_WOUT, I_N2G, I_WUP, I_FCW, I_FCB, I_WDOWN, I_FING };

struct Frame {
    LAS unsigned char* lds; char* ldsg;
    volatile LAS unsigned* MISC;
    int tid, lane, wave, vcu, G, bx;
    unsigned char* ws; float* out;
};

__device__ __forceinline__ const float* inptr(const Frame& F, int i) {
    const LAS unsigned* T = (const LAS unsigned*)(F.lds + PTR_OFF) + 2 * i;
    const unsigned lo = __builtin_amdgcn_readfirstlane(T[0]), hi = __builtin_amdgcn_readfirstlane(T[1]);
    return (const float*)(const GAS float*)(((unsigned long long)hi << 32) | (unsigned long long)lo);
}
__device__ __forceinline__ float wave_sum(float v) {
#pragma unroll
    for (int o = 1; o < 64; o <<= 1) v += __shfl_xor(v, o);
    return v;
}

__device__ __forceinline__ void tr_item(const float* W, int ldw, int k0, int c0, bf16* WT, int ldt, int r0, const float* ks, LAS float* scr, int lane) {
    f32x4 v[8];
#pragma unroll
    for (int i = 0; i < 8; ++i) { const int kk = 8 * i + (lane >> 3); v[i] = *(const GAS f32x4*)(W + (size_t)(k0 + kk) * ldw + c0 + 4 * (lane & 7)); }
#pragma unroll
    for (int i = 0; i < 8; ++i) { const int kk = 8 * i + (lane >> 3); const float sc = ks ? ks[k0 + kk] : 1.0f; LAS float* d = scr + kk * 33 + 4 * (lane & 7);
        d[0] = v[i][0] * sc; d[1] = v[i][1] * sc; d[2] = v[i][2] * sc; d[3] = v[i][3] * sc; }
    LDS_WAIT(); asm volatile("" ::: "memory");
    const int c = lane & 7;
#pragma unroll
    for (int j = 0; j < 4; ++j) { const int n = (lane >> 3) + 8 * j; const LAS float* s = scr + (8 * c) * 33 + n;
        v4u o; o.x = pk2(s[0 * 33], s[1 * 33]); o.y = pk2(s[2 * 33], s[3 * 33]); o.z = pk2(s[4 * 33], s[5 * 33]); o.w = pk2(s[6 * 33], s[7 * 33]);
        *(GAS v4u*)(WT + (size_t)(r0 + n) * ldt + k0 + 8 * c) = o; }
    LDS_WAIT(); asm volatile("" ::: "memory");
}
__device__ __forceinline__ void p0_prologue(Frame& F, int sub) {
    unsigned char* ws = F.ws;
    float* MOD = (float*)(ws + WS_MOD);
    if (F.bx < 192 && (sub & 1)) {
        const int l = F.bx / 96, cb = F.bx % 96;
        LAS float* S = (LAS float*)(F.lds + F.wave * 4608);
        const float* cin = inptr(F, I_C); const float* cctx = inptr(F, I_CCTX);
        for (int i = F.lane; i < 9 * 128; i += 64) { const int r = i >> 7, kk = i & 127, k = 128 * F.wave + kk; const float cv = (r < 8) ? cin[r * 1024 + k] : cctx[k]; S[i] = cv / (1.0f + __expf(-cv)); }
        LDS_WAIT(); asm volatile("" ::: "memory");
        f32x4 acc[9];
#pragma unroll
        for (int r = 0; r < 9; ++r) acc[r] = (f32x4){0.f, 0.f, 0.f, 0.f};
        const int kr = F.lane >> 4, cl = F.lane & 15;
        const float* W = inptr(F, I_ADAW) + (size_t)l * 1024 * 6144 + (size_t)(128 * F.wave) * 6144 + 64 * cb + 4 * cl;
#pragma unroll 4
        for (int i = 0; i < 32; ++i) { const int kk = 4 * i + kr; const f32x4 w = *(const f32x4*)(W + (size_t)kk * 6144);
#pragma unroll
            for (int r = 0; r < 9; ++r) acc[r] += w * S[r * 128 + kk]; }
        LAS float* RED = (LAS float*)(F.lds + 40960);
#pragma unroll
        for (int r = 0; r < 9; ++r)
#pragma unroll
            for (int e = 0; e < 4; ++e) { float v = acc[r][e]; v += __shfl_xor(v, 16); v += __shfl_xor(v, 32); if (kr == 0) RED[(F.wave * 9 + r) * 64 + 4 * cl + e] = v; }
        __syncthreads();
        for (int i = F.tid; i < 576; i += 512) { const int r = i >> 6, col = i & 63; float s = 0.f;
#pragma unroll
            for (int w = 0; w < 8; ++w) s += RED[(w * 9 + r) * 64 + col];
            MOD[(size_t)(l * 9 + r) * 6144 + 64 * cb + col] = s + inptr(F, I_ADAB)[l * 6144 + 64 * cb + col]; }
        __syncthreads();
    }
    if (F.bx == 255 % F.G) {
        float* RC = (float*)(ws + WS_ROPE); float* RS = RC + 1024;
        for (int idx = F.tid; idx < 1024; idx += 512) { const int pos = idx >> 4, i = idx & 15; const float inv = powf(10000.0f, -(float)(2 * i) / 32.0f); const float ang = (float)pos * inv; RC[idx] = cosf(ang); RS[idx] = sinf(ang); }
    }
    LAS float* scr = (LAS float*)(F.lds + F.wave * 16384);
    const int gw = F.vcu * NWAVES + F.wave, NGW = F.G * NWAVES;
    constexpr int I_WINA = 22 * 16, I_WINB = 24 * 16, I_PAD = 8, I_FOLD = 64, I_UQ = 6 * 24, I_UKV = 4 * 32, I_OUT = 16 * 32, I_UP = 16 * 176, I_DOWN = 44 * 32;
    constexpr int PER_LAYER = I_WINA + I_WINB + I_PAD + I_FOLD + I_UQ + I_UKV + I_OUT + I_UP + I_DOWN;
    constexpr int I_DFT = 2048, I_DFTC = 256, I_CST = 512;
    constexpr int NITEMS = 2 * PER_LAYER + I_DFT + I_DFTC + I_CST;
    for (int it = gw; it < NITEMS; it += NGW) {
        int r = it;
        { int cat = 2; if (r < 2 * PER_LAYER) { const int q = r % PER_LAYER;
              cat = q < I_WINA + I_WINB + I_PAD ? 1 : q < I_WINA + I_WINB + I_PAD + I_FOLD ? 3 : q < I_WINA + I_WINB + I_PAD + I_FOLD + I_UQ + I_UKV + I_OUT ? 4 : q < PER_LAYER - I_DOWN ? 5 : 6; }
          if (!((sub >> cat) & 1)) continue; }
        if (r < 2 * PER_LAYER) {
            const int l = r / PER_LAYER; r -= l * PER_LAYER;
            bf16* WinT = (bf16*)(ws + WS_WIN + l * WIN_STRIDE);
            const float* win = inptr(F, I_WIN) + (size_t)l * 1024 * 1728;
            if (r < I_WINA) { const int kb = r / 22, nb = r % 22; tr_item(win, 1728, 64 * kb, 32 * nb, WinT, 1024, 32 * nb, nullptr, scr, F.lane); continue; } r -= I_WINA;
            if (r < I_WINB) { const int kb = r / 24, nb = r % 24; tr_item(win, 1728, 64 * kb, 960 + 32 * nb, WinT, 1024, 1280 + 32 * nb, nullptr, scr, F.lane); continue; } r -= I_WINB;
            if (r < I_PAD) { const v4u z = {0u, 0u, 0u, 0u};
#pragma unroll
                for (int j = 0; j < 16; ++j) { const int q = j * 64 + F.lane; *(GAS v4u*)(WinT + (size_t)(704 + 8 * r + (q >> 7)) * 1024 + (q & 127) * 8) = z; } continue; } r -= I_PAD;
            if (r < I_FOLD) { bf16* WF = (bf16*)(ws + WS_WF) + (size_t)l * 1024 * 256;
#pragma unroll 4
                for (int i = 0; i < 16; ++i) { const int k = 16 * r + i; const f32x4 v = *(const GAS f32x4*)(win + (size_t)k * 1728 + 704 + 4 * F.lane);
                    v2u o; o.x = pk2(v[0], v[1]); o.y = pk2(v[2], v[3]); *(GAS v2u*)(WF + (size_t)k * 256 + 4 * F.lane) = o; } continue; } r -= I_FOLD;
            if (r < I_UQ) { const int kb = r / 24, nb = r % 24; tr_item(inptr(F, I_WUQ) + (size_t)l * 384 * 768, 768, 64 * kb, 32 * nb, (bf16*)(ws + WS_WUQ + l * WUQ_STRIDE), 384, 32 * nb, inptr(F, I_QNG) + l * 384, scr, F.lane); continue; } r -= I_UQ;
            if (r < I_UKV) { const int kb = r / 32, nb = r % 32; tr_item(inptr(F, I_WUKV) + (size_t)l * 256 * 1024, 1024, 64 * kb, 32 * nb, (bf16*)(ws + WS_WUKV + l * WUKV_STRIDE), 256, 32 * nb, inptr(F, I_KVNG) + l * 256, scr, F.lane); continue; } r -= I_UKV;
            if (r < I_OUT) { const int kb = r / 32, nb = r % 32; tr_item(inptr(F, I_WOUT) + (size_t)l * 1024 * 1024, 1024, 64 * kb, 32 * nb, (bf16*)(ws + WS_WOUT + l * WOUT_STRIDE), 1024, 32 * nb, inptr(F, I_ONG) + l * 1024, scr, F.lane); continue; } r -= I_OUT;
            if (r < I_UP) { const int kb = r / 176, nb = r % 176;
                const int j = nb >> 3, h = (nb >> 2) & 1, q = nb & 3;
                tr_item(inptr(F, I_WUP) + (size_t)l * 1024 * NUP, NUP, 64 * kb, h * FF + 128 * j + 32 * q, (bf16*)(ws + WS_WUP + l * WUP_STRIDE), 1024, 32 * nb, nullptr, scr, F.lane); continue; } r -= I_UP;
            { const int kb = r / 32, nb = r % 32; tr_item(inptr(F, I_WDOWN) + (size_t)l * FF * 1024, 1024, 64 * kb, 32 * nb, (bf16*)(ws + WS_WDOWN + l * WDOWN_STRIDE), FF, 32 * nb, nullptr, scr, F.lane); continue; }
        }
        r -= 2 * PER_LAYER;
        if (r < I_DFT) { const int k1 = r; bf16* D = (bf16*)(ws + WS_DFT) + (size_t)k1 * 4096;
#pragma unroll
            for (int j = 0; j < 8; ++j) { const int n0 = 512 * j + 8 * F.lane; float v[8];
#pragma unroll
                for (int e = 0; e < 8; ++e) { const int n = n0 + e, n1 = n & 2047; const float x = (float)((k1 * n1) & 2047) * (1.0f / 1024.0f); v[e] = (n < 2048) ? cospif(x) : -sinpif(x); }
                v4u o; o.x = pk2(v[0], v[1]); o.y = pk2(v[2], v[3]); o.z = pk2(v[4], v[5]); o.w = pk2(v[6], v[7]); *(GAS v4u*)(D + n0) = o; }
            continue; }
        r -= I_DFT;
        if (r >= I_DFTC) { r -= I_DFTC;
            const int sn = r >> 8, g = (r >> 6) & 3, k2 = r & 63; float v[4];
#pragma unroll
            for (int e = 0; e < 4; ++e) { const int j = 4 * F.lane + e; const float x = (float)((k2 * (j & 63)) & 63) * (1.0f / 32.0f); v[e] = ((j >> 6) == g) ? (sn ? sinpif(x) : cospif(x)) : 0.0f; }
            v2u o; o.x = pk2(v[0], v[1]); o.y = pk2(v[2], v[3]); *(GAS v2u*)((bf16*)(ws + WS_CST) + (size_t)r * 256 + 4 * F.lane) = o; continue; }
        { const int k1 = r; bf16* D = (bf16*)(ws + WS_DFTC) + (size_t)k1 * 512; const int n0 = 8 * F.lane; float v[8];
#pragma unroll
            for (int e = 0; e < 8; ++e) { const int n = n0 + e, n1 = n & 255; const float x = (float)((k1 * n1) & 255) * (1.0f / 128.0f); v[e] = (n < 256) ? cospif(x) : -sinpif(x); }
            v4u o; o.x = pk2(v[0], v[1]); o.y = pk2(v[2], v[3]); o.z = pk2(v[4], v[5]); o.w = pk2(v[6], v[7]); *(GAS v4u*)(D + n0) = o; }
    }
}

__device__ __forceinline__ void bias_item(const bf16* WT, int n, const float* mod  , int shofs, float* out, int N, int lane) {
    const v4u w0 = *(const GAS v4u*)(WT + (size_t)n * 1024 + 16 * lane), w1 = *(const GAS v4u*)(WT + (size_t)n * 1024 + 16 * lane + 8);
    float wv[16];
    wv[0] = bf2f(w0.x & 0xffffu); wv[1] = bf2f(w0.x >> 16); wv[2] = bf2f(w0.y & 0xffffu); wv[3] = bf2f(w0.y >> 16); wv[4] = bf2f(w0.z & 0xffffu); wv[5] = bf2f(w0.z >> 16); wv[6] = bf2f(w0.w & 0xffffu); wv[7] = bf2f(w0.w >> 16);
    wv[8] = bf2f(w1.x & 0xffffu); wv[9] = bf2f(w1.x >> 16); wv[10] = bf2f(w1.y & 0xffffu); wv[11] = bf2f(w1.y >> 16); wv[12] = bf2f(w1.z & 0xffffu); wv[13] = bf2f(w1.z >> 16); wv[14] = bf2f(w1.w & 0xffffu); wv[15] = bf2f(w1.w >> 16);
    for (int b = 0; b < 9; ++b) { const float* sh = mod + b * 6144 + shofs + 16 * lane; float a = 0.f;
#pragma unroll
        for (int q = 0; q < 4; ++q) { const f32x4 s = *(const f32x4*)(sh + 4 * q); a += (s[0] * wv[4 * q] + s[1] * wv[4 * q + 1]) + (s[2] * wv[4 * q + 2] + s[3] * wv[4 * q + 3]); }
        a = wave_sum(a); if (lane == 0) out[(size_t)b * N + n] = a; }
}
__device__ __forceinline__ void bias_phase(Frame& F) {
    const int gw = F.vcu * NWAVES + F.wave, NGW = F.G * NWAVES; const float* MODp = (const float*)(F.ws + WS_MOD);
    for (int it = gw; it < 2048 + 2 * 5632; it += NGW) {
        if (it < 2048) bias_item((const bf16*)(F.ws + WS_WIN + WIN_STRIDE), it, MODp + 9 * 6144, 0, (float*)(F.ws + WS_PB) + 9 * 2048, 2048, F.lane);
        else { const int q = it - 2048, l = q / 5632, n = q % 5632; bias_item((const bf16*)(F.ws + WS_WUP + l * WUP_STRIDE), n, MODp + l * 9 * 6144, 3072, (float*)(F.ws + WS_UB) + (size_t)l * 9 * 5632, 5632, F.lane); }
    }
}

__device__ __forceinline__ void norm_mod_phase(Frame& F, const float* src_lat, const float* src_ctx, int nrows, const float* g, const float* mod  , int shofs, int scofs, bf16* xb_lat, bf16* xb_ctx) {
    bf16* XN = (bf16*)(F.ws + WS_XN);
    const int gw = F.vcu * NWAVES + F.wave, NGW = F.G * NWAVES;
    for (int row = gw; row < nrows; row += NGW) {
        const float* xr = row < MLAT ? src_lat + (size_t)row * DM : src_ctx + (size_t)(row - MLAT) * DM;
        const int r = row < MLAT ? (row >> 11) : 8;
        const float* sh = mod + r * 6144 + shofs; const float* sc = mod + r * 6144 + scofs;
        f32x4 v[4]; float ss = 0.f;
#pragma unroll
        for (int j = 0; j < 4; ++j) { v[j] = *(const f32x4*)(xr + 256 * j + 4 * F.lane); ss += (v[j][0] * v[j][0] + v[j][1] * v[j][1]) + (v[j][2] * v[j][2] + v[j][3] * v[j][3]); }
        const float rstd = 1.0f / sqrtf(wave_sum(ss) * (1.0f / DM) + EPS);
        bf16* xb = row < MLAT ? xb_lat + (size_t)row * DM : xb_ctx + (size_t)(row - MLAT) * DM;
#pragma unroll
        for (int j = 0; j < 4; ++j) { const int c = 256 * j + 4 * F.lane; const f32x4 gg = *(const f32x4*)(g + c), s1 = *(const f32x4*)(sc + c), s0 = *(const f32x4*)(sh + c);
            const f32x4 h = (v[j] * rstd) * gg * (s1 + 1.0f) + s0;
            v2u o; o.x = pk2(h[0], h[1]); o.y = pk2(h[2], h[3]); *(GAS v2u*)(XN + (size_t)row * DM + c) = o;
            v2u xo; xo.x = pk2(v[j][0], v[j][1]); xo.y = pk2(v[j][2], v[j][3]); *(GAS v2u*)(xb + c) = xo; }
    }
}
__device__ __forceinline__ void qkv_rows_phase(Frame& F, int l) {
    const bf16* P = (const bf16*)(F.ws + WS_P); bf16* Kb = (bf16*)(F.ws + WS_K); bf16* YC = (bf16*)(F.ws + WS_YC);
    const float* RC = (const float*)(F.ws + WS_ROPE); const float* RS = RC + 1024;
    const float* scw = inptr(F, I_SCW) + l * 3 * 256; const float* scb = inptr(F, I_SCB) + l * 256;
    const int gw = F.vcu * NWAVES + F.wave, NGW = F.G * NWAVES;
    const int nrows_conv = (l == 0) ? MT : MLAT;
    for (int row = gw; row < MT; row += NGW) {
        const bool lat = row < MLAT; const int t = lat ? (row & 2047) : ((row - MLAT) & 255); const int L = lat ? SL : CL;
        const bf16* pr = P + (size_t)row * NIN;
        { const float v = bf2f(pr[640 + F.lane]); const float pv = __shfl_xor(v, 16); float o = v;
          if (lat) { const int j = F.lane, ax = j >> 5, i = j & 15, x2 = (j >> 4) & 1; const int pos = ax ? (t & 63) : (t >> 6); const float c = RC[pos * 16 + i], s = RS[pos * 16 + i];
              o = x2 ? (pv * s + v * c) : (v * c - pv * s); }
          const bf16 ob = (bf16)f2bf(o);
#pragma unroll
          for (int h = 0; h < 4; ++h) Kb[(size_t)row * 768 + 192 * h + 128 + F.lane] = ob; }
        if (row < nrows_conv) { const int c = 4 * F.lane;
            const v2u bgv = *(const GAS v2u*)(pr + 1280 + c);
            const v2u cg1 = *(const GAS v2u*)(pr + 1536 + c), xv1 = *(const GAS v2u*)(pr + 1792 + c);
            v2u cg0 = {0u, 0u}, xv0 = {0u, 0u}, cg2 = {0u, 0u}, xv2 = {0u, 0u};
            if (t > 0) { cg0 = *(const GAS v2u*)(pr - NIN + 1536 + c); xv0 = *(const GAS v2u*)(pr - NIN + 1792 + c); }
            if (t < L - 1) { cg2 = *(const GAS v2u*)(pr + NIN + 1536 + c); xv2 = *(const GAS v2u*)(pr + NIN + 1792 + c); }
            const f32x4 w0 = *(const f32x4*)(scw + c), w1 = *(const f32x4*)(scw + 256 + c), w2 = *(const f32x4*)(scw + 512 + c), bb = *(const f32x4*)(scb + c);
            float y[4];
#pragma unroll
            for (int e = 0; e < 4; ++e) { const unsigned sh = (e & 1) * 16; const unsigned m = 0xffffu;
                const unsigned b_ = ((e < 2 ? bgv.x : bgv.y) >> sh) & m;
                const unsigned c0_ = ((e < 2 ? cg0.x : cg0.y) >> sh) & m, x0_ = ((e < 2 ? xv0.x : xv0.y) >> sh) & m;
                const unsigned c1_ = ((e < 2 ? cg1.x : cg1.y) >> sh) & m, x1_ = ((e < 2 ? xv1.x : xv1.y) >> sh) & m;
                const unsigned c2_ = ((e < 2 ? cg2.x : cg2.y) >> sh) & m, x2_ = ((e < 2 ? xv2.x : xv2.y) >> sh) & m;
                const float u0 = bf2f(c0_) * bf2f(x0_), u1 = bf2f(c1_) * bf2f(x1_), u2 = bf2f(c2_) * bf2f(x2_);
                y[e] = bf2f(b_) * (w0[e] * u0 + w1[e] * u1 + w2[e] * u2 + bb[e]); }
            v2u o; o.x = pk2(y[0], y[1]); o.y = pk2(y[2], y[3]); *(GAS v2u*)(YC + (size_t)row * 256 + c) = o; }
    }
}
__device__ __forceinline__ void zt_phase(Frame& F, int l) {
    const bf16* P = (const bf16*)(F.ws + WS_P);
    LAS bf16* T = (LAS bf16*)(F.lds + F.wave * 16384);
    const int gw = F.vcu * NWAVES + F.wave, NGW = F.G * NWAVES;
    const int nitems = 2048 + (l == 0 ? 256 : 0);
    for (int it = gw; it < nitems; it += NGW) {
        const bool lat = it < 2048; const int r = lat ? it : it - 2048;
        const int pb = r >> 3, cb = r & 7;
        const int row0 = (lat ? 0 : MLAT) + 64 * pb; const int L = lat ? SL : CL;
        const int b = lat ? (pb >> 5) : (pb >> 2); const int n0 = (64 * pb) & (L - 1);
        bf16* ZT = lat ? (bf16*)(F.ws + WS_ZT) : (bf16*)(F.ws + WS_ZTC);
#pragma unroll
        for (int i = 0; i < 8; ++i) { const int pos = 8 * i + (F.lane >> 3), ch = F.lane & 7;
            const v4u v = *(const GAS v4u*)(P + (size_t)(row0 + pos) * NIN + 768 + 64 * cb + 8 * ch);
            LAS unsigned* d = (LAS unsigned*)(T + pos * 66 + 8 * ch); d[0] = v.x; d[1] = v.y; d[2] = v.z; d[3] = v.w; }
        LDS_WAIT(); asm volatile("" ::: "memory");
        const int sn = cb >> 2;
#pragma unroll
        for (int j = 0; j < 8; ++j) { const int chl = 8 * j + (F.lane >> 3), pc = F.lane & 7;
            unsigned e[8];
#pragma unroll
            for (int q = 0; q < 8; ++q) e[q] = T[(8 * pc + q) * 66 + chl];
            v4u o; o.x = e[0] | (e[1] << 16); o.y = e[2] | (e[3] << 16); o.z = e[4] | (e[5] << 16); o.w = e[6] | (e[7] << 16);
            const int chg = 64 * (cb & 3) + chl;
            *(GAS v4u*)(ZT + ((size_t)(b * 256 + chg) * 2 + sn) * L + n0 + 8 * pc) = o; }
        LDS_WAIT(); asm volatile("" ::: "memory");
    }
}
__device__ __forceinline__ void ycat_norm_phase(Frame& F, int nrows) {
    bf16* Y = (bf16*)(F.ws + WS_YCAT); const bf16* YC = (const bf16*)(F.ws + WS_YC); const bf16* YFP = (const bf16*)(F.ws + WS_YFP);
    const int gw = F.vcu * NWAVES + F.wave, NGW = F.G * NWAVES;
    for (int row = gw; row < nrows; row += NGW) {
        bf16* yr = Y + (size_t)row * 1024;
        const v4u a = *(const GAS v4u*)(yr + 8 * F.lane); const v2u c = *(const GAS v2u*)(YC + (size_t)row * 256 + 4 * F.lane);
        const int nsl = row < MLAT ? 4 : 1;
        float av[8], fv[4] = {0.f, 0.f, 0.f, 0.f}, cv[4];
        for (int s = 0; s < nsl; ++s) { const v2u f = *(const GAS v2u*)(YFP + ((size_t)s * MT + row) * 256 + 4 * F.lane);
            fv[0] += bf2f(f.x & 0xffffu); fv[1] += bf2f(f.x >> 16); fv[2] += bf2f(f.y & 0xffffu); fv[3] += bf2f(f.y >> 16); }
        av[0] = bf2f(a.x & 0xffffu); av[1] = bf2f(a.x >> 16); av[2] = bf2f(a.y & 0xffffu); av[3] = bf2f(a.y >> 16); av[4] = bf2f(a.z & 0xffffu); av[5] = bf2f(a.z >> 16); av[6] = bf2f(a.w & 0xffffu); av[7] = bf2f(a.w >> 16);
        cv[0] = bf2f(c.x & 0xffffu); cv[1] = bf2f(c.x >> 16); cv[2] = bf2f(c.y & 0xffffu); cv[3] = bf2f(c.y >> 16);
        float sa = 0.f, sf = 0.f, sc = 0.f;
#pragma unroll
        for (int e = 0; e < 8; ++e) sa += av[e] * av[e];
#pragma unroll
        for (int e = 0; e < 4; ++e) { sf += fv[e] * fv[e]; sc += cv[e] * cv[e]; }
        const float ra = 1.0f / sqrtf(wave_sum(sa) * (1.0f / 512.0f) + EPS), rf = 1.0f / sqrtf(wave_sum(sf) * (1.0f / 256.0f) + EPS), rc = 1.0f / sqrtf(wave_sum(sc) * (1.0f / 256.0f) + EPS);
        v4u oa; oa.x = pk2(av[0] * ra, av[1] * ra); oa.y = pk2(av[2] * ra, av[3] * ra); oa.z = pk2(av[4] * ra, av[5] * ra); oa.w = pk2(av[6] * ra, av[7] * ra);
        v2u of; of.x = pk2(fv[0] * rf, fv[1] * rf); of.y = pk2(fv[2] * rf, fv[3] * rf);
        v2u oc; oc.x = pk2(cv[0] * rc, cv[1] * rc); oc.y = pk2(cv[2] * rc, cv[3] * rc);
        *(GAS v4u*)(yr + 8 * F.lane) = oa; *(GAS v2u*)(yr + 512 + 4 * F.lane) = of; *(GAS v2u*)(yr + 768 + 4 * F.lane) = oc;
    }
}
__device__ __forceinline__ void final_norm_phase(Frame& F, const bf16* xf, const float* g) {
    const int gw = F.vcu * NWAVES + F.wave, NGW = F.G * NWAVES;
    for (int row = gw; row < MLAT; row += NGW) {
        const bf16* xr = xf + (size_t)row * DM; float* orow = F.out + (size_t)row * DM;
        f32x4 v[4]; float ss = 0.f;
#pragma unroll
        for (int j = 0; j < 4; ++j) { const v2u w = *(const GAS v2u*)(xr + 256 * j + 4 * F.lane); v[j][0] = bf2f(w.x & 0xffffu); v[j][1] = bf2f(w.x >> 16); v[j][2] = bf2f(w.y & 0xffffu); v[j][3] = bf2f(w.y >> 16);
            ss += (v[j][0] * v[j][0] + v[j][1] * v[j][1]) + (v[j][2] * v[j][2] + v[j][3] * v[j][3]); }
        const float rstd = 1.0f / sqrtf(wave_sum(ss) * (1.0f / DM) + EPS);
#pragma unroll
        for (int j = 0; j < 4; ++j) { const int c = 256 * j + 4 * F.lane; const f32x4 gg = *(const f32x4*)(g + c); *(f32x4*)(orow + c) = (v[j] * rstd) * gg; }
    }
}
#ifndef PHMASK
#define PHMASK 0xFFFF
#endif
#define PHON(x) (((PHMASK) >> (x)) & 1)
#ifndef SUBMASK
#define SUBMASK 0xFF
#endif
#define SUBON(x) (((SUBMASK) >> (x)) & 1)
struct UpOrder : pg8::StaticOrder {
    typedef pg8::UnitUp UnitT;
    __device__ __forceinline__ bool next(int i, pg8::UnitUp& u) const {
        if (!next_mn(i, u.pm, u.pn)) return false;
        u.kofs = 0; u.nt = ntk;
        if (u.pm < 72) { const int b = u.pm / 9, j = u.pm % 9; u.arow = SL * b + 254 * j - 1; u.seq0 = SL * b; u.seq1 = SL * b + SL; u.olo = 1; u.ohi = 254; }
        else { const int b = u.pm - 72; u.arow = MLAT + CL * b; u.seq0 = u.arow; u.seq1 = u.arow + CL; u.olo = 0; u.ohi = 255; }
        return true;
    }
};

struct FnetOrder {
    typedef pg8::Unit UnitT; int G, c;
    __device__ __forceinline__ bool next(int i, pg8::Unit& u) const { const int L = i * G + c; if (L >= 256) return false;
        u.pm = (L >> 3) & 7; u.pn = L & 7; u.arow = u.pm * 256; u.kofs = (L >> 6) * 1024; u.nt = 16; return true; }
};

__global__ void __launch_bounds__(NWAVES * 64, 2) mk_fwd(Args args) {
    extern __shared__ __attribute__((aligned(16))) unsigned char lds[];
    Frame F;
    F.lds = (LAS unsigned char*)lds; F.ldsg = (char*)lds;
    F.MISC = (volatile LAS unsigned*)(F.lds + MISC_OFF);
    F.tid = threadIdx.x; F.lane = F.tid & 63; F.wave = __builtin_amdgcn_readfirstlane(F.tid >> 6);
    F.G = gridDim.x; F.bx = blockIdx.x; F.vcu = (F.G % 8 == 0) ? (F.bx % 8) * (F.G / 8) + F.bx / 8 : F.bx;
    F.ws = args.ws; F.out = args.out;
    for (int u = F.tid; u < (LDS_BYTES - LDSCTL_OFF) / 4; u += NWAVES * 64) ((LAS unsigned*)(F.lds + LDSCTL_OFF))[u] = 0u;
    __syncthreads();
    if (F.tid == 0) { LAS unsigned long long* T = (LAS unsigned long long*)(F.lds + PTR_OFF);
#pragma unroll
        for (int i = 0; i < 22; ++i) T[i] = (unsigned long long)args.in[i]; }
    __syncthreads();
    XcdBarrier bar; bar.bar = (unsigned*)(F.ws + WS_CTL) + CW_BAR; bar.x = 0; bar.st = nullptr;
    if (!MK_SPLIT) bar = xcd_barrier_post((unsigned*)(F.ws + WS_CTL) + CW_BAR, F.MISC + 8);

#define MOD ((float*)(ws + WS_MOD))
#define SSQ ((float*)(ws + WS_SSQ))
#define XN ((bf16*)(ws + WS_XN))
#define P ((bf16*)(ws + WS_P))
#define Qb ((bf16*)(ws + WS_Q))
#define Kb ((bf16*)(ws + WS_K))
#define Vb ((bf16*)(ws + WS_V))
#define YCAT ((bf16*)(ws + WS_YCAT))
#define ACT ((bf16*)(ws + WS_ACT))
#define XCTX ((bf16*)(ws + WS_XCTX))
#define XBL ((bf16*)F.out + (size_t)MLAT * DM)
#define XFIN ((bf16*)(ws + WS_XN))
    LAS unsigned char* ring = F.lds + RING_OFF;

    const int ph_lo = args.ph_lo, ph_hi = args.ph_hi;
#define PHASE(k) (ph_lo <= (k) && (k) < ph_hi)
#define SEAM(k) do { if (PHASE(k) && PHASE((k) + 1)) xcd_barrier(bar); } while (0)
#ifndef P0SUB
#define P0SUB 0xFF
#endif
#ifndef RPT_PH
#define RPT_PH -1
#endif
#define RELANE() do { int t_ = threadIdx.x; asm volatile("" : "+v"(t_)); F.tid = t_; F.lane = t_ & 63; F.wave = __builtin_amdgcn_readfirstlane(t_ >> 6); } while (0)
    unsigned char* ws = F.ws;
    if (PHASE(0)) for (int rep_ = 0; rep_ < (((0) == RPT_PH) ? 2 : 1); ++rep_) { if (rep_) xcd_barrier(bar); RELANE(); if (PHON(0)) p0_prologue(F, rep_ ? P0SUB : 0xFF); }
    SEAM(0);
    for (int l = 0; l < 2; ++l) {
        const int pb = 1 + 9 * l;
        const int nMall = (l == 0) ? 72 : 64;
        if (PHASE(pb + 0)) for (int rep_ = 0; rep_ < (((pb + 0) == RPT_PH) ? 2 : 1); ++rep_) { if (rep_) xcd_barrier(bar); RELANE();
            if (l == 0) { pg8::Gemm g{(const bf16*)(ws + WS_CST), (const bf16*)(ws + WS_WF), 2, 8, 256, 256}; pg8::StaticOrder S; S.init(2, 8, F.G, F.bx, 256);
                pg8::EpiFold E{(bf16*)(ws + WS_WIN), (unsigned)(WIN_STRIDE / 2)};
                pg8::gemm_phase(ring, g, S, E); RELANE(); }
            if (PHON(1) && l == 0) norm_mod_phase(F, inptr(F, I_X), inptr(F, I_CTX), MT, inptr(F, I_N1G), MOD, 0, 1024, XBL, XCTX); }
        if (l == 0) SEAM(pb + 0);
        if (PHASE(pb + 1)) for (int rep_ = 0; rep_ < (((pb + 1) == RPT_PH) ? 2 : 1); ++rep_) { if (rep_) xcd_barrier(bar); RELANE();
            if (PHON(2)) { pg8::Gemm g{XN, (const bf16*)(ws + WS_WIN + l * WIN_STRIDE), 72, 8, 1024, 1024}; pg8::StaticOrder S; S.init(72, 8, F.G, F.bx, 1024);
                pg8::EpiWin E{P, NIN, SSQ, l == 1 ? (const float*)(ws + WS_SSX) : nullptr, (const float*)(ws + WS_PB) + 9 * 2048};
                pg8::gemm_phase(ring, g, S, E); } }
        SEAM(pb + 1);
        if (PHASE(pb + 2)) for (int rep_ = 0; rep_ < (((pb + 2) == RPT_PH) ? 2 : 1); ++rep_) { if (rep_) xcd_barrier(bar); RELANE();
            if (PHON(3)) {
                if (SUBON(0)) { pg8::Gemm g{P, (const bf16*)(ws + WS_WUQ + l * WUQ_STRIDE), nMall, 3, 384, NIN}; pg8::StaticOrder S; S.init(nMall, 3, F.G, F.bx, 384);
                  pg8::EpiQ E{Qb, SSQ, (const float*)(ws + WS_ROPE), (const float*)(ws + WS_ROPE) + 1024};
                  pg8::gemm_phase(ring, g, S, E); }
                if (SUBON(1)) { pg8::Gemm g{P + 384, (const bf16*)(ws + WS_WUKV + l * WUKV_STRIDE), 72, 4, 256, NIN}; pg8::StaticOrder S; S.init(72, 4, F.G, F.G - 1 - F.bx, 256);
                  pg8::EpiKV E{Kb, Vb, SSQ};
                  pg8::gemm_phase(ring, g, S, E); }
                if (SUBON(2)) qkv_rows_phase(F, l);
                if (SUBON(3)) zt_phase(F, l);
                if (l == 0) bias_phase(F); } }
        SEAM(pb + 2);
        if (PHASE(pb + 3)) for (int rep_ = 0; rep_ < (((pb + 3) == RPT_PH) ? 2 : 1); ++rep_) { if (rep_) xcd_barrier(bar); RELANE();
            if (PHON(4)) {
                const int NU = 256 + (l == 0 ? 32 : 0);
                for (int u = F.vcu; u < NU; u += F.G) {
                    if (u < 256) { const int bh = u >> 3, qb = u & 7, b = bh >> 2, h = bh & 3; const long q0 = (long)b * SL + qb * 256;
                        att::attn_unit(Qb + q0 * 768 + 192 * h, Kb + 192 * h, Vb + 128 * h, YCAT + q0 * 1024 + 128 * h, MLAT + CL * b, 4, SL * b, 36, F.ldsg);
                    } else { const int cu = u - 256, b = cu >> 2, h = cu & 3; const long q0 = MLAT + (long)CL * b;
                        att::attn_unit(Qb + q0 * 768 + 192 * h, Kb + 192 * h, Vb + 128 * h, YCAT + q0 * 1024 + 128 * h, (int)q0, 4, 0, 4, F.ldsg); }
                }
                { pg8::Gemm g{(const bf16*)(ws + WS_DFT), (const bf16*)(ws + WS_ZT), 8, 8, 4096, 4096}; FnetOrder S; S.G = F.G; S.c = F.vcu;
                  pg8::EpiFnet E{(bf16*)(ws + WS_YFP), 0, SL, 0.0027621358640099515f, (unsigned)(MT * 256)};
                  pg8::gemm_phase(ring, g, S, E); }
                if (l == 0) { pg8::Gemm g{(const bf16*)(ws + WS_DFTC), (const bf16*)(ws + WS_ZTC), 1, 8, 512, 512}; pg8::StaticOrder S; S.init(1, 8, F.G, (F.bx + 128) % F.G, 512);
                  pg8::EpiFnet E{(bf16*)(ws + WS_YFP), MLAT, CL, 0.0078125f, (unsigned)(MT * 256)};
                  pg8::gemm_phase(ring, g, S, E); } } }
        SEAM(pb + 3);
        if (PHASE(pb + 4)) for (int rep_ = 0; rep_ < (((pb + 4) == RPT_PH) ? 2 : 1); ++rep_) { if (rep_) xcd_barrier(bar); RELANE();
            if (PHON(5)) ycat_norm_phase(F, nMall * 256); }
        SEAM(pb + 4);
        if (PHASE(pb + 5)) for (int rep_ = 0; rep_ < (((pb + 5) == RPT_PH) ? 2 : 1); ++rep_) { if (rep_) xcd_barrier(bar); RELANE();
            if (PHON(6)) { pg8::Gemm g{YCAT, (const bf16*)(ws + WS_WOUT + l * WOUT_STRIDE), nMall, 4, 1024, 1024}; pg8::StaticOrder S; S.init(nMall, 4, F.G, F.bx, 1024);
                pg8::EpiRes E{XBL, XCTX, XBL, XCTX, MOD + (size_t)l * 9 * 6144, 2048,
                              XN, (float*)(ws + WS_SSX), inptr(F, I_N2G) + l * DM, MOD + (size_t)l * 9 * 6144, 4096, rep_ ? 0.f : 1.f};
                pg8::gemm_phase(ring, g, S, E); } }
        SEAM(pb + 5);
        if (PHASE(pb + 6)) for (int rep_ = 0; rep_ < (((pb + 6) == RPT_PH) ? 2 : 1); ++rep_) { if (rep_) xcd_barrier(bar); RELANE();
            }
        if (PHASE(pb + 7)) for (int rep_ = 0; rep_ < (((pb + 7) == RPT_PH) ? 2 : 1); ++rep_) { if (rep_) xcd_barrier(bar); RELANE();
            if (PHON(8)) { const int nM = 72 + (l == 0 ? 8 : 0);
                pg8::Gemm g{XN, (const bf16*)(ws + WS_WUP + l * WUP_STRIDE), nM, 22, 1024, 1024}; UpOrder S; S.init(nM, 22, F.G, F.bx, 1024);
                pg8::EpiUp E{ACT, inptr(F, I_FCW) + (size_t)l * 3 * FF, inptr(F, I_FCB) + (size_t)l * FF, (LAS float*)(F.lds + EPIX_OFF), (const float*)(ws + WS_SSX), (const float*)(ws + WS_UB) + (size_t)l * 9 * 5632};
                pg8::gemm_phase(ring, g, S, E); } }
        SEAM(pb + 7);
        if (PHASE(pb + 8)) for (int rep_ = 0; rep_ < (((pb + 8) == RPT_PH) ? 2 : 1); ++rep_) { if (rep_) xcd_barrier(bar); RELANE();
            if (PHON(6)) { pg8::Gemm g{ACT, (const bf16*)(ws + WS_WDOWN + l * WDOWN_STRIDE), nMall, 4, FF, FF}; pg8::StaticOrder S; S.init(nMall, 4, F.G, F.bx, FF);
                pg8::EpiRes E{XBL, XCTX, l == 0 ? XBL : XFIN, XCTX, MOD + (size_t)l * 9 * 6144, 5120,
                              l == 0 ? XN : nullptr, (float*)(ws + WS_SSX), inptr(F, I_N1G) + DM, MOD + (size_t)9 * 6144, 1024, rep_ ? 0.f : 1.f};
                pg8::gemm_phase(ring, g, S, E); } }
        SEAM(pb + 8);
    }
    if (PHASE(NPH - 1)) for (int rep_ = 0; rep_ < (((NPH - 1) == RPT_PH) ? 2 : 1); ++rep_) { if (rep_) xcd_barrier(bar); RELANE(); if (PHON(10)) final_norm_phase(F, XFIN, inptr(F, I_FING)); }
#undef PHASE
#undef SEAM
#undef RELANE
#undef MOD
#undef SSQ
#undef XN
#undef P
#undef Qb
#undef Kb
#undef Vb
#undef YCAT
#undef ACT
#undef XCTX
#undef XBL
#undef XFIN
}

extern "C" void kernel_launch(void* const* d_in, const int* in_sizes, int n_in, void* d_out, int out_size, void* d_ws, size_t ws_size, hipStream_t stream) {
    static int grid = 0;
    if (grid == 0) {
        if (n_in != 22 || out_size != MLAT * DM || ws_size < WS_END) { fprintf(stderr, "kernel_launch: unexpected shapes (n_in %d out %d ws %zu)\n", n_in, out_size, ws_size); grid = -1; return; }
        int dev = 0, cus = 0;
        if (hipGetDevice(&dev) != hipSuccess || hipDeviceGetAttribute(&cus, hipDeviceAttributeMultiprocessorCount, dev) != hipSuccess) { grid = -1; return; }
        if (hipFuncSetAttribute((const void*)mk_fwd, hipFuncAttributeMaxDynamicSharedMemorySize, LDS_BYTES) != hipSuccess) { fprintf(stderr, "kernel_launch: hipFuncSetAttribute failed\n"); grid = -1; return; }
        int per_cu = 0;
        if (hipOccupancyMaxActiveBlocksPerMultiprocessor(&per_cu, (const void*)mk_fwd, NWAVES * 64, LDS_BYTES) != hipSuccess || per_cu < 1) fprintf(stderr, "kernel_launch: occupancy query says %d\n", per_cu);
        (void)hipGetLastError();
        grid = cus;
    }
    if (grid < 0) return;
    if (hipMemsetAsync((char*)d_ws + WS_CTL, 0, CTL_ZERO_BYTES, stream) != hipSuccess) return;
    Args a{};
    for (int i = 0; i < 22; ++i) a.in[i] = (const float*)d_in[i];
    a.out = (float*)d_out; a.ws = (unsigned char*)d_ws;
#if MK_SPLIT
    for (int ph = 0; ph < NPH; ++ph) { a.ph_lo = ph; a.ph_hi = ph + 1; hipLaunchKernelGGL(mk_fwd, dim3(grid), dim3(NWAVES * 64), LDS_BYTES, stream, a); }
#else
    a.ph_lo = 0; a.ph_hi = NPH;
    hipLaunchKernelGGL(mk_fwd, dim3(grid), dim3(NWAVES * 64), LDS_BYTES, stream, a);
#endif
    const hipError_t le = hipPeekAtLastError();
    if (le != hipSuccess) fprintf(stderr, "kernel_launch: launch failed: %s\n", hipGetErrorName(le));
}
```

```cpp
#include <hip/hip_runtime.h>
#include <hip/hip_bf16.h>
#include <cstdio>
#include <cstdint>
#include <cmath>
namespace pg8 {
#define PG8_LAS __attribute__((address_space(3)))
typedef unsigned short bf16_t;
typedef short bf16x8 __attribute__((ext_vector_type(8)));
typedef float f32x4 __attribute__((ext_vector_type(4)));
typedef float f32x2 __attribute__((ext_vector_type(2)));
typedef unsigned u32x4 __attribute__((ext_vector_type(4)));
typedef unsigned u32x2 __attribute__((ext_vector_type(2)));
constexpr int BM = 256, BK = 64, HALF = 128, HTB = HALF * BK * 2  , STAGE_BYTES = 8 * HTB, NXCD = 8, WGM = 8;

__host__ __device__ __forceinline__ int lds_byte(int r, int c) { const int st = (r >> 4) * 2 + (c >> 5), rr = r & 15, cc = c & 31, ob = rr * 64 + cc * 2; return st * 1024 + (ob ^ (((ob >> 9) & 1) << 5)); }
__host__ __device__ __forceinline__ void stage_rc(int b, int& R, int& C) { const int st = b / 1024, sb = b % 1024, swz = sb ^ (((sb >> 9) & 1) << 5); R = (st >> 1) * 16 + swz / 64; C = (st & 1) * 32 + (swz % 64) / 2; }
__host__ __device__ __forceinline__ int perm32(int rho) { const int n = rho >> 4, i = rho & 15; return 8 * (i >> 2) + 4 * n + (i & 3); }

struct Unit { int pm, pn, arow, kofs, nt; };
struct Gemm { const bf16_t* A; const bf16_t* Bt; int nM, nN, K, lda; };

struct StaticOrder {
    int nM, nN, nwg, G, c, ntk;
    __device__ __forceinline__ void init(int nM_, int nN_, int G_, int c_, int K_) { nM = nM_; nN = nN_; nwg = nM * nN; G = G_; c = c_; ntk = K_ / BK; }
    __device__ __forceinline__ bool next_mn(int i, int& pm, int& pn) const {
        const long L = (long)i * G + c; if (L >= nwg) return false;
        int wgid = (int)L; { const int q = nwg / NXCD, r = nwg % NXCD, xcd = wgid % NXCD, off = wgid / NXCD; wgid = (xcd < r ? xcd * (q + 1) : r * (q + 1) + (xcd - r) * q) + off; }
        const int nig = WGM * nN, gid = wgid / nig, fm = gid * WGM, gsz = (nM - fm) < WGM ? (nM - fm) : WGM;
        pm = fm + ((wgid % nig) % gsz); pn = (wgid % nig) / gsz; return true;
    }
    typedef Unit UnitT;
    __device__ __forceinline__ bool next(int i, Unit& u) const { if (!next_mn(i, u.pm, u.pn)) return false; u.arow = u.pm * BM; u.kofs = 0; u.nt = ntk; return true; }
};

__device__ __forceinline__ unsigned cvt_pk_bf16(float lo, float hi) { unsigned r; asm volatile("v_cvt_pk_bf16_f32 %0, %1, %2" : "=v"(r) : "v"(lo), "v"(hi)); return r; }

template <class Epi, class Sched>
__device__ __forceinline__ void gemm_phase(PG8_LAS unsigned char* lds, const Gemm g, const Sched& S, const Epi& E) {
    int tid = threadIdx.x; asm volatile("" : "+v"(tid));
    const int wid = __builtin_amdgcn_readfirstlane(tid >> 6), lane = tid & 63, wr = wid >> 2, wc = wid & 3, fr = lane & 15, fq = lane >> 4;
    const int K = g.K, lda = g.lda;
    unsigned voffA[2], voffB[2];
#pragma unroll
    for (int i = 0; i < 2; ++i) { int R, C; stage_rc(tid * 16 + i * 8192, R, C); const int Rb = Epi::PERM ? ((R & ~31) + perm32(R & 31)) : R;
        voffA[i] = (unsigned)(R * lda + C) * 2u; voffB[i] = (unsigned)(Rb * K + C) * 2u; }
    const size_t kstep = (size_t)(BK * 2);
    const size_t hstepA = (size_t)HALF * lda * 2, hstepB = (size_t)HALF * K * 2;
    const size_t tstepB = 2 * hstepB;
    const unsigned ldsw = (unsigned)wid * 1024u;
    const int aoff = lds_byte(wr * 64 + fr, fq * 8), boff = lds_byte(wc * 32 + fr, fq * 8);
#define PG8_SA(b, h) (((b) * 2 + (h)) * HTB)
#define PG8_SB(b, h) ((4 + (b) * 2 + (h)) * HTB)
#define PG8_STAGE(bufoff, gbase, voff) do { _Pragma("unroll") for (int _i = 0; _i < 2; ++_i) \
        __builtin_amdgcn_global_load_lds((const unsigned*)((const char*)(gbase) + (voff)[_i]), (PG8_LAS unsigned*)(lds + (bufoff) + ldsw + _i * 8192), 16, 0, 0); } while (0)
#define PG8_LDA(dst, b, h) do { _Pragma("unroll") for (int m = 0; m < 4; ++m) _Pragma("unroll") for (int k = 0; k < 2; ++k) dst[m][k] = *(const PG8_LAS bf16x8*)(lds + PG8_SA(b, h) + aoff + m * 2048 + k * 1024); } while (0)
#define PG8_LDB(dst, b, h) do { _Pragma("unroll") for (int n = 0; n < 2; ++n) _Pragma("unroll") for (int k = 0; k < 2; ++k) dst[n][k] = *(const PG8_LAS bf16x8*)(lds + PG8_SB(b, h) + boff + n * 2048 + k * 1024); } while (0)
#define PG8_MMA(ai, bj, At, Bt) do { __builtin_amdgcn_s_setprio(1); _Pragma("unroll") for (int m = 0; m < 4; ++m) _Pragma("unroll") for (int n = 0; n < 2; ++n) _Pragma("unroll") for (int k = 0; k < 2; ++k) \
        acc[ai][bj][m][n] = __builtin_amdgcn_mfma_f32_16x16x32_bf16(Bt[n][k], At[m][k], acc[ai][bj][m][n], 0, 0, 0); __builtin_amdgcn_s_setprio(0); } while (0)
#define PG8_WAIT_V(n) asm volatile("s_waitcnt vmcnt(" #n ")" ::: "memory")
#define PG8_WAIT_L(n) asm volatile("s_waitcnt lgkmcnt(" #n ")" ::: "memory")
#define PG8_BAR __builtin_amdgcn_s_barrier()
#define PG8_SCHED __builtin_amdgcn_sched_barrier(0)
    typename Sched::UnitT cur, nxt; int ui = 0;
    if (!S.next(0, cur)) return;
    f32x4 acc[2][2][4][2];
#pragma unroll
    for (int a = 0; a < 2; ++a)
#pragma unroll
        for (int b = 0; b < 2; ++b)
#pragma unroll
            for (int m = 0; m < 4; ++m)
#pragma unroll
                for (int n = 0; n < 2; ++n) acc[a][b][m][n] = (f32x4){0.f, 0.f, 0.f, 0.f};
    bf16x8 At[4][2], B0[2][2], B1[2][2];
    const char* cA = (const char*)g.A + (ptrdiff_t)cur.arow * (ptrdiff_t)(lda * 2) + cur.kofs * 2; const char* cB = (const char*)g.Bt + (size_t)cur.pn * tstepB + cur.kofs * 2;
    if constexpr (Epi::PREFETCH) E.prefetch(cur, wid, lane);
    PG8_STAGE(PG8_SB(0, 0), cB, voffB); PG8_STAGE(PG8_SB(0, 1), cB + hstepB, voffB); PG8_STAGE(PG8_SA(0, 0), cA, voffA); PG8_STAGE(PG8_SA(0, 1), cA + hstepA, voffA);
    if (wr == 1) PG8_BAR;
    PG8_WAIT_V(2); PG8_BAR;
    PG8_STAGE(PG8_SB(1, 0), cB + kstep, voffB); PG8_STAGE(PG8_SA(1, 0), cA + kstep, voffA); PG8_STAGE(PG8_SB(1, 1), cB + hstepB + kstep, voffB);
    PG8_WAIT_V(6); PG8_BAR;
    for (;;) {
        const bool has_next = S.next(ui + 1, nxt);
        const char* nA = has_next ? (const char*)g.A + (ptrdiff_t)nxt.arow * (ptrdiff_t)(lda * 2) + nxt.kofs * 2 : cA; const char* nB = has_next ? (const char*)g.Bt + (size_t)nxt.pn * tstepB + nxt.kofs * 2 : cB;
        const int nt = cur.nt;
        for (int t = 0; t < nt; t += 2) {
            const bool last = (t == nt - 2);
            const char* a1 = cA + (size_t)(t + 1) * kstep;
            const char* a2 = last ? nA : cA + (size_t)(t + 2) * kstep; const char* b2 = last ? nB : cB + (size_t)(t + 2) * kstep;
            const char* a3 = a2 + kstep; const char* b3 = b2 + kstep;
            PG8_LDB(B0, 0, 0); PG8_LDB(B1, 0, 1); PG8_SCHED; PG8_LDA(At, 0, 0); PG8_STAGE(PG8_SA(1, 1), a1 + hstepA, voffA);
            PG8_WAIT_V(8); PG8_WAIT_L(0); PG8_BAR; PG8_MMA(0, 0, At, B0); PG8_MMA(0, 1, At, B1); PG8_BAR; PG8_SCHED;
            PG8_LDA(At, 0, 1); PG8_STAGE(PG8_SB(0, 0), b2, voffB); PG8_STAGE(PG8_SB(0, 1), b2 + hstepB, voffB); PG8_STAGE(PG8_SA(0, 0), a2, voffA);
            PG8_WAIT_V(8); PG8_WAIT_L(0); PG8_BAR; PG8_MMA(1, 0, At, B0); PG8_MMA(1, 1, At, B1); PG8_BAR; PG8_SCHED;
            PG8_LDB(B0, 1, 0); PG8_LDB(B1, 1, 1); PG8_SCHED; PG8_LDA(At, 1, 0); PG8_STAGE(PG8_SA(0, 1), a2 + hstepA, voffA);
            PG8_WAIT_V(8); PG8_WAIT_L(0); PG8_BAR; PG8_MMA(0, 0, At, B0); PG8_MMA(0, 1, At, B1); PG8_BAR; PG8_SCHED;
            PG8_LDA(At, 1, 1); PG8_STAGE(PG8_SB(1, 0), b3, voffB); PG8_STAGE(PG8_SB(1, 1), b3 + hstepB, voffB); PG8_STAGE(PG8_SA(1, 0), a3, voffA);
            PG8_WAIT_V(8); PG8_WAIT_L(0); PG8_BAR; PG8_MMA(1, 0, At, B0); PG8_MMA(1, 1, At, B1); PG8_BAR; PG8_SCHED;
        }
        if (wr == 0) PG8_BAR;
        E(acc, cur, wr, wc, fr, fq);
        if (!has_next) break;
        if constexpr (Epi::PREFETCH) E.prefetch(nxt, wid, lane);
#pragma unroll
        for (int a = 0; a < 2; ++a)
#pragma unroll
            for (int b = 0; b < 2; ++b)
#pragma unroll
                for (int m = 0; m < 4; ++m)
#pragma unroll
                    for (int n = 0; n < 2; ++n) acc[a][b][m][n] = (f32x4){0.f, 0.f, 0.f, 0.f};
        cur = nxt; cA = nA; cB = nB; ++ui;
        if (wr == 1) PG8_BAR;
    }
    PG8_WAIT_V(0);
    PG8_BAR;
#undef PG8_SA
#undef PG8_SB
#undef PG8_STAGE
#undef PG8_LDA
#undef PG8_LDB
#undef PG8_MMA
#undef PG8_WAIT_V
#undef PG8_WAIT_L
#undef PG8_BAR
#undef PG8_SCHED
}
}
namespace pg8 {
constexpr float RMS_EPS = 1e-6f;
template <class T> __device__ __forceinline__ T gld(const void* base, unsigned boff) { return *(const T*)((const char*)base + boff); }
template <class T> __device__ __forceinline__ void gst(void* base, unsigned boff, T v) { *(T*)((char*)base + boff) = v; }
constexpr int EX_XF = 0, EX_XL = 512, EX_CW = 1024, EX_RS = 1536, EX_BL = 1792, EX_SSX = 2304, EX_FLOATS = 6400;
constexpr int MLAT_ = 16384;
__device__ __forceinline__ void dma_ssx(const float* ssx, int arow, PG8_LAS float* xb, int wid, int lane) {
#pragma unroll
    for (int i = 0; i < 2; ++i) { const int ch = 2 * wid + i;
        __builtin_amdgcn_global_load_lds((const unsigned*)((const char*)ssx + (ptrdiff_t)arow * 64 + ch * 1024 + lane * 16), (PG8_LAS unsigned*)(xb + EX_SSX + ch * 256), 16, 0, 0); }
}
__device__ __forceinline__ void rs_from_ssx(PG8_LAS float* xb, int t) {
    if (t < 256) { const PG8_LAS f32x4* p = (const PG8_LAS f32x4*)(xb + EX_SSX + t * 16); const f32x4 a = p[0], b = p[1], c = p[2], d = p[3];
        const float ss = (((a[0] + a[1]) + (a[2] + a[3])) + ((b[0] + b[1]) + (b[2] + b[3]))) + (((c[0] + c[1]) + (c[2] + c[3])) + ((d[0] + d[1]) + (d[2] + d[3])));
        xb[EX_RS + t] = __builtin_amdgcn_rsqf(ss * (1.0f / 1024.0f) + RMS_EPS); }
}

struct EpiWin {
    static constexpr bool PERM = true, PREFETCH = true;
    bf16_t* O; int ldc; float* ssq;
    const float* ssx; const float* pb;
    PG8_LAS float* xb;
    __device__ __forceinline__ void prefetch(const Unit& u, int wid, int lane) const {
        if (ssx == nullptr) return;
        dma_ssx(ssx, u.arow, xb, wid, lane);
        if (wid == 0) __builtin_amdgcn_global_load_lds((const unsigned*)(pb + (u.pm < 64 ? (u.pm >> 3) : 8) * 2048 + u.pn * BM + lane * 4), (PG8_LAS unsigned*)(xb + EX_BL), 16, 0, 0);
    }
    __device__ __forceinline__ void operator()(const f32x4 (&acc)[2][2][4][2], const Unit& u, int wr, int wc, int fr_in, int fq_in) const {
        int t_ = threadIdx.x; asm volatile("" : "+v"(t_)); const int fr = t_ & 15, fq = (t_ >> 4) & 3; (void)fr_in; (void)fq_in;
        const int row0 = u.pm * BM + wr * 64 + fr; const int col0 = u.pn * BM + wc * 32 + 8 * fq; const int tc0 = wc * 32 + 8 * fq;
        const bool fused = ssx != nullptr;
        if (fused) { rs_from_ssx(xb, t_); asm volatile("s_waitcnt lgkmcnt(0)" ::: "memory"); __builtin_amdgcn_s_barrier(); asm volatile("" ::: "memory"); }
        f32x4 bv[2][2];
#pragma unroll
        for (int bj = 0; bj < 2; ++bj)
#pragma unroll
            for (int n = 0; n < 2; ++n) bv[bj][n] = fused ? *(const PG8_LAS f32x4*)(xb + EX_BL + tc0 + bj * HALF + 4 * n) : (f32x4){0.f, 0.f, 0.f, 0.f};
#pragma unroll
        for (int ai = 0; ai < 2; ++ai)
#pragma unroll
            for (int m = 0; m < 4; ++m) { const int tr = ai * HALF + wr * 64 + m * 16 + fr; const int row = u.pm * BM + tr; const unsigned ob = ((unsigned)row * (unsigned)ldc + (unsigned)col0) * 2u;
                const float rs = fused ? xb[EX_RS + tr] : 1.0f;
#pragma unroll
                for (int bj = 0; bj < 2; ++bj) { const f32x4 v0 = acc[ai][bj][m][0] * rs + bv[bj][0], v1 = acc[ai][bj][m][1] * rs + bv[bj][1];
                    u32x4 w; w.x = cvt_pk_bf16(v0[0], v0[1]); w.y = cvt_pk_bf16(v0[2], v0[3]); w.z = cvt_pk_bf16(v1[0], v1[1]); w.w = cvt_pk_bf16(v1[2], v1[3]);
                    gst<u32x4>(O, ob + bj * HALF * 2, w);
                    const int hf = 2 * u.pn + bj;
                    if (hf < 5) {
                        float s = (v0[0] * v0[0] + v0[1] * v0[1]) + (v0[2] * v0[2] + v0[3] * v0[3]) + (v1[0] * v1[0] + v1[1] * v1[1]) + (v1[2] * v1[2] + v1[3] * v1[3]);
                        s += __shfl_xor(s, 16); s += __shfl_xor(s, 32);
                        if (fq == 0) gst<float>(ssq, ((unsigned)row * 20u + hf * 4 + wc) * 4u, s);
                    } }
                if (m & 1) asm volatile("" ::: "memory"); }
        if (fused) { asm volatile("s_waitcnt lgkmcnt(0)" ::: "memory"); __builtin_amdgcn_s_barrier(); asm volatile("" ::: "memory"); }
        (void)row0;
    }
};

struct EpiFold {
    static constexpr bool PERM = true, PREFETCH = false;
    bf16_t* WinT; unsigned lstride;
    __device__ __forceinline__ void operator()(const f32x4 (&acc)[2][2][4][2], const Unit& u, int wr, int wc, int fr_in, int fq_in) const {
        int t_ = threadIdx.x; asm volatile("" : "+v"(t_)); const int fr = t_ & 15, fq = (t_ >> 4) & 3; (void)fr_in; (void)fq_in;
        bf16_t* O = WinT + (size_t)(u.pn >> 2) * lstride;
        const int row0 = 768 + u.pm * BM + wr * 64 + fr; const int col0 = (u.pn & 3) * BM + wc * 32 + 8 * fq;
#pragma unroll
        for (int ai = 0; ai < 2; ++ai)
#pragma unroll
            for (int m = 0; m < 4; ++m) { const unsigned ob = ((unsigned)(row0 + ai * HALF + m * 16) * 1024u + (unsigned)col0) * 2u;
#pragma unroll
                for (int bj = 0; bj < 2; ++bj) { const f32x4 v0 = acc[ai][bj][m][0], v1 = acc[ai][bj][m][1];
                    u32x4 w; w.x = cvt_pk_bf16(v0[0], v0[1]); w.y = cvt_pk_bf16(v0[2], v0[3]); w.z = cvt_pk_bf16(v1[0], v1[1]); w.w = cvt_pk_bf16(v1[2], v1[3]);
                    gst<u32x4>(O, ob + bj * HALF * 2, w); } }
    }
};

struct EpiQ {
    static constexpr bool PERM = false, PREFETCH = false;
    bf16_t* Q; const float* ssq; const float* ropec; const float* ropes;
    __device__ __forceinline__ void operator()(const f32x4 (&acc)[2][2][4][2], const Unit& u, int wr, int wc, int fr_in, int fq_in) const {
        int t_ = threadIdx.x; asm volatile("" : "+v"(t_)); const int fr = t_ & 15, fq = (t_ >> 4) & 3; (void)fr_in; (void)fq_in;
        const int row0 = u.pm * BM + wr * 64 + fr; const bool lat = u.pm < 64;
#pragma unroll
        for (int ai = 0; ai < 2; ++ai)
#pragma unroll
            for (int m = 0; m < 4; ++m) { const int row = row0 + ai * HALF + m * 16;
                const unsigned sb = ((unsigned)row * 20u + 3u * fq) * 4u; float ss = (gld<float>(ssq, sb) + gld<float>(ssq, sb + 4)) + gld<float>(ssq, sb + 8);
                ss += __shfl_xor(ss, 16); ss += __shfl_xor(ss, 32);
                const float rs = __builtin_amdgcn_rsqf(ss * (1.0f / 384.0f) + RMS_EPS);
                const int t = row & 2047;
#pragma unroll
                for (int bj = 0; bj < 2; ++bj) { const int gcol = u.pn * BM + bj * HALF + wc * 32;
                    const int w = gcol % 192; f32x4 x1 = acc[ai][bj][m][0] * rs, x2 = acc[ai][bj][m][1] * rs;
                    if (lat && w >= 128) { const int pos = (w >= 160) ? (t & 63) : (t >> 6);
                        const unsigned rb = (unsigned)(pos * 16 + 4 * fq) * 4u; const f32x4 c = gld<f32x4>(ropec, rb), s = gld<f32x4>(ropes, rb);
                        const f32x4 y1 = x1 * c - x2 * s, y2 = x1 * s + x2 * c; x1 = y1; x2 = y2; }
                    const unsigned qb = ((unsigned)row * 768u + (unsigned)(gcol + 4 * fq)) * 2u;
                    u32x2 a; a.x = cvt_pk_bf16(x1[0], x1[1]); a.y = cvt_pk_bf16(x1[2], x1[3]); gst<u32x2>(Q, qb, a);
                    u32x2 b; b.x = cvt_pk_bf16(x2[0], x2[1]); b.y = cvt_pk_bf16(x2[2], x2[3]); gst<u32x2>(Q, qb + 32, b); }
                if (m & 1) asm volatile("" ::: "memory"); }
    }
};

struct EpiKV {
    static constexpr bool PERM = true, PREFETCH = false;
    bf16_t* Kb; bf16_t* Vb; const float* ssq;
    __device__ __forceinline__ void operator()(const f32x4 (&acc)[2][2][4][2], const Unit& u, int wr, int wc, int fr_in, int fq_in) const {
        int t_ = threadIdx.x; asm volatile("" : "+v"(t_)); const int fr = t_ & 15, fq = (t_ >> 4) & 3; (void)fr_in; (void)fq_in;
        const int row0 = u.pm * BM + wr * 64 + fr; const int cw = wc * 32 + 8 * fq;
#pragma unroll
        for (int ai = 0; ai < 2; ++ai)
#pragma unroll
            for (int m = 0; m < 4; ++m) { const int row = row0 + ai * HALF + m * 16;
                const unsigned sb = ((unsigned)row * 20u + 12u + 2u * fq) * 4u; float ss = gld<float>(ssq, sb) + gld<float>(ssq, sb + 4);
                ss += __shfl_xor(ss, 16); ss += __shfl_xor(ss, 32);
                const float rs = __builtin_amdgcn_rsqf(ss * (1.0f / 256.0f) + RMS_EPS);
#pragma unroll
                for (int bj = 0; bj < 2; ++bj) { const f32x4 v0 = acc[ai][bj][m][0] * rs, v1 = acc[ai][bj][m][1] * rs;
                    u32x4 w; w.x = cvt_pk_bf16(v0[0], v0[1]); w.y = cvt_pk_bf16(v0[2], v0[3]); w.z = cvt_pk_bf16(v1[0], v1[1]); w.w = cvt_pk_bf16(v1[2], v1[3]);
                    if (bj == 0) gst<u32x4>(Kb, ((unsigned)row * 768u + (unsigned)(192 * u.pn + cw)) * 2u, w);
                    else gst<u32x4>(Vb, ((unsigned)row * 512u + (unsigned)(128 * u.pn + cw)) * 2u, w); }
                if (m & 1) asm volatile("" ::: "memory"); }
    }
};

struct EpiFnet {
    static constexpr bool PERM = true, PREFETCH = false;
    bf16_t* Y; int rowbase, seqlen; float scale; unsigned slice_stride;
    __device__ __forceinline__ void operator()(const f32x4 (&acc)[2][2][4][2], const Unit& u, int wr, int wc, int fr_in, int fq_in) const {
        int t_ = threadIdx.x; asm volatile("" : "+v"(t_)); const int fr = t_ & 15, fq = (t_ >> 4) & 3; (void)fr_in; (void)fq_in;
        const int k0 = u.pm * BM + wr * 64 + fr; const int cw = wc * 32 + 8 * fq;
        bf16_t* Yb = Y + (size_t)(u.kofs >> 10) * slice_stride;
#pragma unroll
        for (int ai = 0; ai < 2; ++ai)
#pragma unroll
            for (int m = 0; m < 4; ++m) { const int row = rowbase + u.pn * seqlen + k0 + ai * HALF + m * 16; const unsigned yb = ((unsigned)row * 256u + (unsigned)cw) * 2u;
#pragma unroll
                for (int bj = 0; bj < 2; ++bj) { const f32x4 v0 = acc[ai][bj][m][0] * scale, v1 = acc[ai][bj][m][1] * scale;
                    u32x4 w; w.x = cvt_pk_bf16(v0[0], v0[1]); w.y = cvt_pk_bf16(v0[2], v0[3]); w.z = cvt_pk_bf16(v1[0], v1[1]); w.w = cvt_pk_bf16(v1[2], v1[3]);
                    gst<u32x4>(Yb, yb + bj * HALF * 2, w); } }
    }
};

template <bool F32BASE> struct EpiRes {
    static constexpr bool PERM = true, PREFETCH = false;
    const float* base_lat; const float* base_ctx;
    bf16_t* X; const float* mod; int gofs;
    const float* png; const float* pscmod; int pscofs;
    const float* ng; const float* scmod; int scofs; float* ssx;
    float gmul;
    bf16_t* part;
    __device__ __forceinline__ void operator()(const f32x4 (&acc)[2][2][4][2], const Unit& u, int wr, int wc, int fr_in, int fq_in) const {
        int t_ = threadIdx.x; asm volatile("" : "+v"(t_)); const int fr = t_ & 15, fq = (t_ >> 4) & 3; (void)fr_in; (void)fq_in;
        if (part != nullptr && u.pm >= 64) {
            const int sl = u.kofs < 2304 ? u.kofs / 384 : 6 + (u.kofs - 2304) / 256;
            const int prow0 = (u.pm - 64) * BM + wr * 64 + fr; const int pcol0 = u.pn * BM + wc * 32 + 8 * fq; bf16_t* pb_ = part + (size_t)sl * (2048u * 1024u);
#pragma unroll
            for (int ai = 0; ai < 2; ++ai)
#pragma unroll
                for (int m = 0; m < 4; ++m) { const unsigned off = ((unsigned)(prow0 + ai * HALF + m * 16) * 1024u + (unsigned)pcol0) * 2u;
#pragma unroll
                    for (int bj = 0; bj < 2; ++bj) { const f32x4 v0 = acc[ai][bj][m][0], v1 = acc[ai][bj][m][1];
                        u32x4 w; w.x = cvt_pk_bf16(v0[0], v0[1]); w.y = cvt_pk_bf16(v0[2], v0[3]); w.z = cvt_pk_bf16(v1[0], v1[1]); w.w = cvt_pk_bf16(v1[2], v1[3]);
                        gst<u32x4>(pb_, off + (unsigned)(bj * HALF) * 2u, w); } }
            return;
        }
        const bool lat = u.pm < 64; const int r = lat ? (u.pm >> 3) : 8;
        constexpr bool f32base = F32BASE; const float* bf = lat ? base_lat : base_ctx;
        const float* gate = mod + r * 6144 + gofs;
        const int frow0 = (lat ? u.pm : u.pm - 64) * BM + wr * 64 + fr; const int col0 = u.pn * BM + wc * 32 + 8 * fq;
        const int grow0 = u.pm * BM + wr * 64 + fr;
        const bool scaled = ng != nullptr;
        float ss[8];
#pragma unroll
        for (int q = 0; q < 8; ++q) ss[q] = 0.f;
#pragma unroll
        for (int bj = 0; bj < 2; ++bj) {
            f32x4 gv[2], gs[2], gp[2];
#pragma unroll
            for (int n = 0; n < 2; ++n) { const unsigned cb = (unsigned)(col0 + bj * HALF + n * 4) * 4u; gv[n] = gld<f32x4>(gate, cb) * gmul;
                gs[n] = scaled ? gld<f32x4>(ng, cb) * (gld<f32x4>(scmod, (unsigned)(r * 6144 + scofs) * 4u + cb) + 1.0f) : (f32x4){1.f, 1.f, 1.f, 1.f};
                if constexpr (!f32base) { const f32x4 d = gld<f32x4>(png, cb) * (gld<f32x4>(pscmod, (unsigned)(r * 6144 + pscofs) * 4u + cb) + 1.0f);
                    gp[n] = (f32x4){__builtin_amdgcn_rcpf(d[0]), __builtin_amdgcn_rcpf(d[1]), __builtin_amdgcn_rcpf(d[2]), __builtin_amdgcn_rcpf(d[3])}; }
                else gp[n] = (f32x4){1.f, 1.f, 1.f, 1.f}; }
#pragma unroll
            for (int ai = 0; ai < 2; ++ai) {
                f32x4 x0[4], x1[4];
#pragma unroll
                for (int m = 0; m < 4; ++m) { const unsigned o2 = ((unsigned)(grow0 + ai * HALF + m * 16) * 1024u + (unsigned)(col0 + bj * HALF)) * 2u;
                    const unsigned fo = ((unsigned)(frow0 + ai * HALF + m * 16) * 1024u + (unsigned)(col0 + bj * HALF)) * 4u;
                    if constexpr (f32base) { x0[m] = gld<f32x4>(bf, fo); x1[m] = gld<f32x4>(bf, fo + 16u); }
                    else { const u32x4 bw = gld<u32x4>(X, o2); x0[m] = __builtin_bit_cast(f32x4, (u32x4){bw.x << 16, bw.x & 0xffff0000u, bw.y << 16, bw.y & 0xffff0000u});
                        x1[m] = __builtin_bit_cast(f32x4, (u32x4){bw.z << 16, bw.z & 0xffff0000u, bw.w << 16, bw.w & 0xffff0000u}); } }
                asm volatile("" ::: "memory");
#pragma unroll
                for (int m = 0; m < 4; ++m) { const unsigned o2 = ((unsigned)(grow0 + ai * HALF + m * 16) * 1024u + (unsigned)(col0 + bj * HALF)) * 2u;
                    f32x4 y0 = x0[m], y1 = x1[m];
                    if constexpr (!f32base) { y0 = y0 * gp[0]; y1 = y1 * gp[1]; }
                    y0 = y0 + gv[0] * acc[ai][bj][m][0]; y1 = y1 + gv[1] * acc[ai][bj][m][1];
                    ss[ai * 4 + m] += ((y0[0] * y0[0] + y0[1] * y0[1]) + (y0[2] * y0[2] + y0[3] * y0[3])) + ((y1[0] * y1[0] + y1[1] * y1[1]) + (y1[2] * y1[2] + y1[3] * y1[3]));
                    asm volatile("" : "+v"(ss[ai * 4 + m]));
                    const f32x4 h0 = y0 * gs[0], h1 = y1 * gs[1];
                    u32x4 hw; hw.x = cvt_pk_bf16(h0[0], h0[1]); hw.y = cvt_pk_bf16(h0[2], h0[3]); hw.z = cvt_pk_bf16(h1[0], h1[1]); hw.w = cvt_pk_bf16(h1[2], h1[3]);
                    gst<u32x4>(X, o2, hw); }
                asm volatile("" ::: "memory"); }
        }
        if (scaled) {
#pragma unroll
            for (int q = 0; q < 8; ++q) { float s = ss[q]; s += __shfl_xor(s, 16); s += __shfl_xor(s, 32);
                if (fq == 0) gst<float>(ssx, ((unsigned)(grow0 + (q >> 2) * HALF + (q & 3) * 16) * 16u + (unsigned)(4 * u.pn + wc)) * 4u, s); } }
    }
};

#ifndef DPP_UP
#define DPP_UP 0x121
#define DPP_DN 0x12F
#endif
struct UnitUp : Unit { int nrows; };
struct EpiUp {
    static constexpr bool PERM = true, PREFETCH = true;
    bf16_t* act; const float* cw; const float* cb; PG8_LAS float* xb;
    const float* ssx; const float* ub;
    __device__ __forceinline__ void prefetch(const UnitUp& u, int wid, int lane) const {
        dma_ssx(ssx, u.arow, xb, wid, lane);
        { const int arr = wid >> 1, half = wid & 1; const float* src = (arr < 3 ? cw + arr * 2816 : cb) + u.pn * HALF + half * 64 + lane;
          __builtin_amdgcn_global_load_lds((const unsigned*)src, (PG8_LAS unsigned*)(xb + EX_CW + arr * 128 + half * 64), 4, 0, 0); }
        if (wid < 2) { const int a0 = u.arow < 0 ? 0 : u.arow; const int b0 = a0 >= MLAT_ ? 8 : (a0 >> 11); const int bb_ = b0 + wid > 8 ? 8 : b0 + wid;
            __builtin_amdgcn_global_load_lds((const unsigned*)(ub + bb_ * 5632 + u.pn * BM + lane * 4), (PG8_LAS unsigned*)(xb + EX_BL + wid * 256), 16, 0, 0); }
    }
    __device__ __forceinline__ void operator()(f32x4 (&acc)[2][2][4][2], const UnitUp& u, int wr, int wc, int fr_in, int fq_in) const {
        int t_ = threadIdx.x; asm volatile("" : "+v"(t_)); const int fr = t_ & 15, fq = (t_ >> 4) & 3; (void)fr_in; (void)fq_in;
        const int lane = fq * 16 + fr;
        const int ccol = wc * 32 + 8 * fq;
        const int gc = u.pn * HALF + ccol;
        PG8_LAS float* CW = xb + EX_CW;
        rs_from_ssx(xb, t_);
        asm volatile("s_waitcnt lgkmcnt(0)" ::: "memory"); __builtin_amdgcn_s_barrier(); asm volatile("" ::: "memory");
        unsigned rowflags;
        { unsigned pmask = 0u;
          const int a0 = u.arow < 0 ? 0 : u.arow, e0 = u.arow + 255;
          const int seam = (a0 >= MLAT_) ? (1 << 30) : (((a0 >> 11) + 1) << 11);
          const bool straddle = e0 >= seam;
          const PG8_LAS float* bl = xb + EX_BL + ccol;
          const f32x4 ug0 = *(const PG8_LAS f32x4*)(bl), ug1 = *(const PG8_LAS f32x4*)(bl + 4), uv0 = *(const PG8_LAS f32x4*)(bl + HALF), uv1 = *(const PG8_LAS f32x4*)(bl + HALF + 4);
#pragma unroll
          for (int ai = 0; ai < 2; ++ai)
#pragma unroll
            for (int m = 0; m < 4; ++m) { const int tr = ai * HALF + wr * 64 + m * 16 + fr; const int g = u.arow + tr;
                const int pos = g < MLAT_ ? (g & 2047) : ((g - MLAT_) & 255); const int last = g < MLAT_ ? 2047 : 255;
                if (pos == 0) pmask |= 1u << (4 * ai + m); if (pos == last) pmask |= 256u << (4 * ai + m);
                const float rs = xb[EX_RS + tr];
                acc[ai][0][m][0] = acc[ai][0][m][0] * rs + ug0; acc[ai][0][m][1] = acc[ai][0][m][1] * rs + ug1;
                acc[ai][1][m][0] = acc[ai][1][m][0] * rs + uv0; acc[ai][1][m][1] = acc[ai][1][m][1] * rs + uv1; }
          if (straddle) {
              const f32x4 dg0 = *(const PG8_LAS f32x4*)(bl + 256) - ug0, dg1 = *(const PG8_LAS f32x4*)(bl + 260) - ug1, dv0 = *(const PG8_LAS f32x4*)(bl + 256 + HALF) - uv0, dv1 = *(const PG8_LAS f32x4*)(bl + 260 + HALF) - uv1;
#pragma unroll
              for (int ai = 0; ai < 2; ++ai)
#pragma unroll
                for (int m = 0; m < 4; ++m) { const int g = u.arow + ai * HALF + wr * 64 + m * 16 + fr; const float sel = (g >= seam) ? 1.0f : 0.0f;
                    acc[ai][0][m][0] += dg0 * sel; acc[ai][0][m][1] += dg1 * sel; acc[ai][1][m][0] += dv0 * sel; acc[ai][1][m][1] += dv1 * sel; } }
          rowflags = pmask; }
        PG8_LAS float* XF = xb + EX_XF; PG8_LAS float* XL = xb + EX_XL;
        const bool isF = (fr == 0), isL = (fr == 15);
#pragma unroll
        for (int ai = 0; ai < 2; ++ai) { const int blk = 2 * ai + wr;
            f32x4 s0, s1;
#pragma unroll
            for (int e = 0; e < 4; ++e) { s0[e] = isF ? acc[ai][0][0][0][e] : acc[ai][0][3][0][e]; s1[e] = isF ? acc[ai][0][0][1][e] : acc[ai][0][3][1][e]; }
            PG8_LAS float* dst = xb + (isF ? EX_XF : EX_XL) + blk * 128 + ccol;
            if (isF || isL) { *(PG8_LAS f32x4*)dst = s0; *(PG8_LAS f32x4*)(dst + 4) = s1; } }
        asm volatile("s_waitcnt lgkmcnt(0)" ::: "memory"); __builtin_amdgcn_s_barrier(); asm volatile("" ::: "memory");
        const int lup = (lane & 48) | ((lane - 1) & 15), ldn = (lane & 48) | ((lane + 1) & 15);
#pragma unroll
        for (int ai = 0; ai < 2; ++ai) { const int blk = 2 * ai + wr;
#pragma unroll
            for (int n = 0; n < 2; ++n) {
                const f32x4 w0 = *(const PG8_LAS f32x4*)(CW + ccol + 4 * n), w1 = *(const PG8_LAS f32x4*)(CW + 128 + ccol + 4 * n), w2 = *(const PG8_LAS f32x4*)(CW + 256 + ccol + 4 * n), bb = *(const PG8_LAS f32x4*)(CW + 384 + ccol + 4 * n);
                f32x4 xprev = (f32x4){0.f, 0.f, 0.f, 0.f}, xnext = (f32x4){0.f, 0.f, 0.f, 0.f};
                if (blk > 0) xprev = *(const PG8_LAS f32x4*)(XL + (blk - 1) * 128 + ccol + 4 * n);
                if (blk < 3) xnext = *(const PG8_LAS f32x4*)(XF + (blk + 1) * 128 + ccol + 4 * n);
#pragma unroll
                for (int e = 0; e < 4; ++e) {
                    float cur[4], up[4], dn[4];
#pragma unroll
                    for (int m = 0; m < 4; ++m) cur[m] = acc[ai][0][m][n][e];
#pragma unroll
                    for (int m = 0; m < 4; ++m) {
                        const float tu = isL ? (m > 0 ? cur[m > 0 ? m - 1 : 0] : xprev[e]) : cur[m];
                        const float td = isF ? (m < 3 ? cur[m < 3 ? m + 1 : 3] : xnext[e]) : cur[m];
                        up[m] = __shfl(tu, lup); dn[m] = __shfl(td, ldn); }
                    float rr[4];
#pragma unroll
                    for (int m = 0; m < 4; ++m) { const float upv = ((rowflags >> (4 * ai + m)) & 1u) ? 0.f : up[m], dnv = ((rowflags >> (8 + 4 * ai + m)) & 1u) ? 0.f : dn[m];
                        const float cv = w0[e] * upv + w1[e] * cur[m] + w2[e] * dnv + bb[e];
                        const float sg = cv * __builtin_amdgcn_rcpf(1.0f + __expf(-cv));
                        rr[m] = sg * acc[ai][1][m][n][e]; }
                    asm volatile("" : "+v"(rr[0]), "+v"(rr[1]), "+v"(rr[2]), "+v"(rr[3]));
#pragma unroll
                    for (int m = 0; m < 4; ++m) acc[ai][0][m][n][e] = rr[m];
                }
            }
#pragma unroll
            for (int m = 0; m < 4; ++m) { const int tr = ai * HALF + wr * 64 + m * 16 + fr; const int g = u.arow + tr;
                if (tr >= 1 && tr <= 254 && g < u.nrows) { const f32x4 v0 = acc[ai][0][m][0], v1 = acc[ai][0][m][1];
                    u32x4 w; w.x = cvt_pk_bf16(v0[0], v0[1]); w.y = cvt_pk_bf16(v0[2], v0[3]); w.z = cvt_pk_bf16(v1[0], v1[1]); w.w = cvt_pk_bf16(v1[2], v1[3]);
                    gst<u32x4>(act, ((unsigned)g * 2816u + (unsigned)gc) * 2u, w); } }
            asm volatile("" ::: "memory");
        }
        asm volatile("s_waitcnt lgkmcnt(0)" ::: "memory"); __builtin_amdgcn_s_barrier(); asm volatile("" ::: "memory");
    }
};
}
namespace att {
using bf16x8 = __attribute__((ext_vector_type(8))) short;
using s16x4  = __attribute__((ext_vector_type(4))) short;
using f32x16 = __attribute__((ext_vector_type(16))) float;
using u32x4  = __attribute__((ext_vector_type(4))) unsigned;
typedef unsigned short bf16_t;
constexpr int NW = 8, QBLK = 32, KVBLK = 64;
constexpr int LDQ = 768, LDK = 768, LDV = 512, LDO = 1024;
constexpr float SCALE = 0.07216878364870322f;
constexpr float THR = 8.f;
constexpr int SHM_V = KVBLK * 128 * 2, SHM_K = KVBLK * 192 * 2;
constexpr int OFF_V = 0, OFF_K = 2 * SHM_V, OFF_WS = 2 * SHM_V + 2 * SHM_K, OFF_QR = OFF_WS + NW * 64 * 4, SHM_ATTN = OFF_QR + NW * 4096;
#define KSWZ(row, colB) ((row) * 384 + ((colB) ^ (((row) & 7) << 4)))
#define SBAR() __builtin_amdgcn_sched_barrier(0)
__device__ __forceinline__ int crow(int r, int hi) { return (r & 3) + 8 * (r >> 2) + 4 * hi; }
__device__ __forceinline__ unsigned cvtpk(float lo, float hi) { unsigned r; asm volatile("v_cvt_pk_bf16_f32 %0, %1, %2" : "=v"(r) : "v"(lo), "v"(hi)); return r; }

__device__ __forceinline__ void partialSM(f32x16& p0, f32x16& p1, float& m_reg, float& mn, float& alpha) {
  constexpr float C = SCALE * 1.4426950408889634f;
  float pmax = p0[0];
#pragma unroll
  for (int r = 1; r < 16; ++r) pmax = fmaxf(pmax, p0[r]);
#pragma unroll
  for (int r = 0; r < 16; ++r) pmax = fmaxf(pmax, p1[r]);
  { auto rr = __builtin_amdgcn_permlane32_swap(__float_as_uint(pmax), __float_as_uint(pmax), false, false);
    pmax = fmaxf(__uint_as_float(rr[0]), __uint_as_float(rr[1])); }
  if (__builtin_expect(__all(pmax - m_reg <= THR / SCALE), 1)) { mn = m_reg; alpha = 1.f; }
  else { mn = fmaxf(m_reg, pmax); alpha = __builtin_amdgcn_exp2f((m_reg - mn) * C); m_reg = mn; }
  float mnC = -mn * C;
#pragma unroll
  for (int r = 0; r < 16; ++r) p0[r] = fmaf(p0[r], C, mnC);
#pragma unroll
  for (int r = 0; r < 16; ++r) p1[r] = fmaf(p1[r], C, mnC);
#pragma unroll
  for (int r = 0; r < 16; ++r) p0[r] = __builtin_amdgcn_exp2f(p0[r]);
}
__device__ __forceinline__ void finishSM(f32x16& p0, f32x16& p1, float alpha, float& l_reg, bf16x8& pa0, bf16x8& pa1, bf16x8& pa2, bf16x8& pa3) {
#pragma unroll
  for (int r = 0; r < 16; ++r) p1[r] = __builtin_amdgcn_exp2f(p1[r]);
  float ps = 0;
#pragma unroll
  for (int r = 0; r < 16; ++r) ps += p0[r];
#pragma unroll
  for (int r = 0; r < 16; ++r) ps += p1[r];
  { auto rr = __builtin_amdgcn_permlane32_swap(__float_as_uint(ps), __float_as_uint(ps), false, false);
    ps = __uint_as_float(rr[0]) + __uint_as_float(rr[1]); }
  l_reg = l_reg * alpha + ps;
#define PK4(P, BASE, OUT) do { unsigned a0 = cvtpk(P[BASE + 0], P[BASE + 1]), a1 = cvtpk(P[BASE + 2], P[BASE + 3]);   \
    unsigned b0 = cvtpk(P[BASE + 4], P[BASE + 5]), b1 = cvtpk(P[BASE + 6], P[BASE + 7]);                              \
    auto r0 = __builtin_amdgcn_permlane32_swap(a0, b0, false, false); auto r1 = __builtin_amdgcn_permlane32_swap(a1, b1, false, false); \
    u32x4 w = {r0[0], r1[0], r0[1], r1[1]}; OUT = *reinterpret_cast<bf16x8*>(&w); } while (0)
  PK4(p0, 0, pa0); PK4(p0, 8, pa1); PK4(p1, 0, pa2); PK4(p1, 8, pa3);
#undef PK4
}
__device__ __forceinline__ void qkt(f32x16& p0, f32x16& p1, const char* Ks, const bf16x8* qr, const char* Qr, int r32, int hi) {
  p0 = f32x16{}; p1 = f32x16{};
#pragma unroll
  for (int d0 = 0; d0 < 12; ++d0) { int cb = (d0 * 16 + hi * 8) * 2;
    bf16x8 b0 = *reinterpret_cast<const bf16x8*>(Ks + KSWZ(r32, cb));
    bf16x8 b1 = *reinterpret_cast<const bf16x8*>(Ks + KSWZ(32 + r32, cb));
    bf16x8 q;
    if (d0 < 8) q = qr[d0];
    else q = *reinterpret_cast<const bf16x8*>(Qr + r32 * 128 + ((((d0 - 8) * 16 + hi * 8) * 2) ^ ((r32 & 7) << 4)));
    p0 = __builtin_amdgcn_mfma_f32_32x32x16_bf16(b0, q, p0, 0, 0, 0);
    p1 = __builtin_amdgcn_mfma_f32_32x32x16_bf16(b1, q, p1, 0, 0, 0); }
}
__device__ __forceinline__ int v_st(int k, int c) { const int kk = (k & ~0xC) | ((k & 4) << 1) | ((k & 8) >> 1); return ((kk >> 3) * 4 + (c >> 5)) * 512 + ((kk & 7) * 32 + (c & 31)) * 2; }
__device__ __forceinline__ int v_rd_base(int lane) { return ((lane & 3) << 3) | (((lane >> 2) & 3) << 6) | (((lane >> 4) & 1) << 5) | (((lane >> 5) & 1) << 8); }
constexpr int v_rd_off(int d0, int ks, int half) { return d0 * 512 + ks * 4096 + half * 2048; }
template <int OFF> __device__ __forceinline__ s16x4 tr_read(int vb) {
  s16x4 r; asm volatile("ds_read_b64_tr_b16 %0, %1 offset:%2" : "=&v"(r) : "v"(vb), "i"(OFF) : "memory"); return r;
}
template <int D0> __device__ __forceinline__ void pv_one(f32x16& od, int vb, bf16x8 pa0, bf16x8 pa1, bf16x8 pa2, bf16x8 pa3) {
  const s16x4 l0 = tr_read<v_rd_off(D0, 0, 0)>(vb), h0 = tr_read<v_rd_off(D0, 0, 1)>(vb), l1 = tr_read<v_rd_off(D0, 1, 0)>(vb), h1 = tr_read<v_rd_off(D0, 1, 1)>(vb);
  const s16x4 l2 = tr_read<v_rd_off(D0, 2, 0)>(vb), h2 = tr_read<v_rd_off(D0, 2, 1)>(vb), l3 = tr_read<v_rd_off(D0, 3, 0)>(vb), h3 = tr_read<v_rd_off(D0, 3, 1)>(vb);
  asm volatile("s_waitcnt lgkmcnt(0)" ::: "memory"); SBAR();
#define PK(L, H) (bf16x8){L[0], L[1], L[2], L[3], H[0], H[1], H[2], H[3]}
  od = __builtin_amdgcn_mfma_f32_32x32x16_bf16(pa0, PK(l0, h0), od, 0, 0, 0);
  od = __builtin_amdgcn_mfma_f32_32x32x16_bf16(pa1, PK(l1, h1), od, 0, 0, 0);
  od = __builtin_amdgcn_mfma_f32_32x32x16_bf16(pa2, PK(l2, h2), od, 0, 0, 0);
  od = __builtin_amdgcn_mfma_f32_32x32x16_bf16(pa3, PK(l3, h3), od, 0, 0, 0);
#undef PK
}
__device__ __forceinline__ void pv_d0(f32x16* o, int vb, bf16x8 pa0, bf16x8 pa1, bf16x8 pa2, bf16x8 pa3) {
  pv_one<0>(o[0], vb, pa0, pa1, pa2, pa3); pv_one<1>(o[1], vb, pa0, pa1, pa2, pa3); pv_one<2>(o[2], vb, pa0, pa1, pa2, pa3); pv_one<3>(o[3], vb, pa0, pa1, pa2, pa3);
}

__device__ __forceinline__ void attn_unit(const bf16_t* __restrict__ Qb, const bf16_t* __restrict__ Kg, const bf16_t* __restrict__ Vg, bf16_t* __restrict__ Ob,
                                          int r0, int n0, int r1, int NT, char* lds) {
  int tid = threadIdx.x; asm volatile("" : "+v"(tid));
  const int wid = tid >> 6, lane = tid & 63, r32 = lane & 31, hi = lane >> 5;
  char* V_lds = lds + OFF_V; char* K_lds = lds + OFF_K;
  float* ws = (float*)(lds + OFF_WS) + wid * 64; float* li_l = ws; float* al_l = ws + 32;
  float m_reg = -1e30f, l_reg = 0; f32x16 o[4] = {}; bf16x8 qr[8];
  const bf16_t* Qw = Qb + (long)(wid * QBLK + r32) * LDQ + hi * 8;
  char* Qr = lds + OFF_QR + wid * 4096;
#pragma unroll
  for (int d0 = 0; d0 < 8; ++d0) qr[d0] = *reinterpret_cast<const bf16x8*>(Qw + d0 * 16);
#pragma unroll
  for (int d0 = 8; d0 < 12; ++d0) { const bf16x8 q = *reinterpret_cast<const bf16x8*>(Qw + d0 * 16);
    *reinterpret_cast<bf16x8*>(Qr + r32 * 128 + ((((d0 - 8) * 16 + hi * 8) * 2) ^ ((r32 & 7) << 4))) = q; }
  const int sr = tid >> 4, sc = (tid & 15) * 8, vst0 = v_st(sr, sc), vst1 = v_st(32 + sr, sc);
  unsigned kgo[3], kst[3];
#pragma unroll
  for (int i = 0; i < 3; ++i) { const int id = tid + 512 * i, kr_ = id / 24, kc_ = id % 24; kgo[i] = (unsigned)(kr_ * LDK + kc_ * 8) * 2u; kst[i] = (unsigned)KSWZ(kr_, kc_ * 16); }
  const unsigned vgo0 = (unsigned)(sr * LDV + sc) * 2u, vgo1 = vgo0 + 32u * LDV * 2u;
  const int vb0 = (int)(uintptr_t)V_lds + v_rd_base(lane);
  bf16x8 vs0, vs1, ks0, ks1, ks2;
#define TROW(j) ((j) < n0 ? r0 + 64 * (j) : r1 + 64 * ((j) - n0))
#define SLOAD(j) do { const long tr_ = TROW(j); const char* Vt = (const char*)(Vg + tr_ * LDV); const char* Kt = (const char*)(Kg + tr_ * LDK);     \
    vs0 = *reinterpret_cast<const bf16x8*>(Vt + vgo0); vs1 = *reinterpret_cast<const bf16x8*>(Vt + vgo1); \
    ks0 = *reinterpret_cast<const bf16x8*>(Kt + kgo[0]); ks1 = *reinterpret_cast<const bf16x8*>(Kt + kgo[1]); ks2 = *reinterpret_cast<const bf16x8*>(Kt + kgo[2]); } while (0)
#define SWRITE(b) do { *(bf16x8*)(V_lds + (b) * SHM_V + vst0) = vs0; *(bf16x8*)(V_lds + (b) * SHM_V + vst1) = vs1; \
    *(bf16x8*)(K_lds + (b) * SHM_K + kst[0]) = ks0; *(bf16x8*)(K_lds + (b) * SHM_K + kst[1]) = ks1; *(bf16x8*)(K_lds + (b) * SHM_K + kst[2]) = ks2; } while (0)
#define RESC(a) do { if (__any((a) < 1.f)) { if (hi == 0) al_l[r32] = (a); asm volatile("s_waitcnt lgkmcnt(0)" ::: "memory"); \
    _Pragma("unroll") for (int d = 0; d < 4; ++d) _Pragma("unroll") for (int r = 0; r < 16; ++r) o[d][r] *= al_l[crow(r, hi)]; } } while (0)
  f32x16 pA0, pA1, pB0, pB1; float mnA, mnB, alA, alB; bf16x8 pa0, pa1, pa2, pa3;
  SLOAD(0); asm volatile("s_waitcnt vmcnt(0)" ::: "memory"); SWRITE(0); __syncthreads();
  qkt(pA0, pA1, K_lds, qr, Qr, r32, hi); partialSM(pA0, pA1, m_reg, mnA, alA);
  SLOAD(1);
  asm volatile("s_waitcnt vmcnt(0)" ::: "memory"); SWRITE(1); __syncthreads();
  for (int j = 1; j + 1 < NT; j += 2) {
    SBAR(); qkt(pB0, pB1, K_lds + SHM_K, qr, Qr, r32, hi);
    finishSM(pA0, pA1, alA, l_reg, pa0, pa1, pa2, pa3); SBAR();
    SLOAD(j + 1); SBAR();
    pv_d0(o, vb0, pa0, pa1, pa2, pa3); partialSM(pB0, pB1, m_reg, mnB, alB);
    __syncthreads(); asm volatile("s_waitcnt vmcnt(0)" ::: "memory"); SWRITE(0);
    RESC(alB); __syncthreads();
    SBAR(); qkt(pA0, pA1, K_lds, qr, Qr, r32, hi);
    finishSM(pB0, pB1, alB, l_reg, pa0, pa1, pa2, pa3); SBAR();
    SLOAD(j + 2); SBAR();
    pv_d0(o, vb0 + SHM_V, pa0, pa1, pa2, pa3); partialSM(pA0, pA1, m_reg, mnA, alA);
    __syncthreads(); asm volatile("s_waitcnt vmcnt(0)" ::: "memory"); SWRITE(1);
    RESC(alA); __syncthreads();
  }
  SBAR(); qkt(pB0, pB1, K_lds + SHM_K, qr, Qr, r32, hi);
  finishSM(pA0, pA1, alA, l_reg, pa0, pa1, pa2, pa3); SBAR();
  pv_d0(o, vb0, pa0, pa1, pa2, pa3); partialSM(pB0, pB1, m_reg, mnB, alB);
  __syncthreads(); RESC(alB);
  finishSM(pB0, pB1, alB, l_reg, pa0, pa1, pa2, pa3); SBAR();
  pv_d0(o, vb0 + SHM_V, pa0, pa1, pa2, pa3);
  if (hi == 0) li_l[r32] = l_reg; asm volatile("s_waitcnt lgkmcnt(0)" ::: "memory");
  float rli[16];
#pragma unroll
  for (int r = 0; r < 16; ++r) rli[r] = __builtin_amdgcn_rcpf(li_l[crow(r, hi)]);
  __syncthreads();
  { bf16_t* stg = (bf16_t*)(lds + wid * 8192);
#pragma unroll
    for (int r = 0; r < 16; ++r) { const int orow = crow(r, hi);
#pragma unroll
      for (int d0 = 0; d0 < 4; ++d0) { const unsigned pk = cvtpk(o[d0][r] * rli[r], 0.f); stg[orow * 128 + d0 * 32 + r32] = (bf16_t)(pk & 0xffffu); } }
    asm volatile("s_waitcnt lgkmcnt(0)" ::: "memory");
    bf16_t* Ow = Ob + (long)(wid * QBLK) * LDO;
#pragma unroll
    for (int i = 0; i < 8; ++i) { const int row = i * 4 + (lane >> 4), ch = lane & 15; const u32x4 v = *(const u32x4*)(stg + row * 128 + ch * 8); *(u32x4*)(Ow + (long)row * LDO + ch * 8) = v; } }
  __syncthreads();
#undef TROW
#undef SLOAD
#undef SWRITE
#undef RESC
}
#undef KSWZ
#undef SBAR
}
constexpr int NWAVES = 8;
#ifndef MK_SPLIT
#define MK_SPLIT 0
#endif

constexpr int DM = 1024, NB = 8, SL = 2048, CL = 256, MLAT = NB * SL, MCTX = NB * CL, MT = MLAT + MCTX;
constexpr int NIN = 2048;
constexpr int FF = 2816, NUP = 2 * FF;
constexpr int NPH = 20;
constexpr float EPS = 1e-6f;

constexpr size_t MiB = 1u << 20;
constexpr size_t WS_CTL = 0, CTL_ZERO_BYTES = 64 * 1024;
constexpr size_t WS_MOD = 1 * MiB;
constexpr size_t WS_ROPE = 1 * MiB + 512 * 1024;
constexpr size_t WS_SSQ = 2 * MiB;
constexpr size_t WS_WIN = 4 * MiB, WIN_STRIDE = (size_t)NIN * DM * 2;
constexpr size_t WS_WUQ = 12 * MiB, WUQ_STRIDE = (size_t)768 * 384 * 2;
constexpr size_t WS_WUKV = 13 * MiB + 256 * 1024, WUKV_STRIDE = (size_t)1024 * 256 * 2;
constexpr size_t WS_WOUT = 14 * MiB + 512 * 1024, WOUT_STRIDE = (size_t)DM * DM * 2;
constexpr size_t WS_WUP = 19 * MiB, WUP_STRIDE = (size_t)NUP * DM * 2;
constexpr size_t WS_WDOWN = 41 * MiB, WDOWN_STRIDE = (size_t)DM * FF * 2;
constexpr size_t WS_DFT = 52 * MiB;
constexpr size_t WS_DFTC = 68 * MiB;
constexpr size_t WS_CST = 68 * MiB + 256 * 1024;
constexpr size_t WS_WF = 248 * MiB;
constexpr size_t WS_XCTX = 69 * MiB;
constexpr size_t WS_XN = 77 * MiB;
constexpr size_t WS_Q = WS_XN, WS_YC = WS_XN + 27 * MiB;
constexpr size_t WS_P = 113 * MiB;
constexpr size_t WS_YCAT = WS_P, WS_ACT = WS_P;
constexpr size_t WS_YFP = WS_P + 36 * MiB;
constexpr size_t WS_K = 185 * MiB;
constexpr size_t WS_V = 212 * MiB;
constexpr size_t WS_CPART = 212 * MiB;
constexpr size_t WS_ZT = 230 * MiB;
constexpr size_t WS_ZTC = WS_ZT + 16 * MiB;
constexpr size_t WS_SSX = 250 * MiB;
constexpr size_t WS_PB = 252 * MiB;
constexpr size_t WS_UB = 253 * MiB;
constexpr size_t WS_END = 254 * MiB;
static_assert(WS_WUQ + 2 * WUQ_STRIDE <= WS_WUKV && WS_WUKV + 2 * WUKV_STRIDE <= WS_WOUT && WS_WOUT + 2 * WOUT_STRIDE <= WS_WUP && WS_WUP + 2 * WUP_STRIDE <= WS_WDOWN && WS_WDOWN + 2 * WDOWN_STRIDE <= WS_DFT, "weights map");
static_assert(WS_SSQ + (size_t)MT * 80 <= WS_WIN && WS_XN + (size_t)MT * DM * 2 <= WS_P && WS_P + (size_t)MT * NIN * 2 <= WS_K && WS_K + (size_t)MT * 768 * 2 <= WS_V && WS_V + (size_t)MT * 512 * 2 <= WS_ZT, "activation map");
static_assert(WS_ACT + (size_t)MT * FF * 2 <= WS_V && WS_YC + (size_t)MT * 256 * 2 <= WS_P, "overlay map");
constexpr int CW_BAR = 4096;

constexpr int RING_OFF = 0, RING_BYTES = 131072;
constexpr int LDSCTL_OFF = RING_BYTES, MISC_OFF = LDSCTL_OFF + 320, PTR_OFF = LDSCTL_OFF + 512, EPIX_OFF = LDSCTL_OFF + 1024;
constexpr int LDS_BYTES = 163840;
static_assert(EPIX_OFF + 6400 * 4 <= LDS_BYTES, "LDS map");

#define GAS __attribute__((address_space(1)))
#define LAS __attribute__((address_space(3)))
typedef unsigned short bf16;
typedef unsigned v4u __attribute__((ext_vector_type(4)));
typedef unsigned v2u __attribute__((ext_vector_type(2)));
typedef float f32x4 __attribute__((ext_vector_type(4)));
typedef GAS unsigned gu32;
#define RLX_AGENT __ATOMIC_RELAXED, __HIP_MEMORY_SCOPE_AGENT
#define LDS_WAIT() asm volatile("s_waitcnt lgkmcnt(0)" ::: "memory")
#define VM_WAIT() asm volatile("s_waitcnt vmcnt(0)" ::: "memory")
__device__ __forceinline__ unsigned f2bf(float f) { unsigned u = __builtin_bit_cast(unsigned, f); return (u + 0x7fffu + ((u >> 16) & 1u)) >> 16; }
__device__ __forceinline__ unsigned pk2(float lo, float hi) { return f2bf(lo) | (f2bf(hi) << 16); }
__device__ __forceinline__ float bf2f(unsigned h) { return __builtin_bit_cast(float, h << 16); }

#define XB_TMO      128
#define XB_XCNT(j)  (256  + 64 * (j))
#define XB_XSUB(j)  (1280 + 64 * (j))
#define XB_XGEN(j)  (2304 + 64 * (j))
#define XB_TOP      3328
#define XB_TOPGEN   3392
#define XCD_BAR_WORDS 3456
#define XB_SPIN_CAP (1u << 20)
__device__ __forceinline__ unsigned xb_ld(unsigned* p)              { return __hip_atomic_load(p, __ATOMIC_RELAXED, __HIP_MEMORY_SCOPE_AGENT); }
__device__ __forceinline__ unsigned xb_add(unsigned* p, unsigned v) { return __hip_atomic_fetch_add(p, v, __ATOMIC_RELAXED, __HIP_MEMORY_SCOPE_AGENT); }
__device__ __forceinline__ unsigned xb_xcc_id() { return (unsigned)__builtin_amdgcn_s_getreg((3 << 11) | 20) & 0xFu; }
#define XB_SPIN(cond, bar) do { unsigned _sp = 0; while (cond) { __builtin_amdgcn_s_sleep(1); \
    if ((++_sp & 255u) == 0u) { if (xb_ld(&(bar)[XB_TMO])) break; if (_sp > XB_SPIN_CAP) { atomicAdd(&(bar)[XB_TMO], 1u); break; } } } } while (0)
struct XcdBarrier { unsigned* bar; unsigned x; volatile LAS unsigned* st; };
__device__ __forceinline__ XcdBarrier xcd_barrier_post(unsigned* bar, volatile LAS unsigned* st) {
    XcdBarrier b; b.bar = bar; b.x = xb_xcc_id(); b.st = st;
    if (threadIdx.x == 0) (void)xb_add(&bar[XB_XCNT(b.x)], 1u);
    return b;
}
__device__ __forceinline__ void xcd_barrier_complete(unsigned* bar, unsigned x, unsigned& nloc, unsigned& nx) {
    const unsigned G = gridDim.x * gridDim.y * gridDim.z;
    unsigned sum, cnt, mine, sp = 0u;
    for (;;) {
        sum = 0u; cnt = 0u; mine = 0u;
#pragma unroll
        for (unsigned j = 0; j < 16; ++j) { const unsigned c = xb_ld(&bar[XB_XCNT(j)]); sum += c; cnt += (c > 0u) ? 1u : 0u; mine = (j == x) ? c : mine; }
        if (sum == G) break;
        __builtin_amdgcn_s_sleep(1);
        if ((++sp & 255u) == 0u) { if (xb_ld(&bar[XB_TMO])) break; if (sp > XB_SPIN_CAP) { atomicAdd(&bar[XB_TMO], 1u); break; } }
    }
    nloc = mine > 0u ? mine : 1u; nx = cnt > 0u ? cnt : 1u;
}
__device__ __forceinline__ void xcd_barrier(const XcdBarrier& b) {
    asm volatile("s_waitcnt vmcnt(0)" ::: "memory");
    __syncthreads();
    if (threadIdx.x == 0) {
        unsigned* bar = b.bar;
        __builtin_amdgcn_s_waitcnt(0);
        unsigned nloc = b.st[0], nx = b.st[1];
        if (nloc == 0u) { xcd_barrier_complete(bar, b.x, nloc, nx); b.st[0] = nloc; b.st[1] = nx; }
        const unsigned old = xb_add(&bar[XB_XSUB(b.x)], 1u);
        const unsigned gen = old / nloc;
        if (old + 1u == (gen + 1u) * nloc) {
            __builtin_amdgcn_fence(__ATOMIC_RELEASE, "agent");
            asm volatile("s_waitcnt vmcnt(0)" ::: "memory");
            const unsigned og = xb_add(&bar[XB_TOP], 1u);
            const unsigned tg = og / nx;
            if (og + 1u == (tg + 1u) * nx) xb_add(&bar[XB_TOPGEN], 1u);
            else XB_SPIN(xb_ld(&bar[XB_TOPGEN]) == tg, bar);
            __builtin_amdgcn_fence(__ATOMIC_ACQUIRE, "agent");
            xb_add(&bar[XB_XGEN(b.x)], 1u);
            asm volatile("s_waitcnt vmcnt(0)" ::: "memory");
        } else {
            XB_SPIN(xb_ld(&bar[XB_XGEN(b.x)]) == gen, bar);
            __builtin_amdgcn_fence(__ATOMIC_ACQUIRE, "agent");
            asm volatile("s_waitcnt vmcnt(0)" ::: "memory");
        }
    }
    __syncthreads();
}

struct Args { const float* in[22]; float* out; unsigned char* ws; int ph_lo, ph_hi; };
enum { I_X = 0, I_C, I_CTX, I_CCTX, I_ADAW, I_ADAB, I_N1G, I_WIN, I_QNG, I_KVNG, I_WUQ, I_WUKV, I_SCW, I_SCB, I_ONG, I_WOUT, I_N2G, I_WUP, I_FCW, I_FCB, I_WDOWN, I_FING };

struct Frame {
    LAS unsigned char* lds; char* ldsg;
    volatile LAS unsigned* MISC;
    int tid, lane, wave, vcu, G, bx;
    unsigned char* ws; float* out;
};

__device__ __forceinline__ const float* inptr(const Frame& F, int i) {
    const LAS unsigned* T = (const LAS unsigned*)(F.lds + PTR_OFF) + 2 * i;
    const unsigned lo = __builtin_amdgcn_readfirstlane(T[0]), hi = __builtin_amdgcn_readfirstlane(T[1]);
    return (const float*)(const GAS float*)(((unsigned long long)hi << 32) | (unsigned long long)lo);
}
__device__ __forceinline__ float wave_sum(float v) {
#pragma unroll
    for (int o = 1; o < 64; o <<= 1) v += __shfl_xor(v, o);
    return v;
}

__device__ __forceinline__ void tr_item(const float* W, int ldw, int k0, int c0, bf16* WT, int ldt, int r0, const float* ks, LAS float* scr, int lane) {
    f32x4 v[8];
#pragma unroll
    for (int i = 0; i < 8; ++i) { const int kk = 8 * i + (lane >> 3); v[i] = *(const GAS f32x4*)(W + (size_t)(k0 + kk) * ldw + c0 + 4 * (lane & 7)); }
#pragma unroll
    for (int i = 0; i < 8; ++i) { const int kk = 8 * i + (lane >> 3); const float sc = ks ? ks[k0 + kk] : 1.0f; LAS float* d = scr + kk * 33 + 4 * (lane & 7);
        d[0] = v[i][0] * sc; d[1] = v[i][1] * sc; d[2] = v[i][2] * sc; d[3] = v[i][3] * sc; }
    LDS_WAIT(); asm volatile("" ::: "memory");
    const int c = lane & 7;
#pragma unroll
    for (int j = 0; j < 4; ++j) { const int n = (lane >> 3) + 8 * j; const LAS float* s = scr + (8 * c) * 33 + n;
        v4u o; o.x = pk2(s[0 * 33], s[1 * 33]); o.y = pk2(s[2 * 33], s[3 * 33]); o.z = pk2(s[4 * 33], s[5 * 33]); o.w = pk2(s[6 * 33], s[7 * 33]);
        *(GAS v4u*)(WT + (size_t)(r0 + n) * ldt + k0 + 8 * c) = o; }
    LDS_WAIT(); asm volatile("" ::: "memory");
}
__device__ __forceinline__ void p0_prologue(Frame& F, int sub) {
    unsigned char* ws = F.ws;
    float* MOD = (float*)(ws + WS_MOD);
    if (F.bx < 192 && (sub & 1)) {
        const int l = F.bx / 96, cb = F.bx % 96;
        LAS float* S = (LAS float*)(F.lds + F.wave * 4608);
        const float* cin = inptr(F, I_C); const float* cctx = inptr(F, I_CCTX);
        for (int i = F.lane; i < 9 * 128; i += 64) { const int r = i >> 7, kk = i & 127, k = 128 * F.wave + kk; const float cv = (r < 8) ? cin[r * 1024 + k] : cctx[k]; S[i] = cv / (1.0f + __expf(-cv)); }
        LDS_WAIT(); asm volatile("" ::: "memory");
        f32x4 acc[9];
#pragma unroll
        for (int r = 0; r < 9; ++r) acc[r] = (f32x4){0.f, 0.f, 0.f, 0.f};
        const int kr = F.lane >> 4, cl = F.lane & 15;
        const float* W = inptr(F, I_ADAW) + (size_t)l * 1024 * 6144 + (size_t)(128 * F.wave) * 6144 + 64 * cb + 4 * cl;
#pragma unroll 4
        for (int i = 0; i < 32; ++i) { const int kk = 4 * i + kr; const f32x4 w = *(const f32x4*)(W + (size_t)kk * 6144);
#pragma unroll
            for (int r = 0; r < 9; ++r) acc[r] += w * S[r * 128 + kk]; }
        LAS float* RED = (LAS float*)(F.lds + 40960);
#pragma unroll
        for (int r = 0; r < 9; ++r)
#pragma unroll
            for (int e = 0; e < 4; ++e) { float v = acc[r][e]; v += __shfl_xor(v, 16); v += __shfl_xor(v, 32); if (kr == 0) RED[(F.wave * 9 + r) * 64 + 4 * cl + e] = v; }
        __syncthreads();
        for (int i = F.tid; i < 576; i += 512) { const int r = i >> 6, col = i & 63; float s = 0.f;
#pragma unroll
            for (int w = 0; w < 8; ++w) s += RED[(w * 9 + r) * 64 + col];
            MOD[(size_t)(l * 9 + r) * 6144 + 64 * cb + col] = s + inptr(F, I_ADAB)[l * 6144 + 64 * cb + col]; }
        __syncthreads();
    }
    if (F.bx == 255 % F.G) {
        float* RC = (float*)(ws + WS_ROPE); float* RS = RC + 1024;
        for (int idx = F.tid; idx < 1024; idx += 512) { const int pos = idx >> 4, i = idx & 15; const float inv = powf(10000.0f, -(float)(2 * i) / 32.0f); const float ang = (float)pos * inv; RC[idx] = cosf(ang); RS[idx] = sinf(ang); }
    }
    LAS float* scr = (LAS float*)(F.lds + F.wave * 16384);
    const int gw = F.vcu * NWAVES + F.wave, NGW = F.G * NWAVES;
    constexpr int I_WINA = 22 * 16, I_WINB = 24 * 16, I_PAD = 8, I_FOLD = 64, I_UQ = 6 * 24, I_UKV = 4 * 32, I_OUT = 16 * 32, I_UP = 16 * 176, I_DOWN = 44 * 32;
    constexpr int PER_LAYER = I_WINA + I_WINB + I_PAD + I_FOLD + I_UQ + I_UKV + I_OUT + I_UP + I_DOWN;
    constexpr int I_DFT = 2048, I_DFTC = 256, I_CST = 512;
    constexpr int NITEMS = 2 * PER_LAYER + I_DFT + I_DFTC + I_CST;
    for (int it = gw; it < NITEMS; it += NGW) {
        int r = it;
        { int cat = 2; if (r < 2 * PER_LAYER) { const int q = r % PER_LAYER;
              cat = q < I_WINA + I_WINB + I_PAD ? 1 : q < I_WINA + I_WINB + I_PAD + I_FOLD ? 3 : q < I_WINA + I_WINB + I_PAD + I_FOLD + I_UQ + I_UKV + I_OUT ? 4 : q < PER_LAYER - I_DOWN ? 5 : 6; }
          if (!((sub >> cat) & 1)) continue; }
        if (r < 2 * PER_LAYER) {
            const int l = r / PER_LAYER; r -= l * PER_LAYER;
            bf16* WinT = (bf16*)(ws + WS_WIN + l * WIN_STRIDE);
            const float* win = inptr(F, I_WIN) + (size_t)l * 1024 * 1728;
            if (r < I_WINA) { const int kb = r / 22, nb = r % 22; tr_item(win, 1728, 64 * kb, 32 * nb, WinT, 1024, 32 * nb, nullptr, scr, F.lane); continue; } r -= I_WINA;
            if (r < I_WINB) { const int kb = r / 24, nb = r % 24; tr_item(win, 1728, 64 * kb, 960 + 32 * nb, WinT, 1024, 1280 + 32 * nb, nullptr, scr, F.lane); continue; } r -= I_WINB;
            if (r < I_PAD) { const v4u z = {0u, 0u, 0u, 0u};
#pragma unroll
                for (int j = 0; j < 16; ++j) { const int q = j * 64 + F.lane; *(GAS v4u*)(WinT + (size_t)(704 + 8 * r + (q >> 7)) * 1024 + (q & 127) * 8) = z; } continue; } r -= I_PAD;
            if (r < I_FOLD) { bf16* WF = (bf16*)(ws + WS_WF) + (size_t)l * 1024 * 256;
#pragma unroll 4
                for (int i = 0; i < 16; ++i) { const int k = 16 * r + i; const f32x4 v = *(const GAS f32x4*)(win + (size_t)k * 1728 + 704 + 4 * F.lane);
                    v2u o; o.x = pk2(v[0], v[1]); o.y = pk2(v[2], v[3]); *(GAS v2u*)(WF + (size_t)k * 256 + 4 * F.lane) = o; } continue; } r -= I_FOLD;
            if (r < I_UQ) { const int kb = r / 24, nb = r % 24; tr_item(inptr(F, I_WUQ) + (size_t)l * 384 * 768, 768, 64 * kb, 32 * nb, (bf16*)(ws + WS_WUQ + l * WUQ_STRIDE), 384, 32 * nb, inptr(F, I_QNG) + l * 384, scr, F.lane); continue; } r -= I_UQ;
            if (r < I_UKV) { const int kb = r / 32, nb = r % 32; tr_item(inptr(F, I_WUKV) + (size_t)l * 256 * 1024, 1024, 64 * kb, 32 * nb, (bf16*)(ws + WS_WUKV + l * WUKV_STRIDE), 256, 32 * nb, inptr(F, I_KVNG) + l * 256, scr, F.lane); continue; } r -= I_UKV;
            if (r < I_OUT) { const int kb = r / 32, nb = r % 32; tr_item(inptr(F, I_WOUT) + (size_t)l * 1024 * 1024, 1024, 64 * kb, 32 * nb, (bf16*)(ws + WS_WOUT + l * WOUT_STRIDE), 1024, 32 * nb, inptr(F, I_ONG) + l * 1024, scr, F.lane); continue; } r -= I_OUT;
            if (r < I_UP) { const int kb = r / 176, nb = r % 176;
                const int j = nb >> 3, h = (nb >> 2) & 1, q = nb & 3;
                tr_item(inptr(F, I_WUP) + (size_t)l * 1024 * NUP, NUP, 64 * kb, h * FF + 128 * j + 32 * q, (bf16*)(ws + WS_WUP + l * WUP_STRIDE), 1024, 32 * nb, nullptr, scr, F.lane); continue; } r -= I_UP;
            { const int kb = r / 32, nb = r % 32; tr_item(inptr(F, I_WDOWN) + (size_t)l * FF * 1024, 1024, 64 * kb, 32 * nb, (bf16*)(ws + WS_WDOWN + l * WDOWN_STRIDE), FF, 32 * nb, nullptr, scr, F.lane); continue; }
        }
        r -= 2 * PER_LAYER;
        if (r < I_DFT) { const int k1 = r; bf16* D = (bf16*)(ws + WS_DFT) + (size_t)k1 * 4096;
#pragma unroll
            for (int j = 0; j < 8; ++j) { const int n0 = 512 * j + 8 * F.lane; float v[8];
#pragma unroll
                for (int e = 0; e < 8; ++e) { const int n = n0 + e, n1 = n & 2047; const float x = (float)((k1 * n1) & 2047) * (1.0f / 1024.0f); v[e] = (n < 2048) ? cospif(x) : -sinpif(x); }
                v4u o; o.x = pk2(v[0], v[1]); o.y = pk2(v[2], v[3]); o.z = pk2(v[4], v[5]); o.w = pk2(v[6], v[7]); *(GAS v4u*)(D + n0) = o; }
            continue; }
        r -= I_DFT;
        if (r >= I_DFTC) { r -= I_DFTC;
            const int sn = r >> 8, g = (r >> 6) & 3, k2 = r & 63; float v[4];
#pragma unroll
            for (int e = 0; e < 4; ++e) { const int j = 4 * F.lane + e; const float x = (float)((k2 * (j & 63)) & 63) * (1.0f / 32.0f); v[e] = ((j >> 6) == g) ? (sn ? sinpif(x) : cospif(x)) : 0.0f; }
            v2u o; o.x = pk2(v[0], v[1]); o.y = pk2(v[2], v[3]); *(GAS v2u*)((bf16*)(ws + WS_CST) + (size_t)r * 256 + 4 * F.lane) = o; continue; }
        { const int k1 = r; bf16* D = (bf16*)(ws + WS_DFTC) + (size_t)k1 * 512; const int n0 = 8 * F.lane; float v[8];
#pragma unroll
            for (int e = 0; e < 8; ++e) { const int n = n0 + e, n1 = n & 255; const float x = (float)((k1 * n1) & 255) * (1.0f / 128.0f); v[e] = (n < 256) ? cospif(x) : -sinpif(x); }
            v4u o; o.x = pk2(v[0], v[1]); o.y = pk2(v[2], v[3]); o.z = pk2(v[4], v[5]); o.w = pk2(v[6], v[7]); *(GAS v4u*)(D + n0) = o; }
    }
}

__device__ __forceinline__ void bias_item(const bf16* WT, int n, const float* mod  , int shofs, float* out, int N, int lane) {
    const v4u w0 = *(const GAS v4u*)(WT + (size_t)n * 1024 + 16 * lane), w1 = *(const GAS v4u*)(WT + (size_t)n * 1024 + 16 * lane + 8);
    float wv[16];
    wv[0] = bf2f(w0.x & 0xffffu); wv[1] = bf2f(w0.x >> 16); wv[2] = bf2f(w0.y & 0xffffu); wv[3] = bf2f(w0.y >> 16); wv[4] = bf2f(w0.z & 0xffffu); wv[5] = bf2f(w0.z >> 16); wv[6] = bf2f(w0.w & 0xffffu); wv[7] = bf2f(w0.w >> 16);
    wv[8] = bf2f(w1.x & 0xffffu); wv[9] = bf2f(w1.x >> 16); wv[10] = bf2f(w1.y & 0xffffu); wv[11] = bf2f(w1.y >> 16); wv[12] = bf2f(w1.z & 0xffffu); wv[13] = bf2f(w1.z >> 16); wv[14] = bf2f(w1.w & 0xffffu); wv[15] = bf2f(w1.w >> 16);
    for (int b = 0; b < 9; ++b) { const float* sh = mod + b * 6144 + shofs + 16 * lane; float a = 0.f;
#pragma unroll
        for (int q = 0; q < 4; ++q) { const f32x4 s = *(const f32x4*)(sh + 4 * q); a += (s[0] * wv[4 * q] + s[1] * wv[4 * q + 1]) + (s[2] * wv[4 * q + 2] + s[3] * wv[4 * q + 3]); }
        a = wave_sum(a); if (lane == 0) out[(size_t)b * N + n] = a; }
}
__device__ __forceinline__ void bias_phase(Frame& F) {
    const int gw = F.vcu * NWAVES + F.wave, NGW = F.G * NWAVES; const float* MODp = (const float*)(F.ws + WS_MOD);
    for (int it = gw; it < 2048 + 2 * 5632; it += NGW) {
        if (it < 2048) bias_item((const bf16*)(F.ws + WS_WIN + WIN_STRIDE), it, MODp + 9 * 6144, 0, (float*)(F.ws + WS_PB) + 9 * 2048, 2048, F.lane);
        else { const int q = it - 2048, l = q / 5632, n = q % 5632; bias_item((const bf16*)(F.ws + WS_WUP + l * WUP_STRIDE), n, MODp + l * 9 * 6144, 3072, (float*)(F.ws + WS_UB) + (size_t)l * 9 * 5632, 5632, F.lane); }
    }
}

__device__ __forceinline__ void norm_mod_phase(Frame& F, const float* src_lat, const float* src_ctx, int nrows, const float* g, const float* mod  , int shofs, int scofs) {
    bf16* XN = (bf16*)(F.ws + WS_XN);
    const int gw = F.vcu * NWAVES + F.wave, NGW = F.G * NWAVES;
    constexpr int R = 3;
    for (int row0 = gw; row0 < nrows; row0 += R * NGW) {
        f32x4 v[R][4];
#pragma unroll
        for (int q = 0; q < R; ++q) { const int row = row0 + q * NGW; if (row < nrows) { const float* xr = row < MLAT ? src_lat + (size_t)row * DM : src_ctx + (size_t)(row - MLAT) * DM;
#pragma unroll
            for (int j = 0; j < 4; ++j) v[q][j] = *(const f32x4*)(xr + 256 * j + 4 * F.lane); } }
#pragma unroll
        for (int q = 0; q < R; ++q) { const int row = row0 + q * NGW; if (row < nrows) {
            const int r = row < MLAT ? (row >> 11) : 8;
            const float* sh = mod + r * 6144 + shofs; const float* sc = mod + r * 6144 + scofs; float ss = 0.f;
#pragma unroll
            for (int j = 0; j < 4; ++j) ss += (v[q][j][0] * v[q][j][0] + v[q][j][1] * v[q][j][1]) + (v[q][j][2] * v[q][j][2] + v[q][j][3] * v[q][j][3]);
            const float rstd = 1.0f / sqrtf(wave_sum(ss) * (1.0f / DM) + EPS);
#pragma unroll
            for (int j = 0; j < 4; ++j) { const int c = 256 * j + 4 * F.lane; const f32x4 gg = *(const f32x4*)(g + c), s1 = *(const f32x4*)(sc + c), s0 = *(const f32x4*)(sh + c);
                const f32x4 h = (v[q][j] * rstd) * gg * (s1 + 1.0f) + s0;
                v2u o; o.x = pk2(h[0], h[1]); o.y = pk2(h[2], h[3]); *(GAS v2u*)(XN + (size_t)row * DM + c) = o; } } }
    }
}
__device__ __forceinline__ void qkv_rows_phase(Frame& F, int l) {
    const bf16* P = (const bf16*)(F.ws + WS_P); bf16* Kb = (bf16*)(F.ws + WS_K); bf16* YC = (bf16*)F.out + (size_t)MT * 768;
    const float* RC = (const float*)(F.ws + WS_ROPE); const float* RS = RC + 1024;
    const float* scw = inptr(F, I_SCW) + l * 3 * 256; const float* scb = inptr(F, I_SCB) + l * 256;
    const int gw = F.vcu * NWAVES + F.wave, NGW = F.G * NWAVES;
    const int nrows_conv = (l == 0) ? MT : MLAT;
    for (int row = gw; row < MT; row += NGW) {
        const bool lat = row < MLAT; const int t = lat ? (row & 2047) : ((row - MLAT) & 255); const int L = lat ? SL : CL;
        const bf16* pr = P + (size_t)row * NIN;
        { const float v = bf2f(pr[640 + F.lane]); const float pv = __shfl_xor(v, 16); float o = v;
          if (lat) { const int j = F.lane, ax = j >> 5, i = j & 15, x2 = (j >> 4) & 1; const int pos = ax ? (t & 63) : (t >> 6); const float c = RC[pos * 16 + i], s = RS[pos * 16 + i];
              o = x2 ? (pv * s + v * c) : (v * c - pv * s); }
          const bf16 ob = (bf16)f2bf(o);
#pragma unroll
          for (int h = 0; h < 4; ++h) Kb[(size_t)row * 768 + 192 * h + 128 + F.lane] = ob; }
        if (row < nrows_conv) { const int c = 4 * F.lane;
            const v2u bgv = *(const GAS v2u*)(pr + 1280 + c);
            const v2u cg1 = *(const GAS v2u*)(pr + 1536 + c), xv1 = *(const GAS v2u*)(pr + 1792 + c);
            v2u cg0 = {0u, 0u}, xv0 = {0u, 0u}, cg2 = {0u, 0u}, xv2 = {0u, 0u};
            if (t > 0) { cg0 = *(const GAS v2u*)(pr - NIN + 1536 + c); xv0 = *(const GAS v2u*)(pr - NIN + 1792 + c); }
            if (t < L - 1) { cg2 = *(const GAS v2u*)(pr + NIN + 1536 + c); xv2 = *(const GAS v2u*)(pr + NIN + 1792 + c); }
            const f32x4 w0 = *(const f32x4*)(scw + c), w1 = *(const f32x4*)(scw + 256 + c), w2 = *(const f32x4*)(scw + 512 + c), bb = *(const f32x4*)(scb + c);
            float y[4];
#pragma unroll
            for (int e = 0; e < 4; ++e) { const unsigned sh = (e & 1) * 16; const unsigned m = 0xffffu;
                const unsigned b_ = ((e < 2 ? bgv.x : bgv.y) >> sh) & m;
                const unsigned c0_ = ((e < 2 ? cg0.x : cg0.y) >> sh) & m, x0_ = ((e < 2 ? xv0.x : xv0.y) >> sh) & m;
                const unsigned c1_ = ((e < 2 ? cg1.x : cg1.y) >> sh) & m, x1_ = ((e < 2 ? xv1.x : xv1.y) >> sh) & m;
                const unsigned c2_ = ((e < 2 ? cg2.x : cg2.y) >> sh) & m, x2_ = ((e < 2 ? xv2.x : xv2.y) >> sh) & m;
                const float u0 = bf2f(c0_) * bf2f(x0_), u1 = bf2f(c1_) * bf2f(x1_), u2 = bf2f(c2_) * bf2f(x2_);
                y[e] = bf2f(b_) * (w0[e] * u0 + w1[e] * u1 + w2[e] * u2 + bb[e]); }
            v2u o; o.x = pk2(y[0], y[1]); o.y = pk2(y[2], y[3]); *(GAS v2u*)(YC + (size_t)row * 256 + c) = o; }
    }
}
__device__ __forceinline__ void zt_phase(Frame& F, int l) {
    const bf16* P = (const bf16*)(F.ws + WS_P);
    LAS bf16* T = (LAS bf16*)(F.lds + F.wave * 16384);
    const int gw = F.vcu * NWAVES + F.wave, NGW = F.G * NWAVES;
    const int nitems = 2048 + (l == 0 ? 256 : 0);
    for (int it = gw; it < nitems; it += NGW) {
        const bool lat = it < 2048; const int r = lat ? it : it - 2048;
        const int pb = r >> 3, cb = r & 7;
        const int row0 = (lat ? 0 : MLAT) + 64 * pb; const int L = lat ? SL : CL;
        const int b = lat ? (pb >> 5) : (pb >> 2); const int n0 = (64 * pb) & (L - 1);
        bf16* ZT = lat ? (bf16*)(F.ws + WS_ZT) : (bf16*)(F.ws + WS_ZTC);
#pragma unroll
        for (int i = 0; i < 8; ++i) { const int pos = 8 * i + (F.lane >> 3), ch = F.lane & 7;
            const v4u v = *(const GAS v4u*)(P + (size_t)(row0 + pos) * NIN + 768 + 64 * cb + 8 * ch);
            LAS unsigned* d = (LAS unsigned*)(T + pos * 66 + 8 * ch); d[0] = v.x; d[1] = v.y; d[2] = v.z; d[3] = v.w; }
        LDS_WAIT(); asm volatile("" ::: "memory");
        const int sn = cb >> 2;
#pragma unroll
        for (int j = 0; j < 8; ++j) { const int chl = 8 * j + (F.lane >> 3), pc = F.lane & 7;
            unsigned e[8];
#pragma unroll
            for (int q = 0; q < 8; ++q) e[q] = T[(8 * pc + q) * 66 + chl];
            v4u o; o.x = e[0] | (e[1] << 16); o.y = e[2] | (e[3] << 16); o.z = e[4] | (e[5] << 16); o.w = e[6] | (e[7] << 16);
            const int chg = 64 * (cb & 3) + chl;
            *(GAS v4u*)(ZT + ((size_t)(b * 256 + chg) * 2 + sn) * L + n0 + 8 * pc) = o; }
        LDS_WAIT(); asm volatile("" ::: "memory");
    }
}
__device__ __forceinline__ void ycat_norm_phase(Frame& F, int nrows) {
    bf16* Y = (bf16*)(F.ws + WS_YCAT); const bf16* YC = (const bf16*)F.out + (size_t)MT * 768; const bf16* YFP = (const bf16*)(F.ws + WS_YFP);
    const int gw = F.vcu * NWAVES + F.wave, NGW = F.G * NWAVES;
    constexpr int R = 2;
    for (int row0 = gw; row0 < nrows; row0 += R * NGW) {
        v4u a[R]; v2u c[R]; v2u f[R][4];
#pragma unroll
        for (int q = 0; q < R; ++q) { const int row = row0 + q * NGW; if (row < nrows) { a[q] = *(const GAS v4u*)(Y + (size_t)row * 1024 + 8 * F.lane); c[q] = *(const GAS v2u*)(YC + (size_t)row * 256 + 4 * F.lane);
            const bool lat = row < MLAT;
#pragma unroll
            for (int s = 0; s < 4; ++s) f[q][s] = (s == 0 || lat) ? *(const GAS v2u*)(YFP + ((size_t)s * MT + row) * 256 + 4 * F.lane) : (v2u){0u, 0u}; } }
#pragma unroll
        for (int q = 0; q < R; ++q) { const int row = row0 + q * NGW; if (row < nrows) { bf16* yr = Y + (size_t)row * 1024;
            float av[8], fv[4] = {0.f, 0.f, 0.f, 0.f}, cv[4];
#pragma unroll
            for (int s = 0; s < 4; ++s) { fv[0] += bf2f(f[q][s].x & 0xffffu); fv[1] += bf2f(f[q][s].x >> 16); fv[2] += bf2f(f[q][s].y & 0xffffu); fv[3] += bf2f(f[q][s].y >> 16); }
            av[0] = bf2f(a[q].x & 0xffffu); av[1] = bf2f(a[q].x >> 16); av[2] = bf2f(a[q].y & 0xffffu); av[3] = bf2f(a[q].y >> 16); av[4] = bf2f(a[q].z & 0xffffu); av[5] = bf2f(a[q].z >> 16); av[6] = bf2f(a[q].w & 0xffffu); av[7] = bf2f(a[q].w >> 16);
            cv[0] = bf2f(c[q].x & 0xffffu); cv[1] = bf2f(c[q].x >> 16); cv[2] = bf2f(c[q].y & 0xffffu); cv[3] = bf2f(c[q].y >> 16);
            float sa = 0.f, sf = 0.f, sc = 0.f;
#pragma unroll
            for (int e = 0; e < 8; ++e) sa += av[e] * av[e];
#pragma unroll
            for (int e = 0; e < 4; ++e) { sf += fv[e] * fv[e]; sc += cv[e] * cv[e]; }
            const float ra = 1.0f / sqrtf(wave_sum(sa) * (1.0f / 512.0f) + EPS), rf = 1.0f / sqrtf(wave_sum(sf) * (1.0f / 256.0f) + EPS), rc = 1.0f / sqrtf(wave_sum(sc) * (1.0f / 256.0f) + EPS);
            v4u oa; oa.x = pk2(av[0] * ra, av[1] * ra); oa.y = pk2(av[2] * ra, av[3] * ra); oa.z = pk2(av[4] * ra, av[5] * ra); oa.w = pk2(av[6] * ra, av[7] * ra);
            v2u of; of.x = pk2(fv[0] * rf, fv[1] * rf); of.y = pk2(fv[2] * rf, fv[3] * rf);
            v2u oc; oc.x = pk2(cv[0] * rc, cv[1] * rc); oc.y = pk2(cv[2] * rc, cv[3] * rc);
            *(GAS v4u*)(yr + 8 * F.lane) = oa; *(GAS v2u*)(yr + 512 + 4 * F.lane) = of; *(GAS v2u*)(yr + 768 + 4 * F.lane) = oc; } }
    }
}
__device__ __forceinline__ void ctx_combine_phase(Frame& F, const float* g2  , const float* g1n  ) {
    const bf16* PART = (const bf16*)(F.ws + WS_CPART); bf16* XNp = (bf16*)(F.ws + WS_XN); float* SSXp = (float*)(F.ws + WS_SSX);
    const float* mod0 = (const float*)(F.ws + WS_MOD) + 8 * 6144; const float* mod1 = mod0 + 9 * 6144;
    const int gw = F.vcu * NWAVES + F.wave, NGW = F.G * NWAVES;
    for (int row = gw; row < MCTX; row += NGW) {
        float ss = 0.f; bf16* xr = XNp + (size_t)(MLAT + row) * DM;
#pragma unroll
        for (int j = 0; j < 4; ++j) { const int c = 256 * j + 4 * F.lane; const v2u xw = *(const GAS v2u*)(xr + c);
            f32x4 x; x[0] = bf2f(xw.x & 0xffffu); x[1] = bf2f(xw.x >> 16); x[2] = bf2f(xw.y & 0xffffu); x[3] = bf2f(xw.y >> 16);
            const f32x4 gp = *(const f32x4*)(g2 + c) * (*(const f32x4*)(mod0 + 4096 + c) + 1.0f);
            x[0] = x[0] / gp[0]; x[1] = x[1] / gp[1]; x[2] = x[2] / gp[2]; x[3] = x[3] / gp[3];
            f32x4 s = {0.f, 0.f, 0.f, 0.f};
#pragma unroll
            for (int k = 0; k < 8; ++k) { const v2u pw = *(const GAS v2u*)(PART + ((size_t)k * MCTX + row) * DM + c); s[0] += bf2f(pw.x & 0xffffu); s[1] += bf2f(pw.x >> 16); s[2] += bf2f(pw.y & 0xffffu); s[3] += bf2f(pw.y >> 16); }
            x = x + *(const f32x4*)(mod0 + 5120 + c) * s;
            ss += (x[0] * x[0] + x[1] * x[1]) + (x[2] * x[2] + x[3] * x[3]);
            const f32x4 h = x * (*(const f32x4*)(g1n + c)) * (*(const f32x4*)(mod1 + 1024 + c) + 1.0f);
            v2u ho; ho.x = pk2(h[0], h[1]); ho.y = pk2(h[2], h[3]); *(GAS v2u*)(xr + c) = ho; }
        ss = wave_sum(ss);
        if (F.lane < 16) SSXp[(size_t)(MLAT + row) * 16 + F.lane] = F.lane == 0 ? ss : 0.f;
    }
}
__device__ __forceinline__ void final_norm_phase(Frame& F, const bf16* xf, const float* g) {
    const int gw = F.vcu * NWAVES + F.wave, NGW = F.G * NWAVES;
    constexpr int R = 4;
    for (int row0 = gw; row0 < MLAT; row0 += R * NGW) {
        v2u w[R][4];
#pragma unroll
        for (int q = 0; q < R; ++q) { const int row = row0 + q * NGW; if (row < MLAT) {
#pragma unroll
            for (int j = 0; j < 4; ++j) w[q][j] = *(const GAS v2u*)(xf + (size_t)row * DM + 256 * j + 4 * F.lane); } }
#pragma unroll
        for (int q = 0; q < R; ++q) { const int row = row0 + q * NGW; if (row < MLAT) { float* orow = F.out + (size_t)row * DM;
            f32x4 v[4]; float ss = 0.f;
#pragma unroll
            for (int j = 0; j < 4; ++j) { v[j][0] = bf2f(w[q][j].x & 0xffffu); v[j][1] = bf2f(w[q][j].x >> 16); v[j][2] = bf2f(w[q][j].y & 0xffffu); v[j][3] = bf2f(w[q][j].y >> 16);
                ss += (v[j][0] * v[j][0] + v[j][1] * v[j][1]) + (v[j][2] * v[j][2] + v[j][3] * v[j][3]); }
            const float rstd = 1.0f / sqrtf(wave_sum(ss) * (1.0f / DM) + EPS);
#pragma unroll
            for (int j = 0; j < 4; ++j) { const int c = 256 * j + 4 * F.lane; const f32x4 gg = *(const f32x4*)(g + c); *(f32x4*)(orow + c) = (v[j] * rstd) * gg; } } }
    }
}
#ifndef PHMASK
#define PHMASK 0xFFFF
#endif
#define PHON(x) (((PHMASK) >> (x)) & 1)
#ifndef SUBMASK
#define SUBMASK 0xFF
#endif
#define SUBON(x) (rep_ == 0 || (((SUBMASK) >> (x)) & 1))
struct UpOrder : pg8::StaticOrder {
    typedef pg8::UnitUp UnitT; int nrows;
    __device__ __forceinline__ bool next(int i, pg8::UnitUp& u) const {
        if (!next_mn(i, u.pm, u.pn)) return false;
        u.kofs = 0; u.nt = ntk; u.arow = 254 * u.pm - 1; u.nrows = nrows;
        return true;
    }
};

struct DownOrder0 : pg8::StaticOrder {
    typedef pg8::Unit UnitT;
    __device__ __forceinline__ bool next(int i, pg8::Unit& u) const {
        if (i == 0) { if (!next_mn(0, u.pm, u.pn)) return false; u.arow = u.pm * 256; u.kofs = 0; u.nt = ntk; return true; }
        if (i > 1) return false;
        const int L = c; if (L >= 256) return false;
        const int t = L >> 3, s = L & 7; u.pm = 64 + (t >> 2); u.pn = t & 3; u.arow = u.pm * 256;
        u.kofs = (s < 6 ? 6 * s : 36 + 4 * (s - 6)) * 64; u.nt = s < 6 ? 6 : 4; return true;
    }
};

struct FnetOrder {
    typedef pg8::Unit UnitT; int G, c;
    __device__ __forceinline__ bool next(int i, pg8::Unit& u) const { const int L = i * G + c; if (L >= 256) return false;
        u.pm = (L >> 3) & 7; u.pn = L & 7; u.arow = u.pm * 256; u.kofs = (L >> 6) * 1024; u.nt = 16; return true; }
};

__global__ void __launch_bounds__(NWAVES * 64, 2) mk_fwd(Args args) {
    extern __shared__ __attribute__((aligned(16))) unsigned char lds[];
    Frame F;
    F.lds = (LAS unsigned char*)lds; F.ldsg = (char*)lds;
    F.MISC = (volatile LAS unsigned*)(F.lds + MISC_OFF);
    F.tid = threadIdx.x; F.lane = F.tid & 63; F.wave = __builtin_amdgcn_readfirstlane(F.tid >> 6);
    F.G = gridDim.x; F.bx = blockIdx.x; F.vcu = (F.G % 8 == 0) ? (F.bx % 8) * (F.G / 8) + F.bx / 8 : F.bx;
    F.ws = args.ws; F.out = args.out;
    for (int u = F.tid; u < (LDS_BYTES - LDSCTL_OFF) / 4; u += NWAVES * 64) ((LAS unsigned*)(F.lds + LDSCTL_OFF))[u] = 0u;
    __syncthreads();
    if (F.tid == 0) { LAS unsigned long long* T = (LAS unsigned long long*)(F.lds + PTR_OFF);
#pragma unroll
        for (int i = 0; i < 22; ++i) T[i] = (unsigned long long)args.in[i]; }
    __syncthreads();
    XcdBarrier bar; bar.bar = (unsigned*)(F.ws + WS_CTL) + CW_BAR; bar.x = 0; bar.st = nullptr;
    if (!MK_SPLIT) bar = xcd_barrier_post((unsigned*)(F.ws + WS_CTL) + CW_BAR, F.MISC + 8);

#define MOD ((float*)(ws + WS_MOD))
#define SSQ ((float*)(ws + WS_SSQ))
#define XN ((bf16*)(ws + WS_XN))
#define P ((bf16*)(ws + WS_P))
#define Qb ((bf16*)F.out)
#define Kb ((bf16*)(ws + WS_K))
#define Vb ((bf16*)(ws + WS_V))
#define YCAT ((bf16*)(ws + WS_YCAT))
#define ACT ((bf16*)(ws + WS_ACT))
#define XCTX ((bf16*)(ws + WS_XCTX))
#define XBL ((bf16*)F.out + (size_t)MLAT * DM)
#define XFIN ((bf16*)(ws + WS_XN))
    LAS unsigned char* ring = F.lds + RING_OFF;

    const int ph_lo = args.ph_lo, ph_hi = args.ph_hi;
#define PHASE(k) (ph_lo <= (k) && (k) < ph_hi)
#define SEAM(k) do { if (PHASE(k) && PHASE((k) + 1)) xcd_barrier(bar); } while (0)
#ifndef P0SUB
#define P0SUB 0xFF
#endif
#ifndef RPT_PH
#define RPT_PH -1
#endif
#define RELANE() do { int t_ = threadIdx.x; asm volatile("" : "+v"(t_)); F.tid = t_; F.lane = t_ & 63; F.wave = __builtin_amdgcn_readfirstlane(t_ >> 6); } while (0)
    unsigned char* ws = F.ws;
    if (PHASE(0)) for (int rep_ = 0; rep_ < (((0) == RPT_PH) ? 2 : 1); ++rep_) { if (rep_) xcd_barrier(bar); RELANE(); if (PHON(0)) p0_prologue(F, rep_ ? P0SUB : 0xFF); }
    SEAM(0);
    for (int l = 0; l < 2; ++l) {
        const int pb = 1 + 9 * l;
        const int nMall = (l == 0) ? 72 : 64;
        if (PHASE(pb + 0)) for (int rep_ = 0; rep_ < (((pb + 0) == RPT_PH) ? 2 : 1); ++rep_) { if (rep_) xcd_barrier(bar); RELANE();
            if (l == 0) { pg8::Gemm g{(const bf16*)(ws + WS_CST), (const bf16*)(ws + WS_WF), 2, 8, 256, 256}; pg8::StaticOrder S; S.init(2, 8, F.G, F.bx, 256);
                pg8::EpiFold E{(bf16*)(ws + WS_WIN), (unsigned)(WIN_STRIDE / 2)};
                pg8::gemm_phase(ring, g, S, E); RELANE(); }
            if (PHON(1) && l == 0) norm_mod_phase(F, inptr(F, I_X), inptr(F, I_CTX), MT, inptr(F, I_N1G), MOD, 0, 1024); }
        if (l == 0) SEAM(pb + 0);
        if (PHASE(pb + 1)) for (int rep_ = 0; rep_ < (((pb + 1) == RPT_PH) ? 2 : 1); ++rep_) { if (rep_) xcd_barrier(bar); RELANE();
            if (PHON(2)) { pg8::Gemm g{XN, (const bf16*)(ws + WS_WIN + l * WIN_STRIDE), 72, 8, 1024, 1024}; pg8::StaticOrder S; S.init(72, 8, F.G, F.bx, 1024);
                pg8::EpiWin E{P, NIN, SSQ, l == 1 ? (const float*)(ws + WS_SSX) : nullptr, (const float*)(ws + WS_PB) + 9 * 2048, (LAS float*)(F.lds + EPIX_OFF)};
                pg8::gemm_phase(ring, g, S, E); } }
        SEAM(pb + 1);
        if (PHASE(pb + 2)) for (int rep_ = 0; rep_ < (((pb + 2) == RPT_PH) ? 2 : 1); ++rep_) { if (rep_) xcd_barrier(bar); RELANE();
            if (PHON(3)) {
                if (SUBON(0)) { pg8::Gemm g{P, (const bf16*)(ws + WS_WUQ + l * WUQ_STRIDE), nMall, 3, 384, NIN}; pg8::StaticOrder S; S.init(nMall, 3, F.G, F.bx, 384);
                  pg8::EpiQ E{Qb, SSQ, (const float*)(ws + WS_ROPE), (const float*)(ws + WS_ROPE) + 1024};
                  pg8::gemm_phase(ring, g, S, E); }
                if (SUBON(1)) { pg8::Gemm g{P + 384, (const bf16*)(ws + WS_WUKV + l * WUKV_STRIDE), 72, 4, 256, NIN}; pg8::StaticOrder S; S.init(72, 4, F.G, F.G - 1 - F.bx, 256);
                  pg8::EpiKV E{Kb, Vb, SSQ};
                  pg8::gemm_phase(ring, g, S, E); }
                if (SUBON(2)) qkv_rows_phase(F, l);
                if (SUBON(3)) zt_phase(F, l);
                if (l == 0 && SUBON(4)) bias_phase(F); } }
        SEAM(pb + 2);
        if (PHASE(pb + 3)) for (int rep_ = 0; rep_ < (((pb + 3) == RPT_PH) ? 2 : 1); ++rep_) { if (rep_) xcd_barrier(bar); RELANE();
            if (PHON(4)) {
                const int NU = 256 + (l == 0 ? 32 : 0);
                for (int u = F.vcu; u < NU; u += F.G) {
                    if (u < 256) { const int bh = u >> 3, qb = u & 7, b = bh >> 2, h = bh & 3; const long q0 = (long)b * SL + qb * 256;
                        att::attn_unit(Qb + q0 * 768 + 192 * h, Kb + 192 * h, Vb + 128 * h, YCAT + q0 * 1024 + 128 * h, MLAT + CL * b, 4, SL * b, 36, F.ldsg);
                    } else { const int cu = u - 256, b = cu >> 2, h = cu & 3; const long q0 = MLAT + (long)CL * b;
                        att::attn_unit(Qb + q0 * 768 + 192 * h, Kb + 192 * h, Vb + 128 * h, YCAT + q0 * 1024 + 128 * h, (int)q0, 4, 0, 4, F.ldsg); }
                }
                { pg8::Gemm g{(const bf16*)(ws + WS_DFT), (const bf16*)(ws + WS_ZT), 8, 8, 4096, 4096}; FnetOrder S; S.G = F.G; S.c = F.vcu;
                  pg8::EpiFnet E{(bf16*)(ws + WS_YFP), 0, SL, 0.0027621358640099515f, (unsigned)(MT * 256)};
                  pg8::gemm_phase(ring, g, S, E); }
                if (l == 0) { pg8::Gemm g{(const bf16*)(ws + WS_DFTC), (const bf16*)(ws + WS_ZTC), 1, 8, 512, 512}; pg8::StaticOrder S; S.init(1, 8, F.G, (F.bx + 128) % F.G, 512);
                  pg8::EpiFnet E{(bf16*)(ws + WS_YFP), MLAT, CL, 0.0078125f, (unsigned)(MT * 256)};
                  pg8::gemm_phase(ring, g, S, E); } } }
        SEAM(pb + 3);
        if (PHASE(pb + 4)) for (int rep_ = 0; rep_ < (((pb + 4) == RPT_PH) ? 2 : 1); ++rep_) { if (rep_) xcd_barrier(bar); RELANE();
            if (PHON(5)) ycat_norm_phase(F, nMall * 256); }
        SEAM(pb + 4);
        if (PHASE(pb + 5)) for (int rep_ = 0; rep_ < (((pb + 5) == RPT_PH) ? 2 : 1); ++rep_) { if (rep_) xcd_barrier(bar); RELANE();
            if (PHON(6)) { pg8::Gemm g{YCAT, (const bf16*)(ws + WS_WOUT + l * WOUT_STRIDE), nMall, 4, 1024, 1024}; pg8::StaticOrder S; S.init(nMall, 4, F.G, F.bx, 1024);
                if (l == 0) { pg8::EpiRes<true> E{inptr(F, I_X), inptr(F, I_CTX), XN, MOD, 2048, nullptr, nullptr, 0, inptr(F, I_N2G), MOD, 4096, (float*)(ws + WS_SSX), rep_ ? 0.f : 1.f, nullptr};
                    pg8::gemm_phase(ring, g, S, E); }
                else { pg8::EpiRes<false> E{nullptr, nullptr, XN, MOD + (size_t)9 * 6144, 2048, inptr(F, I_N1G) + DM, MOD + (size_t)9 * 6144, 1024, inptr(F, I_N2G) + DM, MOD + (size_t)9 * 6144, 4096, (float*)(ws + WS_SSX), rep_ ? 0.f : 1.f, nullptr};
                    pg8::gemm_phase(ring, g, S, E); } } }
        SEAM(pb + 5);
        if (PHASE(pb + 6)) for (int rep_ = 0; rep_ < (((pb + 6) == RPT_PH) ? 2 : 1); ++rep_) { if (rep_) xcd_barrier(bar); RELANE();
            }
        if (PHASE(pb + 7)) for (int rep_ = 0; rep_ < (((pb + 7) == RPT_PH) ? 2 : 1); ++rep_) { if (rep_) xcd_barrier(bar); RELANE();
            if (PHON(8)) { const int nrows = (l == 0) ? MT : MLAT; const int nM = (nrows + 253) / 254;
                pg8::Gemm g{XN, (const bf16*)(ws + WS_WUP + l * WUP_STRIDE), nM, 22, 1024, 1024}; UpOrder S; S.init(nM, 22, F.G, F.bx, 1024); S.nrows = nrows;
                pg8::EpiUp E{ACT, inptr(F, I_FCW) + (size_t)l * 3 * FF, inptr(F, I_FCB) + (size_t)l * FF, (LAS float*)(F.lds + EPIX_OFF), (const float*)(ws + WS_SSX), (const float*)(ws + WS_UB) + (size_t)l * 9 * 5632};
                pg8::gemm_phase(ring, g, S, E); } }
        SEAM(pb + 7);
        if (PHASE(pb + 8)) for (int rep_ = 0; rep_ < (((pb + 8) == RPT_PH) ? 2 : 1); ++rep_) { if (rep_) xcd_barrier(bar); RELANE();
            if (PHON(6)) {
                if (l == 0) { pg8::Gemm g{ACT, (const bf16*)(ws + WS_WDOWN), 64, 4, FF, FF}; DownOrder0 S; S.init(64, 4, F.G, F.bx, FF);
                    pg8::EpiRes<false> E{nullptr, nullptr, XN, MOD, 5120, inptr(F, I_N2G), MOD, 4096, inptr(F, I_N1G) + DM, MOD + (size_t)9 * 6144, 1024, (float*)(ws + WS_SSX), rep_ ? 0.f : 1.f, (bf16*)(ws + WS_CPART)};
                    pg8::gemm_phase(ring, g, S, E);
                    xcd_barrier(bar); RELANE();
                    ctx_combine_phase(F, inptr(F, I_N2G), inptr(F, I_N1G) + DM);
                } else { pg8::Gemm g{ACT, (const bf16*)(ws + WS_WDOWN + WDOWN_STRIDE), 64, 4, FF, FF}; pg8::StaticOrder S; S.init(64, 4, F.G, F.bx, FF);
                    pg8::EpiRes<false> E{nullptr, nullptr, XN, MOD + (size_t)9 * 6144, 5120, inptr(F, I_N2G) + DM, MOD + (size_t)9 * 6144, 4096, nullptr, nullptr, 0, nullptr, 1.f, nullptr};
                    pg8::gemm_phase(ring, g, S, E); } } }
        SEAM(pb + 8);
    }
    if (PHASE(NPH - 1)) for (int rep_ = 0; rep_ < (((NPH - 1) == RPT_PH) ? 2 : 1); ++rep_) { if (rep_) xcd_barrier(bar); RELANE(); if (PHON(10)) final_norm_phase(F, XN, inptr(F, I_FING)); }
#undef PHASE
#undef SEAM
#undef RELANE
#undef MOD
#undef SSQ
#undef XN
#undef P
#undef Qb
#undef Kb
#undef Vb
#undef YCAT
#undef ACT
#undef XCTX
#undef XBL
#undef XFIN
}

extern "C" void kernel_launch(void* const* d_in, const int* in_sizes, int n_in, void* d_out, int out_size, void* d_ws, size_t ws_size, hipStream_t stream) {
    static int grid = 0;
    if (grid == 0) {
        if (n_in != 22 || out_size != MLAT * DM || ws_size < WS_END) { fprintf(stderr, "kernel_launch: unexpected shapes (n_in %d out %d ws %zu)\n", n_in, out_size, ws_size); grid = -1; return; }
        int dev = 0, cus = 0;
        if (hipGetDevice(&dev) != hipSuccess || hipDeviceGetAttribute(&cus, hipDeviceAttributeMultiprocessorCount, dev) != hipSuccess) { grid = -1; return; }
        if (hipFuncSetAttribute((const void*)mk_fwd, hipFuncAttributeMaxDynamicSharedMemorySize, LDS_BYTES) != hipSuccess) { fprintf(stderr, "kernel_launch: hipFuncSetAttribute failed\n"); grid = -1; return; }
        int per_cu = 0;
        if (hipOccupancyMaxActiveBlocksPerMultiprocessor(&per_cu, (const void*)mk_fwd, NWAVES * 64, LDS_BYTES) != hipSuccess || per_cu < 1) fprintf(stderr, "kernel_launch: occupancy query says %d\n", per_cu);
        (void)hipGetLastError();
        grid = cus;
    }
    if (grid < 0) return;
    if (hipMemsetAsync((char*)d_ws + WS_CTL, 0, CTL_ZERO_BYTES, stream) != hipSuccess) return;
    Args a{};
    for (int i = 0; i < 22; ++i) a.in[i] = (const float*)d_in[i];
    a.out = (float*)d_out; a.ws = (unsigned char*)d_ws;
#if MK_SPLIT
    for (int ph = 0; ph < NPH; ++ph) { a.ph_lo = ph; a.ph_hi = ph + 1; hipLaunchKernelGGL(mk_fwd, dim3(grid), dim3(NWAVES * 64), LDS_BYTES, stream, a); }
#else
    a.ph_lo = 0; a.ph_hi = NPH;
    hipLaunchKernelGGL(mk_fwd, dim3(grid), dim3(NWAVES * 64), LDS_BYTES, stream, a);
#endif
    const hipError_t le = hipPeekAtLastError();
    if (le != hipSuccess) fprintf(stderr, "kernel_launch: launch failed: %s\n", hipGetErrorName(le));
}
```

```cpp
#include <hip/hip_runtime.h>
#include <hip/hip_bf16.h>
#include <cstdio>
#include <cstdint>
#include <cmath>
namespace pg8 {
#define PG8_LAS __attribute__((address_space(3)))
typedef unsigned short bf16_t;
typedef short bf16x8 __attribute__((ext_vector_type(8)));
typedef float f32x4 __attribute__((ext_vector_type(4)));
typedef float f32x2 __attribute__((ext_vector_type(2)));
typedef unsigned u32x4 __attribute__((ext_vector_type(4)));
typedef unsigned u32x2 __attribute__((ext_vector_type(2)));
constexpr int BM = 256, BK = 64, HALF = 128, HTB = HALF * BK * 2  , STAGE_BYTES = 8 * HTB, NXCD = 8, WGM = 8;

__host__ __device__ __forceinline__ int lds_byte(int r, int c) { const int st = (r >> 4) * 2 + (c >> 5), rr = r & 15, cc = c & 31, ob = rr * 64 + cc * 2; return st * 1024 + (ob ^ (((ob >> 9) & 1) << 5)); }
__host__ __device__ __forceinline__ void stage_rc(int b, int& R, int& C) { const int st = b / 1024, sb = b % 1024, swz = sb ^ (((sb >> 9) & 1) << 5); R = (st >> 1) * 16 + swz / 64; C = (st & 1) * 32 + (swz % 64) / 2; }
__host__ __device__ __forceinline__ int perm32(int rho) { const int n = rho >> 4, i = rho & 15; return 8 * (i >> 2) + 4 * n + (i & 3); }

struct Unit { int pm, pn, arow, kofs, kofb, nt, aux; };
struct Gemm { const bf16_t* A; const bf16_t* Bt; int nM, nN, ldb, lda; };

struct StaticOrder {
    int nM, nN, nwg, G, c, ntk;
    __device__ __forceinline__ void init(int nM_, int nN_, int G_, int c_, int K_) { nM = nM_; nN = nN_; nwg = nM * nN; G = G_; c = c_; ntk = K_ / BK; }
    __device__ __forceinline__ bool next_mn(int i, int& pm, int& pn) const {
        const long L = (long)i * G + c; if (L >= nwg) return false;
        int wgid = (int)L; { const int q = nwg / NXCD, r = nwg % NXCD, xcd = wgid % NXCD, off = wgid / NXCD; wgid = (xcd < r ? xcd * (q + 1) : r * (q + 1) + (xcd - r) * q) + off; }
        const int nig = WGM * nN, gid = wgid / nig, fm = gid * WGM, gsz = (nM - fm) < WGM ? (nM - fm) : WGM;
        pm = fm + ((wgid % nig) % gsz); pn = (wgid % nig) / gsz; return true;
    }
    typedef Unit UnitT;
    __device__ __forceinline__ bool next(int i, Unit& u) const { if (!next_mn(i, u.pm, u.pn)) return false; u.arow = u.pm * BM; u.kofs = 0; u.kofb = 0; u.nt = ntk; u.aux = 0; return true; }
};

__device__ __forceinline__ unsigned cvt_pk_bf16(float lo, float hi) { unsigned r; asm volatile("v_cvt_pk_bf16_f32 %0, %1, %2" : "=v"(r) : "v"(lo), "v"(hi)); return r; }

template <class Epi, class Sched>
__device__ __forceinline__ void gemm_phase(PG8_LAS unsigned char* lds, const Gemm g, const Sched& S, const Epi& E) {
    int tid = threadIdx.x; asm volatile("" : "+v"(tid));
    const int wid = __builtin_amdgcn_readfirstlane(tid >> 6), lane = tid & 63, wr = wid >> 2, wc = wid & 3, fr = lane & 15, fq = lane >> 4;
    const int K = g.ldb, lda = g.lda;
    unsigned voffA[2], voffB[2];
#pragma unroll
    for (int i = 0; i < 2; ++i) { int R, C; stage_rc(tid * 16 + i * 8192, R, C); const int Rb = Epi::PERM ? ((R & ~31) + perm32(R & 31)) : R;
        voffA[i] = (unsigned)(R * lda + C) * 2u; voffB[i] = (unsigned)(Rb * K + C) * 2u; }
    const size_t kstep = (size_t)(BK * 2);
    const size_t hstepA = (size_t)HALF * lda * 2, hstepB = (size_t)HALF * K * 2;
    const size_t tstepB = 2 * hstepB;
    const unsigned ldsw = (unsigned)wid * 1024u;
    const int aoff = lds_byte(wr * 64 + fr, fq * 8), boff = lds_byte(wc * 32 + fr, fq * 8);
#define PG8_SA(b, h) (((b) * 2 + (h)) * HTB)
#define PG8_SB(b, h) ((4 + (b) * 2 + (h)) * HTB)
#define PG8_STAGE(bufoff, gbase, voff) do { _Pragma("unroll") for (int _i = 0; _i < 2; ++_i) \
        __builtin_amdgcn_global_load_lds((const unsigned*)((const char*)(gbase) + (voff)[_i]), (PG8_LAS unsigned*)(lds + (bufoff) + ldsw + _i * 8192), 16, 0, 0); } while (0)
#define PG8_LDA(dst, b, h) do { _Pragma("unroll") for (int m = 0; m < 4; ++m) _Pragma("unroll") for (int k = 0; k < 2; ++k) dst[m][k] = *(const PG8_LAS bf16x8*)(lds + PG8_SA(b, h) + aoff + m * 2048 + k * 1024); } while (0)
#define PG8_LDB(dst, b, h) do { _Pragma("unroll") for (int n = 0; n < 2; ++n) _Pragma("unroll") for (int k = 0; k < 2; ++k) dst[n][k] = *(const PG8_LAS bf16x8*)(lds + PG8_SB(b, h) + boff + n * 2048 + k * 1024); } while (0)
#define PG8_MMA(ai, bj, At, Bt) do { __builtin_amdgcn_s_setprio(1); _Pragma("unroll") for (int m = 0; m < 4; ++m) _Pragma("unroll") for (int n = 0; n < 2; ++n) _Pragma("unroll") for (int k = 0; k < 2; ++k) \
        acc[ai][bj][m][n] = __builtin_amdgcn_mfma_f32_16x16x32_bf16(Bt[n][k], At[m][k], acc[ai][bj][m][n], 0, 0, 0); __builtin_amdgcn_s_setprio(0); } while (0)
#define PG8_WAIT_V(n) asm volatile("s_waitcnt vmcnt(" #n ")" ::: "memory")
#define PG8_WAIT_L(n) asm volatile("s_waitcnt lgkmcnt(" #n ")" ::: "memory")
#define PG8_BAR __builtin_amdgcn_s_barrier()
#define PG8_SCHED __builtin_amdgcn_sched_barrier(0)
    typename Sched::UnitT cur, nxt; int ui = 0;
    if (!S.next(0, cur)) return;
    f32x4 acc[2][2][4][2];
#pragma unroll
    for (int a = 0; a < 2; ++a)
#pragma unroll
        for (int b = 0; b < 2; ++b)
#pragma unroll
            for (int m = 0; m < 4; ++m)
#pragma unroll
                for (int n = 0; n < 2; ++n) acc[a][b][m][n] = (f32x4){0.f, 0.f, 0.f, 0.f};
    bf16x8 At[4][2], B0[2][2], B1[2][2];
    const char* cA = (const char*)g.A + (ptrdiff_t)cur.arow * (ptrdiff_t)(lda * 2) + cur.kofs * 2; const char* cB = (const char*)g.Bt + (size_t)cur.pn * tstepB + cur.kofb * 2;
    if constexpr (Epi::PREFETCH) E.prefetch(cur, wid, lane);
    PG8_STAGE(PG8_SB(0, 0), cB, voffB); PG8_STAGE(PG8_SB(0, 1), cB + hstepB, voffB); PG8_STAGE(PG8_SA(0, 0), cA, voffA); PG8_STAGE(PG8_SA(0, 1), cA + hstepA, voffA);
    if (wr == 1) PG8_BAR;
    PG8_WAIT_V(2); PG8_BAR;
    PG8_STAGE(PG8_SB(1, 0), cB + kstep, voffB); PG8_STAGE(PG8_SA(1, 0), cA + kstep, voffA); PG8_STAGE(PG8_SB(1, 1), cB + hstepB + kstep, voffB);
    PG8_WAIT_V(6); PG8_BAR;
    for (;;) {
        const bool has_next = S.next(ui + 1, nxt);
        const char* nA = has_next ? (const char*)g.A + (ptrdiff_t)nxt.arow * (ptrdiff_t)(lda * 2) + nxt.kofs * 2 : cA; const char* nB = has_next ? (const char*)g.Bt + (size_t)nxt.pn * tstepB + nxt.kofb * 2 : cB;
        const int nt = cur.nt;
        for (int t = 0; t < nt; t += 2) {
            const bool last = (t == nt - 2);
            const char* a1 = cA + (size_t)(t + 1) * kstep;
            const char* a2 = last ? nA : cA + (size_t)(t + 2) * kstep; const char* b2 = last ? nB : cB + (size_t)(t + 2) * kstep;
            const char* a3 = a2 + kstep; const char* b3 = b2 + kstep;
            PG8_LDB(B0, 0, 0); PG8_LDB(B1, 0, 1); PG8_SCHED; PG8_LDA(At, 0, 0); PG8_STAGE(PG8_SA(1, 1), a1 + hstepA, voffA);
            PG8_WAIT_V(8); PG8_WAIT_L(0); PG8_BAR; PG8_MMA(0, 0, At, B0); PG8_MMA(0, 1, At, B1); PG8_BAR; PG8_SCHED;
            PG8_LDA(At, 0, 1); PG8_STAGE(PG8_SB(0, 0), b2, voffB); PG8_STAGE(PG8_SB(0, 1), b2 + hstepB, voffB); PG8_STAGE(PG8_SA(0, 0), a2, voffA);
            PG8_WAIT_V(8); PG8_WAIT_L(0); PG8_BAR; PG8_MMA(1, 0, At, B0); PG8_MMA(1, 1, At, B1); PG8_BAR; PG8_SCHED;
            PG8_LDB(B0, 1, 0); PG8_LDB(B1, 1, 1); PG8_SCHED; PG8_LDA(At, 1, 0); PG8_STAGE(PG8_SA(0, 1), a2 + hstepA, voffA);
            PG8_WAIT_V(8); PG8_WAIT_L(0); PG8_BAR; PG8_MMA(0, 0, At, B0); PG8_MMA(0, 1, At, B1); PG8_BAR; PG8_SCHED;
            PG8_LDA(At, 1, 1); PG8_STAGE(PG8_SB(1, 0), b3, voffB); PG8_STAGE(PG8_SB(1, 1), b3 + hstepB, voffB); PG8_STAGE(PG8_SA(1, 0), a3, voffA);
            PG8_WAIT_V(8); PG8_WAIT_L(0); PG8_BAR; PG8_MMA(1, 0, At, B0); PG8_MMA(1, 1, At, B1); PG8_BAR; PG8_SCHED;
        }
        if (wr == 0) PG8_BAR;
        E(acc, cur, wr, wc, fr, fq);
        if (!has_next) break;
        if constexpr (Epi::PREFETCH) E.prefetch(nxt, wid, lane);
#pragma unroll
        for (int a = 0; a < 2; ++a)
#pragma unroll
            for (int b = 0; b < 2; ++b)
#pragma unroll
                for (int m = 0; m < 4; ++m)
#pragma unroll
                    for (int n = 0; n < 2; ++n) acc[a][b][m][n] = (f32x4){0.f, 0.f, 0.f, 0.f};
        cur = nxt; cA = nA; cB = nB; ++ui;
        if (wr == 1) PG8_BAR;
    }
    PG8_WAIT_V(0);
    PG8_BAR;
#undef PG8_SA
#undef PG8_SB
#undef PG8_STAGE
#undef PG8_LDA
#undef PG8_LDB
#undef PG8_MMA
#undef PG8_WAIT_V
#undef PG8_WAIT_L
#undef PG8_BAR
#undef PG8_SCHED
}
}
namespace pg8 {
constexpr float RMS_EPS = 1e-6f;
template <class T> __device__ __forceinline__ T gld(const void* base, unsigned boff) { return *(const T*)((const char*)base + boff); }
template <class T> __device__ __forceinline__ void gst(void* base, unsigned boff, T v) { *(T*)((char*)base + boff) = v; }
constexpr int EX_XF = 0, EX_XL = 512, EX_CW = 1024, EX_RS = 1536, EX_BL = 1792, EX_SSX = 2304, EX_FLOATS = 6400;
constexpr int MLAT_ = 16384;
__device__ __forceinline__ void dma_ssx(const float* ssx, int arow, PG8_LAS float* xb, int wid, int lane) {
#pragma unroll
    for (int i = 0; i < 2; ++i) { const int ch = 2 * wid + i;
        __builtin_amdgcn_global_load_lds((const unsigned*)((const char*)ssx + (ptrdiff_t)arow * 64 + ch * 1024 + lane * 16), (PG8_LAS unsigned*)(xb + EX_SSX + ch * 256), 16, 0, 0); }
}
__device__ __forceinline__ void rs_from_ssx(PG8_LAS float* xb, int t) {
    if (t < 256) { const PG8_LAS f32x4* p = (const PG8_LAS f32x4*)(xb + EX_SSX + t * 16); const f32x4 a = p[0], b = p[1], c = p[2], d = p[3];
        const float ss = (((a[0] + a[1]) + (a[2] + a[3])) + ((b[0] + b[1]) + (b[2] + b[3]))) + (((c[0] + c[1]) + (c[2] + c[3])) + ((d[0] + d[1]) + (d[2] + d[3])));
        xb[EX_RS + t] = __builtin_amdgcn_rsqf(ss * (1.0f / 1024.0f) + RMS_EPS); }
}

struct EpiWin {
    static constexpr bool PERM = true, PREFETCH = true;
    bf16_t* O; int ldc; float* ssq;
    const float* ssx; const float* pb;
    PG8_LAS float* xb;
    __device__ __forceinline__ void prefetch(const Unit& u, int wid, int lane) const {
        if (ssx == nullptr) return;
        dma_ssx(ssx, u.arow, xb, wid, lane);
        if (wid == 0) __builtin_amdgcn_global_load_lds((const unsigned*)(pb + (u.pm < 64 ? (u.pm >> 3) : 8) * 2048 + u.pn * BM + lane * 4), (PG8_LAS unsigned*)(xb + EX_BL), 16, 0, 0);
    }
    __device__ __forceinline__ void operator()(const f32x4 (&acc)[2][2][4][2], const Unit& u, int wr, int wc, int fr_in, int fq_in) const {
        int t_ = threadIdx.x; asm volatile("" : "+v"(t_)); const int fr = t_ & 15, fq = (t_ >> 4) & 3; (void)fr_in; (void)fq_in;
        const int row0 = u.pm * BM + wr * 64 + fr; const int col0 = u.pn * BM + wc * 32 + 8 * fq; const int tc0 = wc * 32 + 8 * fq;
        const bool fused = ssx != nullptr;
        if (fused) { rs_from_ssx(xb, t_); asm volatile("s_waitcnt lgkmcnt(0)" ::: "memory"); __builtin_amdgcn_s_barrier(); asm volatile("" ::: "memory"); }
        f32x4 bv[2][2];
#pragma unroll
        for (int bj = 0; bj < 2; ++bj)
#pragma unroll
            for (int n = 0; n < 2; ++n) bv[bj][n] = fused ? *(const PG8_LAS f32x4*)(xb + EX_BL + tc0 + bj * HALF + 4 * n) : (f32x4){0.f, 0.f, 0.f, 0.f};
#pragma unroll
        for (int ai = 0; ai < 2; ++ai)
#pragma unroll
            for (int m = 0; m < 4; ++m) { const int tr = ai * HALF + wr * 64 + m * 16 + fr; const int row = u.pm * BM + tr; const unsigned ob = ((unsigned)row * (unsigned)ldc + (unsigned)col0) * 2u;
                const float rs = fused ? xb[EX_RS + tr] : 1.0f;
#pragma unroll
                for (int bj = 0; bj < 2; ++bj) { const f32x4 v0 = acc[ai][bj][m][0] * rs + bv[bj][0], v1 = acc[ai][bj][m][1] * rs + bv[bj][1];
                    u32x4 w; w.x = cvt_pk_bf16(v0[0], v0[1]); w.y = cvt_pk_bf16(v0[2], v0[3]); w.z = cvt_pk_bf16(v1[0], v1[1]); w.w = cvt_pk_bf16(v1[2], v1[3]);
                    gst<u32x4>(O, ob + bj * HALF * 2, w);
                    const int hf = 2 * u.pn + bj;
                    if (hf < 5) {
                        float s = (v0[0] * v0[0] + v0[1] * v0[1]) + (v0[2] * v0[2] + v0[3] * v0[3]) + (v1[0] * v1[0] + v1[1] * v1[1]) + (v1[2] * v1[2] + v1[3] * v1[3]);
                        s += __shfl_xor(s, 16); s += __shfl_xor(s, 32);
                        if (fq == 0) gst<float>(ssq, ((unsigned)row * 20u + hf * 4 + wc) * 4u, s);
                    } }
                if (m & 1) asm volatile("" ::: "memory"); }
        if (fused) { asm volatile("s_waitcnt lgkmcnt(0)" ::: "memory"); __builtin_amdgcn_s_barrier(); asm volatile("" ::: "memory"); }
        (void)row0;
    }
};

struct EpiFold {
    static constexpr bool PERM = true, PREFETCH = false;
    bf16_t* WinT; unsigned lstride;
    __device__ __forceinline__ void operator()(const f32x4 (&acc)[2][2][4][2], const Unit& u, int wr, int wc, int fr_in, int fq_in) const {
        int t_ = threadIdx.x; asm volatile("" : "+v"(t_)); const int fr = t_ & 15, fq = (t_ >> 4) & 3; (void)fr_in; (void)fq_in;
        bf16_t* O = WinT + (size_t)(u.pn >> 2) * lstride;
        const int row0 = 768 + u.pm * BM + wr * 64 + fr; const int col0 = (u.pn & 3) * BM + wc * 32 + 8 * fq;
#pragma unroll
        for (int ai = 0; ai < 2; ++ai)
#pragma unroll
            for (int m = 0; m < 4; ++m) { const unsigned ob = ((unsigned)(row0 + ai * HALF + m * 16) * 1024u + (unsigned)col0) * 2u;
#pragma unroll
                for (int bj = 0; bj < 2; ++bj) { const f32x4 v0 = acc[ai][bj][m][0], v1 = acc[ai][bj][m][1];
                    u32x4 w; w.x = cvt_pk_bf16(v0[0], v0[1]); w.y = cvt_pk_bf16(v0[2], v0[3]); w.z = cvt_pk_bf16(v1[0], v1[1]); w.w = cvt_pk_bf16(v1[2], v1[3]);
                    gst<u32x4>(O, ob + bj * HALF * 2, w); } }
    }
};

struct EpiQKV {
    static constexpr bool PERM = true, PREFETCH = true;
    bf16_t* Q; bf16_t* Kb; bf16_t* Vb; const float* ssq; const float* ropec; const float* ropes; PG8_LAS float* xb;
    __device__ __forceinline__ void prefetch(const Unit& u, int wid, int lane) const {
#pragma unroll
        for (int i = 0; i < 3; ++i) { const int ch = 3 * wid + i;
            if (ch < 20) __builtin_amdgcn_global_load_lds((const unsigned*)((const char*)ssq + (size_t)u.arow * 80 + ch * 1024 + lane * 16), (PG8_LAS unsigned*)(xb + 512 + ch * 256), 16, 0, 0); }
    }
    __device__ __forceinline__ void operator()(const f32x4 (&acc)[2][2][4][2], const Unit& u, int wr, int wc, int fr_in, int fq_in) const {
        int t_ = threadIdx.x; asm volatile("" : "+v"(t_)); const int fr = t_ & 15, fq = (t_ >> 4) & 3; (void)fr_in; (void)fq_in;
        if (t_ < 256) { const PG8_LAS float* p = xb + 512 + t_ * 20; float sq = 0.f, sk = 0.f;
#pragma unroll
            for (int i = 0; i < 12; ++i) sq += p[i];
#pragma unroll
            for (int i = 12; i < 20; ++i) sk += p[i];
            xb[t_] = __builtin_amdgcn_rsqf(sq * (1.0f / 384.0f) + RMS_EPS); xb[256 + t_] = __builtin_amdgcn_rsqf(sk * (1.0f / 256.0f) + RMS_EPS); }
        asm volatile("s_waitcnt lgkmcnt(0)" ::: "memory"); __builtin_amdgcn_s_barrier(); asm volatile("" ::: "memory");
        const int cw = wc * 32 + 8 * fq;
        if (u.pn < 3) {
            const bool lat = u.pm < 64;
#pragma unroll
            for (int ai = 0; ai < 2; ++ai)
#pragma unroll
                for (int m = 0; m < 4; ++m) { const int tr = ai * HALF + wr * 64 + m * 16 + fr; const int row = u.pm * BM + tr; const float rs = xb[tr]; const int t = row & 2047;
#pragma unroll
                    for (int bj = 0; bj < 2; ++bj) { const int gcol = u.pn * BM + bj * HALF + wc * 32;
                        const int w = gcol % 192; f32x4 x1 = acc[ai][bj][m][0] * rs, x2 = acc[ai][bj][m][1] * rs;
                        if (lat && w >= 128) { const int pos = (w >= 160) ? (t & 63) : (t >> 6);
                            const unsigned rb = (unsigned)(pos * 16 + 4 * fq) * 4u; const f32x4 c = gld<f32x4>(ropec, rb), s = gld<f32x4>(ropes, rb);
                            const f32x4 y1 = x1 * c - x2 * s, y2 = x1 * s + x2 * c; x1 = y1; x2 = y2; }
                        u32x4 o; o.x = cvt_pk_bf16(x1[0], x1[1]); o.y = cvt_pk_bf16(x1[2], x1[3]); o.z = cvt_pk_bf16(x2[0], x2[1]); o.w = cvt_pk_bf16(x2[2], x2[3]);
                        gst<u32x4>(Q, ((unsigned)row * 768u + (unsigned)(gcol + 8 * fq)) * 2u, o); }
                    if (m & 1) asm volatile("" ::: "memory"); }
        } else {
            const int h = u.pn - 3;
#pragma unroll
            for (int ai = 0; ai < 2; ++ai)
#pragma unroll
                for (int m = 0; m < 4; ++m) { const int tr = ai * HALF + wr * 64 + m * 16 + fr; const int row = u.pm * BM + tr; const float rs = xb[256 + tr];
#pragma unroll
                    for (int bj = 0; bj < 2; ++bj) { const f32x4 v0 = acc[ai][bj][m][0] * rs, v1 = acc[ai][bj][m][1] * rs;
                        u32x4 w; w.x = cvt_pk_bf16(v0[0], v0[1]); w.y = cvt_pk_bf16(v0[2], v0[3]); w.z = cvt_pk_bf16(v1[0], v1[1]); w.w = cvt_pk_bf16(v1[2], v1[3]);
                        if (bj == 0) gst<u32x4>(Kb, ((unsigned)row * 768u + (unsigned)(192 * h + cw)) * 2u, w);
                        else gst<u32x4>(Vb, ((unsigned)row * 512u + (unsigned)(128 * h + cw)) * 2u, w); }
                    if (m & 1) asm volatile("" ::: "memory"); }
        }
        asm volatile("s_waitcnt lgkmcnt(0)" ::: "memory"); __builtin_amdgcn_s_barrier(); asm volatile("" ::: "memory");
    }
};

struct EpiFnet {
    static constexpr bool PERM = true, PREFETCH = false;
    bf16_t* Y; int rowbase, seqlen; float scale; unsigned slice_stride;
    __device__ __forceinline__ void operator()(const f32x4 (&acc)[2][2][4][2], const Unit& u, int wr, int wc, int fr_in, int fq_in) const {
        int t_ = threadIdx.x; asm volatile("" : "+v"(t_)); const int fr = t_ & 15, fq = (t_ >> 4) & 3; (void)fr_in; (void)fq_in;
        const int k0 = u.pm * BM + wr * 64 + fr; const int cw = wc * 32 + 8 * fq;
        bf16_t* Yb = Y + (size_t)(u.kofs >> 10) * slice_stride;
#pragma unroll
        for (int ai = 0; ai < 2; ++ai)
#pragma unroll
            for (int m = 0; m < 4; ++m) { const int row = rowbase + u.pn * seqlen + k0 + ai * HALF + m * 16; const unsigned yb = ((unsigned)row * 256u + (unsigned)cw) * 2u;
#pragma unroll
                for (int bj = 0; bj < 2; ++bj) { const f32x4 v0 = acc[ai][bj][m][0] * scale, v1 = acc[ai][bj][m][1] * scale;
                    u32x4 w; w.x = cvt_pk_bf16(v0[0], v0[1]); w.y = cvt_pk_bf16(v0[2], v0[3]); w.z = cvt_pk_bf16(v1[0], v1[1]); w.w = cvt_pk_bf16(v1[2], v1[3]);
                    gst<u32x4>(Yb, yb + bj * HALF * 2, w); } }
    }
};

template <bool F32BASE> struct EpiRes {
    static constexpr bool PERM = true, PREFETCH = false;
    const float* base_lat; const float* base_ctx;
    bf16_t* X; const float* mod; int gofs;
    const float* png; const float* pscmod; int pscofs;
    const float* ng; const float* scmod; int scofs; float* ssx;
    float gmul;
    bf16_t* part;
    __device__ __forceinline__ void operator()(const f32x4 (&acc)[2][2][4][2], const Unit& u, int wr, int wc, int fr_in, int fq_in) const {
        int t_ = threadIdx.x; asm volatile("" : "+v"(t_)); const int fr = t_ & 15, fq = (t_ >> 4) & 3; (void)fr_in; (void)fq_in;
        if (part != nullptr && u.pm >= 64) {
            const int sl = u.aux;
            const int prow0 = (u.pm - 64) * BM + wr * 64 + fr; const int pcol0 = u.pn * BM + wc * 32 + 8 * fq; bf16_t* pb_ = part + (size_t)sl * (2048u * 1024u);
#pragma unroll
            for (int ai = 0; ai < 2; ++ai)
#pragma unroll
                for (int m = 0; m < 4; ++m) { const unsigned off = ((unsigned)(prow0 + ai * HALF + m * 16) * 1024u + (unsigned)pcol0) * 2u;
#pragma unroll
                    for (int bj = 0; bj < 2; ++bj) { const f32x4 v0 = acc[ai][bj][m][0], v1 = acc[ai][bj][m][1];
                        u32x4 w; w.x = cvt_pk_bf16(v0[0], v0[1]); w.y = cvt_pk_bf16(v0[2], v0[3]); w.z = cvt_pk_bf16(v1[0], v1[1]); w.w = cvt_pk_bf16(v1[2], v1[3]);
                        gst<u32x4>(pb_, off + (unsigned)(bj * HALF) * 2u, w); } }
            return;
        }
        const bool lat = u.pm < 64; const int r = lat ? (u.pm >> 3) : 8;
        constexpr bool f32base = F32BASE; const float* bf = lat ? base_lat : base_ctx;
        const float* gate = mod + r * 6144 + gofs;
        const int frow0 = (lat ? u.pm : u.pm - 64) * BM + wr * 64 + fr; const int col0 = u.pn * BM + wc * 32 + 8 * fq;
        const int grow0 = u.pm * BM + wr * 64 + fr;
        const bool scaled = ng != nullptr;
        float ss[8];
#pragma unroll
        for (int q = 0; q < 8; ++q) ss[q] = 0.f;
#pragma unroll
        for (int bj = 0; bj < 2; ++bj) {
            f32x4 gv[2], gs[2], gp[2];
#pragma unroll
            for (int n = 0; n < 2; ++n) { const unsigned cb = (unsigned)(col0 + bj * HALF + n * 4) * 4u; gv[n] = gld<f32x4>(gate, cb) * gmul;
                gs[n] = scaled ? gld<f32x4>(ng, cb) * (gld<f32x4>(scmod, (unsigned)(r * 6144 + scofs) * 4u + cb) + 1.0f) : (f32x4){1.f, 1.f, 1.f, 1.f};
                if constexpr (!f32base) { const f32x4 d = gld<f32x4>(png, cb) * (gld<f32x4>(pscmod, (unsigned)(r * 6144 + pscofs) * 4u + cb) + 1.0f);
                    gp[n] = (f32x4){__builtin_amdgcn_rcpf(d[0]), __builtin_amdgcn_rcpf(d[1]), __builtin_amdgcn_rcpf(d[2]), __builtin_amdgcn_rcpf(d[3])}; }
                else gp[n] = (f32x4){1.f, 1.f, 1.f, 1.f}; }
#pragma unroll
            for (int ai = 0; ai < 2; ++ai) {
                f32x4 x0[4], x1[4];
#pragma unroll
                for (int m = 0; m < 4; ++m) { const unsigned o2 = ((unsigned)(grow0 + ai * HALF + m * 16) * 1024u + (unsigned)(col0 + bj * HALF)) * 2u;
                    const unsigned fo = ((unsigned)(frow0 + ai * HALF + m * 16) * 1024u + (unsigned)(col0 + bj * HALF)) * 4u;
                    if constexpr (f32base) { x0[m] = gld<f32x4>(bf, fo); x1[m] = gld<f32x4>(bf, fo + 16u); }
                    else { const u32x4 bw = gld<u32x4>(X, o2); x0[m] = __builtin_bit_cast(f32x4, (u32x4){bw.x << 16, bw.x & 0xffff0000u, bw.y << 16, bw.y & 0xffff0000u});
                        x1[m] = __builtin_bit_cast(f32x4, (u32x4){bw.z << 16, bw.z & 0xffff0000u, bw.w << 16, bw.w & 0xffff0000u}); } }
                asm volatile("" ::: "memory");
#pragma unroll
                for (int m = 0; m < 4; ++m) { const unsigned o2 = ((unsigned)(grow0 + ai * HALF + m * 16) * 1024u + (unsigned)(col0 + bj * HALF)) * 2u;
                    f32x4 y0 = x0[m], y1 = x1[m];
                    if constexpr (!f32base) { y0 = y0 * gp[0]; y1 = y1 * gp[1]; }
                    y0 = y0 + gv[0] * acc[ai][bj][m][0]; y1 = y1 + gv[1] * acc[ai][bj][m][1];
                    ss[ai * 4 + m] += ((y0[0] * y0[0] + y0[1] * y0[1]) + (y0[2] * y0[2] + y0[3] * y0[3])) + ((y1[0] * y1[0] + y1[1] * y1[1]) + (y1[2] * y1[2] + y1[3] * y1[3]));
                    asm volatile("" : "+v"(ss[ai * 4 + m]));
                    const f32x4 h0 = y0 * gs[0], h1 = y1 * gs[1];
                    u32x4 hw; hw.x = cvt_pk_bf16(h0[0], h0[1]); hw.y = cvt_pk_bf16(h0[2], h0[3]); hw.z = cvt_pk_bf16(h1[0], h1[1]); hw.w = cvt_pk_bf16(h1[2], h1[3]);
                    gst<u32x4>(X, o2, hw); }
                asm volatile("" ::: "memory"); }
        }
        if (scaled) {
#pragma unroll
            for (int q = 0; q < 8; ++q) { float s = ss[q]; s += __shfl_xor(s, 16); s += __shfl_xor(s, 32);
                if (fq == 0) gst<float>(ssx, ((unsigned)(grow0 + (q >> 2) * HALF + (q & 3) * 16) * 16u + (unsigned)(4 * u.pn + wc)) * 4u, s); } }
    }
};

#ifndef DPP_UP
#define DPP_UP 0x121
#define DPP_DN 0x12F
#endif
struct UnitUp : Unit { int nrows; };
struct EpiUp {
    static constexpr bool PERM = true, PREFETCH = true;
    bf16_t* act; const float* cw; const float* cb; PG8_LAS float* xb;
    const float* ssx; const float* ub;
    __device__ __forceinline__ void prefetch(const UnitUp& u, int wid, int lane) const {
        dma_ssx(ssx, u.arow, xb, wid, lane);
        { const int arr = wid >> 1, half = wid & 1; const float* src = (arr < 3 ? cw + arr * 2816 : cb) + u.pn * HALF + half * 64 + lane;
          __builtin_amdgcn_global_load_lds((const unsigned*)src, (PG8_LAS unsigned*)(xb + EX_CW + arr * 128 + half * 64), 4, 0, 0); }
        if (wid < 2) { const int a0 = u.arow < 0 ? 0 : u.arow; const int b0 = a0 >= MLAT_ ? 8 : (a0 >> 11); const int bb_ = b0 + wid > 8 ? 8 : b0 + wid;
            __builtin_amdgcn_global_load_lds((const unsigned*)(ub + bb_ * 5632 + u.pn * BM + lane * 4), (PG8_LAS unsigned*)(xb + EX_BL + wid * 256), 16, 0, 0); }
    }
    __device__ __forceinline__ void operator()(f32x4 (&acc)[2][2][4][2], const UnitUp& u, int wr, int wc, int fr_in, int fq_in) const {
        int t_ = threadIdx.x; asm volatile("" : "+v"(t_)); const int fr = t_ & 15, fq = (t_ >> 4) & 3; (void)fr_in; (void)fq_in;
        const int lane = fq * 16 + fr;
        const int ccol = wc * 32 + 8 * fq;
        const int gc = u.pn * HALF + ccol;
        PG8_LAS float* CW = xb + EX_CW;
        unsigned rowflags;
        { unsigned pmask = 0u;
          const int a0 = u.arow < 0 ? 0 : u.arow, e0 = u.arow + 255;
          const int seam = (a0 >= MLAT_) ? (1 << 30) : (((a0 >> 11) + 1) << 11);
          const bool straddle = e0 >= seam;
          const PG8_LAS float* bl = xb + EX_BL + ccol;
          const f32x4 ug0 = *(const PG8_LAS f32x4*)(bl), ug1 = *(const PG8_LAS f32x4*)(bl + 4), uv0 = *(const PG8_LAS f32x4*)(bl + HALF), uv1 = *(const PG8_LAS f32x4*)(bl + HALF + 4);
#pragma unroll
          for (int ai = 0; ai < 2; ++ai)
#pragma unroll
            for (int m = 0; m < 4; ++m) { const int tr = ai * HALF + wr * 64 + m * 16 + fr; const int g = u.arow + tr;
                const int pos = g < MLAT_ ? (g & 2047) : ((g - MLAT_) & 255); const int last = g < MLAT_ ? 2047 : 255;
                if (pos == 0) pmask |= 1u << (4 * ai + m); if (pos == last) pmask |= 256u << (4 * ai + m);
                const f32x4 s4 = *(const PG8_LAS f32x4*)(xb + EX_SSX + tr * 16 + 4 * fq); float ssr = (s4[0] + s4[1]) + (s4[2] + s4[3]); ssr += __shfl_xor(ssr, 16); ssr += __shfl_xor(ssr, 32);
                const float rs = __builtin_amdgcn_rsqf(ssr * (1.0f / 1024.0f) + RMS_EPS);
                acc[ai][0][m][0] = acc[ai][0][m][0] * rs + ug0; acc[ai][0][m][1] = acc[ai][0][m][1] * rs + ug1;
                acc[ai][1][m][0] = acc[ai][1][m][0] * rs + uv0; acc[ai][1][m][1] = acc[ai][1][m][1] * rs + uv1; }
          if (straddle) {
              const f32x4 dg0 = *(const PG8_LAS f32x4*)(bl + 256) - ug0, dg1 = *(const PG8_LAS f32x4*)(bl + 260) - ug1, dv0 = *(const PG8_LAS f32x4*)(bl + 256 + HALF) - uv0, dv1 = *(const PG8_LAS f32x4*)(bl + 260 + HALF) - uv1;
#pragma unroll
              for (int ai = 0; ai < 2; ++ai)
#pragma unroll
                for (int m = 0; m < 4; ++m) { const int g = u.arow + ai * HALF + wr * 64 + m * 16 + fr; const float sel = (g >= seam) ? 1.0f : 0.0f;
                    acc[ai][0][m][0] += dg0 * sel; acc[ai][0][m][1] += dg1 * sel; acc[ai][1][m][0] += dv0 * sel; acc[ai][1][m][1] += dv1 * sel; } }
          rowflags = pmask; }
        PG8_LAS float* XF = xb + EX_XF; PG8_LAS float* XL = xb + EX_XL;
        const bool isF = (fr == 0), isL = (fr == 15);
#pragma unroll
        for (int ai = 0; ai < 2; ++ai) { const int blk = 2 * ai + wr;
            f32x4 s0, s1;
#pragma unroll
            for (int e = 0; e < 4; ++e) { s0[e] = isF ? acc[ai][0][0][0][e] : acc[ai][0][3][0][e]; s1[e] = isF ? acc[ai][0][0][1][e] : acc[ai][0][3][1][e]; }
            PG8_LAS float* dst = xb + (isF ? EX_XF : EX_XL) + blk * 128 + ccol;
            if (isF || isL) { *(PG8_LAS f32x4*)dst = s0; *(PG8_LAS f32x4*)(dst + 4) = s1; } }
        asm volatile("s_waitcnt lgkmcnt(0)" ::: "memory"); __builtin_amdgcn_s_barrier(); asm volatile("" ::: "memory");
        const int lup = (lane & 48) | ((lane - 1) & 15), ldn = (lane & 48) | ((lane + 1) & 15);
#pragma unroll
        for (int ai = 0; ai < 2; ++ai) { const int blk = 2 * ai + wr;
#pragma unroll
            for (int n = 0; n < 2; ++n) {
                const f32x4 w0 = *(const PG8_LAS f32x4*)(CW + ccol + 4 * n), w1 = *(const PG8_LAS f32x4*)(CW + 128 + ccol + 4 * n), w2 = *(const PG8_LAS f32x4*)(CW + 256 + ccol + 4 * n), bb = *(const PG8_LAS f32x4*)(CW + 384 + ccol + 4 * n);
                f32x4 xprev = (f32x4){0.f, 0.f, 0.f, 0.f}, xnext = (f32x4){0.f, 0.f, 0.f, 0.f};
                if (blk > 0) xprev = *(const PG8_LAS f32x4*)(XL + (blk - 1) * 128 + ccol + 4 * n);
                if (blk < 3) xnext = *(const PG8_LAS f32x4*)(XF + (blk + 1) * 128 + ccol + 4 * n);
#pragma unroll
                for (int e = 0; e < 4; ++e) {
                    float cur[4], up[4], dn[4];
#pragma unroll
                    for (int m = 0; m < 4; ++m) cur[m] = acc[ai][0][m][n][e];
#pragma unroll
                    for (int m = 0; m < 4; ++m) {
                        const float tu = isL ? (m > 0 ? cur[m > 0 ? m - 1 : 0] : xprev[e]) : cur[m];
                        const float td = isF ? (m < 3 ? cur[m < 3 ? m + 1 : 3] : xnext[e]) : cur[m];
                        up[m] = __shfl(tu, lup); dn[m] = __shfl(td, ldn); }
                    float rr[4];
#pragma unroll
                    for (int m = 0; m < 4; ++m) { const float upv = ((rowflags >> (4 * ai + m)) & 1u) ? 0.f : up[m], dnv = ((rowflags >> (8 + 4 * ai + m)) & 1u) ? 0.f : dn[m];
                        const float cv = w0[e] * upv + w1[e] * cur[m] + w2[e] * dnv + bb[e];
                        const float sg = cv * __builtin_amdgcn_rcpf(1.0f + __expf(-cv));
                        rr[m] = sg * acc[ai][1][m][n][e]; }
                    asm volatile("" : "+v"(rr[0]), "+v"(rr[1]), "+v"(rr[2]), "+v"(rr[3]));
#pragma unroll
                    for (int m = 0; m < 4; ++m) acc[ai][0][m][n][e] = rr[m];
                }
            }
#pragma unroll
            for (int m = 0; m < 4; ++m) { const int tr = ai * HALF + wr * 64 + m * 16 + fr; const int g = u.arow + tr;
                if (tr >= 1 && tr <= 254 && g < u.nrows) { const f32x4 v0 = acc[ai][0][m][0], v1 = acc[ai][0][m][1];
                    u32x4 w; w.x = cvt_pk_bf16(v0[0], v0[1]); w.y = cvt_pk_bf16(v0[2], v0[3]); w.z = cvt_pk_bf16(v1[0], v1[1]); w.w = cvt_pk_bf16(v1[2], v1[3]);
                    gst<u32x4>(act, ((unsigned)g * 2816u + (unsigned)gc) * 2u, w); } }
            asm volatile("" ::: "memory");
        }
        asm volatile("s_waitcnt lgkmcnt(0)" ::: "memory"); __builtin_amdgcn_s_barrier(); asm volatile("" ::: "memory");
    }
};
}
namespace att {
using bf16x8 = __attribute__((ext_vector_type(8))) short;
using s16x4  = __attribute__((ext_vector_type(4))) short;
using f32x16 = __attribute__((ext_vector_type(16))) float;
using u32x4  = __attribute__((ext_vector_type(4))) unsigned;
typedef unsigned short bf16_t;
constexpr int NW = 8, QBLK = 32, KVBLK = 64;
constexpr int LDQ = 768, LDK = 768, LDV = 512, LDO = 1024;
constexpr float SCALE = 0.07216878364870322f;
constexpr float THR = 8.f;
constexpr int SHM_V = KVBLK * 128 * 2, SHM_K = KVBLK * 192 * 2;
constexpr int OFF_V = 0, OFF_K = 2 * SHM_V, OFF_WS = 2 * SHM_V + 2 * SHM_K, OFF_QR = OFF_WS + NW * 64 * 4, SHM_ATTN = OFF_QR + NW * 4096;
#define KSWZ(row, colB) ((row) * 384 + ((colB) ^ (((row) & 7) << 4)))
#define SBAR() __builtin_amdgcn_sched_barrier(0)
__device__ __forceinline__ int crow(int r, int hi) { return (r & 3) + 8 * (r >> 2) + 4 * hi; }
__device__ __forceinline__ unsigned cvtpk(float lo, float hi) { unsigned r; asm volatile("v_cvt_pk_bf16_f32 %0, %1, %2" : "=v"(r) : "v"(lo), "v"(hi)); return r; }

__device__ __forceinline__ void partialSM(f32x16& p0, f32x16& p1, float& m_reg, float& mn, float& alpha) {
  constexpr float C = SCALE * 1.4426950408889634f;
  float pmax = p0[0];
#pragma unroll
  for (int r = 1; r < 16; ++r) pmax = fmaxf(pmax, p0[r]);
#pragma unroll
  for (int r = 0; r < 16; ++r) pmax = fmaxf(pmax, p1[r]);
  { auto rr = __builtin_amdgcn_permlane32_swap(__float_as_uint(pmax), __float_as_uint(pmax), false, false);
    pmax = fmaxf(__uint_as_float(rr[0]), __uint_as_float(rr[1])); }
  if (__builtin_expect(__all(pmax - m_reg <= THR / SCALE), 1)) { mn = m_reg; alpha = 1.f; }
  else { mn = fmaxf(m_reg, pmax); alpha = __builtin_amdgcn_exp2f((m_reg - mn) * C); m_reg = mn; }
  float mnC = -mn * C;
#pragma unroll
  for (int r = 0; r < 16; ++r) p0[r] = fmaf(p0[r], C, mnC);
#pragma unroll
  for (int r = 0; r < 16; ++r) p1[r] = fmaf(p1[r], C, mnC);
#pragma unroll
  for (int r = 0; r < 16; ++r) p0[r] = __builtin_amdgcn_exp2f(p0[r]);
}
__device__ __forceinline__ void finishSM(f32x16& p0, f32x16& p1, float alpha, float& l_reg, bf16x8& pa0, bf16x8& pa1, bf16x8& pa2, bf16x8& pa3) {
#pragma unroll
  for (int r = 0; r < 16; ++r) p1[r] = __builtin_amdgcn_exp2f(p1[r]);
  float ps = 0;
#pragma unroll
  for (int r = 0; r < 16; ++r) ps += p0[r];
#pragma unroll
  for (int r = 0; r < 16; ++r) ps += p1[r];
  { auto rr = __builtin_amdgcn_permlane32_swap(__float_as_uint(ps), __float_as_uint(ps), false, false);
    ps = __uint_as_float(rr[0]) + __uint_as_float(rr[1]); }
  l_reg = l_reg * alpha + ps;
#define PK4(P, BASE, OUT) do { unsigned a0 = cvtpk(P[BASE + 0], P[BASE + 1]), a1 = cvtpk(P[BASE + 2], P[BASE + 3]);   \
    unsigned b0 = cvtpk(P[BASE + 4], P[BASE + 5]), b1 = cvtpk(P[BASE + 6], P[BASE + 7]);                              \
    auto r0 = __builtin_amdgcn_permlane32_swap(a0, b0, false, false); auto r1 = __builtin_amdgcn_permlane32_swap(a1, b1, false, false); \
    u32x4 w = {r0[0], r1[0], r0[1], r1[1]}; OUT = *reinterpret_cast<bf16x8*>(&w); } while (0)
  PK4(p0, 0, pa0); PK4(p0, 8, pa1); PK4(p1, 0, pa2); PK4(p1, 8, pa3);
#undef PK4
}
__device__ __forceinline__ void qkt(f32x16& p0, f32x16& p1, const char* Ks, const bf16x8* qr, const char* Qr, int r32, int hi) {
  p0 = f32x16{}; p1 = f32x16{};
#pragma unroll
  for (int d0 = 0; d0 < 12; ++d0) { int cb = (d0 * 16 + hi * 8) * 2;
    bf16x8 b0 = *reinterpret_cast<const bf16x8*>(Ks + KSWZ(r32, cb));
    bf16x8 b1 = *reinterpret_cast<const bf16x8*>(Ks + KSWZ(32 + r32, cb));
    bf16x8 q;
    if (d0 < 8) q = qr[d0];
    else q = *reinterpret_cast<const bf16x8*>(Qr + r32 * 128 + ((((d0 - 8) * 16 + hi * 8) * 2) ^ ((r32 & 7) << 4)));
    p0 = __builtin_amdgcn_mfma_f32_32x32x16_bf16(b0, q, p0, 0, 0, 0);
    p1 = __builtin_amdgcn_mfma_f32_32x32x16_bf16(b1, q, p1, 0, 0, 0); }
}
__device__ __forceinline__ int v_st(int k, int c) { const int kk = (k & ~0xC) | ((k & 4) << 1) | ((k & 8) >> 1); return ((kk >> 3) * 4 + (c >> 5)) * 512 + ((kk & 7) * 32 + (c & 31)) * 2; }
__device__ __forceinline__ int v_rd_base(int lane) { return ((lane & 3) << 3) | (((lane >> 2) & 3) << 6) | (((lane >> 4) & 1) << 5) | (((lane >> 5) & 1) << 8); }
constexpr int v_rd_off(int d0, int ks, int half) { return d0 * 512 + ks * 4096 + half * 2048; }
template <int OFF> __device__ __forceinline__ s16x4 tr_read(int vb) {
  s16x4 r; asm volatile("ds_read_b64_tr_b16 %0, %1 offset:%2" : "=&v"(r) : "v"(vb), "i"(OFF) : "memory"); return r;
}
template <int D0> __device__ __forceinline__ void pv_one(f32x16& od, int vb, bf16x8 pa0, bf16x8 pa1, bf16x8 pa2, bf16x8 pa3) {
  const s16x4 l0 = tr_read<v_rd_off(D0, 0, 0)>(vb), h0 = tr_read<v_rd_off(D0, 0, 1)>(vb), l1 = tr_read<v_rd_off(D0, 1, 0)>(vb), h1 = tr_read<v_rd_off(D0, 1, 1)>(vb);
  const s16x4 l2 = tr_read<v_rd_off(D0, 2, 0)>(vb), h2 = tr_read<v_rd_off(D0, 2, 1)>(vb), l3 = tr_read<v_rd_off(D0, 3, 0)>(vb), h3 = tr_read<v_rd_off(D0, 3, 1)>(vb);
  asm volatile("s_waitcnt lgkmcnt(0)" ::: "memory"); SBAR();
#define PK(L, H) (bf16x8){L[0], L[1], L[2], L[3], H[0], H[1], H[2], H[3]}
  od = __builtin_amdgcn_mfma_f32_32x32x16_bf16(pa0, PK(l0, h0), od, 0, 0, 0);
  od = __builtin_amdgcn_mfma_f32_32x32x16_bf16(pa1, PK(l1, h1), od, 0, 0, 0);
  od = __builtin_amdgcn_mfma_f32_32x32x16_bf16(pa2, PK(l2, h2), od, 0, 0, 0);
  od = __builtin_amdgcn_mfma_f32_32x32x16_bf16(pa3, PK(l3, h3), od, 0, 0, 0);
#undef PK
}
__device__ __forceinline__ void pv_d0(f32x16* o, int vb, bf16x8 pa0, bf16x8 pa1, bf16x8 pa2, bf16x8 pa3) {
  pv_one<0>(o[0], vb, pa0, pa1, pa2, pa3); pv_one<1>(o[1], vb, pa0, pa1, pa2, pa3); pv_one<2>(o[2], vb, pa0, pa1, pa2, pa3); pv_one<3>(o[3], vb, pa0, pa1, pa2, pa3);
}

__device__ __forceinline__ void attn_unit(const bf16_t* __restrict__ Qb, const bf16_t* __restrict__ Kg, const bf16_t* __restrict__ Vg, bf16_t* __restrict__ Ob,
                                          int r0, int n0, int r1, int NT, char* lds) {
  int tid = threadIdx.x; asm volatile("" : "+v"(tid));
  const int wid = tid >> 6, lane = tid & 63, r32 = lane & 31, hi = lane >> 5;
  char* V_lds = lds + OFF_V; char* K_lds = lds + OFF_K;
  float* ws = (float*)(lds + OFF_WS) + wid * 64; float* li_l = ws; float* al_l = ws + 32;
  float m_reg = -1e30f, l_reg = 0; f32x16 o[4] = {}; bf16x8 qr[8];
  const bf16_t* Qw = Qb + (long)(wid * QBLK + r32) * LDQ + hi * 8;
  char* Qr = lds + OFF_QR + wid * 4096;
#pragma unroll
  for (int d0 = 0; d0 < 8; ++d0) qr[d0] = *reinterpret_cast<const bf16x8*>(Qw + d0 * 16);
#pragma unroll
  for (int d0 = 8; d0 < 12; ++d0) { const bf16x8 q = *reinterpret_cast<const bf16x8*>(Qw + d0 * 16);
    *reinterpret_cast<bf16x8*>(Qr + r32 * 128 + ((((d0 - 8) * 16 + hi * 8) * 2) ^ ((r32 & 7) << 4))) = q; }
  const int sr = tid >> 4, sc = (tid & 15) * 8, vst0 = v_st(sr, sc), vst1 = v_st(32 + sr, sc);
  unsigned kgo[3], kst[3];
#pragma unroll
  for (int i = 0; i < 3; ++i) { const int id = tid + 512 * i, kr_ = id / 24, kc_ = id % 24; kgo[i] = (unsigned)(kr_ * LDK + kc_ * 8) * 2u; kst[i] = (unsigned)KSWZ(kr_, kc_ * 16); }
  const unsigned vgo0 = (unsigned)(sr * LDV + sc) * 2u, vgo1 = vgo0 + 32u * LDV * 2u;
  const int vb0 = (int)(uintptr_t)V_lds + v_rd_base(lane);
  bf16x8 vs0, vs1, ks0, ks1, ks2;
#define TROW(j) ((j) < n0 ? r0 + 64 * (j) : r1 + 64 * ((j) - n0))
#define SLOAD(j) do { const long tr_ = TROW(j); const char* Vt = (const char*)(Vg + tr_ * LDV); const char* Kt = (const char*)(Kg + tr_ * LDK);     \
    vs0 = *reinterpret_cast<const bf16x8*>(Vt + vgo0); vs1 = *reinterpret_cast<const bf16x8*>(Vt + vgo1); \
    ks0 = *reinterpret_cast<const bf16x8*>(Kt + kgo[0]); ks1 = *reinterpret_cast<const bf16x8*>(Kt + kgo[1]); ks2 = *reinterpret_cast<const bf16x8*>(Kt + kgo[2]); } while (0)
#define SWRITE(b) do { *(bf16x8*)(V_lds + (b) * SHM_V + vst0) = vs0; *(bf16x8*)(V_lds + (b) * SHM_V + vst1) = vs1; \
    *(bf16x8*)(K_lds + (b) * SHM_K + kst[0]) = ks0; *(bf16x8*)(K_lds + (b) * SHM_K + kst[1]) = ks1; *(bf16x8*)(K_lds + (b) * SHM_K + kst[2]) = ks2; } while (0)
#define RESC(a) do { if (__any((a) < 1.f)) { if (hi == 0) al_l[r32] = (a); asm volatile("s_waitcnt lgkmcnt(0)" ::: "memory"); \
    _Pragma("unroll") for (int d = 0; d < 4; ++d) _Pragma("unroll") for (int r = 0; r < 16; ++r) o[d][r] *= al_l[crow(r, hi)]; } } while (0)
  f32x16 pA0, pA1, pB0, pB1; float mnA, mnB, alA, alB; bf16x8 pa0, pa1, pa2, pa3;
  SLOAD(0); asm volatile("s_waitcnt vmcnt(0)" ::: "memory"); SWRITE(0); __syncthreads();
  qkt(pA0, pA1, K_lds, qr, Qr, r32, hi); partialSM(pA0, pA1, m_reg, mnA, alA);
  SLOAD(1);
  asm volatile("s_waitcnt vmcnt(0)" ::: "memory"); SWRITE(1); __syncthreads();
  for (int j = 1; j + 1 < NT; j += 2) {
    SBAR(); qkt(pB0, pB1, K_lds + SHM_K, qr, Qr, r32, hi);
    finishSM(pA0, pA1, alA, l_reg, pa0, pa1, pa2, pa3); SBAR();
    SLOAD(j + 1); SBAR();
    pv_d0(o, vb0, pa0, pa1, pa2, pa3); partialSM(pB0, pB1, m_reg, mnB, alB);
    __syncthreads(); asm volatile("s_waitcnt vmcnt(0)" ::: "memory"); SWRITE(0);
    RESC(alB); __syncthreads();
    SBAR(); qkt(pA0, pA1, K_lds, qr, Qr, r32, hi);
    finishSM(pB0, pB1, alB, l_reg, pa0, pa1, pa2, pa3); SBAR();
    SLOAD(j + 2); SBAR();
    pv_d0(o, vb0 + SHM_V, pa0, pa1, pa2, pa3); partialSM(pA0, pA1, m_reg, mnA, alA);
    __syncthreads(); asm volatile("s_waitcnt vmcnt(0)" ::: "memory"); SWRITE(1);
    RESC(alA); __syncthreads();
  }
  SBAR(); qkt(pB0, pB1, K_lds + SHM_K, qr, Qr, r32, hi);
  finishSM(pA0, pA1, alA, l_reg, pa0, pa1, pa2, pa3); SBAR();
  pv_d0(o, vb0, pa0, pa1, pa2, pa3); partialSM(pB0, pB1, m_reg, mnB, alB);
  __syncthreads(); RESC(alB);
  finishSM(pB0, pB1, alB, l_reg, pa0, pa1, pa2, pa3); SBAR();
  pv_d0(o, vb0 + SHM_V, pa0, pa1, pa2, pa3);
  if (hi == 0) li_l[r32] = l_reg; asm volatile("s_waitcnt lgkmcnt(0)" ::: "memory");
  float rli[16];
#pragma unroll
  for (int r = 0; r < 16; ++r) rli[r] = __builtin_amdgcn_rcpf(li_l[crow(r, hi)]);
  __syncthreads();
  { bf16_t* stg = (bf16_t*)(lds + wid * 8192);
#pragma unroll
    for (int r = 0; r < 16; ++r) { const int orow = crow(r, hi);
#pragma unroll
      for (int d0 = 0; d0 < 4; ++d0) { const unsigned pk = cvtpk(o[d0][r] * rli[r], 0.f); stg[orow * 128 + d0 * 32 + r32] = (bf16_t)(pk & 0xffffu); } }
    asm volatile("s_waitcnt lgkmcnt(0)" ::: "memory");
    bf16_t* Ow = Ob + (long)(wid * QBLK) * LDO;
#pragma unroll
    for (int i = 0; i < 8; ++i) { const int row = i * 4 + (lane >> 4), ch = lane & 15; const u32x4 v = *(const u32x4*)(stg + row * 128 + ch * 8); *(u32x4*)(Ow + (long)row * LDO + ch * 8) = v; } }
  __syncthreads();
#undef TROW
#undef SLOAD
#undef SWRITE
#undef RESC
}
#undef KSWZ
#undef SBAR
}
constexpr int NWAVES = 8;
#ifndef MK_SPLIT
#define MK_SPLIT 0
#endif

constexpr int DM = 1024, NB = 8, SL = 2048, CL = 256, MLAT = NB * SL, MCTX = NB * CL, MT = MLAT + MCTX;
constexpr int NIN = 2048;
constexpr int FF = 2816, NUP = 2 * FF;
constexpr int NPH = 20;
constexpr float EPS = 1e-6f;

constexpr size_t MiB = 1u << 20;
constexpr size_t WS_CTL = 0, CTL_ZERO_BYTES = 64 * 1024;
constexpr size_t WS_MOD = 1 * MiB;
constexpr size_t WS_ROPE = 1 * MiB + 512 * 1024;
constexpr size_t WS_SSQ = 2 * MiB;
constexpr size_t WS_WIN = 4 * MiB, WIN_STRIDE = (size_t)NIN * DM * 2;
constexpr size_t WS_WQKV = 12 * MiB, WQKV_STRIDE = (size_t)1792 * 384 * 2;
constexpr size_t WS_WOUT = 15 * MiB, WOUT_STRIDE = (size_t)DM * DM * 2;
constexpr size_t WS_WUP = 19 * MiB, WUP_STRIDE = (size_t)NUP * DM * 2;
constexpr size_t WS_WDOWN = 41 * MiB, WDOWN_STRIDE = (size_t)DM * FF * 2;
constexpr size_t WS_DFT = 52 * MiB;
constexpr size_t WS_DFTC = 68 * MiB;
constexpr size_t WS_CST = 68 * MiB + 256 * 1024;
constexpr size_t WS_WF = 248 * MiB;
constexpr size_t WS_XCTX = 69 * MiB;
constexpr size_t WS_XN = 77 * MiB;
constexpr size_t WS_Q = WS_XN, WS_YC = WS_XN + 27 * MiB;
constexpr size_t WS_P = 113 * MiB;
constexpr size_t WS_YCAT = WS_P, WS_ACT = WS_P;
constexpr size_t WS_YFP = WS_P + 36 * MiB;
constexpr size_t WS_K = 185 * MiB;
constexpr size_t WS_V = 212 * MiB;
constexpr size_t WS_CPART = 212 * MiB;
constexpr size_t WS_ZT = 230 * MiB;
constexpr size_t WS_ZTC = WS_ZT + 16 * MiB;
constexpr size_t WS_SSX = 250 * MiB;
constexpr size_t WS_PB = 252 * MiB;
constexpr size_t WS_UB = 253 * MiB;
constexpr size_t WS_END = 254 * MiB;
static_assert(WS_WQKV + 2 * WQKV_STRIDE <= WS_WOUT && WS_WOUT + 2 * WOUT_STRIDE <= WS_WUP && WS_WUP + 2 * WUP_STRIDE <= WS_WDOWN && WS_WDOWN + 2 * WDOWN_STRIDE <= WS_DFT, "weights map");
static_assert(WS_SSQ + (size_t)MT * 80 <= WS_WIN && WS_XN + (size_t)MT * DM * 2 <= WS_P && WS_P + (size_t)MT * NIN * 2 <= WS_K && WS_K + (size_t)MT * 768 * 2 <= WS_V && WS_V + (size_t)MT * 512 * 2 <= WS_ZT, "activation map");
static_assert(WS_ACT + (size_t)MT * FF * 2 <= WS_V && WS_YC + (size_t)MT * 256 * 2 <= WS_P, "overlay map");
constexpr int CW_BAR = 4096;

constexpr int RING_OFF = 0, RING_BYTES = 131072;
constexpr int LDSCTL_OFF = RING_BYTES, MISC_OFF = LDSCTL_OFF + 320, PTR_OFF = LDSCTL_OFF + 512, EPIX_OFF = LDSCTL_OFF + 1024;
constexpr int LDS_BYTES = 163840;
static_assert(EPIX_OFF + 6400 * 4 <= LDS_BYTES, "LDS map");

#define GAS __attribute__((address_space(1)))
#define LAS __attribute__((address_space(3)))
typedef unsigned short bf16;
typedef unsigned v4u __attribute__((ext_vector_type(4)));
typedef unsigned v2u __attribute__((ext_vector_type(2)));
typedef float f32x4 __attribute__((ext_vector_type(4)));
typedef GAS unsigned gu32;
#define RLX_AGENT __ATOMIC_RELAXED, __HIP_MEMORY_SCOPE_AGENT
#define LDS_WAIT() asm volatile("s_waitcnt lgkmcnt(0)" ::: "memory")
#define VM_WAIT() asm volatile("s_waitcnt vmcnt(0)" ::: "memory")
__device__ __forceinline__ unsigned f2bf(float f) { unsigned u = __builtin_bit_cast(unsigned, f); return (u + 0x7fffu + ((u >> 16) & 1u)) >> 16; }
__device__ __forceinline__ unsigned pk2(float lo, float hi) { return f2bf(lo) | (f2bf(hi) << 16); }
__device__ __forceinline__ float bf2f(unsigned h) { return __builtin_bit_cast(float, h << 16); }

#define XB_TMO      128
#define XB_XCNT(j)  (256  + 64 * (j))
#define XB_XSUB(j)  (1280 + 64 * (j))
#define XB_XGEN(j)  (2304 + 64 * (j))
#define XB_TOP      3328
#define XB_TOPGEN   3392
#define XCD_BAR_WORDS 3456
#define XB_SPIN_CAP (1u << 20)
__device__ __forceinline__ unsigned xb_ld(unsigned* p)              { return __hip_atomic_load(p, __ATOMIC_RELAXED, __HIP_MEMORY_SCOPE_AGENT); }
__device__ __forceinline__ unsigned xb_add(unsigned* p, unsigned v) { return __hip_atomic_fetch_add(p, v, __ATOMIC_RELAXED, __HIP_MEMORY_SCOPE_AGENT); }
__device__ __forceinline__ unsigned xb_xcc_id() { return (unsigned)__builtin_amdgcn_s_getreg((3 << 11) | 20) & 0xFu; }
#define XB_SPIN(cond, bar) do { unsigned _sp = 0; while (cond) { __builtin_amdgcn_s_sleep(1); \
    if ((++_sp & 255u) == 0u) { if (xb_ld(&(bar)[XB_TMO])) break; if (_sp > XB_SPIN_CAP) { atomicAdd(&(bar)[XB_TMO], 1u); break; } } } } while (0)
struct XcdBarrier { unsigned* bar; unsigned x; volatile LAS unsigned* st; };
__device__ __forceinline__ XcdBarrier xcd_barrier_post(unsigned* bar, volatile LAS unsigned* st) {
    XcdBarrier b; b.bar = bar; b.x = xb_xcc_id(); b.st = st;
    if (threadIdx.x == 0) (void)xb_add(&bar[XB_XCNT(b.x)], 1u);
    return b;
}
__device__ __forceinline__ void xcd_barrier_complete(unsigned* bar, unsigned x, unsigned& nloc, unsigned& nx) {
    const unsigned G = gridDim.x * gridDim.y * gridDim.z;
    unsigned sum, cnt, mine, sp = 0u;
    for (;;) {
        sum = 0u; cnt = 0u; mine = 0u;
#pragma unroll
        for (unsigned j = 0; j < 16; ++j) { const unsigned c = xb_ld(&bar[XB_XCNT(j)]); sum += c; cnt += (c > 0u) ? 1u : 0u; mine = (j == x) ? c : mine; }
        if (sum == G) break;
        __builtin_amdgcn_s_sleep(1);
        if ((++sp & 255u) == 0u) { if (xb_ld(&bar[XB_TMO])) break; if (sp > XB_SPIN_CAP) { atomicAdd(&bar[XB_TMO], 1u); break; } }
    }
    nloc = mine > 0u ? mine : 1u; nx = cnt > 0u ? cnt : 1u;
}
__device__ __forceinline__ void xcd_barrier(const XcdBarrier& b) {
    asm volatile("s_waitcnt vmcnt(0)" ::: "memory");
    __syncthreads();
    if (threadIdx.x == 0) {
        unsigned* bar = b.bar;
        __builtin_amdgcn_s_waitcnt(0);
        unsigned nloc = b.st[0], nx = b.st[1];
        if (nloc == 0u) { xcd_barrier_complete(bar, b.x, nloc, nx); b.st[0] = nloc; b.st[1] = nx; }
        const unsigned old = xb_add(&bar[XB_XSUB(b.x)], 1u);
        const unsigned gen = old / nloc;
        if (old + 1u == (gen + 1u) * nloc) {
            __builtin_amdgcn_fence(__ATOMIC_RELEASE, "agent");
            asm volatile("s_waitcnt vmcnt(0)" ::: "memory");
            const unsigned og = xb_add(&bar[XB_TOP], 1u);
            const unsigned tg = og / nx;
            if (og + 1u == (tg + 1u) * nx) xb_add(&bar[XB_TOPGEN], 1u);
            else XB_SPIN(xb_ld(&bar[XB_TOPGEN]) == tg, bar);
            __builtin_amdgcn_fence(__ATOMIC_ACQUIRE, "agent");
            xb_add(&bar[XB_XGEN(b.x)], 1u);
            asm volatile("s_waitcnt vmcnt(0)" ::: "memory");
        } else {
            XB_SPIN(xb_ld(&bar[XB_XGEN(b.x)]) == gen, bar);
            __builtin_amdgcn_fence(__ATOMIC_ACQUIRE, "agent");
            asm volatile("s_waitcnt vmcnt(0)" ::: "memory");
        }
    }
    __syncthreads();
}

struct Args { const float* in[22]; float* out; unsigned char* ws; int ph_lo, ph_hi; };
enum { I_X = 0, I_C, I_CTX, I_CCTX, I_ADAW, I_ADAB, I_N1G, I_WIN, I_QNG, I_KVNG, I_WUQ, I_WUKV, I_SCW, I_SCB, I_ONG, I_WOUT, I_N2G, I_WUP, I_FCW, I_FCB, I_WDOWN, I_FING };

struct Frame {
    LAS unsigned char* lds; char* ldsg;
    volatile LAS unsigned* MISC;
    int tid, lane, wave, vcu, G, bx;
    unsigned char* ws; float* out;
};

__device__ __forceinline__ const float* inptr(const Frame& F, int i) {
    const LAS unsigned* T = (const LAS unsigned*)(F.lds + PTR_OFF) + 2 * i;
    const unsigned lo = __builtin_amdgcn_readfirstlane(T[0]), hi = __builtin_amdgcn_readfirstlane(T[1]);
    return (const float*)(const GAS float*)(((unsigned long long)hi << 32) | (unsigned long long)lo);
}
__device__ __forceinline__ float wave_sum(float v) {
#pragma unroll
    for (int o = 1; o < 64; o <<= 1) v += __shfl_xor(v, o);
    return v;
}

__device__ __host__ __forceinline__ int rope_slot(int d) { return 8 * ((d & 15) >> 2) + 4 * (d >> 4) + (d & 3); }
__device__ __forceinline__ void tr_item(const float* W, int ldw, int k0, int c0, bf16* WT, int ldt, int r0, const float* ks, LAS float* scr, int lane, bool ropeperm = false) {
    f32x4 v[8];
#pragma unroll
    for (int i = 0; i < 8; ++i) { const int kk = 8 * i + (lane >> 3); v[i] = *(const GAS f32x4*)(W + (size_t)(k0 + kk) * ldw + c0 + 4 * (lane & 7)); }
#pragma unroll
    for (int i = 0; i < 8; ++i) { const int kk = 8 * i + (lane >> 3); const float sc = ks ? ks[k0 + kk] : 1.0f; LAS float* d = scr + kk * 33 + 4 * (lane & 7);
        d[0] = v[i][0] * sc; d[1] = v[i][1] * sc; d[2] = v[i][2] * sc; d[3] = v[i][3] * sc; }
    LDS_WAIT(); asm volatile("" ::: "memory");
    const int c = lane & 7;
#pragma unroll
    for (int j = 0; j < 4; ++j) { const int n = (lane >> 3) + 8 * j; const LAS float* s = scr + (8 * c) * 33 + n;
        v4u o; o.x = pk2(s[0 * 33], s[1 * 33]); o.y = pk2(s[2 * 33], s[3 * 33]); o.z = pk2(s[4 * 33], s[5 * 33]); o.w = pk2(s[6 * 33], s[7 * 33]);
        *(GAS v4u*)(WT + (size_t)(r0 + (ropeperm ? rope_slot(n) : n)) * ldt + k0 + 8 * c) = o; }
    LDS_WAIT(); asm volatile("" ::: "memory");
}
__device__ __forceinline__ void p0_prologue(Frame& F, int sub, int defer, int gw, int NGW) {
    unsigned char* ws = F.ws;
    float* MOD = (float*)(ws + WS_MOD);
    if (F.bx < 192 && (sub & 1) && defer == 0) {
        const int l = F.bx / 96, cb = F.bx % 96;
        LAS float* S = (LAS float*)(F.lds + F.wave * 4608);
        const float* cin = inptr(F, I_C); const float* cctx = inptr(F, I_CCTX);
        for (int i = F.lane; i < 9 * 128; i += 64) { const int r = i >> 7, kk = i & 127, k = 128 * F.wave + kk; const float cv = (r < 8) ? cin[r * 1024 + k] : cctx[k]; S[i] = cv / (1.0f + __expf(-cv)); }
        LDS_WAIT(); asm volatile("" ::: "memory");
        f32x4 acc[9];
#pragma unroll
        for (int r = 0; r < 9; ++r) acc[r] = (f32x4){0.f, 0.f, 0.f, 0.f};
        const int kr = F.lane >> 4, cl = F.lane & 15;
        const float* W = inptr(F, I_ADAW) + (size_t)l * 1024 * 6144 + (size_t)(128 * F.wave) * 6144 + 64 * cb + 4 * cl;
#pragma unroll 8
        for (int i = 0; i < 32; ++i) { const int kk = 4 * i + kr; const f32x4 w = *(const f32x4*)(W + (size_t)kk * 6144);
#pragma unroll
            for (int r = 0; r < 9; ++r) acc[r] += w * S[r * 128 + kk]; }
        LAS float* RED = (LAS float*)(F.lds + 40960);
#pragma unroll
        for (int r = 0; r < 9; ++r)
#pragma unroll
            for (int e = 0; e < 4; ++e) { float v = acc[r][e]; v += __shfl_xor(v, 16); v += __shfl_xor(v, 32); if (kr == 0) RED[(F.wave * 9 + r) * 64 + 4 * cl + e] = v; }
        __syncthreads();
        for (int i = F.tid; i < 576; i += 512) { const int r = i >> 6, col = i & 63; float s = 0.f;
#pragma unroll
            for (int w = 0; w < 8; ++w) s += RED[(w * 9 + r) * 64 + col];
            MOD[(size_t)(l * 9 + r) * 6144 + 64 * cb + col] = s + inptr(F, I_ADAB)[l * 6144 + 64 * cb + col]; }
        __syncthreads();
    }
    if (F.bx == 255 % F.G && defer == 0) {
        float* RC = (float*)(ws + WS_ROPE); float* RS = RC + 1024;
        for (int idx = F.tid; idx < 1024; idx += 512) { const int pos = idx >> 4, i = idx & 15; const float inv = powf(10000.0f, -(float)(2 * i) / 32.0f); const float ang = (float)pos * inv; RC[idx] = cosf(ang); RS[idx] = sinf(ang); }
    }
    LAS float* scr = (LAS float*)(F.lds + F.wave * 16384);
    constexpr int I_WINA = 22 * 16, I_WINB = 24 * 16, I_PAD = 8, I_FOLD = 64, I_UQ = 6 * 24, I_UKV = 4 * 32, I_OUT = 16 * 32, I_UP = 16 * 176, I_DOWN = 44 * 32;
    constexpr int PER_LAYER = I_WINA + I_WINB + I_PAD + I_FOLD + I_UQ + I_UKV + I_OUT + I_UP + I_DOWN;
    constexpr int I_DFT = 2048, I_DFTC = 256, I_CST = 512;
    constexpr int NITEMS = 2 * PER_LAYER + I_DFT + I_DFTC + I_CST;
    for (int it = gw; it < NITEMS; it += NGW) {
        int r = it;
        { int cat = 2; if (r < 2 * PER_LAYER) { const int q = r % PER_LAYER;
              cat = q < I_WINA + I_WINB + I_PAD ? 1 : q < I_WINA + I_WINB + I_PAD + I_FOLD ? 3 : q < I_WINA + I_WINB + I_PAD + I_FOLD + I_UQ + I_UKV + I_OUT ? 4 : q < PER_LAYER - I_DOWN ? 5 : 6; }
          if (!((sub >> cat) & 1)) continue;
          const int dcls = (r < 2 * PER_LAYER && cat >= 4) ? (r < PER_LAYER ? 1 : 2) : 0; if (dcls != defer) continue; }
        if (r < 2 * PER_LAYER) {
            const int l = r / PER_LAYER; r -= l * PER_LAYER;
            bf16* WinT = (bf16*)(ws + WS_WIN + l * WIN_STRIDE);
            const float* win = inptr(F, I_WIN) + (size_t)l * 1024 * 1728;
            if (r < I_WINA) { const int kb = r / 22, nb = r % 22; tr_item(win, 1728, 64 * kb, 32 * nb, WinT, 1024, 32 * nb, nullptr, scr, F.lane); continue; } r -= I_WINA;
            if (r < I_WINB) { const int kb = r / 24, nb = r % 24; tr_item(win, 1728, 64 * kb, 960 + 32 * nb, WinT, 1024, 1280 + 32 * nb, nullptr, scr, F.lane); continue; } r -= I_WINB;
            if (r < I_PAD) { const v4u z = {0u, 0u, 0u, 0u};
#pragma unroll
                for (int j = 0; j < 16; ++j) { const int q = j * 64 + F.lane; *(GAS v4u*)(WinT + (size_t)(704 + 8 * r + (q >> 7)) * 1024 + (q & 127) * 8) = z; } continue; } r -= I_PAD;
            if (r < I_FOLD) { bf16* WF = (bf16*)(ws + WS_WF) + (size_t)l * 1024 * 256;
#pragma unroll 4
                for (int i = 0; i < 16; ++i) { const int k = 16 * r + i; const f32x4 v = *(const GAS f32x4*)(win + (size_t)k * 1728 + 704 + 4 * F.lane);
                    v2u o; o.x = pk2(v[0], v[1]); o.y = pk2(v[2], v[3]); *(GAS v2u*)(WF + (size_t)k * 256 + 4 * F.lane) = o; } continue; } r -= I_FOLD;
            if (r < I_UQ) { const int kb = r / 24, nb = r % 24; tr_item(inptr(F, I_WUQ) + (size_t)l * 384 * 768, 768, 64 * kb, 32 * nb, (bf16*)(ws + WS_WQKV + l * WQKV_STRIDE), 384, 32 * nb, inptr(F, I_QNG) + l * 384, scr, F.lane, (nb % 6) >= 4); continue; } r -= I_UQ;
            if (r < I_UKV) { const int kb = r / 32, nb = r % 32; tr_item(inptr(F, I_WUKV) + (size_t)l * 256 * 1024, 1024, 64 * kb, 32 * nb, (bf16*)(ws + WS_WQKV + l * WQKV_STRIDE) + (size_t)768 * 384, 384, 32 * nb, inptr(F, I_KVNG) + l * 256, scr, F.lane); continue; } r -= I_UKV;
            if (r < I_OUT) { const int kb = r / 32, nb = r % 32; tr_item(inptr(F, I_WOUT) + (size_t)l * 1024 * 1024, 1024, 64 * kb, 32 * nb, (bf16*)(ws + WS_WOUT + l * WOUT_STRIDE), 1024, 32 * nb, inptr(F, I_ONG) + l * 1024, scr, F.lane); continue; } r -= I_OUT;
            if (r < I_UP) { const int kb = r / 176, nb = r % 176;
                const int j = nb >> 3, h = (nb >> 2) & 1, q = nb & 3;
                tr_item(inptr(F, I_WUP) + (size_t)l * 1024 * NUP, NUP, 64 * kb, h * FF + 128 * j + 32 * q, (bf16*)(ws + WS_WUP + l * WUP_STRIDE), 1024, 32 * nb, nullptr, scr, F.lane); continue; } r -= I_UP;
            { const int kb = r / 32, nb = r % 32; tr_item(inptr(F, I_WDOWN) + (size_t)l * FF * 1024, 1024, 64 * kb, 32 * nb, (bf16*)(ws + WS_WDOWN + l * WDOWN_STRIDE), FF, 32 * nb, nullptr, scr, F.lane); continue; }
        }
        r -= 2 * PER_LAYER;
        if (r < I_DFT) { const int k1 = r; bf16* D = (bf16*)(ws + WS_DFT) + (size_t)k1 * 4096;
#pragma unroll
            for (int j = 0; j < 8; ++j) { const int n0 = 512 * j + 8 * F.lane; float v[8];
#pragma unroll
                for (int e = 0; e < 8; ++e) { const int n = n0 + e, n1 = n & 2047; const float x = (float)((k1 * n1) & 2047) * (1.0f / 1024.0f); v[e] = (n < 2048) ? cospif(x) : -sinpif(x); }
                v4u o; o.x = pk2(v[0], v[1]); o.y = pk2(v[2], v[3]); o.z = pk2(v[4], v[5]); o.w = pk2(v[6], v[7]); *(GAS v4u*)(D + n0) = o; }
            continue; }
        r -= I_DFT;
        if (r >= I_DFTC) { r -= I_DFTC;
            const int sn = r >> 8, g = (r >> 6) & 3, k2 = r & 63; float v[4];
#pragma unroll
            for (int e = 0; e < 4; ++e) { const int j = 4 * F.lane + e; const float x = (float)((k2 * (j & 63)) & 63) * (1.0f / 32.0f); v[e] = ((j >> 6) == g) ? (sn ? sinpif(x) : cospif(x)) : 0.0f; }
            v2u o; o.x = pk2(v[0], v[1]); o.y = pk2(v[2], v[3]); *(GAS v2u*)((bf16*)(ws + WS_CST) + (size_t)r * 256 + 4 * F.lane) = o; continue; }
        { const int k1 = r; bf16* D = (bf16*)(ws + WS_DFTC) + (size_t)k1 * 512; const int n0 = 8 * F.lane; float v[8];
#pragma unroll
            for (int e = 0; e < 8; ++e) { const int n = n0 + e, n1 = n & 255; const float x = (float)((k1 * n1) & 255) * (1.0f / 128.0f); v[e] = (n < 256) ? cospif(x) : -sinpif(x); }
            v4u o; o.x = pk2(v[0], v[1]); o.y = pk2(v[2], v[3]); o.z = pk2(v[4], v[5]); o.w = pk2(v[6], v[7]); *(GAS v4u*)(D + n0) = o; }
    }
}

__device__ __forceinline__ void bias_item(const bf16* WT, int n, const float* mod  , int shofs, float* out, int N, int lane) {
    const v4u w0 = *(const GAS v4u*)(WT + (size_t)n * 1024 + 16 * lane), w1 = *(const GAS v4u*)(WT + (size_t)n * 1024 + 16 * lane + 8);
    float wv[16];
    wv[0] = bf2f(w0.x & 0xffffu); wv[1] = bf2f(w0.x >> 16); wv[2] = bf2f(w0.y & 0xffffu); wv[3] = bf2f(w0.y >> 16); wv[4] = bf2f(w0.z & 0xffffu); wv[5] = bf2f(w0.z >> 16); wv[6] = bf2f(w0.w & 0xffffu); wv[7] = bf2f(w0.w >> 16);
    wv[8] = bf2f(w1.x & 0xffffu); wv[9] = bf2f(w1.x >> 16); wv[10] = bf2f(w1.y & 0xffffu); wv[11] = bf2f(w1.y >> 16); wv[12] = bf2f(w1.z & 0xffffu); wv[13] = bf2f(w1.z >> 16); wv[14] = bf2f(w1.w & 0xffffu); wv[15] = bf2f(w1.w >> 16);
    for (int b = 0; b < 9; ++b) { const float* sh = mod + b * 6144 + shofs + 16 * lane; float a = 0.f;
#pragma unroll
        for (int q = 0; q < 4; ++q) { const f32x4 s = *(const f32x4*)(sh + 4 * q); a += (s[0] * wv[4 * q] + s[1] * wv[4 * q + 1]) + (s[2] * wv[4 * q + 2] + s[3] * wv[4 * q + 3]); }
        a = wave_sum(a); if (lane == 0) out[(size_t)b * N + n] = a; }
}
__device__ __forceinline__ void bias_phase(Frame& F, int which, int gw, int NGW) {
    const float* MODp = (const float*)(F.ws + WS_MOD);
    for (int it = gw; it < 2048 + 2 * 5632; it += NGW) {
        if (!((which >> (it < 2048 ? 0 : it < 2048 + 5632 ? 1 : 2)) & 1)) continue;
        if (it < 2048) bias_item((const bf16*)(F.ws + WS_WIN + WIN_STRIDE), it, MODp + 9 * 6144, 0, (float*)(F.ws + WS_PB) + 9 * 2048, 2048, F.lane);
        else { const int q = it - 2048, l = q / 5632, n = q % 5632; bias_item((const bf16*)(F.ws + WS_WUP + l * WUP_STRIDE), n, MODp + l * 9 * 6144, 3072, (float*)(F.ws + WS_UB) + (size_t)l * 9 * 5632, 5632, F.lane); }
    }
}

__device__ __forceinline__ void norm_mod_phase(Frame& F, const float* src_lat, const float* src_ctx, int nrows, const float* g, const float* mod  , int shofs, int scofs, int skip) {
    bf16* XN = (bf16*)(F.ws + WS_XN);
    if (F.bx < skip) return;
    const int gw = (F.bx - skip) * NWAVES + F.wave, NGW = (F.G - skip) * NWAVES;
    constexpr int R = 2;
    f32x4 v[R][4], w[R][4];
#define NM_LOAD(dst, r0_) do { _Pragma("unroll") for (int q = 0; q < R; ++q) { const int row = (r0_) + q * NGW; if (row < nrows) { const float* xr = row < MLAT ? src_lat + (size_t)row * DM : src_ctx + (size_t)(row - MLAT) * DM; \
        _Pragma("unroll") for (int j = 0; j < 4; ++j) dst[q][j] = *(const f32x4*)(xr + 256 * j + 4 * F.lane); } } } while (0)
    NM_LOAD(v, gw);
    for (int row0 = gw; row0 < nrows; row0 += R * NGW) {
        NM_LOAD(w, row0 + R * NGW);
#pragma unroll
        for (int q = 0; q < R; ++q) { const int row = row0 + q * NGW; if (row < nrows) {
            const int r = row < MLAT ? (row >> 11) : 8;
            const float* sh = mod + r * 6144 + shofs; const float* sc = mod + r * 6144 + scofs; float ss = 0.f;
#pragma unroll
            for (int j = 0; j < 4; ++j) ss += (v[q][j][0] * v[q][j][0] + v[q][j][1] * v[q][j][1]) + (v[q][j][2] * v[q][j][2] + v[q][j][3] * v[q][j][3]);
            const float rstd = 1.0f / sqrtf(wave_sum(ss) * (1.0f / DM) + EPS);
#pragma unroll
            for (int j = 0; j < 4; ++j) { const int c = 256 * j + 4 * F.lane; const f32x4 gg = *(const f32x4*)(g + c), s1 = *(const f32x4*)(sc + c), s0 = *(const f32x4*)(sh + c);
                const f32x4 h = (v[q][j] * rstd) * gg * (s1 + 1.0f) + s0;
                v2u o; o.x = pk2(h[0], h[1]); o.y = pk2(h[2], h[3]); *(GAS v2u*)(XN + (size_t)row * DM + c) = o; } } }
#pragma unroll
        for (int q = 0; q < R; ++q)
#pragma unroll
            for (int j = 0; j < 4; ++j) v[q][j] = w[q][j];
    }
#undef NM_LOAD
}
__device__ __forceinline__ void qkv_rows_phase(Frame& F, int l) {
    const bf16* P = (const bf16*)(F.ws + WS_P); bf16* Kb = (bf16*)(F.ws + WS_K); bf16* YC = (bf16*)F.out + (size_t)MT * 768;
    const float* RC = (const float*)(F.ws + WS_ROPE); const float* RS = RC + 1024;
    const float* scw = inptr(F, I_SCW) + l * 3 * 256; const float* scb = inptr(F, I_SCB) + l * 256;
    const int gw = F.vcu * NWAVES + F.wave, NGW = F.G * NWAVES;
    const int nrows_conv = (l == 0) ? MT : MLAT;
    for (int row = gw; row < MT; row += NGW) {
        const bool lat = row < MLAT; const int t = lat ? (row & 2047) : ((row - MLAT) & 255); const int L = lat ? SL : CL;
        const bf16* pr = P + (size_t)row * NIN;
        { const float v = bf2f(pr[640 + F.lane]); const float pv = __shfl_xor(v, 16); float o = v;
          if (lat) { const int j = F.lane, ax = j >> 5, i = j & 15, x2 = (j >> 4) & 1; const int pos = ax ? (t & 63) : (t >> 6); const float c = RC[pos * 16 + i], s = RS[pos * 16 + i];
              o = x2 ? (pv * s + v * c) : (v * c - pv * s); }
          const bf16 ob = (bf16)f2bf(o);
          const int slot = (F.lane & 32) + rope_slot(F.lane & 31);
#pragma unroll
          for (int h = 0; h < 4; ++h) Kb[(size_t)row * 768 + 192 * h + 128 + slot] = ob; }
        if (row < nrows_conv) { const int c = 4 * F.lane;
            const v2u bgv = *(const GAS v2u*)(pr + 1280 + c);
            const v2u cg1 = *(const GAS v2u*)(pr + 1536 + c), xv1 = *(const GAS v2u*)(pr + 1792 + c);
            v2u cg0 = {0u, 0u}, xv0 = {0u, 0u}, cg2 = {0u, 0u}, xv2 = {0u, 0u};
            if (t > 0) { cg0 = *(const GAS v2u*)(pr - NIN + 1536 + c); xv0 = *(const GAS v2u*)(pr - NIN + 1792 + c); }
            if (t < L - 1) { cg2 = *(const GAS v2u*)(pr + NIN + 1536 + c); xv2 = *(const GAS v2u*)(pr + NIN + 1792 + c); }
            const f32x4 w0 = *(const f32x4*)(scw + c), w1 = *(const f32x4*)(scw + 256 + c), w2 = *(const f32x4*)(scw + 512 + c), bb = *(const f32x4*)(scb + c);
            float y[4];
#pragma unroll
            for (int e = 0; e < 4; ++e) { const unsigned sh = (e & 1) * 16; const unsigned m = 0xffffu;
                const unsigned b_ = ((e < 2 ? bgv.x : bgv.y) >> sh) & m;
                const unsigned c0_ = ((e < 2 ? cg0.x : cg0.y) >> sh) & m, x0_ = ((e < 2 ? xv0.x : xv0.y) >> sh) & m;
                const unsigned c1_ = ((e < 2 ? cg1.x : cg1.y) >> sh) & m, x1_ = ((e < 2 ? xv1.x : xv1.y) >> sh) & m;
                const unsigned c2_ = ((e < 2 ? cg2.x : cg2.y) >> sh) & m, x2_ = ((e < 2 ? xv2.x : xv2.y) >> sh) & m;
                const float u0 = bf2f(c0_) * bf2f(x0_), u1 = bf2f(c1_) * bf2f(x1_), u2 = bf2f(c2_) * bf2f(x2_);
                y[e] = bf2f(b_) * (w0[e] * u0 + w1[e] * u1 + w2[e] * u2 + bb[e]); }
            v2u o; o.x = pk2(y[0], y[1]); o.y = pk2(y[2], y[3]); *(GAS v2u*)(YC + (size_t)row * 256 + c) = o; }
    }
}
__device__ __forceinline__ void zt_phase(Frame& F, int l) {
    const bf16* P = (const bf16*)(F.ws + WS_P);
    LAS bf16* T = (LAS bf16*)(F.lds + F.wave * 16384);
    const int gw = F.vcu * NWAVES + F.wave, NGW = F.G * NWAVES;
    const int nitems = 2048 + (l == 0 ? 256 : 0);
    for (int it = gw; it < nitems; it += NGW) {
        const bool lat = it < 2048; const int r = lat ? it : it - 2048;
        const int pb = r >> 3, cb = r & 7;
        const int row0 = (lat ? 0 : MLAT) + 64 * pb; const int L = lat ? SL : CL;
        const int b = lat ? (pb >> 5) : (pb >> 2); const int n0 = (64 * pb) & (L - 1);
        bf16* ZT = lat ? (bf16*)(F.ws + WS_ZT) : (bf16*)(F.ws + WS_ZTC);
#pragma unroll
        for (int i = 0; i < 8; ++i) { const int pos = 8 * i + (F.lane >> 3), ch = F.lane & 7;
            const v4u v = *(const GAS v4u*)(P + (size_t)(row0 + pos) * NIN + 768 + 64 * cb + 8 * ch);
            LAS unsigned* d = (LAS unsigned*)(T + pos * 66 + 8 * ch); d[0] = v.x; d[1] = v.y; d[2] = v.z; d[3] = v.w; }
        LDS_WAIT(); asm volatile("" ::: "memory");
        const int sn = cb >> 2;
#pragma unroll
        for (int j = 0; j < 8; ++j) { const int chl = 8 * j + (F.lane >> 3), pc = F.lane & 7;
            unsigned e[8];
#pragma unroll
            for (int q = 0; q < 8; ++q) e[q] = T[(8 * pc + q) * 66 + chl];
            v4u o; o.x = e[0] | (e[1] << 16); o.y = e[2] | (e[3] << 16); o.z = e[4] | (e[5] << 16); o.w = e[6] | (e[7] << 16);
            const int chg = 64 * (cb & 3) + chl;
            *(GAS v4u*)(ZT + ((size_t)(b * 256 + chg) * 2 + sn) * L + n0 + 8 * pc) = o; }
        LDS_WAIT(); asm volatile("" ::: "memory");
    }
}
__device__ __forceinline__ void ycat_norm_phase(Frame& F, int nrows) {
    bf16* Y = (bf16*)(F.ws + WS_YCAT); const bf16* YC = (const bf16*)F.out + (size_t)MT * 768; const bf16* YFP = (const bf16*)(F.ws + WS_YFP);
    const int gw = F.vcu * NWAVES + F.wave, NGW = F.G * NWAVES;
    constexpr int R = 2;
    for (int row0 = gw; row0 < nrows; row0 += R * NGW) {
        v4u a[R]; v2u c[R]; v2u f[R][4];
#pragma unroll
        for (int q = 0; q < R; ++q) { const int row = row0 + q * NGW; if (row < nrows) { a[q] = *(const GAS v4u*)(Y + (size_t)row * 1024 + 8 * F.lane); c[q] = *(const GAS v2u*)(YC + (size_t)row * 256 + 4 * F.lane);
            const bool lat = row < MLAT;
#pragma unroll
            for (int s = 0; s < 4; ++s) f[q][s] = (s == 0 || lat) ? *(const GAS v2u*)(YFP + ((size_t)s * MT + row) * 256 + 4 * F.lane) : (v2u){0u, 0u}; } }
#pragma unroll
        for (int q = 0; q < R; ++q) { const int row = row0 + q * NGW; if (row < nrows) { bf16* yr = Y + (size_t)row * 1024;
            float av[8], fv[4] = {0.f, 0.f, 0.f, 0.f}, cv[4];
#pragma unroll
            for (int s = 0; s < 4; ++s) { fv[0] += bf2f(f[q][s].x & 0xffffu); fv[1] += bf2f(f[q][s].x >> 16); fv[2] += bf2f(f[q][s].y & 0xffffu); fv[3] += bf2f(f[q][s].y >> 16); }
            av[0] = bf2f(a[q].x & 0xffffu); av[1] = bf2f(a[q].x >> 16); av[2] = bf2f(a[q].y & 0xffffu); av[3] = bf2f(a[q].y >> 16); av[4] = bf2f(a[q].z & 0xffffu); av[5] = bf2f(a[q].z >> 16); av[6] = bf2f(a[q].w & 0xffffu); av[7] = bf2f(a[q].w >> 16);
            cv[0] = bf2f(c[q].x & 0xffffu); cv[1] = bf2f(c[q].x >> 16); cv[2] = bf2f(c[q].y & 0xffffu); cv[3] = bf2f(c[q].y >> 16);
            float sa = 0.f, sf = 0.f, sc = 0.f;
#pragma unroll
            for (int e = 0; e < 8; ++e) sa += av[e] * av[e];
#pragma unroll
            for (int e = 0; e < 4; ++e) { sf += fv[e] * fv[e]; sc += cv[e] * cv[e]; }
            const float ra = 1.0f / sqrtf(wave_sum(sa) * (1.0f / 512.0f) + EPS), rf = 1.0f / sqrtf(wave_sum(sf) * (1.0f / 256.0f) + EPS), rc = 1.0f / sqrtf(wave_sum(sc) * (1.0f / 256.0f) + EPS);
            v4u oa; oa.x = pk2(av[0] * ra, av[1] * ra); oa.y = pk2(av[2] * ra, av[3] * ra); oa.z = pk2(av[4] * ra, av[5] * ra); oa.w = pk2(av[6] * ra, av[7] * ra);
            v2u of; of.x = pk2(fv[0] * rf, fv[1] * rf); of.y = pk2(fv[2] * rf, fv[3] * rf);
            v2u oc; oc.x = pk2(cv[0] * rc, cv[1] * rc); oc.y = pk2(cv[2] * rc, cv[3] * rc);
            *(GAS v4u*)(yr + 8 * F.lane) = oa; *(GAS v2u*)(yr + 512 + 4 * F.lane) = of; *(GAS v2u*)(yr + 768 + 4 * F.lane) = oc; } }
    }
}
__device__ __forceinline__ void ctx_combine_phase(Frame& F, const float* base, const float* gp_g, int gp_ofs, int gate_ofs, const float* gn_g, const float* gn_mod, int gn_ofs, int nsl) {
    const bf16* PART = (const bf16*)(F.ws + WS_CPART); bf16* XNp = (bf16*)(F.ws + WS_XN); float* SSXp = (float*)(F.ws + WS_SSX);
    const float* mod0 = (const float*)(F.ws + WS_MOD) + 8 * 6144;
    const int gw = F.vcu * NWAVES + F.wave, NGW = F.G * NWAVES;
    for (int row = gw; row < MCTX; row += NGW) {
        float ss = 0.f; bf16* xr = XNp + (size_t)(MLAT + row) * DM;
#pragma unroll
        for (int j = 0; j < 4; ++j) { const int c = 256 * j + 4 * F.lane; f32x4 x;
            if (base != nullptr) x = *(const f32x4*)(base + (size_t)row * DM + c);
            else { const v2u xw = *(const GAS v2u*)(xr + c); x[0] = bf2f(xw.x & 0xffffu); x[1] = bf2f(xw.x >> 16); x[2] = bf2f(xw.y & 0xffffu); x[3] = bf2f(xw.y >> 16);
                const f32x4 gp = *(const f32x4*)(gp_g + c) * (*(const f32x4*)(mod0 + gp_ofs + c) + 1.0f);
                x[0] = x[0] / gp[0]; x[1] = x[1] / gp[1]; x[2] = x[2] / gp[2]; x[3] = x[3] / gp[3]; }
            f32x4 s = {0.f, 0.f, 0.f, 0.f};
            for (int k = 0; k < nsl; ++k) { const v2u pw = *(const GAS v2u*)(PART + ((size_t)k * MCTX + row) * DM + c); s[0] += bf2f(pw.x & 0xffffu); s[1] += bf2f(pw.x >> 16); s[2] += bf2f(pw.y & 0xffffu); s[3] += bf2f(pw.y >> 16); }
            x = x + *(const f32x4*)(mod0 + gate_ofs + c) * s;
            ss += (x[0] * x[0] + x[1] * x[1]) + (x[2] * x[2] + x[3] * x[3]);
            const f32x4 h = x * (*(const f32x4*)(gn_g + c)) * (*(const f32x4*)(gn_mod + gn_ofs + c) + 1.0f);
            v2u ho; ho.x = pk2(h[0], h[1]); ho.y = pk2(h[2], h[3]); *(GAS v2u*)(xr + c) = ho; }
        ss = wave_sum(ss);
        if (F.lane < 16) SSXp[(size_t)(MLAT + row) * 16 + F.lane] = F.lane == 0 ? ss : 0.f;
    }
}
__device__ __forceinline__ void final_norm_phase(Frame& F, const bf16* xf, const float* g) {
    const int gw = F.vcu * NWAVES + F.wave, NGW = F.G * NWAVES;
    constexpr int R = 2;
    v2u w[R][4], wn[R][4];
#define FN_LOAD(W_, r0_) do { _Pragma("unroll") for (int q = 0; q < R; ++q) { const int row = (r0_) + q * NGW; if (row < MLAT) { \
        _Pragma("unroll") for (int j = 0; j < 4; ++j) W_[q][j] = *(const GAS v2u*)(xf + (size_t)row * DM + 256 * j + 4 * F.lane); } } } while (0)
    FN_LOAD(w, gw);
    for (int row0 = gw; row0 < MLAT; row0 += R * NGW) {
        FN_LOAD(wn, row0 + R * NGW);
#pragma unroll
        for (int q = 0; q < R; ++q) { const int row = row0 + q * NGW; if (row < MLAT) { float* orow = F.out + (size_t)row * DM;
            f32x4 v[4]; float ss = 0.f;
#pragma unroll
            for (int j = 0; j < 4; ++j) { v[j][0] = bf2f(w[q][j].x & 0xffffu); v[j][1] = bf2f(w[q][j].x >> 16); v[j][2] = bf2f(w[q][j].y & 0xffffu); v[j][3] = bf2f(w[q][j].y >> 16);
                ss += (v[j][0] * v[j][0] + v[j][1] * v[j][1]) + (v[j][2] * v[j][2] + v[j][3] * v[j][3]); }
            const float rstd = 1.0f / sqrtf(wave_sum(ss) * (1.0f / DM) + EPS);
#pragma unroll
            for (int j = 0; j < 4; ++j) { const int c = 256 * j + 4 * F.lane; const f32x4 gg = *(const f32x4*)(g + c); *(f32x4*)(orow + c) = (v[j] * rstd) * gg; } } }
#pragma unroll
        for (int q = 0; q < R; ++q)
#pragma unroll
            for (int j = 0; j < 4; ++j) w[q][j] = wn[q][j];
    }
#undef FN_LOAD
}
#ifndef PHMASK
#define PHMASK 0xFFFF
#endif
#define PHON(x) (((PHMASK) >> (x)) & 1)
#ifndef SUBMASK
#define SUBMASK 0xFF
#endif
#define SUBON(x) (rep_ == 0 || (((SUBMASK) >> (x)) & 1))
struct UpOrder : pg8::StaticOrder {
    typedef pg8::UnitUp UnitT; int nrows;
    __device__ __forceinline__ bool next(int i, pg8::UnitUp& u) const {
        if (!next_mn(i, u.pm, u.pn)) return false;
        u.kofs = 0; u.kofb = 0; u.nt = ntk; u.arow = 254 * u.pm - 1; u.nrows = nrows;
        return true;
    }
};

struct SliceOrder0 : pg8::StaticOrder {
    typedef pg8::Unit UnitT; int nsl;
    __device__ __forceinline__ bool next(int i, pg8::Unit& u) const {
        if (i == 0) { if (!next_mn(0, u.pm, u.pn)) return false; u.arow = u.pm * 256; u.kofs = 0; u.kofb = 0; u.nt = ntk; u.aux = 0; return true; }
        const int L = (i - 1) * G + c; if (L >= 32 * nsl) return false;
        const int t = L / nsl, s = L % nsl; u.pm = 64 + (t >> 2); u.pn = t & 3; u.arow = u.pm * 256; u.aux = s;
        if (nsl == 8) { u.kofs = (s < 6 ? 6 * s : 36 + 4 * (s - 6)) * 64; u.nt = s < 6 ? 6 : 4; } else { u.kofs = s * 256; u.nt = 4; }
        u.kofb = u.kofs; return true;
    }
};

struct QkvOrder {
    typedef pg8::Unit UnitT; int G, c, nq;
    __device__ __forceinline__ bool next(int i, pg8::Unit& u) const { const int L = i * G + c; if (L >= 288 + nq) return false;
        if (L < 288) { u.pm = L >> 2; u.pn = 3 + (L & 3); u.kofs = 384; u.nt = 4; } else { const int j = L - 288; u.pm = j / 3; u.pn = j % 3; u.kofs = 0; u.nt = 6; }
        u.kofb = 0; u.arow = u.pm * 256; return true; }
};

struct FnetOrder {
    typedef pg8::Unit UnitT; int G, c;
    __device__ __forceinline__ bool next(int i, pg8::Unit& u) const { const int L = i * G + c; if (L >= 256) return false;
        u.pm = (L >> 3) & 7; u.pn = L & 7; u.arow = u.pm * 256; u.kofs = (L >> 6) * 1024; u.kofb = u.kofs; u.nt = 16; return true; }
};

__global__ void __launch_bounds__(NWAVES * 64, 2) mk_fwd(Args args) {
    extern __shared__ __attribute__((aligned(16))) unsigned char lds[];
    Frame F;
    F.lds = (LAS unsigned char*)lds; F.ldsg = (char*)lds;
    F.MISC = (volatile LAS unsigned*)(F.lds + MISC_OFF);
    F.tid = threadIdx.x; F.lane = F.tid & 63; F.wave = __builtin_amdgcn_readfirstlane(F.tid >> 6);
    F.G = gridDim.x; F.bx = blockIdx.x; F.vcu = (F.G % 8 == 0) ? (F.bx % 8) * (F.G / 8) + F.bx / 8 : F.bx;
    F.ws = args.ws; F.out = args.out;
    for (int u = F.tid; u < (LDS_BYTES - LDSCTL_OFF) / 4; u += NWAVES * 64) ((LAS unsigned*)(F.lds + LDSCTL_OFF))[u] = 0u;
    __syncthreads();
    if (F.tid == 0) { LAS unsigned long long* T = (LAS unsigned long long*)(F.lds + PTR_OFF);
#pragma unroll
        for (int i = 0; i < 22; ++i) T[i] = (unsigned long long)args.in[i]; }
    __syncthreads();
    XcdBarrier bar; bar.bar = (unsigned*)(F.ws + WS_CTL) + CW_BAR; bar.x = 0; bar.st = nullptr;
    if (!MK_SPLIT) bar = xcd_barrier_post((unsigned*)(F.ws + WS_CTL) + CW_BAR, F.MISC + 8);

#define MOD ((float*)(ws + WS_MOD))
#define SSQ ((float*)(ws + WS_SSQ))
#define XN ((bf16*)(ws + WS_XN))
#define P ((bf16*)(ws + WS_P))
#define Qb ((bf16*)F.out)
#define Kb ((bf16*)(ws + WS_K))
#define Vb ((bf16*)(ws + WS_V))
#define YCAT ((bf16*)(ws + WS_YCAT))
#define ACT ((bf16*)(ws + WS_ACT))
#define XCTX ((bf16*)(ws + WS_XCTX))
#define XBL ((bf16*)F.out + (size_t)MLAT * DM)
#define XFIN ((bf16*)(ws + WS_XN))
    LAS unsigned char* ring = F.lds + RING_OFF;

    const int ph_lo = args.ph_lo, ph_hi = args.ph_hi;
#define PHASE(k) (ph_lo <= (k) && (k) < ph_hi)
#define SEAM(k) do { if (PHASE(k) && PHASE((k) + 1)) xcd_barrier(bar); } while (0)
#ifndef P0SUB
#define P0SUB 0xFF
#endif
#ifndef UPPROBE
#define UPPROBE 0
#endif
#ifndef RPT_PH
#define RPT_PH -1
#endif
#define RELANE() do { int t_ = threadIdx.x; asm volatile("" : "+v"(t_)); F.tid = t_; F.lane = t_ & 63; F.wave = __builtin_amdgcn_readfirstlane(t_ >> 6); } while (0)
    unsigned char* ws = F.ws;
    if (PHASE(0)) for (int rep_ = 0; rep_ < (((0) == RPT_PH) ? 2 : 1); ++rep_) { if (rep_) xcd_barrier(bar); RELANE(); if (PHON(0)) p0_prologue(F, rep_ ? P0SUB : 0xFF, 0, F.vcu * NWAVES + F.wave, F.G * NWAVES); }
    SEAM(0);
    for (int l = 0; l < 2; ++l) {
        const int pb = 1 + 9 * l;
        const int nMall = (l == 0) ? 72 : 64;
        if (PHASE(pb + 0)) for (int rep_ = 0; rep_ < (((pb + 0) == RPT_PH) ? 2 : 1); ++rep_) { if (rep_) xcd_barrier(bar); RELANE();
            if (l == 0 && (rep_ == 0 || (SUBMASK & 1))) { pg8::Gemm g{(const bf16*)(ws + WS_CST), (const bf16*)(ws + WS_WF), 2, 8, 256, 256}; pg8::StaticOrder S; S.init(2, 8, F.G, F.bx, 256);
                pg8::EpiFold E{(bf16*)(ws + WS_WIN), (unsigned)(WIN_STRIDE / 2)};
                pg8::gemm_phase(ring, g, S, E); RELANE(); }
            if (PHON(1) && l == 0 && (rep_ == 0 || (SUBMASK & 2))) norm_mod_phase(F, inptr(F, I_X), inptr(F, I_CTX), MT, inptr(F, I_N1G), MOD, 0, 1024, 16); }
        if (l == 0) SEAM(pb + 0);
        if (PHASE(pb + 1)) for (int rep_ = 0; rep_ < (((pb + 1) == RPT_PH) ? 2 : 1); ++rep_) { if (rep_) xcd_barrier(bar); RELANE();
            if (PHON(2)) { pg8::Gemm g{XN, (const bf16*)(ws + WS_WIN + l * WIN_STRIDE), 72, 8, 1024, 1024}; pg8::StaticOrder S; S.init(72, 8, F.G, F.bx, 1024);
                pg8::EpiWin E{P, NIN, SSQ, l == 1 ? (const float*)(ws + WS_SSX) : nullptr, (const float*)(ws + WS_PB) + 9 * 2048, (LAS float*)(F.lds + EPIX_OFF)};
                pg8::gemm_phase(ring, g, S, E);
                if (rep_ == 0) {
                    RELANE(); int nb = 576 - 2 * F.G; nb = nb < 0 ? 0 : (nb > F.G ? F.G : nb);
                    const bool all = (nb == F.G); if (all || F.bx >= nb) { const int rk = all ? F.bx : F.bx - nb, n = all ? F.G : F.G - nb;
                        if (l == 0) { p0_prologue(F, 0xFF, 1, rk * NWAVES + F.wave, n * NWAVES); bias_phase(F, 1, rk * NWAVES + F.wave, n * NWAVES); }
                        else bias_phase(F, 4, rk * NWAVES + F.wave, n * NWAVES); } } } }
        SEAM(pb + 1);
        if (PHASE(pb + 2)) for (int rep_ = 0; rep_ < (((pb + 2) == RPT_PH) ? 2 : 1); ++rep_) { if (rep_) xcd_barrier(bar); RELANE();
            if (PHON(3)) {
                if (SUBON(0)) { pg8::Gemm g{P, (const bf16*)(ws + WS_WQKV + l * WQKV_STRIDE), 72, 7, 384, NIN}; QkvOrder S; S.G = F.G; S.c = F.vcu; S.nq = 3 * nMall;
                  pg8::EpiQKV E{Qb, Kb, Vb, SSQ, (const float*)(ws + WS_ROPE), (const float*)(ws + WS_ROPE) + 1024, (LAS float*)(F.lds + EPIX_OFF)};
                  pg8::gemm_phase(ring, g, S, E); }
                if (SUBON(2)) qkv_rows_phase(F, l);
                if (SUBON(3)) zt_phase(F, l);
                } }
        SEAM(pb + 2);
        if (PHASE(pb + 3)) for (int rep_ = 0; rep_ < (((pb + 3) == RPT_PH) ? 2 : 1); ++rep_) { if (rep_) xcd_barrier(bar); RELANE();
            if (PHON(4)) {
                const int NU = 256 + (l == 0 ? 32 : 0);
                for (int u = F.vcu; u < NU; u += F.G) {
                    if (u < 256) { const int bh = u >> 3, qb = u & 7, b = bh >> 2, h = bh & 3; const long q0 = (long)b * SL + qb * 256;
                        att::attn_unit(Qb + q0 * 768 + 192 * h, Kb + 192 * h, Vb + 128 * h, YCAT + q0 * 1024 + 128 * h, MLAT + CL * b, 4, SL * b, 36, F.ldsg);
                    } else { const int cu = u - 256, b = cu >> 2, h = cu & 3; const long q0 = MLAT + (long)CL * b;
                        att::attn_unit(Qb + q0 * 768 + 192 * h, Kb + 192 * h, Vb + 128 * h, YCAT + q0 * 1024 + 128 * h, (int)q0, 4, 0, 4, F.ldsg); }
                }
                { pg8::Gemm g{(const bf16*)(ws + WS_DFT), (const bf16*)(ws + WS_ZT), 8, 8, 4096, 4096}; FnetOrder S; S.G = F.G; S.c = F.vcu;
                  pg8::EpiFnet E{(bf16*)(ws + WS_YFP), 0, SL, 0.0027621358640099515f, (unsigned)(MT * 256)};
                  pg8::gemm_phase(ring, g, S, E); }
                if (l == 0) { pg8::Gemm g{(const bf16*)(ws + WS_DFTC), (const bf16*)(ws + WS_ZTC), 1, 8, 512, 512}; pg8::StaticOrder S; S.init(1, 8, F.G, (F.bx + 128) % F.G, 512);
                  pg8::EpiFnet E{(bf16*)(ws + WS_YFP), MLAT, CL, 0.0078125f, (unsigned)(MT * 256)};
                  pg8::gemm_phase(ring, g, S, E); } } }
        SEAM(pb + 3);
        if (PHASE(pb + 4)) for (int rep_ = 0; rep_ < (((pb + 4) == RPT_PH) ? 2 : 1); ++rep_) { if (rep_) xcd_barrier(bar); RELANE();
            if (PHON(5)) ycat_norm_phase(F, nMall * 256); }
        SEAM(pb + 4);
        if (PHASE(pb + 5)) for (int rep_ = 0; rep_ < (((pb + 5) == RPT_PH) ? 2 : 1); ++rep_) { if (rep_) xcd_barrier(bar); RELANE();
            if (PHON(6)) { pg8::Gemm g{YCAT, (const bf16*)(ws + WS_WOUT + l * WOUT_STRIDE), nMall, 4, 1024, 1024}; pg8::StaticOrder S; S.init(nMall, 4, F.G, F.bx, 1024);
                if (l == 0) { SliceOrder0 S0; S0.init(64, 4, F.G, F.bx, 1024); S0.nsl = 4; pg8::Gemm g0{YCAT, (const bf16*)(ws + WS_WOUT), 64, 4, 1024, 1024};
                    pg8::EpiRes<true> E{inptr(F, I_X), inptr(F, I_CTX), XN, MOD, 2048, nullptr, nullptr, 0, inptr(F, I_N2G), MOD, 4096, (float*)(ws + WS_SSX), rep_ ? 0.f : 1.f, (bf16*)(ws + WS_CPART)};
                    pg8::gemm_phase(ring, g0, S0, E);
                    RELANE(); { int nb = 128; nb = nb > F.G ? F.G : nb; const bool all = (nb == F.G); if (rep_ == 0 && (all || F.bx >= nb)) { const int rk = all ? F.bx : F.bx - nb, n = all ? F.G : F.G - nb; bias_phase(F, 2, rk * NWAVES + F.wave, n * NWAVES); } }
                    xcd_barrier(bar); RELANE();
                    ctx_combine_phase(F, inptr(F, I_CTX), nullptr, 0, 2048, inptr(F, I_N2G), MOD + 8 * 6144, 4096, 4); }
                else { pg8::EpiRes<false> E{nullptr, nullptr, XN, MOD + (size_t)9 * 6144, 2048, inptr(F, I_N1G) + DM, MOD + (size_t)9 * 6144, 1024, inptr(F, I_N2G) + DM, MOD + (size_t)9 * 6144, 4096, (float*)(ws + WS_SSX), rep_ ? 0.f : 1.f, nullptr};
                    pg8::gemm_phase(ring, g, S, E); } } }
        SEAM(pb + 5);
        if (PHASE(pb + 6)) for (int rep_ = 0; rep_ < (((pb + 6) == RPT_PH) ? 2 : 1); ++rep_) { if (rep_) xcd_barrier(bar); RELANE();
            }
        if (PHASE(pb + 7)) for (int rep_ = 0; rep_ < (((pb + 7) == RPT_PH) ? 2 : 1); ++rep_) { if (rep_) xcd_barrier(bar); RELANE();
            if (PHON(8)) { const int nrows = (l == 0) ? MT : MLAT; const int nM = (nrows + 253) / 254;
                pg8::Gemm g{XN, (const bf16*)(ws + WS_WUP + l * WUP_STRIDE), nM, 22, 1024, 1024}; UpOrder S; S.init(nM, 22, F.G, F.bx, 1024); S.nrows = nrows;
                pg8::EpiUp E{ACT, inptr(F, I_FCW) + (size_t)l * 3 * FF, inptr(F, I_FCB) + (size_t)l * FF, (LAS float*)(F.lds + EPIX_OFF), (const float*)(ws + WS_SSX), (const float*)(ws + WS_UB) + (size_t)l * 9 * 5632};
                pg8::gemm_phase(ring, g, S, E);
                if (l == 0 && rep_ == 0) {
                    RELANE(); int nb = nM * 22 - 6 * F.G; nb = nb < 0 ? 0 : (nb > F.G ? F.G : nb);
                    const bool all = (nb == F.G); if (all || F.bx >= nb) { const int rk = all ? F.bx : F.bx - nb, n = all ? F.G : F.G - nb; p0_prologue(F, 0xFF, 2, rk * NWAVES + F.wave, n * NWAVES); } } } }
        SEAM(pb + 7);
        if (PHASE(pb + 8)) for (int rep_ = 0; rep_ < (((pb + 8) == RPT_PH) ? 2 : 1); ++rep_) { if (rep_) xcd_barrier(bar); RELANE();
            if (PHON(6)) {
                if (l == 0) { pg8::Gemm g{ACT, (const bf16*)(ws + WS_WDOWN), 64, 4, FF, FF}; SliceOrder0 S; S.init(64, 4, F.G, F.bx, FF); S.nsl = 8;
                    pg8::EpiRes<false> E{nullptr, nullptr, XN, MOD, 5120, inptr(F, I_N2G), MOD, 4096, inptr(F, I_N1G) + DM, MOD + (size_t)9 * 6144, 1024, (float*)(ws + WS_SSX), rep_ ? 0.f : 1.f, (bf16*)(ws + WS_CPART)};
                    pg8::gemm_phase(ring, g, S, E);
                    xcd_barrier(bar); RELANE();
                    ctx_combine_phase(F, nullptr, inptr(F, I_N2G), 4096, 5120, inptr(F, I_N1G) + DM, MOD + (size_t)9 * 6144 + 8 * 6144, 1024, 8);
                } else { pg8::Gemm g{ACT, (const bf16*)(ws + WS_WDOWN + WDOWN_STRIDE), 64, 4, FF, FF}; pg8::StaticOrder S; S.init(64, 4, F.G, F.bx, FF);
                    pg8::EpiRes<false> E{nullptr, nullptr, XN, MOD + (size_t)9 * 6144, 5120, inptr(F, I_N2G) + DM, MOD + (size_t)9 * 6144, 4096, nullptr, nullptr, 0, nullptr, 1.f, nullptr};
                    pg8::gemm_phase(ring, g, S, E); } } }
        SEAM(pb + 8);
    }
    if (PHASE(NPH - 1)) for (int rep_ = 0; rep_ < (((NPH - 1) == RPT_PH) ? 2 : 1); ++rep_) { if (rep_) xcd_barrier(bar); RELANE(); if (PHON(10)) final_norm_phase(F, XN, inptr(F, I_FING)); }
#undef PHASE
#undef SEAM
#undef RELANE
#undef MOD
#undef SSQ
#undef XN
#undef P
#undef Qb
#undef Kb
#undef Vb
#undef YCAT
#undef ACT
#undef XCTX
#undef XBL
#undef XFIN
}

extern "C" void kernel_launch(void* const* d_in, const int* in_sizes, int n_in, void* d_out, int out_size, void* d_ws, size_t ws_size, hipStream_t stream) {
    static int grid = 0;
    if (grid == 0) {
        if (n_in != 22 || out_size != MLAT * DM || ws_size < WS_END) { fprintf(stderr, "kernel_launch: unexpected shapes (n_in %d out %d ws %zu)\n", n_in, out_size, ws_size); grid = -1; return; }
        int dev = 0, cus = 0;
        if (hipGetDevice(&dev) != hipSuccess || hipDeviceGetAttribute(&cus, hipDeviceAttributeMultiprocessorCount, dev) != hipSuccess) { grid = -1; return; }
        if (hipFuncSetAttribute((const void*)mk_fwd, hipFuncAttributeMaxDynamicSharedMemorySize, LDS_BYTES) != hipSuccess) { fprintf(stderr, "kernel_launch: hipFuncSetAttribute failed\n"); grid = -1; return; }
        int per_cu = 0;
        if (hipOccupancyMaxActiveBlocksPerMultiprocessor(&per_cu, (const void*)mk_fwd, NWAVES * 64, LDS_BYTES) != hipSuccess || per_cu < 1) fprintf(stderr, "kernel_launch: occupancy query says %d\n", per_cu);
        (void)hipGetLastError();
        grid = cus;
    }
    if (grid < 0) return;
    if (hipMemsetAsync((char*)d_ws + WS_CTL, 0, CTL_ZERO_BYTES, stream) != hipSuccess) return;
    Args a{};
    for (int i = 0; i < 22; ++i) a.in[i] = (const float*)d_in[i];
    a.out = (float*)d_out; a.ws = (unsigned char*)d_ws;
#if MK_SPLIT
    for (int ph = 0; ph < NPH; ++ph) { a.ph_lo = ph; a.ph_hi = ph + 1; hipLaunchKernelGGL(mk_fwd, dim3(grid), dim3(NWAVES * 64), LDS_BYTES, stream, a); }
#else
    a.ph_lo = 0; a.ph_hi = NPH;
    hipLaunchKernelGGL(mk_fwd, dim3(grid), dim3(NWAVES * 64), LDS_BYTES, stream, a);
#endif
    const hipError_t le = hipPeekAtLastError();
    if (le != hipSuccess) fprintf(stderr, "kernel_launch: launch failed: %s\n", hipGetErrorName(le));
}
```

```cpp
#include <hip/hip_runtime.h>
#include <hip/hip_bf16.h>
#include <cstdio>
#include <cstdint>
#include <cmath>
namespace pg8 {
#define PG8_LAS __attribute__((address_space(3)))
typedef unsigned short bf16_t;
typedef short bf16x8 __attribute__((ext_vector_type(8)));
typedef float f32x4 __attribute__((ext_vector_type(4)));
typedef float f32x2 __attribute__((ext_vector_type(2)));
typedef unsigned u32x4 __attribute__((ext_vector_type(4)));
typedef unsigned u32x2 __attribute__((ext_vector_type(2)));
constexpr int BM = 256, BK = 64, HALF = 128, HTB = HALF * BK * 2  , STAGE_BYTES = 8 * HTB, NXCD = 8, WGM = 8;

__host__ __device__ __forceinline__ int lds_byte(int r, int c) { const int st = (r >> 4) * 2 + (c >> 5), rr = r & 15, cc = c & 31, ob = rr * 64 + cc * 2; return st * 1024 + (ob ^ (((ob >> 9) & 1) << 5)); }
__host__ __device__ __forceinline__ void stage_rc(int b, int& R, int& C) { const int st = b / 1024, sb = b % 1024, swz = sb ^ (((sb >> 9) & 1) << 5); R = (st >> 1) * 16 + swz / 64; C = (st & 1) * 32 + (swz % 64) / 2; }
__host__ __device__ __forceinline__ int perm32(int rho) { const int n = rho >> 4, i = rho & 15; return 8 * (i >> 2) + 4 * n + (i & 3); }

struct Unit { int pm, pn, arow, kofs, kofb, nt, aux; };
struct Gemm { const bf16_t* A; const bf16_t* Bt; int nM, nN, ldb, lda; };

struct StaticOrder {
    int nM, nN, nwg, G, c, ntk;
    __device__ __forceinline__ void init(int nM_, int nN_, int G_, int c_, int K_) { nM = nM_; nN = nN_; nwg = nM * nN; G = G_; c = c_; ntk = K_ / BK; }
    __device__ __forceinline__ bool next_mn(int i, int& pm, int& pn) const {
        const long L = (long)i * G + c; if (L >= nwg) return false;
        int wgid = (int)L; { const int q = nwg / NXCD, r = nwg % NXCD, xcd = wgid % NXCD, off = wgid / NXCD; wgid = (xcd < r ? xcd * (q + 1) : r * (q + 1) + (xcd - r) * q) + off; }
        const int nig = WGM * nN, gid = wgid / nig, fm = gid * WGM, gsz = (nM - fm) < WGM ? (nM - fm) : WGM;
        pm = fm + ((wgid % nig) % gsz); pn = (wgid % nig) / gsz; return true;
    }
    typedef Unit UnitT;
    __device__ __forceinline__ bool next(int i, Unit& u) const { if (!next_mn(i, u.pm, u.pn)) return false; u.arow = u.pm * BM; u.kofs = 0; u.kofb = 0; u.nt = ntk; u.aux = 0; return true; }
};

__device__ __forceinline__ unsigned cvt_pk_bf16(float lo, float hi) { unsigned r; asm volatile("v_cvt_pk_bf16_f32 %0, %1, %2" : "=v"(r) : "v"(lo), "v"(hi)); return r; }

template <class Epi, class Sched>
__device__ __forceinline__ void gemm_phase(PG8_LAS unsigned char* lds, const Gemm g, const Sched& S, const Epi& E) {
    int tid = threadIdx.x; asm volatile("" : "+v"(tid));
    const int wid = __builtin_amdgcn_readfirstlane(tid >> 6), lane = tid & 63, wr = wid >> 2, wc = wid & 3, fr = lane & 15, fq = lane >> 4;
    const int K = g.ldb, lda = g.lda;
    unsigned voffA[2], voffB[2];
#pragma unroll
    for (int i = 0; i < 2; ++i) { int R, C; stage_rc(tid * 16 + i * 8192, R, C); const int Rb = Epi::PERM ? ((R & ~31) + perm32(R & 31)) : R;
        voffA[i] = (unsigned)(R * lda + C) * 2u; voffB[i] = (unsigned)(Rb * K + C) * 2u; }
    const size_t kstep = (size_t)(BK * 2);
    const size_t hstepA = (size_t)HALF * lda * 2, hstepB = (size_t)HALF * K * 2;
    const size_t tstepB = 2 * hstepB;
    const unsigned ldsw = (unsigned)wid * 1024u;
    const int aoff = lds_byte(wr * 64 + fr, fq * 8), boff = lds_byte(wc * 32 + fr, fq * 8);
#define PG8_SA(b, h) (((b) * 2 + (h)) * HTB)
#define PG8_SB(b, h) ((4 + (b) * 2 + (h)) * HTB)
#define PG8_STAGE(bufoff, gbase, voff) do { _Pragma("unroll") for (int _i = 0; _i < 2; ++_i) \
        __builtin_amdgcn_global_load_lds((const unsigned*)((const char*)(gbase) + (voff)[_i]), (PG8_LAS unsigned*)(lds + (bufoff) + ldsw + _i * 8192), 16, 0, 0); } while (0)
#define PG8_LDA(dst, b, h) do { _Pragma("unroll") for (int m = 0; m < 4; ++m) _Pragma("unroll") for (int k = 0; k < 2; ++k) dst[m][k] = *(const PG8_LAS bf16x8*)(lds + PG8_SA(b, h) + aoff + m * 2048 + k * 1024); } while (0)
#define PG8_LDB(dst, b, h) do { _Pragma("unroll") for (int n = 0; n < 2; ++n) _Pragma("unroll") for (int k = 0; k < 2; ++k) dst[n][k] = *(const PG8_LAS bf16x8*)(lds + PG8_SB(b, h) + boff + n * 2048 + k * 1024); } while (0)
#define PG8_MMA(ai, bj, At, Bt) do { __builtin_amdgcn_s_setprio(1); _Pragma("unroll") for (int m = 0; m < 4; ++m) _Pragma("unroll") for (int n = 0; n < 2; ++n) _Pragma("unroll") for (int k = 0; k < 2; ++k) \
        acc[ai][bj][m][n] = __builtin_amdgcn_mfma_f32_16x16x32_bf16(Bt[n][k], At[m][k], acc[ai][bj][m][n], 0, 0, 0); __builtin_amdgcn_s_setprio(0); } while (0)
#define PG8_WAIT_V(n) asm volatile("s_waitcnt vmcnt(" #n ")" ::: "memory")
#define PG8_WAIT_L(n) asm volatile("s_waitcnt lgkmcnt(" #n ")" ::: "memory")
#define PG8_BAR __builtin_amdgcn_s_barrier()
#define PG8_SCHED __builtin_amdgcn_sched_barrier(0)
    typename Sched::UnitT cur, nxt; int ui = 0;
    if (!S.next(0, cur)) return;
    f32x4 acc[2][2][4][2];
#pragma unroll
    for (int a = 0; a < 2; ++a)
#pragma unroll
        for (int b = 0; b < 2; ++b)
#pragma unroll
            for (int m = 0; m < 4; ++m)
#pragma unroll
                for (int n = 0; n < 2; ++n) acc[a][b][m][n] = (f32x4){0.f, 0.f, 0.f, 0.f};
    bf16x8 At[4][2], B0[2][2], B1[2][2];
    const char* cA = (const char*)g.A + (ptrdiff_t)cur.arow * (ptrdiff_t)(lda * 2) + cur.kofs * 2; const char* cB = (const char*)g.Bt + (size_t)cur.pn * tstepB + cur.kofb * 2;
    if constexpr (Epi::PREFETCH) E.prefetch(cur, wid, lane);
    PG8_STAGE(PG8_SB(0, 0), cB, voffB); PG8_STAGE(PG8_SB(0, 1), cB + hstepB, voffB); PG8_STAGE(PG8_SA(0, 0), cA, voffA); PG8_STAGE(PG8_SA(0, 1), cA + hstepA, voffA);
    if (wr == 1) PG8_BAR;
    PG8_WAIT_V(2); PG8_BAR;
    PG8_STAGE(PG8_SB(1, 0), cB + kstep, voffB); PG8_STAGE(PG8_SA(1, 0), cA + kstep, voffA); PG8_STAGE(PG8_SB(1, 1), cB + hstepB + kstep, voffB);
    PG8_WAIT_V(6); PG8_BAR;
    for (;;) {
        const bool has_next = S.next(ui + 1, nxt);
        const char* nA = has_next ? (const char*)g.A + (ptrdiff_t)nxt.arow * (ptrdiff_t)(lda * 2) + nxt.kofs * 2 : cA; const char* nB = has_next ? (const char*)g.Bt + (size_t)nxt.pn * tstepB + nxt.kofb * 2 : cB;
        const int nt = cur.nt;
        for (int t = 0; t < nt; t += 2) {
            const bool last = (t == nt - 2);
            const char* a1 = cA + (size_t)(t + 1) * kstep;
            const char* a2 = last ? nA : cA + (size_t)(t + 2) * kstep; const char* b2 = last ? nB : cB + (size_t)(t + 2) * kstep;
            const char* a3 = a2 + kstep; const char* b3 = b2 + kstep;
            PG8_LDB(B0, 0, 0); PG8_LDB(B1, 0, 1); PG8_SCHED; PG8_LDA(At, 0, 0); PG8_STAGE(PG8_SA(1, 1), a1 + hstepA, voffA);
            PG8_WAIT_V(8); PG8_WAIT_L(0); PG8_BAR; PG8_MMA(0, 0, At, B0); PG8_MMA(0, 1, At, B1); PG8_BAR; PG8_SCHED;
            PG8_LDA(At, 0, 1); PG8_STAGE(PG8_SB(0, 0), b2, voffB); PG8_STAGE(PG8_SB(0, 1), b2 + hstepB, voffB); PG8_STAGE(PG8_SA(0, 0), a2, voffA);
            PG8_WAIT_V(8); PG8_WAIT_L(0); PG8_BAR; PG8_MMA(1, 0, At, B0); PG8_MMA(1, 1, At, B1); PG8_BAR; PG8_SCHED;
            PG8_LDB(B0, 1, 0); PG8_LDB(B1, 1, 1); PG8_SCHED; PG8_LDA(At, 1, 0); PG8_STAGE(PG8_SA(0, 1), a2 + hstepA, voffA);
            PG8_WAIT_V(8); PG8_WAIT_L(0); PG8_BAR; PG8_MMA(0, 0, At, B0); PG8_MMA(0, 1, At, B1); PG8_BAR; PG8_SCHED;
            PG8_LDA(At, 1, 1); PG8_STAGE(PG8_SB(1, 0), b3, voffB); PG8_STAGE(PG8_SB(1, 1), b3 + hstepB, voffB); PG8_STAGE(PG8_SA(1, 0), a3, voffA);
            PG8_WAIT_V(8); PG8_WAIT_L(0); PG8_BAR; PG8_MMA(1, 0, At, B0); PG8_MMA(1, 1, At, B1); PG8_BAR; PG8_SCHED;
        }
        if (wr == 0) PG8_BAR;
        E(acc, cur, wr, wc, fr, fq);
        if (!has_next) break;
        if constexpr (Epi::PREFETCH) E.prefetch(nxt, wid, lane);
#pragma unroll
        for (int a = 0; a < 2; ++a)
#pragma unroll
            for (int b = 0; b < 2; ++b)
#pragma unroll
                for (int m = 0; m < 4; ++m)
#pragma unroll
                    for (int n = 0; n < 2; ++n) acc[a][b][m][n] = (f32x4){0.f, 0.f, 0.f, 0.f};
        cur = nxt; cA = nA; cB = nB; ++ui;
        if (wr == 1) PG8_BAR;
    }
    PG8_WAIT_V(0);
    PG8_BAR;
#undef PG8_SA
#undef PG8_SB
#undef PG8_STAGE
#undef PG8_LDA
#undef PG8_LDB
#undef PG8_MMA
#undef PG8_WAIT_V
#undef PG8_WAIT_L
#undef PG8_BAR
#undef PG8_SCHED
}
}
namespace pg8 {
constexpr float RMS_EPS = 1e-6f;
template <class T> __device__ __forceinline__ T gld(const void* base, unsigned boff) { return *(const T*)((const char*)base + boff); }
template <class T> __device__ __forceinline__ void gst(void* base, unsigned boff, T v) { *(T*)((char*)base + boff) = v; }
constexpr int EX_XF = 0, EX_XL = 512, EX_CW = 1024, EX_RS = 1536, EX_BL = 1792, EX_SSX = 2304, EX_FLOATS = 6400;
constexpr int MLAT_ = 16384;
__device__ __forceinline__ void dma_ssx(const float* ssx, int arow, PG8_LAS float* xb, int wid, int lane) {
#pragma unroll
    for (int i = 0; i < 2; ++i) { const int ch = 2 * wid + i;
        __builtin_amdgcn_global_load_lds((const unsigned*)((const char*)ssx + (ptrdiff_t)arow * 64 + ch * 1024 + lane * 16), (PG8_LAS unsigned*)(xb + EX_SSX + ch * 256), 16, 0, 0); }
}
__device__ __forceinline__ void rs_from_ssx(PG8_LAS float* xb, int t) {
    if (t < 256) { const PG8_LAS f32x4* p = (const PG8_LAS f32x4*)(xb + EX_SSX + t * 16); const f32x4 a = p[0], b = p[1], c = p[2], d = p[3];
        const float ss = (((a[0] + a[1]) + (a[2] + a[3])) + ((b[0] + b[1]) + (b[2] + b[3]))) + (((c[0] + c[1]) + (c[2] + c[3])) + ((d[0] + d[1]) + (d[2] + d[3])));
        xb[EX_RS + t] = __builtin_amdgcn_rsqf(ss * (1.0f / 1024.0f) + RMS_EPS); }
}

struct EpiWin {
    static constexpr bool PERM = true, PREFETCH = true;
    bf16_t* O; int ldc; float* ssq;
    const float* ssx; const float* pb;
    PG8_LAS float* xb;
    __device__ __forceinline__ void prefetch(const Unit& u, int wid, int lane) const {
        if (ssx == nullptr) return;
        dma_ssx(ssx, u.arow, xb, wid, lane);
        if (wid == 0) __builtin_amdgcn_global_load_lds((const unsigned*)(pb + (u.pm < 64 ? (u.pm >> 3) : 8) * 2048 + u.pn * BM + lane * 4), (PG8_LAS unsigned*)(xb + EX_BL), 16, 0, 0);
    }
    __device__ __forceinline__ void operator()(const f32x4 (&acc)[2][2][4][2], const Unit& u, int wr, int wc, int fr_in, int fq_in) const {
        int t_ = threadIdx.x; asm volatile("" : "+v"(t_)); const int fr = t_ & 15, fq = (t_ >> 4) & 3; (void)fr_in; (void)fq_in;
        const int row0 = u.pm * BM + wr * 64 + fr; const int col0 = u.pn * BM + wc * 32 + 8 * fq; const int tc0 = wc * 32 + 8 * fq;
        const bool fused = ssx != nullptr;
        if (fused) { rs_from_ssx(xb, t_); asm volatile("s_waitcnt lgkmcnt(0)" ::: "memory"); __builtin_amdgcn_s_barrier(); asm volatile("" ::: "memory"); }
        f32x4 bv[2][2];
#pragma unroll
        for (int bj = 0; bj < 2; ++bj)
#pragma unroll
            for (int n = 0; n < 2; ++n) bv[bj][n] = fused ? *(const PG8_LAS f32x4*)(xb + EX_BL + tc0 + bj * HALF + 4 * n) : (f32x4){0.f, 0.f, 0.f, 0.f};
#pragma unroll
        for (int ai = 0; ai < 2; ++ai)
#pragma unroll
            for (int m = 0; m < 4; ++m) { const int tr = ai * HALF + wr * 64 + m * 16 + fr; const int row = u.pm * BM + tr; const unsigned ob = ((unsigned)row * (unsigned)ldc + (unsigned)col0) * 2u;
                const float rs = fused ? xb[EX_RS + tr] : 1.0f;
#pragma unroll
                for (int bj = 0; bj < 2; ++bj) { const f32x4 v0 = acc[ai][bj][m][0] * rs + bv[bj][0], v1 = acc[ai][bj][m][1] * rs + bv[bj][1];
                    u32x4 w; w.x = cvt_pk_bf16(v0[0], v0[1]); w.y = cvt_pk_bf16(v0[2], v0[3]); w.z = cvt_pk_bf16(v1[0], v1[1]); w.w = cvt_pk_bf16(v1[2], v1[3]);
                    gst<u32x4>(O, ob + bj * HALF * 2, w);
                    const int hf = 2 * u.pn + bj;
                    if (hf < 5) {
                        float s = (v0[0] * v0[0] + v0[1] * v0[1]) + (v0[2] * v0[2] + v0[3] * v0[3]) + (v1[0] * v1[0] + v1[1] * v1[1]) + (v1[2] * v1[2] + v1[3] * v1[3]);
                        s += __shfl_xor(s, 16); s += __shfl_xor(s, 32);
                        if (fq == 0) gst<float>(ssq, ((unsigned)row * 20u + hf * 4 + wc) * 4u, s);
                    } }
                if (m & 1) asm volatile("" ::: "memory"); }
        if (fused) { asm volatile("s_waitcnt lgkmcnt(0)" ::: "memory"); __builtin_amdgcn_s_barrier(); asm volatile("" ::: "memory"); }
        (void)row0;
    }
};

struct EpiFold {
    static constexpr bool PERM = true, PREFETCH = false;
    bf16_t* WinT; unsigned lstride;
    __device__ __forceinline__ void operator()(const f32x4 (&acc)[2][2][4][2], const Unit& u, int wr, int wc, int fr_in, int fq_in) const {
        int t_ = threadIdx.x; asm volatile("" : "+v"(t_)); const int fr = t_ & 15, fq = (t_ >> 4) & 3; (void)fr_in; (void)fq_in;
        bf16_t* O = WinT + (size_t)(u.pn >> 2) * lstride;
        const int row0 = 768 + u.pm * BM + wr * 64 + fr; const int col0 = (u.pn & 3) * BM + wc * 32 + 8 * fq;
#pragma unroll
        for (int ai = 0; ai < 2; ++ai)
#pragma unroll
            for (int m = 0; m < 4; ++m) { const unsigned ob = ((unsigned)(row0 + ai * HALF + m * 16) * 1024u + (unsigned)col0) * 2u;
#pragma unroll
                for (int bj = 0; bj < 2; ++bj) { const f32x4 v0 = acc[ai][bj][m][0], v1 = acc[ai][bj][m][1];
                    u32x4 w; w.x = cvt_pk_bf16(v0[0], v0[1]); w.y = cvt_pk_bf16(v0[2], v0[3]); w.z = cvt_pk_bf16(v1[0], v1[1]); w.w = cvt_pk_bf16(v1[2], v1[3]);
                    gst<u32x4>(O, ob + bj * HALF * 2, w); } }
    }
};

struct EpiQKV {
    static constexpr bool PERM = true, PREFETCH = true;
    bf16_t* Q; bf16_t* Kb; bf16_t* Vb; const float* ssq; const float* ropec; const float* ropes; PG8_LAS float* xb;
    __device__ __forceinline__ void prefetch(const Unit& u, int wid, int lane) const {
#pragma unroll
        for (int i = 0; i < 3; ++i) { const int ch = 3 * wid + i;
            if (ch < 20) __builtin_amdgcn_global_load_lds((const unsigned*)((const char*)ssq + (size_t)u.arow * 80 + ch * 1024 + lane * 16), (PG8_LAS unsigned*)(xb + 512 + ch * 256), 16, 0, 0); }
    }
    __device__ __forceinline__ void operator()(const f32x4 (&acc)[2][2][4][2], const Unit& u, int wr, int wc, int fr_in, int fq_in) const {
        int t_ = threadIdx.x; asm volatile("" : "+v"(t_)); const int fr = t_ & 15, fq = (t_ >> 4) & 3; (void)fr_in; (void)fq_in;
        if (t_ < 256) { const PG8_LAS float* p = xb + 512 + t_ * 20; float sq = 0.f, sk = 0.f;
#pragma unroll
            for (int i = 0; i < 12; ++i) sq += p[i];
#pragma unroll
            for (int i = 12; i < 20; ++i) sk += p[i];
            xb[t_] = __builtin_amdgcn_rsqf(sq * (1.0f / 384.0f) + RMS_EPS); xb[256 + t_] = __builtin_amdgcn_rsqf(sk * (1.0f / 256.0f) + RMS_EPS); }
        asm volatile("s_waitcnt lgkmcnt(0)" ::: "memory"); __builtin_amdgcn_s_barrier(); asm volatile("" ::: "memory");
        const int cw = wc * 32 + 8 * fq;
        if (u.pn < 3) {
            const bool lat = u.pm < 64;
#pragma unroll
            for (int ai = 0; ai < 2; ++ai)
#pragma unroll
                for (int m = 0; m < 4; ++m) { const int tr = ai * HALF + wr * 64 + m * 16 + fr; const int row = u.pm * BM + tr; const float rs = xb[tr]; const int t = row & 2047;
#pragma unroll
                    for (int bj = 0; bj < 2; ++bj) { const int gcol = u.pn * BM + bj * HALF + wc * 32;
                        const int w = gcol % 192; f32x4 x1 = acc[ai][bj][m][0] * rs, x2 = acc[ai][bj][m][1] * rs;
                        if (lat && w >= 128) { const int pos = (w >= 160) ? (t & 63) : (t >> 6);
                            const unsigned rb = (unsigned)(pos * 16 + 4 * fq) * 4u; const f32x4 c = gld<f32x4>(ropec, rb), s = gld<f32x4>(ropes, rb);
                            const f32x4 y1 = x1 * c - x2 * s, y2 = x1 * s + x2 * c; x1 = y1; x2 = y2; }
                        u32x4 o; o.x = cvt_pk_bf16(x1[0], x1[1]); o.y = cvt_pk_bf16(x1[2], x1[3]); o.z = cvt_pk_bf16(x2[0], x2[1]); o.w = cvt_pk_bf16(x2[2], x2[3]);
                        gst<u32x4>(Q, ((unsigned)row * 768u + (unsigned)(gcol + 8 * fq)) * 2u, o); }
                    if (m & 1) asm volatile("" ::: "memory"); }
        } else {
            const int h = u.pn - 3;
#pragma unroll
            for (int ai = 0; ai < 2; ++ai)
#pragma unroll
                for (int m = 0; m < 4; ++m) { const int tr = ai * HALF + wr * 64 + m * 16 + fr; const int row = u.pm * BM + tr; const float rs = xb[256 + tr];
#pragma unroll
                    for (int bj = 0; bj < 2; ++bj) { const f32x4 v0 = acc[ai][bj][m][0] * rs, v1 = acc[ai][bj][m][1] * rs;
                        u32x4 w; w.x = cvt_pk_bf16(v0[0], v0[1]); w.y = cvt_pk_bf16(v0[2], v0[3]); w.z = cvt_pk_bf16(v1[0], v1[1]); w.w = cvt_pk_bf16(v1[2], v1[3]);
                        if (bj == 0) gst<u32x4>(Kb, ((unsigned)row * 768u + (unsigned)(192 * h + cw)) * 2u, w);
                        else gst<u32x4>(Vb, ((unsigned)row * 512u + (unsigned)(128 * h + cw)) * 2u, w); }
                    if (m & 1) asm volatile("" ::: "memory"); }
        }
        asm volatile("s_waitcnt lgkmcnt(0)" ::: "memory"); __builtin_amdgcn_s_barrier(); asm volatile("" ::: "memory");
    }
};

struct EpiFnet {
    static constexpr bool PERM = true, PREFETCH = false;
    bf16_t* Y; int rowbase, seqlen; float scale; unsigned slice_stride;
    __device__ __forceinline__ void operator()(const f32x4 (&acc)[2][2][4][2], const Unit& u, int wr, int wc, int fr_in, int fq_in) const {
        int t_ = threadIdx.x; asm volatile("" : "+v"(t_)); const int fr = t_ & 15, fq = (t_ >> 4) & 3; (void)fr_in; (void)fq_in;
        const int k0 = u.pm * BM + wr * 64 + fr; const int cw = wc * 32 + 8 * fq;
        bf16_t* Yb = Y + (size_t)(u.kofs >> 10) * slice_stride;
#pragma unroll
        for (int ai = 0; ai < 2; ++ai)
#pragma unroll
            for (int m = 0; m < 4; ++m) { const int row = rowbase + u.pn * seqlen + k0 + ai * HALF + m * 16; const unsigned yb = ((unsigned)row * 256u + (unsigned)cw) * 2u;
#pragma unroll
                for (int bj = 0; bj < 2; ++bj) { const f32x4 v0 = acc[ai][bj][m][0] * scale, v1 = acc[ai][bj][m][1] * scale;
                    u32x4 w; w.x = cvt_pk_bf16(v0[0], v0[1]); w.y = cvt_pk_bf16(v0[2], v0[3]); w.z = cvt_pk_bf16(v1[0], v1[1]); w.w = cvt_pk_bf16(v1[2], v1[3]);
                    gst<u32x4>(Yb, yb + bj * HALF * 2, w); } }
    }
};

template <bool F32BASE> struct EpiRes {
    static constexpr bool PERM = true, PREFETCH = false;
    const float* base_lat; const float* base_ctx;
    bf16_t* X; const float* mod; int gofs;
    const float* png; const float* pscmod; int pscofs;
    const float* ng; const float* scmod; int scofs; float* ssx;
    float gmul;
    bf16_t* part;
    __device__ __forceinline__ void operator()(const f32x4 (&acc)[2][2][4][2], const Unit& u, int wr, int wc, int fr_in, int fq_in) const {
        int t_ = threadIdx.x; asm volatile("" : "+v"(t_)); const int fr = t_ & 15, fq = (t_ >> 4) & 3; (void)fr_in; (void)fq_in;
        if (part != nullptr && u.pm >= 64) {
            const int sl = u.aux;
            const int prow0 = (u.pm - 64) * BM + wr * 64 + fr; const int pcol0 = u.pn * BM + wc * 32 + 8 * fq; bf16_t* pb_ = part + (size_t)sl * (2048u * 1024u);
#pragma unroll
            for (int ai = 0; ai < 2; ++ai)
#pragma unroll
                for (int m = 0; m < 4; ++m) { const unsigned off = ((unsigned)(prow0 + ai * HALF + m * 16) * 1024u + (unsigned)pcol0) * 2u;
#pragma unroll
                    for (int bj = 0; bj < 2; ++bj) { const f32x4 v0 = acc[ai][bj][m][0], v1 = acc[ai][bj][m][1];
                        u32x4 w; w.x = cvt_pk_bf16(v0[0], v0[1]); w.y = cvt_pk_bf16(v0[2], v0[3]); w.z = cvt_pk_bf16(v1[0], v1[1]); w.w = cvt_pk_bf16(v1[2], v1[3]);
                        gst<u32x4>(pb_, off + (unsigned)(bj * HALF) * 2u, w); } }
            return;
        }
        const bool lat = u.pm < 64; const int r = lat ? (u.pm >> 3) : 8;
        constexpr bool f32base = F32BASE; const float* bf = lat ? base_lat : base_ctx;
        const float* gate = mod + r * 6144 + gofs;
        const int frow0 = (lat ? u.pm : u.pm - 64) * BM + wr * 64 + fr; const int col0 = u.pn * BM + wc * 32 + 8 * fq;
        const int grow0 = u.pm * BM + wr * 64 + fr;
        const bool scaled = ng != nullptr;
        float ss[8];
#pragma unroll
        for (int q = 0; q < 8; ++q) ss[q] = 0.f;
#pragma unroll
        for (int bj = 0; bj < 2; ++bj) {
            f32x4 gv[2], gs[2], gp[2];
#pragma unroll
            for (int n = 0; n < 2; ++n) { const unsigned cb = (unsigned)(col0 + bj * HALF + n * 4) * 4u; gv[n] = gld<f32x4>(gate, cb) * gmul;
                gs[n] = scaled ? gld<f32x4>(ng, cb) * (gld<f32x4>(scmod, (unsigned)(r * 6144 + scofs) * 4u + cb) + 1.0f) : (f32x4){1.f, 1.f, 1.f, 1.f};
                if constexpr (!f32base) { const f32x4 d = gld<f32x4>(png, cb) * (gld<f32x4>(pscmod, (unsigned)(r * 6144 + pscofs) * 4u + cb) + 1.0f);
                    gp[n] = (f32x4){__builtin_amdgcn_rcpf(d[0]), __builtin_amdgcn_rcpf(d[1]), __builtin_amdgcn_rcpf(d[2]), __builtin_amdgcn_rcpf(d[3])}; }
                else gp[n] = (f32x4){1.f, 1.f, 1.f, 1.f}; }
#pragma unroll
            for (int ai = 0; ai < 2; ++ai) {
                f32x4 x0[4], x1[4];
#pragma unroll
                for (int m = 0; m < 4; ++m) { const unsigned o2 = ((unsigned)(grow0 + ai * HALF + m * 16) * 1024u + (unsigned)(col0 + bj * HALF)) * 2u;
                    const unsigned fo = ((unsigned)(frow0 + ai * HALF + m * 16) * 1024u + (unsigned)(col0 + bj * HALF)) * 4u;
                    if constexpr (f32base) { x0[m] = gld<f32x4>(bf, fo); x1[m] = gld<f32x4>(bf, fo + 16u); }
                    else { const u32x4 bw = gld<u32x4>(X, o2); x0[m] = __builtin_bit_cast(f32x4, (u32x4){bw.x << 16, bw.x & 0xffff0000u, bw.y << 16, bw.y & 0xffff0000u});
                        x1[m] = __builtin_bit_cast(f32x4, (u32x4){bw.z << 16, bw.z & 0xffff0000u, bw.w << 16, bw.w & 0xffff0000u}); } }
                asm volatile("" ::: "memory");
#pragma unroll
                for (int m = 0; m < 4; ++m) { const unsigned o2 = ((unsigned)(grow0 + ai * HALF + m * 16) * 1024u + (unsigned)(col0 + bj * HALF)) * 2u;
                    f32x4 y0 = x0[m], y1 = x1[m];
                    if constexpr (!f32base) { y0 = y0 * gp[0]; y1 = y1 * gp[1]; }
                    y0 = y0 + gv[0] * acc[ai][bj][m][0]; y1 = y1 + gv[1] * acc[ai][bj][m][1];
                    ss[ai * 4 + m] += ((y0[0] * y0[0] + y0[1] * y0[1]) + (y0[2] * y0[2] + y0[3] * y0[3])) + ((y1[0] * y1[0] + y1[1] * y1[1]) + (y1[2] * y1[2] + y1[3] * y1[3]));
                    asm volatile("" : "+v"(ss[ai * 4 + m]));
                    const f32x4 h0 = y0 * gs[0], h1 = y1 * gs[1];
                    u32x4 hw; hw.x = cvt_pk_bf16(h0[0], h0[1]); hw.y = cvt_pk_bf16(h0[2], h0[3]); hw.z = cvt_pk_bf16(h1[0], h1[1]); hw.w = cvt_pk_bf16(h1[2], h1[3]);
                    gst<u32x4>(X, o2, hw); }
                asm volatile("" ::: "memory"); }
        }
        if (scaled) {
#pragma unroll
            for (int q = 0; q < 8; ++q) { float s = ss[q]; s += __shfl_xor(s, 16); s += __shfl_xor(s, 32);
                if (fq == 0) gst<float>(ssx, ((unsigned)(grow0 + (q >> 2) * HALF + (q & 3) * 16) * 16u + (unsigned)(4 * u.pn + wc)) * 4u, s); } }
    }
};

#ifndef DPP_UP
#define DPP_UP 0x121
#define DPP_DN 0x12F
#endif
struct UnitUp : Unit { int nrows; };
struct EpiUp {
    static constexpr bool PERM = true, PREFETCH = true;
    bf16_t* act; const float* cw; const float* cb; PG8_LAS float* xb;
    const float* ssx; const float* ub;
    __device__ __forceinline__ void prefetch(const UnitUp& u, int wid, int lane) const {
        dma_ssx(ssx, u.arow, xb, wid, lane);
        { const int arr = wid >> 1, half = wid & 1; const float* src = (arr < 3 ? cw + arr * 2816 : cb) + u.pn * HALF + half * 64 + lane;
          __builtin_amdgcn_global_load_lds((const unsigned*)src, (PG8_LAS unsigned*)(xb + EX_CW + arr * 128 + half * 64), 4, 0, 0); }
        if (wid < 2) { const int a0 = u.arow < 0 ? 0 : u.arow; const int b0 = a0 >= MLAT_ ? 8 : (a0 >> 11); const int bb_ = b0 + wid > 8 ? 8 : b0 + wid;
            __builtin_amdgcn_global_load_lds((const unsigned*)(ub + bb_ * 5632 + u.pn * BM + lane * 4), (PG8_LAS unsigned*)(xb + EX_BL + wid * 256), 16, 0, 0); }
    }
    __device__ __forceinline__ void operator()(f32x4 (&acc)[2][2][4][2], const UnitUp& u, int wr, int wc, int fr_in, int fq_in) const {
        int t_ = threadIdx.x; asm volatile("" : "+v"(t_)); const int fr = t_ & 15, fq = (t_ >> 4) & 3; (void)fr_in; (void)fq_in;
        const int lane = fq * 16 + fr;
        const int ccol = wc * 32 + 8 * fq;
        const int gc = u.pn * HALF + ccol;
        PG8_LAS float* CW = xb + EX_CW;
        unsigned rowflags;
        { unsigned pmask = 0u;
          const int a0 = u.arow < 0 ? 0 : u.arow, e0 = u.arow + 255;
          const int seam = (a0 >= MLAT_) ? (1 << 30) : (((a0 >> 11) + 1) << 11);
          const bool straddle = e0 >= seam;
          const PG8_LAS float* bl = xb + EX_BL + ccol;
          const f32x4 ug0 = *(const PG8_LAS f32x4*)(bl), ug1 = *(const PG8_LAS f32x4*)(bl + 4), uv0 = *(const PG8_LAS f32x4*)(bl + HALF), uv1 = *(const PG8_LAS f32x4*)(bl + HALF + 4);
#pragma unroll
          for (int ai = 0; ai < 2; ++ai)
#pragma unroll
            for (int m = 0; m < 4; ++m) { const int tr = ai * HALF + wr * 64 + m * 16 + fr; const int g = u.arow + tr;
                const int pos = g < MLAT_ ? (g & 2047) : ((g - MLAT_) & 255); const int last = g < MLAT_ ? 2047 : 255;
                if (pos == 0) pmask |= 1u << (4 * ai + m); if (pos == last) pmask |= 256u << (4 * ai + m);
                const f32x4 s4 = *(const PG8_LAS f32x4*)(xb + EX_SSX + tr * 16 + 4 * fq); float ssr = (s4[0] + s4[1]) + (s4[2] + s4[3]); ssr += __shfl_xor(ssr, 16); ssr += __shfl_xor(ssr, 32);
                const float rs = __builtin_amdgcn_rsqf(ssr * (1.0f / 1024.0f) + RMS_EPS);
                acc[ai][0][m][0] = acc[ai][0][m][0] * rs + ug0; acc[ai][0][m][1] = acc[ai][0][m][1] * rs + ug1;
                acc[ai][1][m][0] = acc[ai][1][m][0] * rs + uv0; acc[ai][1][m][1] = acc[ai][1][m][1] * rs + uv1; }
          if (straddle) {
              const f32x4 dg0 = *(const PG8_LAS f32x4*)(bl + 256) - ug0, dg1 = *(const PG8_LAS f32x4*)(bl + 260) - ug1, dv0 = *(const PG8_LAS f32x4*)(bl + 256 + HALF) - uv0, dv1 = *(const PG8_LAS f32x4*)(bl + 260 + HALF) - uv1;
#pragma unroll
              for (int ai = 0; ai < 2; ++ai)
#pragma unroll
                for (int m = 0; m < 4; ++m) { const int g = u.arow + ai * HALF + wr * 64 + m * 16 + fr; const float sel = (g >= seam) ? 1.0f : 0.0f;
                    acc[ai][0][m][0] += dg0 * sel; acc[ai][0][m][1] += dg1 * sel; acc[ai][1][m][0] += dv0 * sel; acc[ai][1][m][1] += dv1 * sel; } }
          rowflags = pmask; }
        PG8_LAS float* XF = xb + EX_XF; PG8_LAS float* XL = xb + EX_XL;
        const bool isF = (fr == 0), isL = (fr == 15);
#pragma unroll
        for (int ai = 0; ai < 2; ++ai) { const int blk = 2 * ai + wr;
            f32x4 s0, s1;
#pragma unroll
            for (int e = 0; e < 4; ++e) { s0[e] = isF ? acc[ai][0][0][0][e] : acc[ai][0][3][0][e]; s1[e] = isF ? acc[ai][0][0][1][e] : acc[ai][0][3][1][e]; }
            PG8_LAS float* dst = xb + (isF ? EX_XF : EX_XL) + blk * 128 + ccol;
            if (isF || isL) { *(PG8_LAS f32x4*)dst = s0; *(PG8_LAS f32x4*)(dst + 4) = s1; } }
        asm volatile("s_waitcnt lgkmcnt(0)" ::: "memory"); __builtin_amdgcn_s_barrier(); asm volatile("" ::: "memory");
        const int lup = (lane & 48) | ((lane - 1) & 15), ldn = (lane & 48) | ((lane + 1) & 15);
#pragma unroll
        for (int ai = 0; ai < 2; ++ai) { const int blk = 2 * ai + wr;
#pragma unroll
            for (int n = 0; n < 2; ++n) {
                const f32x4 w0 = *(const PG8_LAS f32x4*)(CW + ccol + 4 * n), w1 = *(const PG8_LAS f32x4*)(CW + 128 + ccol + 4 * n), w2 = *(const PG8_LAS f32x4*)(CW + 256 + ccol + 4 * n), bb = *(const PG8_LAS f32x4*)(CW + 384 + ccol + 4 * n);
                f32x4 xprev = (f32x4){0.f, 0.f, 0.f, 0.f}, xnext = (f32x4){0.f, 0.f, 0.f, 0.f};
                if (blk > 0) xprev = *(const PG8_LAS f32x4*)(XL + (blk - 1) * 128 + ccol + 4 * n);
                if (blk < 3) xnext = *(const PG8_LAS f32x4*)(XF + (blk + 1) * 128 + ccol + 4 * n);
#pragma unroll
                for (int e = 0; e < 4; ++e) {
                    float cur[4], up[4], dn[4];
#pragma unroll
                    for (int m = 0; m < 4; ++m) cur[m] = acc[ai][0][m][n][e];
#pragma unroll
                    for (int m = 0; m < 4; ++m) {
                        const float tu = isL ? (m > 0 ? cur[m > 0 ? m - 1 : 0] : xprev[e]) : cur[m];
                        const float td = isF ? (m < 3 ? cur[m < 3 ? m + 1 : 3] : xnext[e]) : cur[m];
                        up[m] = __shfl(tu, lup); dn[m] = __shfl(td, ldn); }
                    float rr[4];
#pragma unroll
                    for (int m = 0; m < 4; ++m) { const float upv = ((rowflags >> (4 * ai + m)) & 1u) ? 0.f : up[m], dnv = ((rowflags >> (8 + 4 * ai + m)) & 1u) ? 0.f : dn[m];
                        const float cv = w0[e] * upv + w1[e] * cur[m] + w2[e] * dnv + bb[e];
                        const float sg = cv * __builtin_amdgcn_rcpf(1.0f + __expf(-cv));
                        rr[m] = sg * acc[ai][1][m][n][e]; }
                    asm volatile("" : "+v"(rr[0]), "+v"(rr[1]), "+v"(rr[2]), "+v"(rr[3]));
#pragma unroll
                    for (int m = 0; m < 4; ++m) acc[ai][0][m][n][e] = rr[m];
                }
            }
#pragma unroll
            for (int m = 0; m < 4; ++m) { const int tr = ai * HALF + wr * 64 + m * 16 + fr; const int g = u.arow + tr;
                if (tr >= 1 && tr <= 254 && g < u.nrows) { const f32x4 v0 = acc[ai][0][m][0], v1 = acc[ai][0][m][1];
                    u32x4 w; w.x = cvt_pk_bf16(v0[0], v0[1]); w.y = cvt_pk_bf16(v0[2], v0[3]); w.z = cvt_pk_bf16(v1[0], v1[1]); w.w = cvt_pk_bf16(v1[2], v1[3]);
                    gst<u32x4>(act, ((unsigned)g * 2816u + (unsigned)gc) * 2u, w); } }
            asm volatile("" ::: "memory");
        }
        asm volatile("s_waitcnt lgkmcnt(0)" ::: "memory"); __builtin_amdgcn_s_barrier(); asm volatile("" ::: "memory");
    }
};
}
namespace att {
using bf16x8 = __attribute__((ext_vector_type(8))) short;
using s16x4  = __attribute__((ext_vector_type(4))) short;
using f32x16 = __attribute__((ext_vector_type(16))) float;
using u32x4  = __attribute__((ext_vector_type(4))) unsigned;
typedef unsigned short bf16_t;
constexpr int NW = 8, QBLK = 32, KVBLK = 64;
constexpr int LDQ = 768, LDK = 768, LDV = 512, LDO = 512;
constexpr float SCALE = 0.07216878364870322f;
constexpr float THR = 8.f;
constexpr int SHM_V = KVBLK * 128 * 2, SHM_K = KVBLK * 192 * 2;
constexpr int OFF_V = 0, OFF_K = 2 * SHM_V, OFF_WS = 2 * SHM_V + 2 * SHM_K, OFF_QR = OFF_WS + NW * 64 * 4, SHM_ATTN = OFF_QR + NW * 4096;
#define KSWZ(row, colB) ((row) * 384 + ((colB) ^ (((row) & 7) << 4)))
#define SBAR() __builtin_amdgcn_sched_barrier(0)
__device__ __forceinline__ int crow(int r, int hi) { return (r & 3) + 8 * (r >> 2) + 4 * hi; }
__device__ __forceinline__ unsigned cvtpk(float lo, float hi) { unsigned r; asm volatile("v_cvt_pk_bf16_f32 %0, %1, %2" : "=v"(r) : "v"(lo), "v"(hi)); return r; }

__device__ __forceinline__ void partialSM(f32x16& p0, f32x16& p1, float& m_reg, float& mn, float& alpha) {
  constexpr float C = SCALE * 1.4426950408889634f;
  float pmax = p0[0];
#pragma unroll
  for (int r = 1; r < 16; ++r) pmax = fmaxf(pmax, p0[r]);
#pragma unroll
  for (int r = 0; r < 16; ++r) pmax = fmaxf(pmax, p1[r]);
  { auto rr = __builtin_amdgcn_permlane32_swap(__float_as_uint(pmax), __float_as_uint(pmax), false, false);
    pmax = fmaxf(__uint_as_float(rr[0]), __uint_as_float(rr[1])); }
  if (__builtin_expect(__all(pmax - m_reg <= THR / SCALE), 1)) { mn = m_reg; alpha = 1.f; }
  else { mn = fmaxf(m_reg, pmax); alpha = __builtin_amdgcn_exp2f((m_reg - mn) * C); m_reg = mn; }
  float mnC = -mn * C;
#pragma unroll
  for (int r = 0; r < 16; ++r) p0[r] = fmaf(p0[r], C, mnC);
#pragma unroll
  for (int r = 0; r < 16; ++r) p1[r] = fmaf(p1[r], C, mnC);
#pragma unroll
  for (int r = 0; r < 16; ++r) p0[r] = __builtin_amdgcn_exp2f(p0[r]);
}
__device__ __forceinline__ void finishSM(f32x16& p0, f32x16& p1, float alpha, float& l_reg, bf16x8& pa0, bf16x8& pa1, bf16x8& pa2, bf16x8& pa3) {
#pragma unroll
  for (int r = 0; r < 16; ++r) p1[r] = __builtin_amdgcn_exp2f(p1[r]);
  float ps = 0;
#pragma unroll
  for (int r = 0; r < 16; ++r) ps += p0[r];
#pragma unroll
  for (int r = 0; r < 16; ++r) ps += p1[r];
  { auto rr = __builtin_amdgcn_permlane32_swap(__float_as_uint(ps), __float_as_uint(ps), false, false);
    ps = __uint_as_float(rr[0]) + __uint_as_float(rr[1]); }
  l_reg = l_reg * alpha + ps;
#define PK4(P, BASE, OUT) do { unsigned a0 = cvtpk(P[BASE + 0], P[BASE + 1]), a1 = cvtpk(P[BASE + 2], P[BASE + 3]);   \
    unsigned b0 = cvtpk(P[BASE + 4], P[BASE + 5]), b1 = cvtpk(P[BASE + 6], P[BASE + 7]);                              \
    auto r0 = __builtin_amdgcn_permlane32_swap(a0, b0, false, false); auto r1 = __builtin_amdgcn_permlane32_swap(a1, b1, false, false); \
    u32x4 w = {r0[0], r1[0], r0[1], r1[1]}; OUT = *reinterpret_cast<bf16x8*>(&w); } while (0)
  PK4(p0, 0, pa0); PK4(p0, 8, pa1); PK4(p1, 0, pa2); PK4(p1, 8, pa3);
#undef PK4
}
__device__ __forceinline__ void qkt(f32x16& p0, f32x16& p1, const char* Ks, const bf16x8* qr, const char* Qr, int r32, int hi) {
  p0 = f32x16{}; p1 = f32x16{};
#pragma unroll
  for (int d0 = 0; d0 < 12; ++d0) { int cb = (d0 * 16 + hi * 8) * 2;
    bf16x8 b0 = *reinterpret_cast<const bf16x8*>(Ks + KSWZ(r32, cb));
    bf16x8 b1 = *reinterpret_cast<const bf16x8*>(Ks + KSWZ(32 + r32, cb));
    bf16x8 q;
    if (d0 < 8) q = qr[d0];
    else q = *reinterpret_cast<const bf16x8*>(Qr + r32 * 128 + ((((d0 - 8) * 16 + hi * 8) * 2) ^ ((r32 & 7) << 4)));
    p0 = __builtin_amdgcn_mfma_f32_32x32x16_bf16(b0, q, p0, 0, 0, 0);
    p1 = __builtin_amdgcn_mfma_f32_32x32x16_bf16(b1, q, p1, 0, 0, 0); }
}
__device__ __forceinline__ int v_st(int k, int c) { const int kk = (k & ~0xC) | ((k & 4) << 1) | ((k & 8) >> 1); return ((kk >> 3) * 4 + (c >> 5)) * 512 + ((kk & 7) * 32 + (c & 31)) * 2; }
__device__ __forceinline__ int v_rd_base(int lane) { return ((lane & 3) << 3) | (((lane >> 2) & 3) << 6) | (((lane >> 4) & 1) << 5) | (((lane >> 5) & 1) << 8); }
constexpr int v_rd_off(int d0, int ks, int half) { return d0 * 512 + ks * 4096 + half * 2048; }
template <int OFF> __device__ __forceinline__ s16x4 tr_read(int vb) {
  s16x4 r; asm volatile("ds_read_b64_tr_b16 %0, %1 offset:%2" : "=&v"(r) : "v"(vb), "i"(OFF) : "memory"); return r;
}
template <int D0> __device__ __forceinline__ void pv_one(f32x16& od, int vb, bf16x8 pa0, bf16x8 pa1, bf16x8 pa2, bf16x8 pa3) {
  const s16x4 l0 = tr_read<v_rd_off(D0, 0, 0)>(vb), h0 = tr_read<v_rd_off(D0, 0, 1)>(vb), l1 = tr_read<v_rd_off(D0, 1, 0)>(vb), h1 = tr_read<v_rd_off(D0, 1, 1)>(vb);
  const s16x4 l2 = tr_read<v_rd_off(D0, 2, 0)>(vb), h2 = tr_read<v_rd_off(D0, 2, 1)>(vb), l3 = tr_read<v_rd_off(D0, 3, 0)>(vb), h3 = tr_read<v_rd_off(D0, 3, 1)>(vb);
  asm volatile("s_waitcnt lgkmcnt(0)" ::: "memory"); SBAR();
#define PK(L, H) (bf16x8){L[0], L[1], L[2], L[3], H[0], H[1], H[2], H[3]}
  od = __builtin_amdgcn_mfma_f32_32x32x16_bf16(pa0, PK(l0, h0), od, 0, 0, 0);
  od = __builtin_amdgcn_mfma_f32_32x32x16_bf16(pa1, PK(l1, h1), od, 0, 0, 0);
  od = __builtin_amdgcn_mfma_f32_32x32x16_bf16(pa2, PK(l2, h2), od, 0, 0, 0);
  od = __builtin_amdgcn_mfma_f32_32x32x16_bf16(pa3, PK(l3, h3), od, 0, 0, 0);
#undef PK
}
__device__ __forceinline__ void pv_d0(f32x16* o, int vb, bf16x8 pa0, bf16x8 pa1, bf16x8 pa2, bf16x8 pa3) {
  pv_one<0>(o[0], vb, pa0, pa1, pa2, pa3); pv_one<1>(o[1], vb, pa0, pa1, pa2, pa3); pv_one<2>(o[2], vb, pa0, pa1, pa2, pa3); pv_one<3>(o[3], vb, pa0, pa1, pa2, pa3);
}

__device__ __forceinline__ void attn_unit(const bf16_t* __restrict__ Qb, const bf16_t* __restrict__ Kg, const bf16_t* __restrict__ Vg, bf16_t* __restrict__ Ob,
                                          int r0, int n0, int r1, int NT, char* lds) {
  int tid = threadIdx.x; asm volatile("" : "+v"(tid));
  const int wid = tid >> 6, lane = tid & 63, r32 = lane & 31, hi = lane >> 5;
  char* V_lds = lds + OFF_V; char* K_lds = lds + OFF_K;
  float* ws = (float*)(lds + OFF_WS) + wid * 64; float* li_l = ws; float* al_l = ws + 32;
  float m_reg = -1e30f, l_reg = 0; f32x16 o[4] = {}; bf16x8 qr[8];
  const bf16_t* Qw = Qb + (long)(wid * QBLK + r32) * LDQ + hi * 8;
  char* Qr = lds + OFF_QR + wid * 4096;
#pragma unroll
  for (int d0 = 0; d0 < 8; ++d0) qr[d0] = *reinterpret_cast<const bf16x8*>(Qw + d0 * 16);
#pragma unroll
  for (int d0 = 8; d0 < 12; ++d0) { const bf16x8 q = *reinterpret_cast<const bf16x8*>(Qw + d0 * 16);
    *reinterpret_cast<bf16x8*>(Qr + r32 * 128 + ((((d0 - 8) * 16 + hi * 8) * 2) ^ ((r32 & 7) << 4))) = q; }
  const int sr = tid >> 4, sc = (tid & 15) * 8, vst0 = v_st(sr, sc), vst1 = v_st(32 + sr, sc);
  unsigned kgo[3], kst[3];
#pragma unroll
  for (int i = 0; i < 3; ++i) { const int id = tid + 512 * i, kr_ = id / 24, kc_ = id % 24; kgo[i] = (unsigned)(kr_ * LDK + kc_ * 8) * 2u; kst[i] = (unsigned)KSWZ(kr_, kc_ * 16); }
  const unsigned vgo0 = (unsigned)(sr * LDV + sc) * 2u, vgo1 = vgo0 + 32u * LDV * 2u;
  const int vb0 = (int)(uintptr_t)V_lds + v_rd_base(lane);
  bf16x8 vs0, vs1, ks0, ks1, ks2;
#define TROW(j) ((j) < n0 ? r0 + 64 * (j) : r1 + 64 * ((j) - n0))
#define SLOAD(j) do { const long tr_ = TROW(j); const char* Vt = (const char*)(Vg + tr_ * LDV); const char* Kt = (const char*)(Kg + tr_ * LDK);     \
    vs0 = *reinterpret_cast<const bf16x8*>(Vt + vgo0); vs1 = *reinterpret_cast<const bf16x8*>(Vt + vgo1); \
    ks0 = *reinterpret_cast<const bf16x8*>(Kt + kgo[0]); ks1 = *reinterpret_cast<const bf16x8*>(Kt + kgo[1]); ks2 = *reinterpret_cast<const bf16x8*>(Kt + kgo[2]); } while (0)
#define SWRITE(b) do { *(bf16x8*)(V_lds + (b) * SHM_V + vst0) = vs0; *(bf16x8*)(V_lds + (b) * SHM_V + vst1) = vs1; \
    *(bf16x8*)(K_lds + (b) * SHM_K + kst[0]) = ks0; *(bf16x8*)(K_lds + (b) * SHM_K + kst[1]) = ks1; *(bf16x8*)(K_lds + (b) * SHM_K + kst[2]) = ks2; } while (0)
#define RESC(a) do { if (__any((a) < 1.f)) { if (hi == 0) al_l[r32] = (a); asm volatile("s_waitcnt lgkmcnt(0)" ::: "memory"); \
    _Pragma("unroll") for (int d = 0; d < 4; ++d) _Pragma("unroll") for (int r = 0; r < 16; ++r) o[d][r] *= al_l[crow(r, hi)]; } } while (0)
  f32x16 pA0, pA1, pB0, pB1; float mnA, mnB, alA, alB; bf16x8 pa0, pa1, pa2, pa3;
  SLOAD(0); asm volatile("s_waitcnt vmcnt(0)" ::: "memory"); SWRITE(0); __syncthreads();
  qkt(pA0, pA1, K_lds, qr, Qr, r32, hi); partialSM(pA0, pA1, m_reg, mnA, alA);
  SLOAD(1);
  asm volatile("s_waitcnt vmcnt(0)" ::: "memory"); SWRITE(1); __syncthreads();
  for (int j = 1; j + 1 < NT; j += 2) {
    SBAR(); qkt(pB0, pB1, K_lds + SHM_K, qr, Qr, r32, hi);
    finishSM(pA0, pA1, alA, l_reg, pa0, pa1, pa2, pa3); SBAR();
    SLOAD(j + 1); SBAR();
    pv_d0(o, vb0, pa0, pa1, pa2, pa3); partialSM(pB0, pB1, m_reg, mnB, alB);
    __syncthreads(); asm volatile("s_waitcnt vmcnt(0)" ::: "memory"); SWRITE(0);
    RESC(alB); __syncthreads();
    SBAR(); qkt(pA0, pA1, K_lds, qr, Qr, r32, hi);
    finishSM(pB0, pB1, alB, l_reg, pa0, pa1, pa2, pa3); SBAR();
    SLOAD(j + 2); SBAR();
    pv_d0(o, vb0 + SHM_V, pa0, pa1, pa2, pa3); partialSM(pA0, pA1, m_reg, mnA, alA);
    __syncthreads(); asm volatile("s_waitcnt vmcnt(0)" ::: "memory"); SWRITE(1);
    RESC(alA); __syncthreads();
  }
  SBAR(); qkt(pB0, pB1, K_lds + SHM_K, qr, Qr, r32, hi);
  finishSM(pA0, pA1, alA, l_reg, pa0, pa1, pa2, pa3); SBAR();
  pv_d0(o, vb0, pa0, pa1, pa2, pa3); partialSM(pB0, pB1, m_reg, mnB, alB);
  __syncthreads(); RESC(alB);
  finishSM(pB0, pB1, alB, l_reg, pa0, pa1, pa2, pa3); SBAR();
  pv_d0(o, vb0 + SHM_V, pa0, pa1, pa2, pa3);
  if (hi == 0) li_l[r32] = l_reg; asm volatile("s_waitcnt lgkmcnt(0)" ::: "memory");
  float rli[16];
#pragma unroll
  for (int r = 0; r < 16; ++r) rli[r] = __builtin_amdgcn_rcpf(li_l[crow(r, hi)]);
  __syncthreads();
  { bf16_t* stg = (bf16_t*)(lds + wid * 8192);
#pragma unroll
    for (int r = 0; r < 16; ++r) { const int orow = crow(r, hi);
#pragma unroll
      for (int d0 = 0; d0 < 4; ++d0) { const unsigned pk = cvtpk(o[d0][r] * rli[r], 0.f); stg[orow * 128 + d0 * 32 + r32] = (bf16_t)(pk & 0xffffu); } }
    asm volatile("s_waitcnt lgkmcnt(0)" ::: "memory");
    bf16_t* Ow = Ob + (long)(wid * QBLK) * LDO;
#pragma unroll
    for (int i = 0; i < 8; ++i) { const int row = i * 4 + (lane >> 4), ch = lane & 15; const u32x4 v = *(const u32x4*)(stg + row * 128 + ch * 8); *(u32x4*)(Ow + (long)row * LDO + ch * 8) = v; } }
  __syncthreads();
#undef TROW
#undef SLOAD
#undef SWRITE
#undef RESC
}
#undef KSWZ
#undef SBAR
}
constexpr int NWAVES = 8;
#ifndef MK_SPLIT
#define MK_SPLIT 0
#endif

constexpr int DM = 1024, NB = 8, SL = 2048, CL = 256, MLAT = NB * SL, MCTX = NB * CL, MT = MLAT + MCTX;
constexpr int NIN = 2048;
constexpr int FF = 2816, NUP = 2 * FF;
constexpr int NPH = 20;
constexpr float EPS = 1e-6f;

constexpr size_t MiB = 1u << 20;
constexpr size_t WS_CTL = 0, CTL_ZERO_BYTES = 64 * 1024;
constexpr size_t WS_MOD = 1 * MiB;
constexpr size_t WS_ROPE = 1 * MiB + 512 * 1024;
constexpr size_t WS_SSQ = 2 * MiB;
constexpr size_t WS_WIN = 4 * MiB, WIN_STRIDE = (size_t)NIN * DM * 2;
constexpr size_t WS_WQKV = 12 * MiB, WQKV_STRIDE = (size_t)1792 * 384 * 2;
constexpr size_t WS_WOUT = 15 * MiB, WOUT_STRIDE = (size_t)DM * DM * 2;
constexpr size_t WS_WUP = 19 * MiB, WUP_STRIDE = (size_t)NUP * DM * 2;
constexpr size_t WS_WDOWN = 41 * MiB, WDOWN_STRIDE = (size_t)DM * FF * 2;
constexpr size_t WS_DFT = 52 * MiB;
constexpr size_t WS_DFTC = 68 * MiB;
constexpr size_t WS_CST = 68 * MiB + 256 * 1024;
constexpr size_t WS_WF = 248 * MiB;
constexpr size_t WS_XCTX = 69 * MiB;
constexpr size_t WS_XN = 77 * MiB;
constexpr size_t WS_Q = WS_XN, WS_YC = WS_XN + 27 * MiB;
constexpr size_t WS_P = 113 * MiB;
constexpr size_t WS_YCAT = WS_P, WS_ACT = WS_P;
constexpr size_t WS_YFP = WS_P + 36 * MiB;
constexpr size_t WS_K = 185 * MiB;
constexpr size_t WS_V = 212 * MiB;
constexpr size_t WS_CPART = 212 * MiB;
constexpr size_t WS_ZT = 230 * MiB;
constexpr size_t WS_ZTC = WS_ZT + 16 * MiB;
constexpr size_t WS_YF = WS_ZT;
constexpr size_t WS_FTAB = WS_DFT;
constexpr size_t OUT_ATT = 36 * MiB;
constexpr size_t WS_SSX = 250 * MiB;
constexpr size_t WS_PB = 252 * MiB;
constexpr size_t WS_UB = 253 * MiB;
constexpr size_t WS_END = 254 * MiB;
static_assert(WS_WQKV + 2 * WQKV_STRIDE <= WS_WOUT && WS_WOUT + 2 * WOUT_STRIDE <= WS_WUP && WS_WUP + 2 * WUP_STRIDE <= WS_WDOWN && WS_WDOWN + 2 * WDOWN_STRIDE <= WS_DFT, "weights map");
static_assert(WS_SSQ + (size_t)MT * 80 <= WS_WIN && WS_XN + (size_t)MT * DM * 2 <= WS_P && WS_P + (size_t)MT * NIN * 2 <= WS_K && WS_K + (size_t)MT * 768 * 2 <= WS_V && WS_V + (size_t)MT * 512 * 2 <= WS_ZT, "activation map");
static_assert(WS_ACT + (size_t)MT * FF * 2 <= WS_V && WS_YC + (size_t)MT * 256 * 2 <= WS_P, "overlay map");
constexpr int CW_BAR = 4096;

constexpr int RING_OFF = 0, RING_BYTES = 131072;
constexpr int LDSCTL_OFF = RING_BYTES, MISC_OFF = LDSCTL_OFF + 320, PTR_OFF = LDSCTL_OFF + 512, EPIX_OFF = LDSCTL_OFF + 1024;
constexpr int LDS_BYTES = 163840;
static_assert(EPIX_OFF + 6400 * 4 <= LDS_BYTES, "LDS map");

#define GAS __attribute__((address_space(1)))
#define LAS __attribute__((address_space(3)))
typedef unsigned short bf16;
typedef unsigned v4u __attribute__((ext_vector_type(4)));
typedef unsigned v2u __attribute__((ext_vector_type(2)));
typedef float f32x4 __attribute__((ext_vector_type(4)));
typedef GAS unsigned gu32;
#define RLX_AGENT __ATOMIC_RELAXED, __HIP_MEMORY_SCOPE_AGENT
#define LDS_WAIT() asm volatile("s_waitcnt lgkmcnt(0)" ::: "memory")
#define VM_WAIT() asm volatile("s_waitcnt vmcnt(0)" ::: "memory")
__device__ __forceinline__ unsigned f2bf(float f) { unsigned u = __builtin_bit_cast(unsigned, f); return (u + 0x7fffu + ((u >> 16) & 1u)) >> 16; }
__device__ __forceinline__ unsigned pk2(float lo, float hi) { return f2bf(lo) | (f2bf(hi) << 16); }
__device__ __forceinline__ float bf2f(unsigned h) { return __builtin_bit_cast(float, h << 16); }

#define XB_TMO      128
#define XB_XCNT(j)  (256  + 64 * (j))
#define XB_XSUB(j)  (1280 + 64 * (j))
#define XB_XGEN(j)  (2304 + 64 * (j))
#define XB_TOP      3328
#define XB_TOPGEN   3392
#define XCD_BAR_WORDS 3456
#define XB_SPIN_CAP (1u << 20)
__device__ __forceinline__ unsigned xb_ld(unsigned* p)              { return __hip_atomic_load(p, __ATOMIC_RELAXED, __HIP_MEMORY_SCOPE_AGENT); }
__device__ __forceinline__ unsigned xb_add(unsigned* p, unsigned v) { return __hip_atomic_fetch_add(p, v, __ATOMIC_RELAXED, __HIP_MEMORY_SCOPE_AGENT); }
__device__ __forceinline__ unsigned xb_xcc_id() { return (unsigned)__builtin_amdgcn_s_getreg((3 << 11) | 20) & 0xFu; }
#define XB_SPIN(cond, bar) do { unsigned _sp = 0; while (cond) { __builtin_amdgcn_s_sleep(1); \
    if ((++_sp & 255u) == 0u) { if (xb_ld(&(bar)[XB_TMO])) break; if (_sp > XB_SPIN_CAP) { atomicAdd(&(bar)[XB_TMO], 1u); break; } } } } while (0)
struct XcdBarrier { unsigned* bar; unsigned x; volatile LAS unsigned* st; };
__device__ __forceinline__ XcdBarrier xcd_barrier_post(unsigned* bar, volatile LAS unsigned* st) {
    XcdBarrier b; b.bar = bar; b.x = xb_xcc_id(); b.st = st;
    if (threadIdx.x == 0) (void)xb_add(&bar[XB_XCNT(b.x)], 1u);
    return b;
}
__device__ __forceinline__ void xcd_barrier_complete(unsigned* bar, unsigned x, unsigned& nloc, unsigned& nx) {
    const unsigned G = gridDim.x * gridDim.y * gridDim.z;
    unsigned sum, cnt, mine, sp = 0u;
    for (;;) {
        sum = 0u; cnt = 0u; mine = 0u;
#pragma unroll
        for (unsigned j = 0; j < 16; ++j) { const unsigned c = xb_ld(&bar[XB_XCNT(j)]); sum += c; cnt += (c > 0u) ? 1u : 0u; mine = (j == x) ? c : mine; }
        if (sum == G) break;
        __builtin_amdgcn_s_sleep(1);
        if ((++sp & 255u) == 0u) { if (xb_ld(&bar[XB_TMO])) break; if (sp > XB_SPIN_CAP) { atomicAdd(&bar[XB_TMO], 1u); break; } }
    }
    nloc = mine > 0u ? mine : 1u; nx = cnt > 0u ? cnt : 1u;
}
__device__ __forceinline__ void xcd_barrier(const XcdBarrier& b) {
    asm volatile("s_waitcnt vmcnt(0)" ::: "memory");
    __syncthreads();
    if (threadIdx.x == 0) {
        unsigned* bar = b.bar;
        __builtin_amdgcn_s_waitcnt(0);
        unsigned nloc = b.st[0], nx = b.st[1];
        if (nloc == 0u) { xcd_barrier_complete(bar, b.x, nloc, nx); b.st[0] = nloc; b.st[1] = nx; }
        const unsigned old = xb_add(&bar[XB_XSUB(b.x)], 1u);
        const unsigned gen = old / nloc;
        if (old + 1u == (gen + 1u) * nloc) {
            __builtin_amdgcn_fence(__ATOMIC_RELEASE, "agent");
            asm volatile("s_waitcnt vmcnt(0)" ::: "memory");
            const unsigned og = xb_add(&bar[XB_TOP], 1u);
            const unsigned tg = og / nx;
            if (og + 1u == (tg + 1u) * nx) xb_add(&bar[XB_TOPGEN], 1u);
            else XB_SPIN(xb_ld(&bar[XB_TOPGEN]) == tg, bar);
            __builtin_amdgcn_fence(__ATOMIC_ACQUIRE, "agent");
            xb_add(&bar[XB_XGEN(b.x)], 1u);
            asm volatile("s_waitcnt vmcnt(0)" ::: "memory");
        } else {
            XB_SPIN(xb_ld(&bar[XB_XGEN(b.x)]) == gen, bar);
            __builtin_amdgcn_fence(__ATOMIC_ACQUIRE, "agent");
            asm volatile("s_waitcnt vmcnt(0)" ::: "memory");
        }
    }
    __syncthreads();
}

struct Args { const float* in[22]; float* out; unsigned char* ws; int ph_lo, ph_hi; };
enum { I_X = 0, I_C, I_CTX, I_CCTX, I_ADAW, I_ADAB, I_N1G, I_WIN, I_QNG, I_KVNG, I_WUQ, I_WUKV, I_SCW, I_SCB, I_ONG, I_WOUT, I_N2G, I_WUP, I_FCW, I_FCB, I_WDOWN, I_FING };

struct Frame {
    LAS unsigned char* lds; char* ldsg;
    volatile LAS unsigned* MISC;
    int tid, lane, wave, vcu, G, bx;
    unsigned char* ws; float* out;
};

__device__ __forceinline__ const float* inptr(const Frame& F, int i) {
    const LAS unsigned* T = (const LAS unsigned*)(F.lds + PTR_OFF) + 2 * i;
    const unsigned lo = __builtin_amdgcn_readfirstlane(T[0]), hi = __builtin_amdgcn_readfirstlane(T[1]);
    return (const float*)(const GAS float*)(((unsigned long long)hi << 32) | (unsigned long long)lo);
}
__device__ __forceinline__ float wave_sum(float v) {
#pragma unroll
    for (int o = 1; o < 64; o <<= 1) v += __shfl_xor(v, o);
    return v;
}

__device__ __host__ __forceinline__ int rope_slot(int d) { return 8 * ((d & 15) >> 2) + 4 * (d >> 4) + (d & 3); }
__device__ __forceinline__ void tr_item(const float* W, int ldw, int k0, int c0, bf16* WT, int ldt, int r0, const float* ks, LAS float* scr, int lane, bool ropeperm = false) {
    f32x4 v[8];
#pragma unroll
    for (int i = 0; i < 8; ++i) { const int kk = 8 * i + (lane >> 3); v[i] = *(const GAS f32x4*)(W + (size_t)(k0 + kk) * ldw + c0 + 4 * (lane & 7)); }
#pragma unroll
    for (int i = 0; i < 8; ++i) { const int kk = 8 * i + (lane >> 3); const float sc = ks ? ks[k0 + kk] : 1.0f; LAS float* d = scr + kk * 33 + 4 * (lane & 7);
        d[0] = v[i][0] * sc; d[1] = v[i][1] * sc; d[2] = v[i][2] * sc; d[3] = v[i][3] * sc; }
    LDS_WAIT(); asm volatile("" ::: "memory");
    const int c = lane & 7;
#pragma unroll
    for (int j = 0; j < 4; ++j) { const int n = (lane >> 3) + 8 * j; const LAS float* s = scr + (8 * c) * 33 + n;
        v4u o; o.x = pk2(s[0 * 33], s[1 * 33]); o.y = pk2(s[2 * 33], s[3 * 33]); o.z = pk2(s[4 * 33], s[5 * 33]); o.w = pk2(s[6 * 33], s[7 * 33]);
        *(GAS v4u*)(WT + (size_t)(r0 + (ropeperm ? rope_slot(n) : n)) * ldt + k0 + 8 * c) = o; }
    LDS_WAIT(); asm volatile("" ::: "memory");
}
__device__ __forceinline__ void p0_prologue(Frame& F, int sub, int defer, int gw, int NGW) {
    unsigned char* ws = F.ws;
    float* MOD = (float*)(ws + WS_MOD);
    if (F.bx < 192 && (sub & 1) && defer == 0) {
        const int l = F.bx / 96, cb = F.bx % 96;
        LAS float* S = (LAS float*)(F.lds + F.wave * 4608);
        const float* cin = inptr(F, I_C); const float* cctx = inptr(F, I_CCTX);
        for (int i = F.lane; i < 9 * 128; i += 64) { const int r = i >> 7, kk = i & 127, k = 128 * F.wave + kk; const float cv = (r < 8) ? cin[r * 1024 + k] : cctx[k]; S[i] = cv / (1.0f + __expf(-cv)); }
        LDS_WAIT(); asm volatile("" ::: "memory");
        f32x4 acc[9];
#pragma unroll
        for (int r = 0; r < 9; ++r) acc[r] = (f32x4){0.f, 0.f, 0.f, 0.f};
        const int kr = F.lane >> 4, cl = F.lane & 15;
        const float* W = inptr(F, I_ADAW) + (size_t)l * 1024 * 6144 + (size_t)(128 * F.wave) * 6144 + 64 * cb + 4 * cl;
#pragma unroll 8
        for (int i = 0; i < 32; ++i) { const int kk = 4 * i + kr; const f32x4 w = *(const f32x4*)(W + (size_t)kk * 6144);
#pragma unroll
            for (int r = 0; r < 9; ++r) acc[r] += w * S[r * 128 + kk]; }
        LAS float* RED = (LAS float*)(F.lds + 40960);
#pragma unroll
        for (int r = 0; r < 9; ++r)
#pragma unroll
            for (int e = 0; e < 4; ++e) { float v = acc[r][e]; v += __shfl_xor(v, 16); v += __shfl_xor(v, 32); if (kr == 0) RED[(F.wave * 9 + r) * 64 + 4 * cl + e] = v; }
        __syncthreads();
        for (int i = F.tid; i < 576; i += 512) { const int r = i >> 6, col = i & 63; float s = 0.f;
#pragma unroll
            for (int w = 0; w < 8; ++w) s += RED[(w * 9 + r) * 64 + col];
            MOD[(size_t)(l * 9 + r) * 6144 + 64 * cb + col] = s + inptr(F, I_ADAB)[l * 6144 + 64 * cb + col]; }
        __syncthreads();
    }
    if (F.bx == 255 % F.G && defer == 0) {
        float* RC = (float*)(ws + WS_ROPE); float* RS = RC + 1024;
        for (int idx = F.tid; idx < 1024; idx += 512) { const int pos = idx >> 4, i = idx & 15; const float inv = powf(10000.0f, -(float)(2 * i) / 32.0f); const float ang = (float)pos * inv; RC[idx] = cosf(ang); RS[idx] = sinf(ang); }
    }
    LAS float* scr = (LAS float*)(F.lds + F.wave * 16384);
    constexpr int I_WINA = 22 * 16, I_WINB = 24 * 16, I_PAD = 8, I_FOLD = 64, I_UQ = 6 * 24, I_UKV = 4 * 32, I_OUT = 16 * 32, I_UP = 16 * 176, I_DOWN = 44 * 32;
    constexpr int PER_LAYER = I_WINA + I_WINB + I_PAD + I_FOLD + I_UQ + I_UKV + I_OUT + I_UP + I_DOWN;
    constexpr int I_DFT = 224, I_DFTC = 256, I_CST = 512;
    constexpr int NITEMS = 2 * PER_LAYER + I_DFT + I_DFTC + I_CST;
    for (int it = gw; it < NITEMS; it += NGW) {
        int r = it;
        { int cat = 2; if (r < 2 * PER_LAYER) { const int q = r % PER_LAYER;
              cat = q < I_WINA + I_WINB + I_PAD ? 1 : q < I_WINA + I_WINB + I_PAD + I_FOLD ? 3 : q < I_WINA + I_WINB + I_PAD + I_FOLD + I_UQ + I_UKV + I_OUT ? 4 : q < PER_LAYER - I_DOWN ? 5 : 6; }
          if (!((sub >> cat) & 1)) continue;
          const int dcls = (r < 2 * PER_LAYER && cat >= 4) ? (r < PER_LAYER ? 1 : 2) : 0; if (dcls != defer) continue; }
        if (r < 2 * PER_LAYER) {
            const int l = r / PER_LAYER; r -= l * PER_LAYER;
            bf16* WinT = (bf16*)(ws + WS_WIN + l * WIN_STRIDE);
            const float* win = inptr(F, I_WIN) + (size_t)l * 1024 * 1728;
            if (r < I_WINA) { const int kb = r / 22, nb = r % 22; tr_item(win, 1728, 64 * kb, 32 * nb, WinT, 1024, 32 * nb, nullptr, scr, F.lane); continue; } r -= I_WINA;
            if (r < I_WINB) { const int kb = r / 24, nb = r % 24; tr_item(win, 1728, 64 * kb, 960 + 32 * nb, WinT, 1024, 1280 + 32 * nb, nullptr, scr, F.lane); continue; } r -= I_WINB;
            if (r < I_PAD) { const v4u z = {0u, 0u, 0u, 0u};
#pragma unroll
                for (int j = 0; j < 16; ++j) { const int q = j * 64 + F.lane; *(GAS v4u*)(WinT + (size_t)(704 + 8 * r + (q >> 7)) * 1024 + (q & 127) * 8) = z; } continue; } r -= I_PAD;
            if (r < I_FOLD) { bf16* WF = (bf16*)(ws + WS_WF) + (size_t)l * 1024 * 256;
#pragma unroll 4
                for (int i = 0; i < 16; ++i) { const int k = 16 * r + i; const f32x4 v = *(const GAS f32x4*)(win + (size_t)k * 1728 + 704 + 4 * F.lane);
                    v2u o; o.x = pk2(v[0], v[1]); o.y = pk2(v[2], v[3]); *(GAS v2u*)(WF + (size_t)k * 256 + 4 * F.lane) = o; } continue; } r -= I_FOLD;
            if (r < I_UQ) { const int kb = r / 24, nb = r % 24; tr_item(inptr(F, I_WUQ) + (size_t)l * 384 * 768, 768, 64 * kb, 32 * nb, (bf16*)(ws + WS_WQKV + l * WQKV_STRIDE), 384, 32 * nb, inptr(F, I_QNG) + l * 384, scr, F.lane, (nb % 6) >= 4); continue; } r -= I_UQ;
            if (r < I_UKV) { const int kb = r / 32, nb = r % 32; tr_item(inptr(F, I_WUKV) + (size_t)l * 256 * 1024, 1024, 64 * kb, 32 * nb, (bf16*)(ws + WS_WQKV + l * WQKV_STRIDE) + (size_t)768 * 384, 384, 32 * nb, inptr(F, I_KVNG) + l * 256, scr, F.lane); continue; } r -= I_UKV;
            if (r < I_OUT) { const int kb = r / 32, nb = r % 32; tr_item(inptr(F, I_WOUT) + (size_t)l * 1024 * 1024, 1024, 64 * kb, 32 * nb, (bf16*)(ws + WS_WOUT + l * WOUT_STRIDE), 1024, 32 * nb, inptr(F, I_ONG) + l * 1024, scr, F.lane); continue; } r -= I_OUT;
            if (r < I_UP) { const int kb = r / 176, nb = r % 176;
                const int j = nb >> 3, h = (nb >> 2) & 1, q = nb & 3;
                tr_item(inptr(F, I_WUP) + (size_t)l * 1024 * NUP, NUP, 64 * kb, h * FF + 128 * j + 32 * q, (bf16*)(ws + WS_WUP + l * WUP_STRIDE), 1024, 32 * nb, nullptr, scr, F.lane); continue; } r -= I_UP;
            { const int kb = r / 32, nb = r % 32; tr_item(inptr(F, I_WDOWN) + (size_t)l * FF * 1024, 1024, 64 * kb, 32 * nb, (bf16*)(ws + WS_WDOWN + l * WDOWN_STRIDE), FF, 32 * nb, nullptr, scr, F.lane); continue; }
        }
        r -= 2 * PER_LAYER;
        if (r < I_DFT) {
            if (r < 128) { const int ro = r >> 6, c = r & 63; bf16* D = (bf16*)(ws + WS_FTAB) + (size_t)r * 128; float v[2];
#pragma unroll
                for (int e = 0; e < 2; ++e) { const int k = 2 * F.lane + e, ri = k >> 6, s = k & 63; const float x = (float)((c * s) & 63) * (1.0f / 32.0f); const float C = cospif(x), S = sinpif(x);
                    v[e] = (ro == ri) ? C : (ro == 0 ? -S : S); }
                *(GAS unsigned*)(D + 2 * F.lane) = pk2(v[0], v[1]); continue; }
            if (r < 160) { const int a = r - 128, ro = F.lane >> 5, rr = F.lane & 31; const float x = (float)((a * rr) & 31) * (1.0f / 16.0f); const float v = ro ? -sinpif(x) : cospif(x);
                *(GAS unsigned short*)((bf16*)(ws + WS_FTAB + 32768) + (size_t)a * 64 + F.lane) = (unsigned short)(pk2(v, 0.f) & 0xffffu); continue; }
            { const int c = r - 160; if (F.lane < 32) { const float x = (float)(c * F.lane) * (1.0f / 1024.0f); pg8::f32x2 t; t.x = cospif(x); t.y = sinpif(x);
                *(GAS pg8::f32x2*)((float*)(ws + WS_FTAB + 40960) + (size_t)(c * 32 + F.lane) * 2) = t; } }
            continue; }
        r -= I_DFT;
        if (r >= I_DFTC) { r -= I_DFTC;
            const int sn = r >> 8, g = (r >> 6) & 3, k2 = r & 63; float v[4];
#pragma unroll
            for (int e = 0; e < 4; ++e) { const int j = 4 * F.lane + e; const float x = (float)((k2 * (j & 63)) & 63) * (1.0f / 32.0f); v[e] = ((j >> 6) == g) ? (sn ? sinpif(x) : cospif(x)) : 0.0f; }
            v2u o; o.x = pk2(v[0], v[1]); o.y = pk2(v[2], v[3]); *(GAS v2u*)((bf16*)(ws + WS_CST) + (size_t)r * 256 + 4 * F.lane) = o; continue; }
        { const int k1 = r; bf16* D = (bf16*)(ws + WS_DFTC) + (size_t)k1 * 512; const int n0 = 8 * F.lane; float v[8];
#pragma unroll
            for (int e = 0; e < 8; ++e) { const int n = n0 + e, n1 = n & 255; const float x = (float)((k1 * n1) & 255) * (1.0f / 128.0f); v[e] = (n < 256) ? cospif(x) : -sinpif(x); }
            v4u o; o.x = pk2(v[0], v[1]); o.y = pk2(v[2], v[3]); o.z = pk2(v[4], v[5]); o.w = pk2(v[6], v[7]); *(GAS v4u*)(D + n0) = o; }
    }
}

__device__ __forceinline__ void bias_item(const bf16* WT, int n, const float* mod  , int shofs, float* out, int N, int lane) {
    const v4u w0 = *(const GAS v4u*)(WT + (size_t)n * 1024 + 16 * lane), w1 = *(const GAS v4u*)(WT + (size_t)n * 1024 + 16 * lane + 8);
    float wv[16];
    wv[0] = bf2f(w0.x & 0xffffu); wv[1] = bf2f(w0.x >> 16); wv[2] = bf2f(w0.y & 0xffffu); wv[3] = bf2f(w0.y >> 16); wv[4] = bf2f(w0.z & 0xffffu); wv[5] = bf2f(w0.z >> 16); wv[6] = bf2f(w0.w & 0xffffu); wv[7] = bf2f(w0.w >> 16);
    wv[8] = bf2f(w1.x & 0xffffu); wv[9] = bf2f(w1.x >> 16); wv[10] = bf2f(w1.y & 0xffffu); wv[11] = bf2f(w1.y >> 16); wv[12] = bf2f(w1.z & 0xffffu); wv[13] = bf2f(w1.z >> 16); wv[14] = bf2f(w1.w & 0xffffu); wv[15] = bf2f(w1.w >> 16);
    for (int b = 0; b < 9; ++b) { const float* sh = mod + b * 6144 + shofs + 16 * lane; float a = 0.f;
#pragma unroll
        for (int q = 0; q < 4; ++q) { const f32x4 s = *(const f32x4*)(sh + 4 * q); a += (s[0] * wv[4 * q] + s[1] * wv[4 * q + 1]) + (s[2] * wv[4 * q + 2] + s[3] * wv[4 * q + 3]); }
        a = wave_sum(a); if (lane == 0) out[(size_t)b * N + n] = a; }
}
__device__ __forceinline__ void bias_phase(Frame& F, int which, int gw, int NGW) {
    const float* MODp = (const float*)(F.ws + WS_MOD);
    for (int it = gw; it < 2048 + 2 * 5632; it += NGW) {
        if (!((which >> (it < 2048 ? 0 : it < 2048 + 5632 ? 1 : 2)) & 1)) continue;
        if (it < 2048) bias_item((const bf16*)(F.ws + WS_WIN + WIN_STRIDE), it, MODp + 9 * 6144, 0, (float*)(F.ws + WS_PB) + 9 * 2048, 2048, F.lane);
        else { const int q = it - 2048, l = q / 5632, n = q % 5632; bias_item((const bf16*)(F.ws + WS_WUP + l * WUP_STRIDE), n, MODp + l * 9 * 6144, 3072, (float*)(F.ws + WS_UB) + (size_t)l * 9 * 5632, 5632, F.lane); }
    }
}

__device__ __forceinline__ void norm_mod_phase(Frame& F, const float* src_lat, const float* src_ctx, int nrows, const float* g, const float* mod  , int shofs, int scofs, int skip) {
    bf16* XN = (bf16*)(F.ws + WS_XN);
    if (F.bx < skip) return;
    const int gw = (F.bx - skip) * NWAVES + F.wave, NGW = (F.G - skip) * NWAVES;
    constexpr int R = 2;
    f32x4 v[R][4], w[R][4];
#define NM_LOAD(dst, r0_) do { _Pragma("unroll") for (int q = 0; q < R; ++q) { const int row = (r0_) + q * NGW; if (row < nrows) { const float* xr = row < MLAT ? src_lat + (size_t)row * DM : src_ctx + (size_t)(row - MLAT) * DM; \
        _Pragma("unroll") for (int j = 0; j < 4; ++j) dst[q][j] = *(const f32x4*)(xr + 256 * j + 4 * F.lane); } } } while (0)
    NM_LOAD(v, gw);
    for (int row0 = gw; row0 < nrows; row0 += R * NGW) {
        NM_LOAD(w, row0 + R * NGW);
#pragma unroll
        for (int q = 0; q < R; ++q) { const int row = row0 + q * NGW; if (row < nrows) {
            const int r = row < MLAT ? (row >> 11) : 8;
            const float* sh = mod + r * 6144 + shofs; const float* sc = mod + r * 6144 + scofs; float ss = 0.f;
#pragma unroll
            for (int j = 0; j < 4; ++j) ss += (v[q][j][0] * v[q][j][0] + v[q][j][1] * v[q][j][1]) + (v[q][j][2] * v[q][j][2] + v[q][j][3] * v[q][j][3]);
            const float rstd = 1.0f / sqrtf(wave_sum(ss) * (1.0f / DM) + EPS);
#pragma unroll
            for (int j = 0; j < 4; ++j) { const int c = 256 * j + 4 * F.lane; const f32x4 gg = *(const f32x4*)(g + c), s1 = *(const f32x4*)(sc + c), s0 = *(const f32x4*)(sh + c);
                const f32x4 h = (v[q][j] * rstd) * gg * (s1 + 1.0f) + s0;
                v2u o; o.x = pk2(h[0], h[1]); o.y = pk2(h[2], h[3]); *(GAS v2u*)(XN + (size_t)row * DM + c) = o; } } }
#pragma unroll
        for (int q = 0; q < R; ++q)
#pragma unroll
            for (int j = 0; j < 4; ++j) v[q][j] = w[q][j];
    }
#undef NM_LOAD
}
__device__ __forceinline__ void qkv_rows_phase(Frame& F, int l) {
    const bf16* P = (const bf16*)(F.ws + WS_P); bf16* Kb = (bf16*)(F.ws + WS_K); bf16* YC = (bf16*)F.out + (size_t)MT * 768;
    const float* RC = (const float*)(F.ws + WS_ROPE); const float* RS = RC + 1024;
    const float* scw = inptr(F, I_SCW) + l * 3 * 256; const float* scb = inptr(F, I_SCB) + l * 256;
    const int gw = F.vcu * NWAVES + F.wave, NGW = F.G * NWAVES;
    const int nrows_conv = (l == 0) ? MT : MLAT;
    for (int row = gw; row < MT; row += NGW) {
        const bool lat = row < MLAT; const int t = lat ? (row & 2047) : ((row - MLAT) & 255); const int L = lat ? SL : CL;
        const bf16* pr = P + (size_t)row * NIN;
        { const float v = bf2f(pr[640 + F.lane]); const float pv = __shfl_xor(v, 16); float o = v;
          if (lat) { const int j = F.lane, ax = j >> 5, i = j & 15, x2 = (j >> 4) & 1; const int pos = ax ? (t & 63) : (t >> 6); const float c = RC[pos * 16 + i], s = RS[pos * 16 + i];
              o = x2 ? (pv * s + v * c) : (v * c - pv * s); }
          const bf16 ob = (bf16)f2bf(o);
          const int slot = (F.lane & 32) + rope_slot(F.lane & 31);
#pragma unroll
          for (int h = 0; h < 4; ++h) Kb[(size_t)row * 768 + 192 * h + 128 + slot] = ob; }
        if (row < nrows_conv) { const int c = 4 * F.lane;
            const v2u bgv = *(const GAS v2u*)(pr + 1280 + c);
            const v2u cg1 = *(const GAS v2u*)(pr + 1536 + c), xv1 = *(const GAS v2u*)(pr + 1792 + c);
            v2u cg0 = {0u, 0u}, xv0 = {0u, 0u}, cg2 = {0u, 0u}, xv2 = {0u, 0u};
            if (t > 0) { cg0 = *(const GAS v2u*)(pr - NIN + 1536 + c); xv0 = *(const GAS v2u*)(pr - NIN + 1792 + c); }
            if (t < L - 1) { cg2 = *(const GAS v2u*)(pr + NIN + 1536 + c); xv2 = *(const GAS v2u*)(pr + NIN + 1792 + c); }
            const f32x4 w0 = *(const f32x4*)(scw + c), w1 = *(const f32x4*)(scw + 256 + c), w2 = *(const f32x4*)(scw + 512 + c), bb = *(const f32x4*)(scb + c);
            float y[4];
#pragma unroll
            for (int e = 0; e < 4; ++e) { const unsigned sh = (e & 1) * 16; const unsigned m = 0xffffu;
                const unsigned b_ = ((e < 2 ? bgv.x : bgv.y) >> sh) & m;
                const unsigned c0_ = ((e < 2 ? cg0.x : cg0.y) >> sh) & m, x0_ = ((e < 2 ? xv0.x : xv0.y) >> sh) & m;
                const unsigned c1_ = ((e < 2 ? cg1.x : cg1.y) >> sh) & m, x1_ = ((e < 2 ? xv1.x : xv1.y) >> sh) & m;
                const unsigned c2_ = ((e < 2 ? cg2.x : cg2.y) >> sh) & m, x2_ = ((e < 2 ? xv2.x : xv2.y) >> sh) & m;
                const float u0 = bf2f(c0_) * bf2f(x0_), u1 = bf2f(c1_) * bf2f(x1_), u2 = bf2f(c2_) * bf2f(x2_);
                y[e] = bf2f(b_) * (w0[e] * u0 + w1[e] * u1 + w2[e] * u2 + bb[e]); }
            v2u o; o.x = pk2(y[0], y[1]); o.y = pk2(y[2], y[3]); *(GAS v2u*)(YC + (size_t)row * 256 + c) = o; }
    }
}
__device__ __forceinline__ void fnet_fft_unit(Frame& F, int b, int jb) {
    int tid = threadIdx.x; asm volatile("" : "+v"(tid));
    const int w = tid >> 6, l = tid & 63, l15 = l & 15, lq = l >> 4;
    const bf16* P = (const bf16*)(F.ws + WS_P); bf16* YF = (bf16*)(F.ws + WS_YF);
    const bf16* A1g = (const bf16*)(F.ws + WS_FTAB); const bf16* W2g = (const bf16*)(F.ws + WS_FTAB + 32768); const float* TWg = (const float*)(F.ws + WS_FTAB + 40960);
    LAS unsigned char* B1 = F.lds; LAS unsigned char* A1 = F.lds + 69632;
#pragma unroll
    for (int i = 0; i < 4; ++i) { const int idx = tid + 512 * i, row = idx >> 4, ch = idx & 15; const v4u v = *(const GAS v4u*)(A1g + row * 128 + ch * 8); *(LAS v4u*)(A1 + row * 272 + ch * 16) = v; }
    { v4u z[8];
#pragma unroll
      for (int it = 0; it < 8; ++it) { const int pr = w * 8 + it, r = pr >> 1, ri = pr & 1; z[it] = *(const GAS v4u*)(P + (size_t)(b * SL + r + 32 * l) * NIN + 768 + ri * 256 + jb * 8); }
#pragma unroll
      for (int it = 0; it < 8; ++it) { const int pr = w * 8 + it, r = pr >> 1, ri = pr & 1; LAS unsigned char* d = B1 + (r * 8) * 272 + (ri * 64 + l) * 2;
          *(LAS unsigned short*)(d + 0 * 272) = (unsigned short)(z[it].x & 0xffffu); *(LAS unsigned short*)(d + 1 * 272) = (unsigned short)(z[it].x >> 16);
          *(LAS unsigned short*)(d + 2 * 272) = (unsigned short)(z[it].y & 0xffffu); *(LAS unsigned short*)(d + 3 * 272) = (unsigned short)(z[it].y >> 16);
          *(LAS unsigned short*)(d + 4 * 272) = (unsigned short)(z[it].z & 0xffffu); *(LAS unsigned short*)(d + 5 * 272) = (unsigned short)(z[it].z >> 16);
          *(LAS unsigned short*)(d + 6 * 272) = (unsigned short)(z[it].w & 0xffffu); *(LAS unsigned short*)(d + 7 * 272) = (unsigned short)(z[it].w >> 16); } }
    pg8::bf16x8 w2[2][2];
#pragma unroll
    for (int ab = 0; ab < 2; ++ab)
#pragma unroll
        for (int ks = 0; ks < 2; ++ks) w2[ab][ks] = *(const GAS pg8::bf16x8*)(W2g + (ab * 16 + l15) * 64 + ks * 32 + 8 * lq);
    __syncthreads();
    f32x4 acc[8][2];
#pragma unroll
    for (int mb = 0; mb < 8; ++mb) { acc[mb][0] = (f32x4){0.f, 0.f, 0.f, 0.f}; acc[mb][1] = (f32x4){0.f, 0.f, 0.f, 0.f}; }
#pragma unroll
    for (int ks = 0; ks < 4; ++ks) {
        const pg8::bf16x8 b0 = *(const LAS pg8::bf16x8*)(B1 + ((2 * w + 0) * 16 + l15) * 272 + ks * 64 + lq * 16);
        const pg8::bf16x8 b1 = *(const LAS pg8::bf16x8*)(B1 + ((2 * w + 1) * 16 + l15) * 272 + ks * 64 + lq * 16);
#pragma unroll
        for (int mb = 0; mb < 8; ++mb) { const pg8::bf16x8 af = *(const LAS pg8::bf16x8*)(A1 + (mb * 16 + l15) * 272 + ks * 64 + lq * 16);
            acc[mb][0] = __builtin_amdgcn_mfma_f32_16x16x32_bf16(af, b0, acc[mb][0], 0, 0, 0);
            acc[mb][1] = __builtin_amdgcn_mfma_f32_16x16x32_bf16(af, b1, acc[mb][1], 0, 0, 0); } }
    __syncthreads();
    LAS unsigned char* B2 = F.lds;
    { const int j = l & 7, rl = (l >> 3) & 1;
#pragma unroll
      for (int mbp = 0; mbp < 4; ++mbp)
#pragma unroll
        for (int nbl = 0; nbl < 2; ++nbl) { const int r = (2 * w + nbl) * 2 + rl;
#pragma unroll
            for (int i = 0; i < 4; ++i) { const int c = mbp * 16 + 4 * lq + i;
                const pg8::f32x2 t = *(const GAS pg8::f32x2*)(TWg + (c * 32 + r) * 2);
                const float ar = acc[mbp][nbl][i], ai = acc[mbp + 4][nbl][i];
                const unsigned pk = pk2(ar * t.x - ai * t.y, ar * t.y + ai * t.x);
                LAS unsigned char* d = B2 + (c * 8 + j) * 144 + r * 2;
                *(LAS unsigned short*)d = (unsigned short)(pk & 0xffffu); *(LAS unsigned short*)(d + 64) = (unsigned short)(pk >> 16); } } }
    __syncthreads();
    f32x4 y[4][2];
#pragma unroll
    for (int nbp = 0; nbp < 4; ++nbp) { y[nbp][0] = (f32x4){0.f, 0.f, 0.f, 0.f}; y[nbp][1] = (f32x4){0.f, 0.f, 0.f, 0.f}; }
#pragma unroll
    for (int nbp = 0; nbp < 4; ++nbp)
#pragma unroll
        for (int ks = 0; ks < 2; ++ks) { const pg8::bf16x8 af = *(const LAS pg8::bf16x8*)(B2 + ((4 * w + nbp) * 16 + l15) * 144 + ks * 64 + lq * 16);
            y[nbp][0] = __builtin_amdgcn_mfma_f32_16x16x32_bf16(af, w2[0][ks], y[nbp][0], 0, 0, 0);
            y[nbp][1] = __builtin_amdgcn_mfma_f32_16x16x32_bf16(af, w2[1][ks], y[nbp][1], 0, 0, 0); }
    constexpr float SC = 0.0027621358640099515f;
#pragma unroll
    for (int nbp = 0; nbp < 4; ++nbp)
#pragma unroll
        for (int ab = 0; ab < 2; ++ab) { const int c = (4 * w + nbp) * 2 + (lq >> 1), a = ab * 16 + l15, p = 64 * a + c;
            v2u o; o.x = pk2(y[nbp][ab][0] * SC, y[nbp][ab][1] * SC); o.y = pk2(y[nbp][ab][2] * SC, y[nbp][ab][3] * SC);
            *(GAS v2u*)(YF + (size_t)(b * SL + p) * 256 + jb * 8 + 4 * (lq & 1)) = o; }
    __syncthreads();
}
__device__ __forceinline__ void zt_phase(Frame& F, int l) {
    const bf16* P = (const bf16*)(F.ws + WS_P);
    LAS bf16* T = (LAS bf16*)(F.lds + F.wave * 16384);
    const int gw = F.vcu * NWAVES + F.wave, NGW = F.G * NWAVES;
    const int nitems = (l == 0 ? 256 : 0);
    for (int it = gw; it < nitems; it += NGW) {
        const bool lat = false; const int r = it;
        const int pb = r >> 3, cb = r & 7;
        const int row0 = (lat ? 0 : MLAT) + 64 * pb; const int L = lat ? SL : CL;
        const int b = lat ? (pb >> 5) : (pb >> 2); const int n0 = (64 * pb) & (L - 1);
        bf16* ZT = lat ? (bf16*)(F.ws + WS_ZT) : (bf16*)(F.ws + WS_ZTC);
#pragma unroll
        for (int i = 0; i < 8; ++i) { const int pos = 8 * i + (F.lane >> 3), ch = F.lane & 7;
            const v4u v = *(const GAS v4u*)(P + (size_t)(row0 + pos) * NIN + 768 + 64 * cb + 8 * ch);
            LAS unsigned* d = (LAS unsigned*)(T + pos * 66 + 8 * ch); d[0] = v.x; d[1] = v.y; d[2] = v.z; d[3] = v.w; }
        LDS_WAIT(); asm volatile("" ::: "memory");
        const int sn = cb >> 2;
#pragma unroll
        for (int j = 0; j < 8; ++j) { const int chl = 8 * j + (F.lane >> 3), pc = F.lane & 7;
            unsigned e[8];
#pragma unroll
            for (int q = 0; q < 8; ++q) e[q] = T[(8 * pc + q) * 66 + chl];
            v4u o; o.x = e[0] | (e[1] << 16); o.y = e[2] | (e[3] << 16); o.z = e[4] | (e[5] << 16); o.w = e[6] | (e[7] << 16);
            const int chg = 64 * (cb & 3) + chl;
            *(GAS v4u*)(ZT + ((size_t)(b * 256 + chg) * 2 + sn) * L + n0 + 8 * pc) = o; }
        LDS_WAIT(); asm volatile("" ::: "memory");
    }
}
__device__ __forceinline__ void ycat_norm_phase(Frame& F, int nrows) {
    bf16* Y = (bf16*)(F.ws + WS_YCAT); const bf16* YC = (const bf16*)F.out + (size_t)MT * 768; const bf16* YF = (const bf16*)(F.ws + WS_YF); const bf16* AT = (const bf16*)((const char*)F.out + OUT_ATT);
    const int gw = F.vcu * NWAVES + F.wave, NGW = F.G * NWAVES;
    constexpr int R = 2;
    for (int row0 = gw; row0 < nrows; row0 += R * NGW) {
        v4u a[R]; v2u c[R]; v2u f[R];
#pragma unroll
        for (int q = 0; q < R; ++q) { const int row = row0 + q * NGW; if (row < nrows) { a[q] = *(const GAS v4u*)(AT + (size_t)row * 512 + 8 * F.lane); c[q] = *(const GAS v2u*)(YC + (size_t)row * 256 + 4 * F.lane);
            f[q] = *(const GAS v2u*)(YF + (size_t)row * 256 + 4 * F.lane); } }
#pragma unroll
        for (int q = 0; q < R; ++q) { const int row = row0 + q * NGW; if (row < nrows) { bf16* yr = Y + (size_t)row * 1024;
            float av[8], fv[4], cv[4];
            fv[0] = bf2f(f[q].x & 0xffffu); fv[1] = bf2f(f[q].x >> 16); fv[2] = bf2f(f[q].y & 0xffffu); fv[3] = bf2f(f[q].y >> 16);
            av[0] = bf2f(a[q].x & 0xffffu); av[1] = bf2f(a[q].x >> 16); av[2] = bf2f(a[q].y & 0xffffu); av[3] = bf2f(a[q].y >> 16); av[4] = bf2f(a[q].z & 0xffffu); av[5] = bf2f(a[q].z >> 16); av[6] = bf2f(a[q].w & 0xffffu); av[7] = bf2f(a[q].w >> 16);
            cv[0] = bf2f(c[q].x & 0xffffu); cv[1] = bf2f(c[q].x >> 16); cv[2] = bf2f(c[q].y & 0xffffu); cv[3] = bf2f(c[q].y >> 16);
            float sa = 0.f, sf = 0.f, sc = 0.f;
#pragma unroll
            for (int e = 0; e < 8; ++e) sa += av[e] * av[e];
#pragma unroll
            for (int e = 0; e < 4; ++e) { sf += fv[e] * fv[e]; sc += cv[e] * cv[e]; }
            const float ra = 1.0f / sqrtf(wave_sum(sa) * (1.0f / 512.0f) + EPS), rf = 1.0f / sqrtf(wave_sum(sf) * (1.0f / 256.0f) + EPS), rc = 1.0f / sqrtf(wave_sum(sc) * (1.0f / 256.0f) + EPS);
            v4u oa; oa.x = pk2(av[0] * ra, av[1] * ra); oa.y = pk2(av[2] * ra, av[3] * ra); oa.z = pk2(av[4] * ra, av[5] * ra); oa.w = pk2(av[6] * ra, av[7] * ra);
            v2u of; of.x = pk2(fv[0] * rf, fv[1] * rf); of.y = pk2(fv[2] * rf, fv[3] * rf);
            v2u oc; oc.x = pk2(cv[0] * rc, cv[1] * rc); oc.y = pk2(cv[2] * rc, cv[3] * rc);
            *(GAS v4u*)(yr + 8 * F.lane) = oa; *(GAS v2u*)(yr + 512 + 4 * F.lane) = of; *(GAS v2u*)(yr + 768 + 4 * F.lane) = oc; } }
    }
}
__device__ __forceinline__ void ctx_combine_phase(Frame& F, const float* base, const float* gp_g, int gp_ofs, int gate_ofs, const float* gn_g, const float* gn_mod, int gn_ofs, int nsl) {
    const bf16* PART = (const bf16*)(F.ws + WS_CPART); bf16* XNp = (bf16*)(F.ws + WS_XN); float* SSXp = (float*)(F.ws + WS_SSX);
    const float* mod0 = (const float*)(F.ws + WS_MOD) + 8 * 6144;
    const int gw = F.vcu * NWAVES + F.wave, NGW = F.G * NWAVES;
    for (int row = gw; row < MCTX; row += NGW) {
        float ss = 0.f; bf16* xr = XNp + (size_t)(MLAT + row) * DM;
#pragma unroll
        for (int j = 0; j < 4; ++j) { const int c = 256 * j + 4 * F.lane; f32x4 x;
            if (base != nullptr) x = *(const f32x4*)(base + (size_t)row * DM + c);
            else { const v2u xw = *(const GAS v2u*)(xr + c); x[0] = bf2f(xw.x & 0xffffu); x[1] = bf2f(xw.x >> 16); x[2] = bf2f(xw.y & 0xffffu); x[3] = bf2f(xw.y >> 16);
                const f32x4 gp = *(const f32x4*)(gp_g + c) * (*(const f32x4*)(mod0 + gp_ofs + c) + 1.0f);
                x[0] = x[0] / gp[0]; x[1] = x[1] / gp[1]; x[2] = x[2] / gp[2]; x[3] = x[3] / gp[3]; }
            f32x4 s = {0.f, 0.f, 0.f, 0.f};
            for (int k = 0; k < nsl; ++k) { const v2u pw = *(const GAS v2u*)(PART + ((size_t)k * MCTX + row) * DM + c); s[0] += bf2f(pw.x & 0xffffu); s[1] += bf2f(pw.x >> 16); s[2] += bf2f(pw.y & 0xffffu); s[3] += bf2f(pw.y >> 16); }
            x = x + *(const f32x4*)(mod0 + gate_ofs + c) * s;
            ss += (x[0] * x[0] + x[1] * x[1]) + (x[2] * x[2] + x[3] * x[3]);
            const f32x4 h = x * (*(const f32x4*)(gn_g + c)) * (*(const f32x4*)(gn_mod + gn_ofs + c) + 1.0f);
            v2u ho; ho.x = pk2(h[0], h[1]); ho.y = pk2(h[2], h[3]); *(GAS v2u*)(xr + c) = ho; }
        ss = wave_sum(ss);
        if (F.lane < 16) SSXp[(size_t)(MLAT + row) * 16 + F.lane] = F.lane == 0 ? ss : 0.f;
    }
}
__device__ __forceinline__ void final_norm_phase(Frame& F, const bf16* xf, const float* g) {
    const int gw = F.vcu * NWAVES + F.wave, NGW = F.G * NWAVES;
    constexpr int R = 2;
    v2u w[R][4], wn[R][4];
#define FN_LOAD(W_, r0_) do { _Pragma("unroll") for (int q = 0; q < R; ++q) { const int row = (r0_) + q * NGW; if (row < MLAT) { \
        _Pragma("unroll") for (int j = 0; j < 4; ++j) W_[q][j] = *(const GAS v2u*)(xf + (size_t)row * DM + 256 * j + 4 * F.lane); } } } while (0)
    FN_LOAD(w, gw);
    for (int row0 = gw; row0 < MLAT; row0 += R * NGW) {
        FN_LOAD(wn, row0 + R * NGW);
#pragma unroll
        for (int q = 0; q < R; ++q) { const int row = row0 + q * NGW; if (row < MLAT) { float* orow = F.out + (size_t)row * DM;
            f32x4 v[4]; float ss = 0.f;
#pragma unroll
            for (int j = 0; j < 4; ++j) { v[j][0] = bf2f(w[q][j].x & 0xffffu); v[j][1] = bf2f(w[q][j].x >> 16); v[j][2] = bf2f(w[q][j].y & 0xffffu); v[j][3] = bf2f(w[q][j].y >> 16);
                ss += (v[j][0] * v[j][0] + v[j][1] * v[j][1]) + (v[j][2] * v[j][2] + v[j][3] * v[j][3]); }
            const float rstd = 1.0f / sqrtf(wave_sum(ss) * (1.0f / DM) + EPS);
#pragma unroll
            for (int j = 0; j < 4; ++j) { const int c = 256 * j + 4 * F.lane; const f32x4 gg = *(const f32x4*)(g + c); *(f32x4*)(orow + c) = (v[j] * rstd) * gg; } } }
#pragma unroll
        for (int q = 0; q < R; ++q)
#pragma unroll
            for (int j = 0; j < 4; ++j) w[q][j] = wn[q][j];
    }
#undef FN_LOAD
}
#ifndef PHMASK
#define PHMASK 0xFFFF
#endif
#define PHON(x) (((PHMASK) >> (x)) & 1)
#ifndef SUBMASK
#define SUBMASK 0xFF
#endif
#define SUBON(x) (rep_ == 0 || (((SUBMASK) >> (x)) & 1))
struct UpOrder : pg8::StaticOrder {
    typedef pg8::UnitUp UnitT; int nrows;
    __device__ __forceinline__ bool next(int i, pg8::UnitUp& u) const {
        if (!next_mn(i, u.pm, u.pn)) return false;
        u.kofs = 0; u.kofb = 0; u.nt = ntk; u.arow = 254 * u.pm - 1; u.nrows = nrows;
        return true;
    }
};

struct SliceOrder0 : pg8::StaticOrder {
    typedef pg8::Unit UnitT; int nsl;
    __device__ __forceinline__ bool next(int i, pg8::Unit& u) const {
        if (i == 0) { if (!next_mn(0, u.pm, u.pn)) return false; u.arow = u.pm * 256; u.kofs = 0; u.kofb = 0; u.nt = ntk; u.aux = 0; return true; }
        const int L = (i - 1) * G + c; if (L >= 32 * nsl) return false;
        const int t = L / nsl, s = L % nsl; u.pm = 64 + (t >> 2); u.pn = t & 3; u.arow = u.pm * 256; u.aux = s;
        if (nsl == 8) { u.kofs = (s < 6 ? 6 * s : 36 + 4 * (s - 6)) * 64; u.nt = s < 6 ? 6 : 4; } else { u.kofs = s * 256; u.nt = 4; }
        u.kofb = u.kofs; return true;
    }
};

struct QkvOrder {
    typedef pg8::Unit UnitT; int G, c, nq;
    __device__ __forceinline__ bool next(int i, pg8::Unit& u) const { const int L = i * G + c; if (L >= 288 + nq) return false;
        if (L < 288) { u.pm = L >> 2; u.pn = 3 + (L & 3); u.kofs = 384; u.nt = 4; } else { const int j = L - 288; u.pm = j / 3; u.pn = j % 3; u.kofs = 0; u.nt = 6; }
        u.kofb = 0; u.arow = u.pm * 256; return true; }
};

struct FnetOrder {
    typedef pg8::Unit UnitT; int G, c;
    __device__ __forceinline__ bool next(int i, pg8::Unit& u) const { const int L = i * G + c; if (L >= 256) return false;
        u.pm = (L >> 3) & 7; u.pn = L & 7; u.arow = u.pm * 256; u.kofs = (L >> 6) * 1024; u.kofb = u.kofs; u.nt = 16; return true; }
};

__global__ void __launch_bounds__(NWAVES * 64, 2) mk_fwd(Args args) {
    extern __shared__ __attribute__((aligned(16))) unsigned char lds[];
    Frame F;
    F.lds = (LAS unsigned char*)lds; F.ldsg = (char*)lds;
    F.MISC = (volatile LAS unsigned*)(F.lds + MISC_OFF);
    F.tid = threadIdx.x; F.lane = F.tid & 63; F.wave = __builtin_amdgcn_readfirstlane(F.tid >> 6);
    F.G = gridDim.x; F.bx = blockIdx.x; F.vcu = (F.G % 8 == 0) ? (F.bx % 8) * (F.G / 8) + F.bx / 8 : F.bx;
    F.ws = args.ws; F.out = args.out;
    for (int u = F.tid; u < (LDS_BYTES - LDSCTL_OFF) / 4; u += NWAVES * 64) ((LAS unsigned*)(F.lds + LDSCTL_OFF))[u] = 0u;
    __syncthreads();
    if (F.tid == 0) { LAS unsigned long long* T = (LAS unsigned long long*)(F.lds + PTR_OFF);
#pragma unroll
        for (int i = 0; i < 22; ++i) T[i] = (unsigned long long)args.in[i]; }
    __syncthreads();
    XcdBarrier bar; bar.bar = (unsigned*)(F.ws + WS_CTL) + CW_BAR; bar.x = 0; bar.st = nullptr;
    if (!MK_SPLIT) bar = xcd_barrier_post((unsigned*)(F.ws + WS_CTL) + CW_BAR, F.MISC + 8);

#define MOD ((float*)(ws + WS_MOD))
#define SSQ ((float*)(ws + WS_SSQ))
#define XN ((bf16*)(ws + WS_XN))
#define P ((bf16*)(ws + WS_P))
#define Qb ((bf16*)F.out)
#define Kb ((bf16*)(ws + WS_K))
#define Vb ((bf16*)(ws + WS_V))
#define YCAT ((bf16*)(ws + WS_YCAT))
#define ATTO ((bf16*)((char*)F.out + OUT_ATT))
#define ACT ((bf16*)(ws + WS_ACT))
#define XCTX ((bf16*)(ws + WS_XCTX))
#define XBL ((bf16*)F.out + (size_t)MLAT * DM)
#define XFIN ((bf16*)(ws + WS_XN))
    LAS unsigned char* ring = F.lds + RING_OFF;

    const int ph_lo = args.ph_lo, ph_hi = args.ph_hi;
#define PHASE(k) (ph_lo <= (k) && (k) < ph_hi)
#define SEAM(k) do { if (PHASE(k) && PHASE((k) + 1)) xcd_barrier(bar); } while (0)
#ifndef P0SUB
#define P0SUB 0xFF
#endif
#ifndef UPPROBE
#define UPPROBE 0
#endif
#ifndef RPT_PH
#define RPT_PH -1
#endif
#define RELANE() do { int t_ = threadIdx.x; asm volatile("" : "+v"(t_)); F.tid = t_; F.lane = t_ & 63; F.wave = __builtin_amdgcn_readfirstlane(t_ >> 6); } while (0)
    unsigned char* ws = F.ws;
    if (PHASE(0)) for (int rep_ = 0; rep_ < (((0) == RPT_PH) ? 2 : 1); ++rep_) { if (rep_) xcd_barrier(bar); RELANE(); if (PHON(0)) p0_prologue(F, rep_ ? P0SUB : 0xFF, 0, F.vcu * NWAVES + F.wave, F.G * NWAVES); }
    SEAM(0);
    for (int l = 0; l < 2; ++l) {
        const int pb = 1 + 9 * l;
        const int nMall = (l == 0) ? 72 : 64;
        if (PHASE(pb + 0)) for (int rep_ = 0; rep_ < (((pb + 0) == RPT_PH) ? 2 : 1); ++rep_) { if (rep_) xcd_barrier(bar); RELANE();
            if (l == 0 && (rep_ == 0 || (SUBMASK & 1))) { pg8::Gemm g{(const bf16*)(ws + WS_CST), (const bf16*)(ws + WS_WF), 2, 8, 256, 256}; pg8::StaticOrder S; S.init(2, 8, F.G, F.bx, 256);
                pg8::EpiFold E{(bf16*)(ws + WS_WIN), (unsigned)(WIN_STRIDE / 2)};
                pg8::gemm_phase(ring, g, S, E); RELANE(); }
            if (PHON(1) && l == 0 && (rep_ == 0 || (SUBMASK & 2))) norm_mod_phase(F, inptr(F, I_X), inptr(F, I_CTX), MT, inptr(F, I_N1G), MOD, 0, 1024, 16); }
        if (l == 0) SEAM(pb + 0);
        if (PHASE(pb + 1)) for (int rep_ = 0; rep_ < (((pb + 1) == RPT_PH) ? 2 : 1); ++rep_) { if (rep_) xcd_barrier(bar); RELANE();
            if (PHON(2)) { pg8::Gemm g{XN, (const bf16*)(ws + WS_WIN + l * WIN_STRIDE), 72, 8, 1024, 1024}; pg8::StaticOrder S; S.init(72, 8, F.G, F.bx, 1024);
                pg8::EpiWin E{P, NIN, SSQ, l == 1 ? (const float*)(ws + WS_SSX) : nullptr, (const float*)(ws + WS_PB) + 9 * 2048, (LAS float*)(F.lds + EPIX_OFF)};
                pg8::gemm_phase(ring, g, S, E);
                if (rep_ == 0) {
                    RELANE(); int nb = 576 - 2 * F.G; nb = nb < 0 ? 0 : (nb > F.G ? F.G : nb);
                    const bool all = (nb == F.G); if (all || F.bx >= nb) { const int rk = all ? F.bx : F.bx - nb, n = all ? F.G : F.G - nb;
                        if (l == 0) { p0_prologue(F, 0xFF, 1, rk * NWAVES + F.wave, n * NWAVES); bias_phase(F, 1, rk * NWAVES + F.wave, n * NWAVES); }
                        else bias_phase(F, 4, rk * NWAVES + F.wave, n * NWAVES); } } } }
        SEAM(pb + 1);
        if (PHASE(pb + 2)) for (int rep_ = 0; rep_ < (((pb + 2) == RPT_PH) ? 2 : 1); ++rep_) { if (rep_) xcd_barrier(bar); RELANE();
            if (PHON(3)) {
                if (SUBON(0)) { pg8::Gemm g{P, (const bf16*)(ws + WS_WQKV + l * WQKV_STRIDE), 72, 7, 384, NIN}; QkvOrder S; S.G = F.G; S.c = F.vcu; S.nq = 3 * nMall;
                  pg8::EpiQKV E{Qb, Kb, Vb, SSQ, (const float*)(ws + WS_ROPE), (const float*)(ws + WS_ROPE) + 1024, (LAS float*)(F.lds + EPIX_OFF)};
                  pg8::gemm_phase(ring, g, S, E); }
                if (SUBON(2)) qkv_rows_phase(F, l);
                if (SUBON(3)) zt_phase(F, l);
                } }
        SEAM(pb + 2);
        if (PHASE(pb + 3)) for (int rep_ = 0; rep_ < (((pb + 3) == RPT_PH) ? 2 : 1); ++rep_) { if (rep_) xcd_barrier(bar); RELANE();
            if (PHON(4)) {
                const int NU = 256 + (l == 0 ? 32 : 0);
                for (int u = F.vcu; u < NU; u += F.G) {
                    if (u < 256) { const int bh = u >> 3, qb = u & 7, b = bh >> 2, h = bh & 3; const long q0 = (long)b * SL + qb * 256;
                        att::attn_unit(Qb + q0 * 768 + 192 * h, Kb + 192 * h, Vb + 128 * h, ATTO + q0 * 512 + 128 * h, MLAT + CL * b, 4, SL * b, 36, F.ldsg);
                    } else { const int cu = u - 256, b = cu >> 2, h = cu & 3; const long q0 = MLAT + (long)CL * b;
                        att::attn_unit(Qb + q0 * 768 + 192 * h, Kb + 192 * h, Vb + 128 * h, ATTO + q0 * 512 + 128 * h, (int)q0, 4, 0, 4, F.ldsg); }
                }
                RELANE(); for (int u = F.vcu; u < 256; u += F.G) fnet_fft_unit(F, u >> 5, u & 31);
                RELANE();
                if (l == 0) { pg8::Gemm g{(const bf16*)(ws + WS_DFTC), (const bf16*)(ws + WS_ZTC), 1, 8, 512, 512}; pg8::StaticOrder S; S.init(1, 8, F.G, (F.bx + 128) % F.G, 512);
                  pg8::EpiFnet E{(bf16*)(ws + WS_YF), MLAT, CL, 0.0078125f, (unsigned)(MT * 256)};
                  pg8::gemm_phase(ring, g, S, E); } } }
        SEAM(pb + 3);
        if (PHASE(pb + 4)) for (int rep_ = 0; rep_ < (((pb + 4) == RPT_PH) ? 2 : 1); ++rep_) { if (rep_) xcd_barrier(bar); RELANE();
            if (PHON(5)) ycat_norm_phase(F, nMall * 256); }
        SEAM(pb + 4);
        if (PHASE(pb + 5)) for (int rep_ = 0; rep_ < (((pb + 5) == RPT_PH) ? 2 : 1); ++rep_) { if (rep_) xcd_barrier(bar); RELANE();
            if (PHON(6)) { pg8::Gemm g{YCAT, (const bf16*)(ws + WS_WOUT + l * WOUT_STRIDE), nMall, 4, 1024, 1024}; pg8::StaticOrder S; S.init(nMall, 4, F.G, F.bx, 1024);
                if (l == 0) { SliceOrder0 S0; S0.init(64, 4, F.G, F.bx, 1024); S0.nsl = 4; pg8::Gemm g0{YCAT, (const bf16*)(ws + WS_WOUT), 64, 4, 1024, 1024};
                    pg8::EpiRes<true> E{inptr(F, I_X), inptr(F, I_CTX), XN, MOD, 2048, nullptr, nullptr, 0, inptr(F, I_N2G), MOD, 4096, (float*)(ws + WS_SSX), rep_ ? 0.f : 1.f, (bf16*)(ws + WS_CPART)};
                    pg8::gemm_phase(ring, g0, S0, E);
                    RELANE(); { int nb = 128; nb = nb > F.G ? F.G : nb; const bool all = (nb == F.G); if (rep_ == 0 && (all || F.bx >= nb)) { const int rk = all ? F.bx : F.bx - nb, n = all ? F.G : F.G - nb; bias_phase(F, 2, rk * NWAVES + F.wave, n * NWAVES); } }
                    xcd_barrier(bar); RELANE();
                    ctx_combine_phase(F, inptr(F, I_CTX), nullptr, 0, 2048, inptr(F, I_N2G), MOD + 8 * 6144, 4096, 4); }
                else { pg8::EpiRes<false> E{nullptr, nullptr, XN, MOD + (size_t)9 * 6144, 2048, inptr(F, I_N1G) + DM, MOD + (size_t)9 * 6144, 1024, inptr(F, I_N2G) + DM, MOD + (size_t)9 * 6144, 4096, (float*)(ws + WS_SSX), rep_ ? 0.f : 1.f, nullptr};
                    pg8::gemm_phase(ring, g, S, E); } } }
        SEAM(pb + 5);
        if (PHASE(pb + 6)) for (int rep_ = 0; rep_ < (((pb + 6) == RPT_PH) ? 2 : 1); ++rep_) { if (rep_) xcd_barrier(bar); RELANE();
            }
        if (PHASE(pb + 7)) for (int rep_ = 0; rep_ < (((pb + 7) == RPT_PH) ? 2 : 1); ++rep_) { if (rep_) xcd_barrier(bar); RELANE();
            if (PHON(8)) { const int nrows = (l == 0) ? MT : MLAT; const int nM = (nrows + 253) / 254;
                pg8::Gemm g{XN, (const bf16*)(ws + WS_WUP + l * WUP_STRIDE), nM, 22, 1024, 1024}; UpOrder S; S.init(nM, 22, F.G, F.bx, 1024); S.nrows = nrows;
                pg8::EpiUp E{ACT, inptr(F, I_FCW) + (size_t)l * 3 * FF, inptr(F, I_FCB) + (size_t)l * FF, (LAS float*)(F.lds + EPIX_OFF), (const float*)(ws + WS_SSX), (const float*)(ws + WS_UB) + (size_t)l * 9 * 5632};
                pg8::gemm_phase(ring, g, S, E);
                if (l == 0 && rep_ == 0) {
                    RELANE(); int nb = nM * 22 - 6 * F.G; nb = nb < 0 ? 0 : (nb > F.G ? F.G : nb);
                    const bool all = (nb == F.G); if (all || F.bx >= nb) { const int rk = all ? F.bx : F.bx - nb, n = all ? F.G : F.G - nb; p0_prologue(F, 0xFF, 2, rk * NWAVES + F.wave, n * NWAVES); } } } }
        SEAM(pb + 7);
        if (PHASE(pb + 8)) for (int rep_ = 0; rep_ < (((pb + 8) == RPT_PH) ? 2 : 1); ++rep_) { if (rep_) xcd_barrier(bar); RELANE();
            if (PHON(6)) {
                if (l == 0) { pg8::Gemm g{ACT, (const bf16*)(ws + WS_WDOWN), 64, 4, FF, FF}; SliceOrder0 S; S.init(64, 4, F.G, F.bx, FF); S.nsl = 8;
                    pg8::EpiRes<false> E{nullptr, nullptr, XN, MOD, 5120, inptr(F, I_N2G), MOD, 4096, inptr(F, I_N1G) + DM, MOD + (size_t)9 * 6144, 1024, (float*)(ws + WS_SSX), rep_ ? 0.f : 1.f, (bf16*)(ws + WS_CPART)};
                    pg8::gemm_phase(ring, g, S, E);
                    xcd_barrier(bar); RELANE();
                    ctx_combine_phase(F, nullptr, inptr(F, I_N2G), 4096, 5120, inptr(F, I_N1G) + DM, MOD + (size_t)9 * 6144 + 8 * 6144, 1024, 8);
                } else { pg8::Gemm g{ACT, (const bf16*)(ws + WS_WDOWN + WDOWN_STRIDE), 64, 4, FF, FF}; pg8::StaticOrder S; S.init(64, 4, F.G, F.bx, FF);
                    pg8::EpiRes<false> E{nullptr, nullptr, XN, MOD + (size_t)9 * 6144, 5120, inptr(F, I_N2G) + DM, MOD + (size_t)9 * 6144, 4096, nullptr, nullptr, 0, nullptr, 1.f, nullptr};
                    pg8::gemm_phase(ring, g, S, E); } } }
        SEAM(pb + 8);
    }
    if (PHASE(NPH - 1)) for (int rep_ = 0; rep_ < (((NPH - 1) == RPT_PH) ? 2 : 1); ++rep_) { if (rep_) xcd_barrier(bar); RELANE(); if (PHON(10)) final_norm_phase(F, XN, inptr(F, I_FING)); }
#undef PHASE
#undef SEAM
#undef RELANE
#undef MOD
#undef SSQ
#undef XN
#undef P
#undef Qb
#undef Kb
#undef Vb
#undef YCAT
#undef ATTO
#undef ACT
#undef XCTX
#undef XBL
#undef XFIN
}

extern "C" void kernel_launch(void* const* d_in, const int* in_sizes, int n_in, void* d_out, int out_size, void* d_ws, size_t ws_size, hipStream_t stream) {
    static int grid = 0;
    if (grid == 0) {
        if (n_in != 22 || out_size != MLAT * DM || ws_size < WS_END) { fprintf(stderr, "kernel_launch: unexpected shapes (n_in %d out %d ws %zu)\n", n_in, out_size, ws_size); grid = -1; return; }
        int dev = 0, cus = 0;
        if (hipGetDevice(&dev) != hipSuccess || hipDeviceGetAttribute(&cus, hipDeviceAttributeMultiprocessorCount, dev) != hipSuccess) { grid = -1; return; }
        if (hipFuncSetAttribute((const void*)mk_fwd, hipFuncAttributeMaxDynamicSharedMemorySize, LDS_BYTES) != hipSuccess) { fprintf(stderr, "kernel_launch: hipFuncSetAttribute failed\n"); grid = -1; return; }
        int per_cu = 0;
        if (hipOccupancyMaxActiveBlocksPerMultiprocessor(&per_cu, (const void*)mk_fwd, NWAVES * 64, LDS_BYTES) != hipSuccess || per_cu < 1) fprintf(stderr, "kernel_launch: occupancy query says %d\n", per_cu);
        (void)hipGetLastError();
        grid = cus;
    }
    if (grid < 0) return;
    if (hipMemsetAsync((char*)d_ws + WS_CTL, 0, CTL_ZERO_BYTES, stream) != hipSuccess) return;
    Args a{};
    for (int i = 0; i < 22; ++i) a.in[i] = (const float*)d_in[i];
    a.out = (float*)d_out; a.ws = (unsigned char*)d_ws;
#if MK_SPLIT
    for (int ph = 0; ph < NPH; ++ph) { a.ph_lo = ph; a.ph_hi = ph + 1; hipLaunchKernelGGL(mk_fwd, dim3(grid), dim3(NWAVES * 64), LDS_BYTES, stream, a); }
#else
    a.ph_lo = 0; a.ph_hi = NPH;
    hipLaunchKernelGGL(mk_fwd, dim3(grid), dim3(NWAVES * 64), LDS_BYTES, stream, a);
#endif
    const hipError_t le = hipPeekAtLastError();
    if (le != hipSuccess) fprintf(stderr, "kernel_launch: launch failed: %s\n", hipGetErrorName(le));
}
```

```cpp
#include <hip/hip_runtime.h>
#include <hip/hip_bf16.h>
#include <cstdio>
#include <cstdint>
#include <cmath>
namespace pg8 {
#define PG8_LAS __attribute__((address_space(3)))
typedef unsigned short bf16_t;
typedef short bf16x8 __attribute__((ext_vector_type(8)));
typedef float f32x4 __attribute__((ext_vector_type(4)));
typedef float f32x2 __attribute__((ext_vector_type(2)));
typedef unsigned u32x4 __attribute__((ext_vector_type(4)));
typedef unsigned u32x2 __attribute__((ext_vector_type(2)));
constexpr int BM = 256, BK = 64, HALF = 128, HTB = HALF * BK * 2  , STAGE_BYTES = 8 * HTB, NXCD = 8, WGM = 8;

__host__ __device__ __forceinline__ int lds_byte(int r, int c) { const int st = (r >> 4) * 2 + (c >> 5), rr = r & 15, cc = c & 31, ob = rr * 64 + cc * 2; return st * 1024 + (ob ^ (((ob >> 9) & 1) << 5)); }
__host__ __device__ __forceinline__ void stage_rc(int b, int& R, int& C) { const int st = b / 1024, sb = b % 1024, swz = sb ^ (((sb >> 9) & 1) << 5); R = (st >> 1) * 16 + swz / 64; C = (st & 1) * 32 + (swz % 64) / 2; }
__host__ __device__ __forceinline__ int perm32(int rho) { const int n = rho >> 4, i = rho & 15; return 8 * (i >> 2) + 4 * n + (i & 3); }

struct Unit { int pm, pn, arow, kofs, kofb, nt, aux; };
struct Gemm { const bf16_t* A; const bf16_t* Bt; int nM, nN, ldb, lda; };

struct StaticOrder {
    int nM, nN, nwg, G, c, ntk;
    __device__ __forceinline__ void init(int nM_, int nN_, int G_, int c_, int K_) { nM = nM_; nN = nN_; nwg = nM * nN; G = G_; c = c_; ntk = K_ / BK; }
    __device__ __forceinline__ bool next_mn(int i, int& pm, int& pn) const {
        const long L = (long)i * G + c; if (L >= nwg) return false;
        int wgid = (int)L; { const int q = nwg / NXCD, r = nwg % NXCD, xcd = wgid % NXCD, off = wgid / NXCD; wgid = (xcd < r ? xcd * (q + 1) : r * (q + 1) + (xcd - r) * q) + off; }
        const int nig = WGM * nN, gid = wgid / nig, fm = gid * WGM, gsz = (nM - fm) < WGM ? (nM - fm) : WGM;
        pm = fm + ((wgid % nig) % gsz); pn = (wgid % nig) / gsz; return true;
    }
    typedef Unit UnitT;
    __device__ __forceinline__ bool next(int i, Unit& u) const { if (!next_mn(i, u.pm, u.pn)) return false; u.arow = u.pm * BM; u.kofs = 0; u.kofb = 0; u.nt = ntk; u.aux = 0; return true; }
};

__device__ __forceinline__ unsigned cvt_pk_bf16(float lo, float hi) { unsigned r; asm volatile("v_cvt_pk_bf16_f32 %0, %1, %2" : "=v"(r) : "v"(lo), "v"(hi)); return r; }

template <class Epi, class Sched>
__device__ __forceinline__ void gemm_phase(PG8_LAS unsigned char* lds, const Gemm g, const Sched& S, const Epi& E) {
    int tid = threadIdx.x; asm volatile("" : "+v"(tid));
    const int wid = __builtin_amdgcn_readfirstlane(tid >> 6), lane = tid & 63, wr = wid >> 2, wc = wid & 3, fr = lane & 15, fq = lane >> 4;
    const int K = g.ldb, lda = g.lda;
    unsigned voffA[2], voffB[2];
#pragma unroll
    for (int i = 0; i < 2; ++i) { int R, C; stage_rc(tid * 16 + i * 8192, R, C); const int Rb = Epi::PERM ? ((R & ~31) + perm32(R & 31)) : R;
        voffA[i] = (unsigned)(R * lda + C) * 2u; voffB[i] = (unsigned)(Rb * K + C) * 2u; }
    const size_t kstep = (size_t)(BK * 2);
    const size_t hstepA = (size_t)HALF * lda * 2, hstepB = (size_t)HALF * K * 2;
    const size_t tstepB = 2 * hstepB;
    const unsigned ldsw = (unsigned)wid * 1024u;
    const int aoff = lds_byte(wr * 64 + fr, fq * 8), boff = lds_byte(wc * 32 + fr, fq * 8);
#define PG8_SA(b, h) (((b) * 2 + (h)) * HTB)
#define PG8_SB(b, h) ((4 + (b) * 2 + (h)) * HTB)
#define PG8_STAGE(bufoff, gbase, voff) do { _Pragma("unroll") for (int _i = 0; _i < 2; ++_i) \
        __builtin_amdgcn_global_load_lds((const unsigned*)((const char*)(gbase) + (voff)[_i]), (PG8_LAS unsigned*)(lds + (bufoff) + ldsw + _i * 8192), 16, 0, 0); } while (0)
#define PG8_LDA(dst, b, h) do { _Pragma("unroll") for (int m = 0; m < 4; ++m) _Pragma("unroll") for (int k = 0; k < 2; ++k) dst[m][k] = *(const PG8_LAS bf16x8*)(lds + PG8_SA(b, h) + aoff + m * 2048 + k * 1024); } while (0)
#define PG8_LDB(dst, b, h) do { _Pragma("unroll") for (int n = 0; n < 2; ++n) _Pragma("unroll") for (int k = 0; k < 2; ++k) dst[n][k] = *(const PG8_LAS bf16x8*)(lds + PG8_SB(b, h) + boff + n * 2048 + k * 1024); } while (0)
#define PG8_MMA(ai, bj, At, Bt) do { __builtin_amdgcn_s_setprio(1); _Pragma("unroll") for (int m = 0; m < 4; ++m) _Pragma("unroll") for (int n = 0; n < 2; ++n) _Pragma("unroll") for (int k = 0; k < 2; ++k) \
        acc[ai][bj][m][n] = __builtin_amdgcn_mfma_f32_16x16x32_bf16(Bt[n][k], At[m][k], acc[ai][bj][m][n], 0, 0, 0); __builtin_amdgcn_s_setprio(0); } while (0)
#define PG8_WAIT_V(n) asm volatile("s_waitcnt vmcnt(" #n ")" ::: "memory")
#define PG8_WAIT_L(n) asm volatile("s_waitcnt lgkmcnt(" #n ")" ::: "memory")
#define PG8_BAR __builtin_amdgcn_s_barrier()
#define PG8_SCHED __builtin_amdgcn_sched_barrier(0)
    typename Sched::UnitT cur, nxt; int ui = 0;
    if (!S.next(0, cur)) return;
    f32x4 acc[2][2][4][2];
#pragma unroll
    for (int a = 0; a < 2; ++a)
#pragma unroll
        for (int b = 0; b < 2; ++b)
#pragma unroll
            for (int m = 0; m < 4; ++m)
#pragma unroll
                for (int n = 0; n < 2; ++n) acc[a][b][m][n] = (f32x4){0.f, 0.f, 0.f, 0.f};
    bf16x8 At[4][2], B0[2][2], B1[2][2];
    const char* cA = (const char*)g.A + (ptrdiff_t)cur.arow * (ptrdiff_t)(lda * 2) + cur.kofs * 2; const char* cB = (const char*)g.Bt + (size_t)cur.pn * tstepB + cur.kofb * 2;
    if constexpr (Epi::PREFETCH) E.prefetch(cur, wid, lane);
    PG8_STAGE(PG8_SB(0, 0), cB, voffB); PG8_STAGE(PG8_SB(0, 1), cB + hstepB, voffB); PG8_STAGE(PG8_SA(0, 0), cA, voffA); PG8_STAGE(PG8_SA(0, 1), cA + hstepA, voffA);
    if (wr == 1) PG8_BAR;
    PG8_WAIT_V(2); PG8_BAR;
    PG8_STAGE(PG8_SB(1, 0), cB + kstep, voffB); PG8_STAGE(PG8_SA(1, 0), cA + kstep, voffA); PG8_STAGE(PG8_SB(1, 1), cB + hstepB + kstep, voffB);
    PG8_WAIT_V(6); PG8_BAR;
    for (;;) {
        const bool has_next = S.next(ui + 1, nxt);
        const char* nA = has_next ? (const char*)g.A + (ptrdiff_t)nxt.arow * (ptrdiff_t)(lda * 2) + nxt.kofs * 2 : cA; const char* nB = has_next ? (const char*)g.Bt + (size_t)nxt.pn * tstepB + nxt.kofb * 2 : cB;
        const int nt = cur.nt;
        for (int t = 0; t < nt; t += 2) {
            const bool last = (t == nt - 2);
            const char* a1 = cA + (size_t)(t + 1) * kstep;
            const char* a2 = last ? nA : cA + (size_t)(t + 2) * kstep; const char* b2 = last ? nB : cB + (size_t)(t + 2) * kstep;
            const char* a3 = a2 + kstep; const char* b3 = b2 + kstep;
            PG8_LDB(B0, 0, 0); PG8_LDB(B1, 0, 1); PG8_SCHED; PG8_LDA(At, 0, 0); PG8_STAGE(PG8_SA(1, 1), a1 + hstepA, voffA);
            PG8_WAIT_V(8); PG8_WAIT_L(0); PG8_BAR; PG8_MMA(0, 0, At, B0); PG8_MMA(0, 1, At, B1); PG8_BAR; PG8_SCHED;
            PG8_LDA(At, 0, 1); PG8_STAGE(PG8_SB(0, 0), b2, voffB); PG8_STAGE(PG8_SB(0, 1), b2 + hstepB, voffB); PG8_STAGE(PG8_SA(0, 0), a2, voffA);
            PG8_WAIT_V(8); PG8_WAIT_L(0); PG8_BAR; PG8_MMA(1, 0, At, B0); PG8_MMA(1, 1, At, B1); PG8_BAR; PG8_SCHED;
            PG8_LDB(B0, 1, 0); PG8_LDB(B1, 1, 1); PG8_SCHED; PG8_LDA(At, 1, 0); PG8_STAGE(PG8_SA(0, 1), a2 + hstepA, voffA);
            PG8_WAIT_V(8); PG8_WAIT_L(0); PG8_BAR; PG8_MMA(0, 0, At, B0); PG8_MMA(0, 1, At, B1); PG8_BAR; PG8_SCHED;
            PG8_LDA(At, 1, 1); PG8_STAGE(PG8_SB(1, 0), b3, voffB); PG8_STAGE(PG8_SB(1, 1), b3 + hstepB, voffB); PG8_STAGE(PG8_SA(1, 0), a3, voffA);
            PG8_WAIT_V(8); PG8_WAIT_L(0); PG8_BAR; PG8_MMA(1, 0, At, B0); PG8_MMA(1, 1, At, B1); PG8_BAR; PG8_SCHED;
        }
        if (wr == 0) PG8_BAR;
        E(acc, cur, wr, wc, fr, fq);
        if (!has_next) break;
        if constexpr (Epi::PREFETCH) E.prefetch(nxt, wid, lane);
#pragma unroll
        for (int a = 0; a < 2; ++a)
#pragma unroll
            for (int b = 0; b < 2; ++b)
#pragma unroll
                for (int m = 0; m < 4; ++m)
#pragma unroll
                    for (int n = 0; n < 2; ++n) acc[a][b][m][n] = (f32x4){0.f, 0.f, 0.f, 0.f};
        cur = nxt; cA = nA; cB = nB; ++ui;
        if (wr == 1) PG8_BAR;
    }
    PG8_WAIT_V(0);
    PG8_BAR;
#undef PG8_SA
#undef PG8_SB
#undef PG8_STAGE
#undef PG8_LDA
#undef PG8_LDB
#undef PG8_MMA
#undef PG8_WAIT_V
#undef PG8_WAIT_L
#undef PG8_BAR
#undef PG8_SCHED
}
}
namespace pg8 {
constexpr float RMS_EPS = 1e-6f;
template <class T> __device__ __forceinline__ T gld(const void* base, unsigned boff) { return *(const T*)((const char*)base + boff); }
template <class T> __device__ __forceinline__ void gst(void* base, unsigned boff, T v) { *(T*)((char*)base + boff) = v; }
constexpr int EX_XF = 0, EX_XL = 512, EX_CW = 1024, EX_RS = 1536, EX_BL = 1792, EX_SSX = 2304, EX_FLOATS = 6400;
constexpr int MLAT_ = 16384;
__device__ __forceinline__ void dma_ssx(const float* ssx, int arow, PG8_LAS float* xb, int wid, int lane) {
#pragma unroll
    for (int i = 0; i < 2; ++i) { const int ch = 2 * wid + i;
        __builtin_amdgcn_global_load_lds((const unsigned*)((const char*)ssx + (ptrdiff_t)arow * 64 + ch * 1024 + lane * 16), (PG8_LAS unsigned*)(xb + EX_SSX + ch * 256), 16, 0, 0); }
}
__device__ __forceinline__ void rs_from_ssx(PG8_LAS float* xb, int t) {
    if (t < 256) { const PG8_LAS f32x4* p = (const PG8_LAS f32x4*)(xb + EX_SSX + t * 16); const f32x4 a = p[0], b = p[1], c = p[2], d = p[3];
        const float ss = (((a[0] + a[1]) + (a[2] + a[3])) + ((b[0] + b[1]) + (b[2] + b[3]))) + (((c[0] + c[1]) + (c[2] + c[3])) + ((d[0] + d[1]) + (d[2] + d[3])));
        xb[EX_RS + t] = __builtin_amdgcn_rsqf(ss * (1.0f / 1024.0f) + RMS_EPS); }
}

struct EpiWin {
    static constexpr bool PERM = true, PREFETCH = true;
    bf16_t* O; int ldc; float* ssq;
    const float* ssx; const float* pb;
    PG8_LAS float* xb;
    __device__ __forceinline__ void prefetch(const Unit& u, int wid, int lane) const {
        if (ssx == nullptr) return;
        dma_ssx(ssx, u.arow, xb, wid, lane);
        if (wid == 0) __builtin_amdgcn_global_load_lds((const unsigned*)(pb + (u.pm < 64 ? (u.pm >> 3) : 8) * 2304 + u.pn * BM + lane * 4), (PG8_LAS unsigned*)(xb + EX_BL), 16, 0, 0);
    }
    __device__ __forceinline__ void operator()(const f32x4 (&acc)[2][2][4][2], const Unit& u, int wr, int wc, int fr_in, int fq_in) const {
        int t_ = threadIdx.x; asm volatile("" : "+v"(t_)); const int fr = t_ & 15, fq = (t_ >> 4) & 3; (void)fr_in; (void)fq_in;
        const int row0 = u.pm * BM + wr * 64 + fr; const int col0 = (u.pn == 8 ? 3 : u.pn) * BM + wc * 32 + 8 * fq; const int tc0 = wc * 32 + 8 * fq;
        const bool fused = ssx != nullptr;
        if (fused) { rs_from_ssx(xb, t_); asm volatile("s_waitcnt lgkmcnt(0)" ::: "memory"); __builtin_amdgcn_s_barrier(); asm volatile("" ::: "memory"); }
        f32x4 bv[2][2];
#pragma unroll
        for (int bj = 0; bj < 2; ++bj)
#pragma unroll
            for (int n = 0; n < 2; ++n) bv[bj][n] = fused ? *(const PG8_LAS f32x4*)(xb + EX_BL + tc0 + bj * HALF + 4 * n) : (f32x4){0.f, 0.f, 0.f, 0.f};
#pragma unroll
        for (int ai = 0; ai < 2; ++ai)
#pragma unroll
            for (int m = 0; m < 4; ++m) { const int tr = ai * HALF + wr * 64 + m * 16 + fr; const int row = u.pm * BM + tr; const unsigned ob = ((unsigned)row * (unsigned)ldc + (unsigned)col0) * 2u;
                const float rs = fused ? xb[EX_RS + tr] : 1.0f;
#pragma unroll
                for (int bj = 0; bj < 2; ++bj) { const f32x4 v0 = acc[ai][bj][m][0] * rs + bv[bj][0], v1 = acc[ai][bj][m][1] * rs + bv[bj][1];
                    u32x4 w; w.x = cvt_pk_bf16(v0[0], v0[1]); w.y = cvt_pk_bf16(v0[2], v0[3]); w.z = cvt_pk_bf16(v1[0], v1[1]); w.w = cvt_pk_bf16(v1[2], v1[3]);
                    gst<u32x4>(O, ob + bj * HALF * 2, w);
                    const int hf = 2 * u.pn + bj;
                    if (hf < 5) {
                        float s = (v0[0] * v0[0] + v0[1] * v0[1]) + (v0[2] * v0[2] + v0[3] * v0[3]) + (v1[0] * v1[0] + v1[1] * v1[1]) + (v1[2] * v1[2] + v1[3] * v1[3]);
                        s += __shfl_xor(s, 16); s += __shfl_xor(s, 32);
                        if (fq == 0) gst<float>(ssq, ((unsigned)row * 20u + hf * 4 + wc) * 4u, s);
                    } }
                if (m & 1) asm volatile("" ::: "memory"); }
        if (fused) { asm volatile("s_waitcnt lgkmcnt(0)" ::: "memory"); __builtin_amdgcn_s_barrier(); asm volatile("" ::: "memory"); }
        (void)row0;
    }
};

struct EpiFold {
    static constexpr bool PERM = true, PREFETCH = false;
    bf16_t* WinT; unsigned lstride;
    __device__ __forceinline__ void operator()(const f32x4 (&acc)[2][2][4][2], const Unit& u, int wr, int wc, int fr_in, int fq_in) const {
        int t_ = threadIdx.x; asm volatile("" : "+v"(t_)); const int fr = t_ & 15, fq = (t_ >> 4) & 3; (void)fr_in; (void)fq_in;
        bf16_t* O = WinT + (size_t)(u.pn >> 2) * lstride;
        const int row0 = 768 + u.pm * BM + wr * 64 + fr; const int col0 = (u.pn & 3) * BM + wc * 32 + 8 * fq;
#pragma unroll
        for (int ai = 0; ai < 2; ++ai)
#pragma unroll
            for (int m = 0; m < 4; ++m) { const unsigned ob = ((unsigned)(row0 + ai * HALF + m * 16) * 1024u + (unsigned)col0) * 2u;
#pragma unroll
                for (int bj = 0; bj < 2; ++bj) { const f32x4 v0 = acc[ai][bj][m][0], v1 = acc[ai][bj][m][1];
                    u32x4 w; w.x = cvt_pk_bf16(v0[0], v0[1]); w.y = cvt_pk_bf16(v0[2], v0[3]); w.z = cvt_pk_bf16(v1[0], v1[1]); w.w = cvt_pk_bf16(v1[2], v1[3]);
                    gst<u32x4>(O, ob + bj * HALF * 2, w); } }
    }
};

struct EpiQKV {
    static constexpr bool PERM = true, PREFETCH = true;
    bf16_t* Q; bf16_t* Kb; bf16_t* Vb; const float* ssq; const float* ropec; const float* ropes; PG8_LAS float* xb;
    __device__ __forceinline__ void prefetch(const Unit& u, int wid, int lane) const {
#pragma unroll
        for (int i = 0; i < 3; ++i) { const int ch = 3 * wid + i;
            if (ch < 20) __builtin_amdgcn_global_load_lds((const unsigned*)((const char*)ssq + (size_t)u.arow * 80 + ch * 1024 + lane * 16), (PG8_LAS unsigned*)(xb + 512 + ch * 256), 16, 0, 0); }
    }
    __device__ __forceinline__ void operator()(const f32x4 (&acc)[2][2][4][2], const Unit& u, int wr, int wc, int fr_in, int fq_in) const {
        int t_ = threadIdx.x; asm volatile("" : "+v"(t_)); const int fr = t_ & 15, fq = (t_ >> 4) & 3; (void)fr_in; (void)fq_in;
        if (t_ < 256) { const PG8_LAS float* p = xb + 512 + t_ * 20; float sq = 0.f, sk = 0.f;
#pragma unroll
            for (int i = 0; i < 12; ++i) sq += p[i];
#pragma unroll
            for (int i = 12; i < 20; ++i) sk += p[i];
            xb[t_] = __builtin_amdgcn_rsqf(sq * (1.0f / 384.0f) + RMS_EPS); xb[256 + t_] = __builtin_amdgcn_rsqf(sk * (1.0f / 256.0f) + RMS_EPS); }
        asm volatile("s_waitcnt lgkmcnt(0)" ::: "memory"); __builtin_amdgcn_s_barrier(); asm volatile("" ::: "memory");
        const int cw = wc * 32 + 8 * fq;
        if (u.pn < 3) {
            const bool lat = u.pm < 64;
#pragma unroll
            for (int ai = 0; ai < 2; ++ai)
#pragma unroll
                for (int m = 0; m < 4; ++m) { const int tr = ai * HALF + wr * 64 + m * 16 + fr; const int row = u.pm * BM + tr; const float rs = xb[tr]; const int t = row & 2047;
#pragma unroll
                    for (int bj = 0; bj < 2; ++bj) { const int gcol = u.pn * BM + bj * HALF + wc * 32;
                        const int w = gcol % 192; f32x4 x1 = acc[ai][bj][m][0] * rs, x2 = acc[ai][bj][m][1] * rs;
                        if (lat && w >= 128) { const int pos = (w >= 160) ? (t & 63) : (t >> 6);
                            const unsigned rb = (unsigned)(pos * 16 + 4 * fq) * 4u; const f32x4 c = gld<f32x4>(ropec, rb), s = gld<f32x4>(ropes, rb);
                            const f32x4 y1 = x1 * c - x2 * s, y2 = x1 * s + x2 * c; x1 = y1; x2 = y2; }
                        u32x4 o; o.x = cvt_pk_bf16(x1[0], x1[1]); o.y = cvt_pk_bf16(x1[2], x1[3]); o.z = cvt_pk_bf16(x2[0], x2[1]); o.w = cvt_pk_bf16(x2[2], x2[3]);
                        gst<u32x4>(Q, ((unsigned)row * 768u + (unsigned)(gcol + 8 * fq)) * 2u, o); }
                    if (m & 1) asm volatile("" ::: "memory"); }
        } else {
            const int h = u.pn - 3;
#pragma unroll
            for (int ai = 0; ai < 2; ++ai)
#pragma unroll
                for (int m = 0; m < 4; ++m) { const int tr = ai * HALF + wr * 64 + m * 16 + fr; const int row = u.pm * BM + tr; const float rs = xb[256 + tr];
#pragma unroll
                    for (int bj = 0; bj < 2; ++bj) { const f32x4 v0 = acc[ai][bj][m][0] * rs, v1 = acc[ai][bj][m][1] * rs;
                        u32x4 w; w.x = cvt_pk_bf16(v0[0], v0[1]); w.y = cvt_pk_bf16(v0[2], v0[3]); w.z = cvt_pk_bf16(v1[0], v1[1]); w.w = cvt_pk_bf16(v1[2], v1[3]);
                        if (bj == 0) gst<u32x4>(Kb, ((unsigned)row * 768u + (unsigned)(192 * h + cw)) * 2u, w);
                        else gst<u32x4>(Vb, ((unsigned)row * 512u + (unsigned)(128 * h + cw)) * 2u, w); }
                    if (m & 1) asm volatile("" ::: "memory"); }
        }
        asm volatile("s_waitcnt lgkmcnt(0)" ::: "memory"); __builtin_amdgcn_s_barrier(); asm volatile("" ::: "memory");
    }
};

struct EpiFnet {
    static constexpr bool PERM = true, PREFETCH = false;
    bf16_t* Y; int rowbase, seqlen; float scale; unsigned slice_stride;
    __device__ __forceinline__ void operator()(const f32x4 (&acc)[2][2][4][2], const Unit& u, int wr, int wc, int fr_in, int fq_in) const {
        int t_ = threadIdx.x; asm volatile("" : "+v"(t_)); const int fr = t_ & 15, fq = (t_ >> 4) & 3; (void)fr_in; (void)fq_in;
        const int k0 = u.pm * BM + wr * 64 + fr; const int cw = wc * 32 + 8 * fq;
        bf16_t* Yb = Y + (size_t)(u.kofs >> 10) * slice_stride;
#pragma unroll
        for (int ai = 0; ai < 2; ++ai)
#pragma unroll
            for (int m = 0; m < 4; ++m) { const int row = rowbase + u.pn * seqlen + k0 + ai * HALF + m * 16; const unsigned yb = ((unsigned)row * 256u + (unsigned)cw) * 2u;
#pragma unroll
                for (int bj = 0; bj < 2; ++bj) { const f32x4 v0 = acc[ai][bj][m][0] * scale, v1 = acc[ai][bj][m][1] * scale;
                    u32x4 w; w.x = cvt_pk_bf16(v0[0], v0[1]); w.y = cvt_pk_bf16(v0[2], v0[3]); w.z = cvt_pk_bf16(v1[0], v1[1]); w.w = cvt_pk_bf16(v1[2], v1[3]);
                    gst<u32x4>(Yb, yb + bj * HALF * 2, w); } }
    }
};

template <bool F32BASE> struct EpiRes {
    static constexpr bool PERM = true, PREFETCH = false;
    const float* base_lat; const float* base_ctx;
    bf16_t* X; const float* mod; int gofs;
    const float* png; const float* pscmod; int pscofs;
    const float* ng; const float* scmod; int scofs; float* ssx;
    float gmul;
    bf16_t* part;
    __device__ __forceinline__ void operator()(const f32x4 (&acc)[2][2][4][2], const Unit& u, int wr, int wc, int fr_in, int fq_in) const {
        int t_ = threadIdx.x; asm volatile("" : "+v"(t_)); const int fr = t_ & 15, fq = (t_ >> 4) & 3; (void)fr_in; (void)fq_in;
        if (part != nullptr && u.pm >= 64) {
            const int sl = u.aux;
            const int prow0 = (u.pm - 64) * BM + wr * 64 + fr; const int pcol0 = u.pn * BM + wc * 32 + 8 * fq; bf16_t* pb_ = part + (size_t)sl * (2048u * 1024u);
#pragma unroll
            for (int ai = 0; ai < 2; ++ai)
#pragma unroll
                for (int m = 0; m < 4; ++m) { const unsigned off = ((unsigned)(prow0 + ai * HALF + m * 16) * 1024u + (unsigned)pcol0) * 2u;
#pragma unroll
                    for (int bj = 0; bj < 2; ++bj) { const f32x4 v0 = acc[ai][bj][m][0], v1 = acc[ai][bj][m][1];
                        u32x4 w; w.x = cvt_pk_bf16(v0[0], v0[1]); w.y = cvt_pk_bf16(v0[2], v0[3]); w.z = cvt_pk_bf16(v1[0], v1[1]); w.w = cvt_pk_bf16(v1[2], v1[3]);
                        gst<u32x4>(pb_, off + (unsigned)(bj * HALF) * 2u, w); } }
            return;
        }
        const bool lat = u.pm < 64; const int r = lat ? (u.pm >> 3) : 8;
        constexpr bool f32base = F32BASE; const float* bf = lat ? base_lat : base_ctx;
        const float* gate = mod + r * 6144 + gofs;
        const int frow0 = (lat ? u.pm : u.pm - 64) * BM + wr * 64 + fr; const int col0 = u.pn * BM + wc * 32 + 8 * fq;
        const int grow0 = u.pm * BM + wr * 64 + fr;
        const bool scaled = ng != nullptr;
        float ss[8];
#pragma unroll
        for (int q = 0; q < 8; ++q) ss[q] = 0.f;
#pragma unroll
        for (int bj = 0; bj < 2; ++bj) {
            f32x4 gv[2], gs[2], gp[2];
#pragma unroll
            for (int n = 0; n < 2; ++n) { const unsigned cb = (unsigned)(col0 + bj * HALF + n * 4) * 4u; gv[n] = gld<f32x4>(gate, cb) * gmul;
                gs[n] = scaled ? gld<f32x4>(ng, cb) * (gld<f32x4>(scmod, (unsigned)(r * 6144 + scofs) * 4u + cb) + 1.0f) : (f32x4){1.f, 1.f, 1.f, 1.f};
                if constexpr (!f32base) { const f32x4 d = gld<f32x4>(png, cb) * (gld<f32x4>(pscmod, (unsigned)(r * 6144 + pscofs) * 4u + cb) + 1.0f);
                    gp[n] = (f32x4){__builtin_amdgcn_rcpf(d[0]), __builtin_amdgcn_rcpf(d[1]), __builtin_amdgcn_rcpf(d[2]), __builtin_amdgcn_rcpf(d[3])}; }
                else gp[n] = (f32x4){1.f, 1.f, 1.f, 1.f}; }
#pragma unroll
            for (int ai = 0; ai < 2; ++ai) {
                f32x4 x0[4], x1[4];
#pragma unroll
                for (int m = 0; m < 4; ++m) { const unsigned o2 = ((unsigned)(grow0 + ai * HALF + m * 16) * 1024u + (unsigned)(col0 + bj * HALF)) * 2u;
                    const unsigned fo = ((unsigned)(frow0 + ai * HALF + m * 16) * 1024u + (unsigned)(col0 + bj * HALF)) * 4u;
                    if constexpr (f32base) { x0[m] = gld<f32x4>(bf, fo); x1[m] = gld<f32x4>(bf, fo + 16u); }
                    else { const u32x4 bw = gld<u32x4>(X, o2); x0[m] = __builtin_bit_cast(f32x4, (u32x4){bw.x << 16, bw.x & 0xffff0000u, bw.y << 16, bw.y & 0xffff0000u});
                        x1[m] = __builtin_bit_cast(f32x4, (u32x4){bw.z << 16, bw.z & 0xffff0000u, bw.w << 16, bw.w & 0xffff0000u}); } }
                asm volatile("" ::: "memory");
#pragma unroll
                for (int m = 0; m < 4; ++m) { const unsigned o2 = ((unsigned)(grow0 + ai * HALF + m * 16) * 1024u + (unsigned)(col0 + bj * HALF)) * 2u;
                    f32x4 y0 = x0[m], y1 = x1[m];
                    if constexpr (!f32base) { y0 = y0 * gp[0]; y1 = y1 * gp[1]; }
                    y0 = y0 + gv[0] * acc[ai][bj][m][0]; y1 = y1 + gv[1] * acc[ai][bj][m][1];
                    ss[ai * 4 + m] += ((y0[0] * y0[0] + y0[1] * y0[1]) + (y0[2] * y0[2] + y0[3] * y0[3])) + ((y1[0] * y1[0] + y1[1] * y1[1]) + (y1[2] * y1[2] + y1[3] * y1[3]));
                    asm volatile("" : "+v"(ss[ai * 4 + m]));
                    const f32x4 h0 = y0 * gs[0], h1 = y1 * gs[1];
                    u32x4 hw; hw.x = cvt_pk_bf16(h0[0], h0[1]); hw.y = cvt_pk_bf16(h0[2], h0[3]); hw.z = cvt_pk_bf16(h1[0], h1[1]); hw.w = cvt_pk_bf16(h1[2], h1[3]);
                    gst<u32x4>(X, o2, hw); }
                asm volatile("" ::: "memory"); }
        }
        if (scaled) {
#pragma unroll
            for (int q = 0; q < 8; ++q) { float s = ss[q]; s += __shfl_xor(s, 16); s += __shfl_xor(s, 32);
                if (fq == 0) gst<float>(ssx, ((unsigned)(grow0 + (q >> 2) * HALF + (q & 3) * 16) * 16u + (unsigned)(4 * u.pn + wc)) * 4u, s); } }
    }
};

#ifndef DPP_UP
#define DPP_UP 0x121
#define DPP_DN 0x12F
#endif
struct UnitUp : Unit { int nrows; };
struct EpiUp {
    static constexpr bool PERM = true, PREFETCH = true;
    bf16_t* act; const float* cw; const float* cb; PG8_LAS float* xb;
    const float* ssx; const float* ub;
    __device__ __forceinline__ void prefetch(const UnitUp& u, int wid, int lane) const {
        dma_ssx(ssx, u.arow, xb, wid, lane);
        { const int arr = wid >> 1, half = wid & 1; const float* src = (arr < 3 ? cw + arr * 2816 : cb) + u.pn * HALF + half * 64 + lane;
          __builtin_amdgcn_global_load_lds((const unsigned*)src, (PG8_LAS unsigned*)(xb + EX_CW + arr * 128 + half * 64), 4, 0, 0); }
        if (wid < 2) { const int a0 = u.arow < 0 ? 0 : u.arow; const int b0 = a0 >= MLAT_ ? 8 : (a0 >> 11); const int bb_ = b0 + wid > 8 ? 8 : b0 + wid;
            __builtin_amdgcn_global_load_lds((const unsigned*)(ub + bb_ * 5632 + u.pn * BM + lane * 4), (PG8_LAS unsigned*)(xb + EX_BL + wid * 256), 16, 0, 0); }
    }
    __device__ __forceinline__ void operator()(f32x4 (&acc)[2][2][4][2], const UnitUp& u, int wr, int wc, int fr_in, int fq_in) const {
        int t_ = threadIdx.x; asm volatile("" : "+v"(t_)); const int fr = t_ & 15, fq = (t_ >> 4) & 3; (void)fr_in; (void)fq_in;
        const int lane = fq * 16 + fr;
        const int ccol = wc * 32 + 8 * fq;
        const int gc = u.pn * HALF + ccol;
        PG8_LAS float* CW = xb + EX_CW;
        unsigned rowflags;
        { unsigned pmask = 0u;
          const int a0 = u.arow < 0 ? 0 : u.arow, e0 = u.arow + 255;
          const int seam = (a0 >= MLAT_) ? (1 << 30) : (((a0 >> 11) + 1) << 11);
          const bool straddle = e0 >= seam;
          const PG8_LAS float* bl = xb + EX_BL + ccol;
          const f32x4 ug0 = *(const PG8_LAS f32x4*)(bl), ug1 = *(const PG8_LAS f32x4*)(bl + 4), uv0 = *(const PG8_LAS f32x4*)(bl + HALF), uv1 = *(const PG8_LAS f32x4*)(bl + HALF + 4);
#pragma unroll
          for (int ai = 0; ai < 2; ++ai)
#pragma unroll
            for (int m = 0; m < 4; ++m) { const int tr = ai * HALF + wr * 64 + m * 16 + fr; const int g = u.arow + tr;
                const int pos = g < MLAT_ ? (g & 2047) : ((g - MLAT_) & 255); const int last = g < MLAT_ ? 2047 : 255;
                if (pos == 0) pmask |= 1u << (4 * ai + m); if (pos == last) pmask |= 256u << (4 * ai + m);
                const f32x4 s4 = *(const PG8_LAS f32x4*)(xb + EX_SSX + tr * 16 + 4 * fq); float ssr = (s4[0] + s4[1]) + (s4[2] + s4[3]); ssr += __shfl_xor(ssr, 16); ssr += __shfl_xor(ssr, 32);
                const float rs = __builtin_amdgcn_rsqf(ssr * (1.0f / 1024.0f) + RMS_EPS);
                acc[ai][0][m][0] = acc[ai][0][m][0] * rs + ug0; acc[ai][0][m][1] = acc[ai][0][m][1] * rs + ug1;
                acc[ai][1][m][0] = acc[ai][1][m][0] * rs + uv0; acc[ai][1][m][1] = acc[ai][1][m][1] * rs + uv1; }
          if (straddle) {
              const f32x4 dg0 = *(const PG8_LAS f32x4*)(bl + 256) - ug0, dg1 = *(const PG8_LAS f32x4*)(bl + 260) - ug1, dv0 = *(const PG8_LAS f32x4*)(bl + 256 + HALF) - uv0, dv1 = *(const PG8_LAS f32x4*)(bl + 260 + HALF) - uv1;
#pragma unroll
              for (int ai = 0; ai < 2; ++ai)
#pragma unroll
                for (int m = 0; m < 4; ++m) { const int g = u.arow + ai * HALF + wr * 64 + m * 16 + fr; const float sel = (g >= seam) ? 1.0f : 0.0f;
                    acc[ai][0][m][0] += dg0 * sel; acc[ai][0][m][1] += dg1 * sel; acc[ai][1][m][0] += dv0 * sel; acc[ai][1][m][1] += dv1 * sel; } }
          rowflags = pmask; }
        PG8_LAS float* XF = xb + EX_XF; PG8_LAS float* XL = xb + EX_XL;
        const bool isF = (fr == 0), isL = (fr == 15);
#pragma unroll
        for (int ai = 0; ai < 2; ++ai) { const int blk = 2 * ai + wr;
            f32x4 s0, s1;
#pragma unroll
            for (int e = 0; e < 4; ++e) { s0[e] = isF ? acc[ai][0][0][0][e] : acc[ai][0][3][0][e]; s1[e] = isF ? acc[ai][0][0][1][e] : acc[ai][0][3][1][e]; }
            PG8_LAS float* dst = xb + (isF ? EX_XF : EX_XL) + blk * 128 + ccol;
            if (isF || isL) { *(PG8_LAS f32x4*)dst = s0; *(PG8_LAS f32x4*)(dst + 4) = s1; } }
        asm volatile("s_waitcnt lgkmcnt(0)" ::: "memory"); __builtin_amdgcn_s_barrier(); asm volatile("" ::: "memory");
        const int lup = (lane & 48) | ((lane - 1) & 15), ldn = (lane & 48) | ((lane + 1) & 15);
#pragma unroll
        for (int ai = 0; ai < 2; ++ai) { const int blk = 2 * ai + wr;
#pragma unroll
            for (int n = 0; n < 2; ++n) {
                const f32x4 w0 = *(const PG8_LAS f32x4*)(CW + ccol + 4 * n), w1 = *(const PG8_LAS f32x4*)(CW + 128 + ccol + 4 * n), w2 = *(const PG8_LAS f32x4*)(CW + 256 + ccol + 4 * n), bb = *(const PG8_LAS f32x4*)(CW + 384 + ccol + 4 * n);
                f32x4 xprev = (f32x4){0.f, 0.f, 0.f, 0.f}, xnext = (f32x4){0.f, 0.f, 0.f, 0.f};
                if (blk > 0) xprev = *(const PG8_LAS f32x4*)(XL + (blk - 1) * 128 + ccol + 4 * n);
                if (blk < 3) xnext = *(const PG8_LAS f32x4*)(XF + (blk + 1) * 128 + ccol + 4 * n);
#pragma unroll
                for (int e = 0; e < 4; ++e) {
                    float cur[4], up[4], dn[4];
#pragma unroll
                    for (int m = 0; m < 4; ++m) cur[m] = acc[ai][0][m][n][e];
#pragma unroll
                    for (int m = 0; m < 4; ++m) {
                        const float tu = isL ? (m > 0 ? cur[m > 0 ? m - 1 : 0] : xprev[e]) : cur[m];
                        const float td = isF ? (m < 3 ? cur[m < 3 ? m + 1 : 3] : xnext[e]) : cur[m];
                        up[m] = __shfl(tu, lup); dn[m] = __shfl(td, ldn); }
                    float rr[4];
#pragma unroll
                    for (int m = 0; m < 4; ++m) { const float upv = ((rowflags >> (4 * ai + m)) & 1u) ? 0.f : up[m], dnv = ((rowflags >> (8 + 4 * ai + m)) & 1u) ? 0.f : dn[m];
                        const float cv = w0[e] * upv + w1[e] * cur[m] + w2[e] * dnv + bb[e];
                        const float sg = cv * __builtin_amdgcn_rcpf(1.0f + __expf(-cv));
                        rr[m] = sg * acc[ai][1][m][n][e]; }
                    asm volatile("" : "+v"(rr[0]), "+v"(rr[1]), "+v"(rr[2]), "+v"(rr[3]));
#pragma unroll
                    for (int m = 0; m < 4; ++m) acc[ai][0][m][n][e] = rr[m];
                }
            }
#pragma unroll
            for (int m = 0; m < 4; ++m) { const int tr = ai * HALF + wr * 64 + m * 16 + fr; const int g = u.arow + tr;
                if (tr >= 1 && tr <= 254 && g < u.nrows) { const f32x4 v0 = acc[ai][0][m][0], v1 = acc[ai][0][m][1];
                    u32x4 w; w.x = cvt_pk_bf16(v0[0], v0[1]); w.y = cvt_pk_bf16(v0[2], v0[3]); w.z = cvt_pk_bf16(v1[0], v1[1]); w.w = cvt_pk_bf16(v1[2], v1[3]);
                    gst<u32x4>(act, ((unsigned)g * 2816u + (unsigned)gc) * 2u, w); } }
            asm volatile("" ::: "memory");
        }
        asm volatile("s_waitcnt lgkmcnt(0)" ::: "memory"); __builtin_amdgcn_s_barrier(); asm volatile("" ::: "memory");
    }
};
}
namespace att {
using bf16x8 = __attribute__((ext_vector_type(8))) short;
using s16x4  = __attribute__((ext_vector_type(4))) short;
using f32x16 = __attribute__((ext_vector_type(16))) float;
using u32x4  = __attribute__((ext_vector_type(4))) unsigned;
typedef unsigned short bf16_t;
constexpr int NW = 8, QBLK = 32, KVBLK = 64;
constexpr int LDQ = 768, LDK = 768, LDV = 512, LDO = 512;
constexpr float SCALE = 0.07216878364870322f;
constexpr float THR = 8.f;
constexpr int SHM_V = KVBLK * 128 * 2, SHM_K = KVBLK * 192 * 2;
constexpr int OFF_V = 0, OFF_K = 2 * SHM_V, OFF_WS = 2 * SHM_V + 2 * SHM_K, OFF_QR = OFF_WS + NW * 64 * 4, SHM_ATTN = OFF_QR + NW * 4096;
#define KSWZ(row, colB) ((row) * 384 + ((colB) ^ (((row) & 7) << 4)))
#define SBAR() __builtin_amdgcn_sched_barrier(0)
__device__ __forceinline__ int crow(int r, int hi) { return (r & 3) + 8 * (r >> 2) + 4 * hi; }
__device__ __forceinline__ unsigned cvtpk(float lo, float hi) { unsigned r; asm volatile("v_cvt_pk_bf16_f32 %0, %1, %2" : "=v"(r) : "v"(lo), "v"(hi)); return r; }

__device__ __forceinline__ void partialSM(f32x16& p0, f32x16& p1, float& m_reg, float& mn, float& alpha) {
  constexpr float C = SCALE * 1.4426950408889634f;
  float pmax = p0[0];
#pragma unroll
  for (int r = 1; r < 16; ++r) pmax = fmaxf(pmax, p0[r]);
#pragma unroll
  for (int r = 0; r < 16; ++r) pmax = fmaxf(pmax, p1[r]);
  { auto rr = __builtin_amdgcn_permlane32_swap(__float_as_uint(pmax), __float_as_uint(pmax), false, false);
    pmax = fmaxf(__uint_as_float(rr[0]), __uint_as_float(rr[1])); }
  if (__builtin_expect(__all(pmax - m_reg <= THR / SCALE), 1)) { mn = m_reg; alpha = 1.f; }
  else { mn = fmaxf(m_reg, pmax); alpha = __builtin_amdgcn_exp2f((m_reg - mn) * C); m_reg = mn; }
  float mnC = -mn * C;
#pragma unroll
  for (int r = 0; r < 16; ++r) p0[r] = fmaf(p0[r], C, mnC);
#pragma unroll
  for (int r = 0; r < 16; ++r) p1[r] = fmaf(p1[r], C, mnC);
#pragma unroll
  for (int r = 0; r < 16; ++r) p0[r] = __builtin_amdgcn_exp2f(p0[r]);
}
__device__ __forceinline__ void finishSM(f32x16& p0, f32x16& p1, float alpha, float& l_reg, bf16x8& pa0, bf16x8& pa1, bf16x8& pa2, bf16x8& pa3) {
#pragma unroll
  for (int r = 0; r < 16; ++r) p1[r] = __builtin_amdgcn_exp2f(p1[r]);
  float ps = 0;
#pragma unroll
  for (int r = 0; r < 16; ++r) ps += p0[r];
#pragma unroll
  for (int r = 0; r < 16; ++r) ps += p1[r];
  { auto rr = __builtin_amdgcn_permlane32_swap(__float_as_uint(ps), __float_as_uint(ps), false, false);
    ps = __uint_as_float(rr[0]) + __uint_as_float(rr[1]); }
  l_reg = l_reg * alpha + ps;
#define PK4(P, BASE, OUT) do { unsigned a0 = cvtpk(P[BASE + 0], P[BASE + 1]), a1 = cvtpk(P[BASE + 2], P[BASE + 3]);   \
    unsigned b0 = cvtpk(P[BASE + 4], P[BASE + 5]), b1 = cvtpk(P[BASE + 6], P[BASE + 7]);                              \
    auto r0 = __builtin_amdgcn_permlane32_swap(a0, b0, false, false); auto r1 = __builtin_amdgcn_permlane32_swap(a1, b1, false, false); \
    u32x4 w = {r0[0], r1[0], r0[1], r1[1]}; OUT = *reinterpret_cast<bf16x8*>(&w); } while (0)
  PK4(p0, 0, pa0); PK4(p0, 8, pa1); PK4(p1, 0, pa2); PK4(p1, 8, pa3);
#undef PK4
}
__device__ __forceinline__ void qkt(f32x16& p0, f32x16& p1, const char* Ks, const bf16x8* qr, const char* Qr, int r32, int hi) {
  p0 = f32x16{}; p1 = f32x16{};
#pragma unroll
  for (int d0 = 0; d0 < 12; ++d0) { int cb = (d0 * 16 + hi * 8) * 2;
    bf16x8 b0 = *reinterpret_cast<const bf16x8*>(Ks + KSWZ(r32, cb));
    bf16x8 b1 = *reinterpret_cast<const bf16x8*>(Ks + KSWZ(32 + r32, cb));
    bf16x8 q;
    if (d0 < 8) q = qr[d0];
    else q = *reinterpret_cast<const bf16x8*>(Qr + r32 * 128 + ((((d0 - 8) * 16 + hi * 8) * 2) ^ ((r32 & 7) << 4)));
    p0 = __builtin_amdgcn_mfma_f32_32x32x16_bf16(b0, q, p0, 0, 0, 0);
    p1 = __builtin_amdgcn_mfma_f32_32x32x16_bf16(b1, q, p1, 0, 0, 0); }
}
__device__ __forceinline__ int v_st(int k, int c) { const int kk = (k & ~0xC) | ((k & 4) << 1) | ((k & 8) >> 1); return ((kk >> 3) * 4 + (c >> 5)) * 512 + ((kk & 7) * 32 + (c & 31)) * 2; }
__device__ __forceinline__ int v_rd_base(int lane) { return ((lane & 3) << 3) | (((lane >> 2) & 3) << 6) | (((lane >> 4) & 1) << 5) | (((lane >> 5) & 1) << 8); }
constexpr int v_rd_off(int d0, int ks, int half) { return d0 * 512 + ks * 4096 + half * 2048; }
template <int OFF> __device__ __forceinline__ s16x4 tr_read(int vb) {
  s16x4 r; asm volatile("ds_read_b64_tr_b16 %0, %1 offset:%2" : "=&v"(r) : "v"(vb), "i"(OFF) : "memory"); return r;
}
template <int D0> __device__ __forceinline__ void pv_one(f32x16& od, int vb, bf16x8 pa0, bf16x8 pa1, bf16x8 pa2, bf16x8 pa3) {
  const s16x4 l0 = tr_read<v_rd_off(D0, 0, 0)>(vb), h0 = tr_read<v_rd_off(D0, 0, 1)>(vb), l1 = tr_read<v_rd_off(D0, 1, 0)>(vb), h1 = tr_read<v_rd_off(D0, 1, 1)>(vb);
  const s16x4 l2 = tr_read<v_rd_off(D0, 2, 0)>(vb), h2 = tr_read<v_rd_off(D0, 2, 1)>(vb), l3 = tr_read<v_rd_off(D0, 3, 0)>(vb), h3 = tr_read<v_rd_off(D0, 3, 1)>(vb);
  asm volatile("s_waitcnt lgkmcnt(0)" ::: "memory"); SBAR();
#define PK(L, H) (bf16x8){L[0], L[1], L[2], L[3], H[0], H[1], H[2], H[3]}
  od = __builtin_amdgcn_mfma_f32_32x32x16_bf16(pa0, PK(l0, h0), od, 0, 0, 0);
  od = __builtin_amdgcn_mfma_f32_32x32x16_bf16(pa1, PK(l1, h1), od, 0, 0, 0);
  od = __builtin_amdgcn_mfma_f32_32x32x16_bf16(pa2, PK(l2, h2), od, 0, 0, 0);
  od = __builtin_amdgcn_mfma_f32_32x32x16_bf16(pa3, PK(l3, h3), od, 0, 0, 0);
#undef PK
}
__device__ __forceinline__ void pv_d0(f32x16* o, int vb, bf16x8 pa0, bf16x8 pa1, bf16x8 pa2, bf16x8 pa3) {
  pv_one<0>(o[0], vb, pa0, pa1, pa2, pa3); pv_one<1>(o[1], vb, pa0, pa1, pa2, pa3); pv_one<2>(o[2], vb, pa0, pa1, pa2, pa3); pv_one<3>(o[3], vb, pa0, pa1, pa2, pa3);
}

__device__ __forceinline__ void attn_unit(const bf16_t* __restrict__ Qb, const bf16_t* __restrict__ Kg, const bf16_t* __restrict__ Vg, bf16_t* __restrict__ Ob,
                                          int r0, int n0, int r1, int NT, char* lds) {
  int tid = threadIdx.x; asm volatile("" : "+v"(tid));
  const int wid = tid >> 6, lane = tid & 63, r32 = lane & 31, hi = lane >> 5;
  char* V_lds = lds + OFF_V; char* K_lds = lds + OFF_K;
  float* ws = (float*)(lds + OFF_WS) + wid * 64; float* li_l = ws; float* al_l = ws + 32;
  float m_reg = -1e30f, l_reg = 0; f32x16 o[4] = {}; bf16x8 qr[8];
  const bf16_t* Qw = Qb + (long)(wid * QBLK + r32) * LDQ + hi * 8;
  char* Qr = lds + OFF_QR + wid * 4096;
#pragma unroll
  for (int d0 = 0; d0 < 8; ++d0) qr[d0] = *reinterpret_cast<const bf16x8*>(Qw + d0 * 16);
#pragma unroll
  for (int d0 = 8; d0 < 12; ++d0) { const bf16x8 q = *reinterpret_cast<const bf16x8*>(Qw + d0 * 16);
    *reinterpret_cast<bf16x8*>(Qr + r32 * 128 + ((((d0 - 8) * 16 + hi * 8) * 2) ^ ((r32 & 7) << 4))) = q; }
  const int sr = tid >> 4, sc = (tid & 15) * 8, vst0 = v_st(sr, sc), vst1 = v_st(32 + sr, sc);
  unsigned kgo[3], kst[3];
#pragma unroll
  for (int i = 0; i < 3; ++i) { const int id = tid + 512 * i, kr_ = id / 24, kc_ = id % 24; kgo[i] = (unsigned)(kr_ * LDK + kc_ * 8) * 2u; kst[i] = (unsigned)KSWZ(kr_, kc_ * 16); }
  const unsigned vgo0 = (unsigned)(sr * LDV + sc) * 2u, vgo1 = vgo0 + 32u * LDV * 2u;
  const int vb0 = (int)(uintptr_t)V_lds + v_rd_base(lane);
  bf16x8 vs0, vs1, ks0, ks1, ks2;
#define TROW(j) ((j) < n0 ? r0 + 64 * (j) : r1 + 64 * ((j) - n0))
#define SLOAD(j) do { const long tr_ = TROW(j); const char* Vt = (const char*)(Vg + tr_ * LDV); const char* Kt = (const char*)(Kg + tr_ * LDK);     \
    vs0 = *reinterpret_cast<const bf16x8*>(Vt + vgo0); vs1 = *reinterpret_cast<const bf16x8*>(Vt + vgo1); \
    ks0 = *reinterpret_cast<const bf16x8*>(Kt + kgo[0]); ks1 = *reinterpret_cast<const bf16x8*>(Kt + kgo[1]); ks2 = *reinterpret_cast<const bf16x8*>(Kt + kgo[2]); } while (0)
#define SWRITE(b) do { *(bf16x8*)(V_lds + (b) * SHM_V + vst0) = vs0; *(bf16x8*)(V_lds + (b) * SHM_V + vst1) = vs1; \
    *(bf16x8*)(K_lds + (b) * SHM_K + kst[0]) = ks0; *(bf16x8*)(K_lds + (b) * SHM_K + kst[1]) = ks1; *(bf16x8*)(K_lds + (b) * SHM_K + kst[2]) = ks2; } while (0)
#define RESC(a) do { if (__any((a) < 1.f)) { if (hi == 0) al_l[r32] = (a); asm volatile("s_waitcnt lgkmcnt(0)" ::: "memory"); \
    _Pragma("unroll") for (int d = 0; d < 4; ++d) _Pragma("unroll") for (int r = 0; r < 16; ++r) o[d][r] *= al_l[crow(r, hi)]; } } while (0)
  f32x16 pA0, pA1, pB0, pB1; float mnA, mnB, alA, alB; bf16x8 pa0, pa1, pa2, pa3;
  SLOAD(0); asm volatile("s_waitcnt vmcnt(0)" ::: "memory"); SWRITE(0); __syncthreads();
  qkt(pA0, pA1, K_lds, qr, Qr, r32, hi); partialSM(pA0, pA1, m_reg, mnA, alA);
  SLOAD(1);
  asm volatile("s_waitcnt vmcnt(0)" ::: "memory"); SWRITE(1); __syncthreads();
  for (int j = 1; j + 1 < NT; j += 2) {
    SBAR(); qkt(pB0, pB1, K_lds + SHM_K, qr, Qr, r32, hi);
    finishSM(pA0, pA1, alA, l_reg, pa0, pa1, pa2, pa3); SBAR();
    SLOAD(j + 1); SBAR();
    pv_d0(o, vb0, pa0, pa1, pa2, pa3); partialSM(pB0, pB1, m_reg, mnB, alB);
    __syncthreads(); asm volatile("s_waitcnt vmcnt(0)" ::: "memory"); SWRITE(0);
    RESC(alB); __syncthreads();
    SBAR(); qkt(pA0, pA1, K_lds, qr, Qr, r32, hi);
    finishSM(pB0, pB1, alB, l_reg, pa0, pa1, pa2, pa3); SBAR();
    SLOAD(j + 2); SBAR();
    pv_d0(o, vb0 + SHM_V, pa0, pa1, pa2, pa3); partialSM(pA0, pA1, m_reg, mnA, alA);
    __syncthreads(); asm volatile("s_waitcnt vmcnt(0)" ::: "memory"); SWRITE(1);
    RESC(alA); __syncthreads();
  }
  SBAR(); qkt(pB0, pB1, K_lds + SHM_K, qr, Qr, r32, hi);
  finishSM(pA0, pA1, alA, l_reg, pa0, pa1, pa2, pa3); SBAR();
  pv_d0(o, vb0, pa0, pa1, pa2, pa3); partialSM(pB0, pB1, m_reg, mnB, alB);
  __syncthreads(); RESC(alB);
  finishSM(pB0, pB1, alB, l_reg, pa0, pa1, pa2, pa3); SBAR();
  pv_d0(o, vb0 + SHM_V, pa0, pa1, pa2, pa3);
  if (hi == 0) li_l[r32] = l_reg; asm volatile("s_waitcnt lgkmcnt(0)" ::: "memory");
  float rli[16];
#pragma unroll
  for (int r = 0; r < 16; ++r) rli[r] = __builtin_amdgcn_rcpf(li_l[crow(r, hi)]);
  __syncthreads();
  { bf16_t* stg = (bf16_t*)(lds + wid * 8192);
#pragma unroll
    for (int r = 0; r < 16; ++r) { const int orow = crow(r, hi);
#pragma unroll
      for (int d0 = 0; d0 < 4; ++d0) { const unsigned pk = cvtpk(o[d0][r] * rli[r], 0.f); stg[orow * 128 + d0 * 32 + r32] = (bf16_t)(pk & 0xffffu); } }
    asm volatile("s_waitcnt lgkmcnt(0)" ::: "memory");
    bf16_t* Ow = Ob + (long)(wid * QBLK) * LDO;
#pragma unroll
    for (int i = 0; i < 8; ++i) { const int row = i * 4 + (lane >> 4), ch = lane & 15; const u32x4 v = *(const u32x4*)(stg + row * 128 + ch * 8); *(u32x4*)(Ow + (long)row * LDO + ch * 8) = v; } }
  __syncthreads();
#undef TROW
#undef SLOAD
#undef SWRITE
#undef RESC
}
#undef KSWZ
#undef SBAR
}
constexpr int NWAVES = 8;
#ifndef MK_SPLIT
#define MK_SPLIT 0
#endif

constexpr int DM = 1024, NB = 8, SL = 2048, CL = 256, MLAT = NB * SL, MCTX = NB * CL, MT = MLAT + MCTX;
constexpr int NIN = 2048;
constexpr int FF = 2816, NUP = 2 * FF;
constexpr int NPH = 20;
constexpr float EPS = 1e-6f;

constexpr size_t MiB = 1u << 20;
constexpr size_t WS_CTL = 0, CTL_ZERO_BYTES = 64 * 1024;
constexpr size_t WS_MOD = 1 * MiB;
constexpr size_t WS_ROPE = 1 * MiB + 512 * 1024;
constexpr size_t WS_SSQ = 2 * MiB;
constexpr int NWIN = 2304;
constexpr size_t WS_WIN = 53 * MiB, WIN_STRIDE = (size_t)NWIN * DM * 2;
constexpr size_t WS_WQKV = 12 * MiB, WQKV_STRIDE = (size_t)1792 * 384 * 2;
constexpr size_t WS_WOUT = 15 * MiB, WOUT_STRIDE = (size_t)DM * DM * 2;
constexpr size_t WS_WUP = 19 * MiB, WUP_STRIDE = (size_t)NUP * DM * 2;
constexpr size_t WS_WDOWN = 41 * MiB, WDOWN_STRIDE = (size_t)DM * FF * 2;
constexpr size_t WS_DFT = 52 * MiB;
constexpr size_t WS_DFTC = 68 * MiB;
constexpr size_t WS_CST = 68 * MiB + 256 * 1024;
constexpr size_t WS_WF = 248 * MiB;
constexpr size_t WS_XCTX = 69 * MiB;
constexpr size_t WS_XN = 77 * MiB;
constexpr size_t WS_Q = WS_XN, WS_YC = WS_XN + 27 * MiB;
constexpr size_t WS_P = 113 * MiB;
constexpr size_t WS_YCAT = WS_P, WS_ACT = WS_P;
constexpr size_t WS_YFP = WS_P + 36 * MiB;
constexpr size_t WS_K = 185 * MiB;
constexpr size_t WS_V = 212 * MiB;
constexpr size_t WS_CPART = 212 * MiB;
constexpr size_t WS_ZT = 230 * MiB;
constexpr size_t WS_ZTC = WS_ZT + 16 * MiB;
constexpr size_t WS_YF = WS_ZT;
constexpr size_t WS_FTAB = WS_DFT;
constexpr size_t OUT_ATT = 36 * MiB;
constexpr size_t WS_SSX = 250 * MiB;
constexpr size_t WS_PB = 252 * MiB;
constexpr size_t WS_UB = 253 * MiB;
constexpr size_t WS_END = 254 * MiB;
static_assert(WS_WQKV + 2 * WQKV_STRIDE <= WS_WOUT && WS_WOUT + 2 * WOUT_STRIDE <= WS_WUP && WS_WUP + 2 * WUP_STRIDE <= WS_WDOWN && WS_WDOWN + 2 * WDOWN_STRIDE <= WS_DFT, "weights map");
static_assert(WS_WIN + 2 * WIN_STRIDE <= 68 * MiB && WS_SSQ + (size_t)MT * 80 <= 4 * MiB && WS_XN + (size_t)MT * DM * 2 <= WS_P && WS_P + (size_t)MT * NIN * 2 <= WS_K && WS_K + (size_t)MT * 768 * 2 <= WS_V && WS_V + (size_t)MT * 512 * 2 <= WS_ZT, "activation map");
static_assert(WS_ACT + (size_t)MT * FF * 2 <= WS_V && WS_YC + (size_t)MT * 256 * 2 <= WS_P, "overlay map");
constexpr int CW_BAR = 4096;

constexpr int RING_OFF = 0, RING_BYTES = 131072;
constexpr int LDSCTL_OFF = RING_BYTES, MISC_OFF = LDSCTL_OFF + 320, PTR_OFF = LDSCTL_OFF + 512, EPIX_OFF = LDSCTL_OFF + 1024;
constexpr int LDS_BYTES = 163840;
static_assert(EPIX_OFF + 6400 * 4 <= LDS_BYTES, "LDS map");

#define GAS __attribute__((address_space(1)))
#define LAS __attribute__((address_space(3)))
typedef unsigned short bf16;
typedef unsigned v4u __attribute__((ext_vector_type(4)));
typedef unsigned v2u __attribute__((ext_vector_type(2)));
typedef float f32x4 __attribute__((ext_vector_type(4)));
typedef GAS unsigned gu32;
#define RLX_AGENT __ATOMIC_RELAXED, __HIP_MEMORY_SCOPE_AGENT
#define LDS_WAIT() asm volatile("s_waitcnt lgkmcnt(0)" ::: "memory")
#define VM_WAIT() asm volatile("s_waitcnt vmcnt(0)" ::: "memory")
__device__ __forceinline__ unsigned f2bf(float f) { unsigned u = __builtin_bit_cast(unsigned, f); return (u + 0x7fffu + ((u >> 16) & 1u)) >> 16; }
__device__ __forceinline__ unsigned pk2(float lo, float hi) { return f2bf(lo) | (f2bf(hi) << 16); }
__device__ __forceinline__ float bf2f(unsigned h) { return __builtin_bit_cast(float, h << 16); }

#define XB_TMO      128
#define XB_XCNT(j)  (256  + 64 * (j))
#define XB_XSUB(j)  (1280 + 64 * (j))
#define XB_XGEN(j)  (2304 + 64 * (j))
#define XB_TOP      3328
#define XB_TOPGEN   3392
#define XCD_BAR_WORDS 3456
#define XB_SPIN_CAP (1u << 20)
__device__ __forceinline__ unsigned xb_ld(unsigned* p)              { return __hip_atomic_load(p, __ATOMIC_RELAXED, __HIP_MEMORY_SCOPE_AGENT); }
__device__ __forceinline__ unsigned xb_add(unsigned* p, unsigned v) { return __hip_atomic_fetch_add(p, v, __ATOMIC_RELAXED, __HIP_MEMORY_SCOPE_AGENT); }
__device__ __forceinline__ unsigned xb_xcc_id() { return (unsigned)__builtin_amdgcn_s_getreg((3 << 11) | 20) & 0xFu; }
#define XB_SPIN(cond, bar) do { unsigned _sp = 0; while (cond) { __builtin_amdgcn_s_sleep(1); \
    if ((++_sp & 255u) == 0u) { if (xb_ld(&(bar)[XB_TMO])) break; if (_sp > XB_SPIN_CAP) { atomicAdd(&(bar)[XB_TMO], 1u); break; } } } } while (0)
struct XcdBarrier { unsigned* bar; unsigned x; volatile LAS unsigned* st; };
__device__ __forceinline__ XcdBarrier xcd_barrier_post(unsigned* bar, volatile LAS unsigned* st) {
    XcdBarrier b; b.bar = bar; b.x = xb_xcc_id(); b.st = st;
    if (threadIdx.x == 0) (void)xb_add(&bar[XB_XCNT(b.x)], 1u);
    return b;
}
__device__ __forceinline__ void xcd_barrier_complete(unsigned* bar, unsigned x, unsigned& nloc, unsigned& nx) {
    const unsigned G = gridDim.x * gridDim.y * gridDim.z;
    unsigned sum, cnt, mine, sp = 0u;
    for (;;) {
        sum = 0u; cnt = 0u; mine = 0u;
#pragma unroll
        for (unsigned j = 0; j < 16; ++j) { const unsigned c = xb_ld(&bar[XB_XCNT(j)]); sum += c; cnt += (c > 0u) ? 1u : 0u; mine = (j == x) ? c : mine; }
        if (sum == G) break;
        __builtin_amdgcn_s_sleep(1);
        if ((++sp & 255u) == 0u) { if (xb_ld(&bar[XB_TMO])) break; if (sp > XB_SPIN_CAP) { atomicAdd(&bar[XB_TMO], 1u); break; } }
    }
    nloc = mine > 0u ? mine : 1u; nx = cnt > 0u ? cnt : 1u;
}
__device__ __forceinline__ void xcd_barrier(const XcdBarrier& b) {
    asm volatile("s_waitcnt vmcnt(0)" ::: "memory");
    __syncthreads();
    if (threadIdx.x == 0) {
        unsigned* bar = b.bar;
        __builtin_amdgcn_s_waitcnt(0);
        unsigned nloc = b.st[0], nx = b.st[1];
        if (nloc == 0u) { xcd_barrier_complete(bar, b.x, nloc, nx); b.st[0] = nloc; b.st[1] = nx; }
        const unsigned old = xb_add(&bar[XB_XSUB(b.x)], 1u);
        const unsigned gen = old / nloc;
        if (old + 1u == (gen + 1u) * nloc) {
            __builtin_amdgcn_fence(__ATOMIC_RELEASE, "agent");
            asm volatile("s_waitcnt vmcnt(0)" ::: "memory");
            const unsigned og = xb_add(&bar[XB_TOP], 1u);
            const unsigned tg = og / nx;
            if (og + 1u == (tg + 1u) * nx) xb_add(&bar[XB_TOPGEN], 1u);
            else XB_SPIN(xb_ld(&bar[XB_TOPGEN]) == tg, bar);
            __builtin_amdgcn_fence(__ATOMIC_ACQUIRE, "agent");
            xb_add(&bar[XB_XGEN(b.x)], 1u);
            asm volatile("s_waitcnt vmcnt(0)" ::: "memory");
        } else {
            XB_SPIN(xb_ld(&bar[XB_XGEN(b.x)]) == gen, bar);
            __builtin_amdgcn_fence(__ATOMIC_ACQUIRE, "agent");
            asm volatile("s_waitcnt vmcnt(0)" ::: "memory");
        }
    }
    __syncthreads();
}

struct Args { const float* in[22]; float* out; unsigned char* ws; int ph_lo, ph_hi; };
enum { I_X = 0, I_C, I_CTX, I_CCTX, I_ADAW, I_ADAB, I_N1G, I_WIN, I_QNG, I_KVNG, I_WUQ, I_WUKV, I_SCW, I_SCB, I_ONG, I_WOUT, I_N2G, I_WUP, I_FCW, I_FCB, I_WDOWN, I_FING };

struct Frame {
    LAS unsigned char* lds; char* ldsg;
    volatile LAS unsigned* MISC;
    int tid, lane, wave, vcu, G, bx;
    unsigned char* ws; float* out;
};

__device__ __forceinline__ const float* inptr(const Frame& F, int i) {
    const LAS unsigned* T = (const LAS unsigned*)(F.lds + PTR_OFF) + 2 * i;
    const unsigned lo = __builtin_amdgcn_readfirstlane(T[0]), hi = __builtin_amdgcn_readfirstlane(T[1]);
    return (const float*)(const GAS float*)(((unsigned long long)hi << 32) | (unsigned long long)lo);
}
__device__ __forceinline__ float wave_sum(float v) {
#pragma unroll
    for (int o = 1; o < 64; o <<= 1) v += __shfl_xor(v, o);
    return v;
}

__device__ __host__ __forceinline__ int rope_slot(int d) { return 8 * ((d & 15) >> 2) + 4 * (d >> 4) + (d & 3); }
__device__ __forceinline__ void tr_item(const float* W, int ldw, int k0, int c0, bf16* WT, int ldt, int r0, const float* ks, LAS float* scr, int lane, bool ropeperm = false) {
    f32x4 v[8];
#pragma unroll
    for (int i = 0; i < 8; ++i) { const int kk = 8 * i + (lane >> 3); v[i] = *(const GAS f32x4*)(W + (size_t)(k0 + kk) * ldw + c0 + 4 * (lane & 7)); }
#pragma unroll
    for (int i = 0; i < 8; ++i) { const int kk = 8 * i + (lane >> 3); const float sc = ks ? ks[k0 + kk] : 1.0f; LAS float* d = scr + kk * 33 + 4 * (lane & 7);
        d[0] = v[i][0] * sc; d[1] = v[i][1] * sc; d[2] = v[i][2] * sc; d[3] = v[i][3] * sc; }
    LDS_WAIT(); asm volatile("" ::: "memory");
    const int c = lane & 7;
#pragma unroll
    for (int j = 0; j < 4; ++j) { const int n = (lane >> 3) + 8 * j; const LAS float* s = scr + (8 * c) * 33 + n;
        v4u o; o.x = pk2(s[0 * 33], s[1 * 33]); o.y = pk2(s[2 * 33], s[3 * 33]); o.z = pk2(s[4 * 33], s[5 * 33]); o.w = pk2(s[6 * 33], s[7 * 33]);
        *(GAS v4u*)(WT + (size_t)(r0 + (ropeperm ? rope_slot(n) : n)) * ldt + k0 + 8 * c) = o; }
    LDS_WAIT(); asm volatile("" ::: "memory");
}
__device__ __forceinline__ void p0_prologue(Frame& F, int sub, int defer, int gw, int NGW) {
    unsigned char* ws = F.ws;
    float* MOD = (float*)(ws + WS_MOD);
    if (F.bx < 192 && (sub & 1) && defer == 0) {
        const int l = F.bx / 96, cb = F.bx % 96;
        LAS float* S = (LAS float*)(F.lds + F.wave * 4608);
        const float* cin = inptr(F, I_C); const float* cctx = inptr(F, I_CCTX);
        for (int i = F.lane; i < 9 * 128; i += 64) { const int r = i >> 7, kk = i & 127, k = 128 * F.wave + kk; const float cv = (r < 8) ? cin[r * 1024 + k] : cctx[k]; S[i] = cv / (1.0f + __expf(-cv)); }
        LDS_WAIT(); asm volatile("" ::: "memory");
        f32x4 acc[9];
#pragma unroll
        for (int r = 0; r < 9; ++r) acc[r] = (f32x4){0.f, 0.f, 0.f, 0.f};
        const int kr = F.lane >> 4, cl = F.lane & 15;
        const float* W = inptr(F, I_ADAW) + (size_t)l * 1024 * 6144 + (size_t)(128 * F.wave) * 6144 + 64 * cb + 4 * cl;
#pragma unroll 8
        for (int i = 0; i < 32; ++i) { const int kk = 4 * i + kr; const f32x4 w = *(const f32x4*)(W + (size_t)kk * 6144);
#pragma unroll
            for (int r = 0; r < 9; ++r) acc[r] += w * S[r * 128 + kk]; }
        LAS float* RED = (LAS float*)(F.lds + 40960);
#pragma unroll
        for (int r = 0; r < 9; ++r)
#pragma unroll
            for (int e = 0; e < 4; ++e) { float v = acc[r][e]; v += __shfl_xor(v, 16); v += __shfl_xor(v, 32); if (kr == 0) RED[(F.wave * 9 + r) * 64 + 4 * cl + e] = v; }
        __syncthreads();
        for (int i = F.tid; i < 576; i += 512) { const int r = i >> 6, col = i & 63; float s = 0.f;
#pragma unroll
            for (int w = 0; w < 8; ++w) s += RED[(w * 9 + r) * 64 + col];
            MOD[(size_t)(l * 9 + r) * 6144 + 64 * cb + col] = s + inptr(F, I_ADAB)[l * 6144 + 64 * cb + col]; }
        __syncthreads();
    }
    if (F.bx == 255 % F.G && defer == 0) {
        float* RC = (float*)(ws + WS_ROPE); float* RS = RC + 1024;
        for (int idx = F.tid; idx < 1024; idx += 512) { const int pos = idx >> 4, i = idx & 15; const float inv = powf(10000.0f, -(float)(2 * i) / 32.0f); const float ang = (float)pos * inv; RC[idx] = cosf(ang); RS[idx] = sinf(ang); }
    }
    LAS float* scr = (LAS float*)(F.lds + F.wave * 16384);
    constexpr int I_WINA = 22 * 16, I_WINB = 24 * 16, I_WINC = 8 * 16, I_PAD = 8, I_FOLD = 64, I_UQ = 6 * 24, I_UKV = 4 * 32, I_OUT = 16 * 32, I_UP = 16 * 176, I_DOWN = 44 * 32;
    constexpr int PER_LAYER = I_WINA + I_WINB + I_WINC + I_PAD + I_FOLD + I_UQ + I_UKV + I_OUT + I_UP + I_DOWN;
    constexpr int I_DFT = 352, I_DFTC = 256, I_CST = 512;
    constexpr int NITEMS = 2 * PER_LAYER + I_DFT + I_DFTC + I_CST;
    for (int it = gw; it < NITEMS; it += NGW) {
        int r = it;
        { int cat = 2; bool early = false; if (r < 2 * PER_LAYER) { const int q = r % PER_LAYER;
              constexpr int W0 = I_WINA + I_WINB + I_WINC + I_PAD; early = r < PER_LAYER && q >= W0 + I_FOLD && q < W0 + I_FOLD + I_UQ + I_UKV;
              cat = q < W0 ? 1 : q < W0 + I_FOLD ? 3 : q < W0 + I_FOLD + I_UQ + I_UKV + I_OUT ? 4 : q < PER_LAYER - I_DOWN ? 5 : 6; }
          if (!((sub >> cat) & 1)) continue;
          const int dcls = (r < 2 * PER_LAYER && cat >= 4 && !early) ? ((r < PER_LAYER && cat < 6) ? 1 : 2) : 0; if (dcls != defer) continue; }
        if (r < 2 * PER_LAYER) {
            const int l = r / PER_LAYER; r -= l * PER_LAYER;
            bf16* WinT = (bf16*)(ws + WS_WIN + l * WIN_STRIDE);
            const float* win = inptr(F, I_WIN) + (size_t)l * 1024 * 1728;
            if (r < I_WINA) { const int kb = r / 22, nb = r % 22; tr_item(win, 1728, 64 * kb, 32 * nb, WinT, 1024, 32 * nb, nullptr, scr, F.lane); continue; } r -= I_WINA;
            if (r < I_WINB) { const int kb = r / 24, nb = r % 24; tr_item(win, 1728, 64 * kb, 960 + 32 * nb, WinT, 1024, 1280 + 32 * nb, nullptr, scr, F.lane); continue; } r -= I_WINB;
            if (r < I_WINC) { const int kb = r / 8, nb = r % 8; tr_item(win, 1728, 64 * kb, 704 + 32 * nb, WinT, 1024, 2048 + 32 * nb, nullptr, scr, F.lane); continue; } r -= I_WINC;
            if (r < I_PAD) { const v4u z = {0u, 0u, 0u, 0u};
#pragma unroll
                for (int j = 0; j < 16; ++j) { const int q = j * 64 + F.lane; *(GAS v4u*)(WinT + (size_t)(704 + 8 * r + (q >> 7)) * 1024 + (q & 127) * 8) = z; } continue; } r -= I_PAD;
            if (r < I_FOLD) { bf16* WF = (bf16*)(ws + WS_WF) + (size_t)l * 1024 * 256;
#pragma unroll 4
                for (int i = 0; i < 16; ++i) { const int k = 16 * r + i; const f32x4 v = *(const GAS f32x4*)(win + (size_t)k * 1728 + 704 + 4 * F.lane);
                    v2u o; o.x = pk2(v[0], v[1]); o.y = pk2(v[2], v[3]); *(GAS v2u*)(WF + (size_t)k * 256 + 4 * F.lane) = o; } continue; } r -= I_FOLD;
            if (r < I_UQ) { const int kb = r / 24, nb = r % 24; tr_item(inptr(F, I_WUQ) + (size_t)l * 384 * 768, 768, 64 * kb, 32 * nb, (bf16*)(ws + WS_WQKV + l * WQKV_STRIDE), 384, 32 * nb, inptr(F, I_QNG) + l * 384, scr, F.lane, (nb % 6) >= 4); continue; } r -= I_UQ;
            if (r < I_UKV) { const int kb = r / 32, nb = r % 32; tr_item(inptr(F, I_WUKV) + (size_t)l * 256 * 1024, 1024, 64 * kb, 32 * nb, (bf16*)(ws + WS_WQKV + l * WQKV_STRIDE) + (size_t)768 * 384, 384, 32 * nb, inptr(F, I_KVNG) + l * 256, scr, F.lane); continue; } r -= I_UKV;
            if (r < I_OUT) { const int kb = r / 32, nb = r % 32; tr_item(inptr(F, I_WOUT) + (size_t)l * 1024 * 1024, 1024, 64 * kb, 32 * nb, (bf16*)(ws + WS_WOUT + l * WOUT_STRIDE), 1024, 32 * nb, inptr(F, I_ONG) + l * 1024, scr, F.lane); continue; } r -= I_OUT;
            if (r < I_UP) { const int kb = r / 176, nb = r % 176;
                const int j = nb >> 3, h = (nb >> 2) & 1, q = nb & 3;
                tr_item(inptr(F, I_WUP) + (size_t)l * 1024 * NUP, NUP, 64 * kb, h * FF + 128 * j + 32 * q, (bf16*)(ws + WS_WUP + l * WUP_STRIDE), 1024, 32 * nb, nullptr, scr, F.lane); continue; } r -= I_UP;
            { const int kb = r / 32, nb = r % 32; tr_item(inptr(F, I_WDOWN) + (size_t)l * FF * 1024, 1024, 64 * kb, 32 * nb, (bf16*)(ws + WS_WDOWN + l * WDOWN_STRIDE), FF, 32 * nb, nullptr, scr, F.lane); continue; }
        }
        r -= 2 * PER_LAYER;
        if (r < I_DFT) {
            if (r < 128) { const int ro = r >> 6, c = r & 63; bf16* D = (bf16*)(ws + WS_FTAB) + (size_t)r * 128; float v[2];
#pragma unroll
                for (int e = 0; e < 2; ++e) { const int k = 2 * F.lane + e, ri = k >> 6, s = k & 63; const float x = (float)((c * s) & 63) * (1.0f / 32.0f); const float C = cospif(x), S = sinpif(x);
                    v[e] = (ro == ri) ? C : (ro == 0 ? -S : S); }
                *(GAS unsigned*)(D + 2 * F.lane) = pk2(v[0], v[1]); continue; }
            if (r < 160) { const int a = r - 128, ro = F.lane >> 5, rr = F.lane & 31; const float x = (float)((a * rr) & 31) * (1.0f / 16.0f); const float v = ro ? -sinpif(x) : cospif(x);
                *(GAS unsigned short*)((bf16*)(ws + WS_FTAB + 32768) + (size_t)a * 64 + F.lane) = (unsigned short)(pk2(v, 0.f) & 0xffffu); continue; }
            if (r >= 224) { const int rr = r - 224, kb = rr >> 4, col = rr & 15, ri = col >> 3, k2 = 8 * kb + (col & 7);
                const float x = (float)((k2 * F.lane) & 63) * (1.0f / 32.0f); const float v = ri ? sinpif(x) : cospif(x);
                *(GAS unsigned short*)((bf16*)(ws + WS_FTAB + 65536) + (size_t)rr * 64 + F.lane) = (unsigned short)(pk2(v, 0.f) & 0xffffu); continue; }
            { const int c = r - 160; if (F.lane < 32) { const float x = (float)(c * F.lane) * (1.0f / 1024.0f); pg8::f32x2 t; t.x = cospif(x); t.y = sinpif(x);
                *(GAS pg8::f32x2*)((float*)(ws + WS_FTAB + 40960) + (size_t)(c * 32 + F.lane) * 2) = t; } }
            continue; }
        r -= I_DFT;
        if (r >= I_DFTC) { r -= I_DFTC;
            const int sn = r >> 8, g = (r >> 6) & 3, k2 = r & 63; float v[4];
#pragma unroll
            for (int e = 0; e < 4; ++e) { const int j = 4 * F.lane + e; const float x = (float)((k2 * (j & 63)) & 63) * (1.0f / 32.0f); v[e] = ((j >> 6) == g) ? (sn ? sinpif(x) : cospif(x)) : 0.0f; }
            v2u o; o.x = pk2(v[0], v[1]); o.y = pk2(v[2], v[3]); *(GAS v2u*)((bf16*)(ws + WS_CST) + (size_t)r * 256 + 4 * F.lane) = o; continue; }
        { const int k1 = r; bf16* D = (bf16*)(ws + WS_DFTC) + (size_t)k1 * 512; const int n0 = 8 * F.lane; float v[8];
#pragma unroll
            for (int e = 0; e < 8; ++e) { const int n = n0 + e, n1 = n & 255; const float x = (float)((k1 * n1) & 255) * (1.0f / 128.0f); v[e] = (n < 256) ? cospif(x) : -sinpif(x); }
            v4u o; o.x = pk2(v[0], v[1]); o.y = pk2(v[2], v[3]); o.z = pk2(v[4], v[5]); o.w = pk2(v[6], v[7]); *(GAS v4u*)(D + n0) = o; }
    }
}

__device__ __forceinline__ void bias_section(Frame& F, const bf16* WT, int nrows, const float* mod, int shofs, float* out, int gw, int NGW) {
    LAS float* SH = (LAS float*)F.lds;
    __syncthreads();
    for (int i = F.tid; i < 9 * 256; i += NWAVES * 64) { const int bb = i >> 8, k4 = i & 255; *(LAS f32x4*)(SH + bb * 1024 + 4 * k4) = *(const GAS f32x4*)(mod + bb * 6144 + shofs + 4 * k4); }
    __syncthreads();
    for (int n0 = gw; n0 < nrows; n0 += 2 * NGW) {
        const int n1 = n0 + NGW; const bool two = n1 < nrows; const int n1c = two ? n1 : n0;
        v2u w0[4], w1[4];
#pragma unroll
        for (int q = 0; q < 4; ++q) { w0[q] = *(const GAS v2u*)(WT + (size_t)n0 * 1024 + 256 * q + 4 * F.lane); w1[q] = *(const GAS v2u*)(WT + (size_t)n1c * 1024 + 256 * q + 4 * F.lane); }
#pragma unroll 3
        for (int bb = 0; bb < 9; ++bb) { float s0 = 0.f, s1 = 0.f;
#pragma unroll
            for (int q = 0; q < 4; ++q) { const f32x4 s = *(const LAS f32x4*)(SH + bb * 1024 + 256 * q + 4 * F.lane);
                s0 += (s[0] * bf2f(w0[q].x & 0xffffu) + s[1] * bf2f(w0[q].x >> 16)) + (s[2] * bf2f(w0[q].y & 0xffffu) + s[3] * bf2f(w0[q].y >> 16));
                s1 += (s[0] * bf2f(w1[q].x & 0xffffu) + s[1] * bf2f(w1[q].x >> 16)) + (s[2] * bf2f(w1[q].y & 0xffffu) + s[3] * bf2f(w1[q].y >> 16)); }
            const float r0 = wave_sum(s0), r1 = wave_sum(s1);
            if (F.lane == 0) { out[(size_t)bb * nrows + n0] = r0; if (two) out[(size_t)bb * nrows + n1] = r1; } }
    }
    __syncthreads();
}
__device__ __forceinline__ void bias_phase(Frame& F, int which, int gw, int NGW) {
    const float* MODp = (const float*)(F.ws + WS_MOD);
    if (which & 1) bias_section(F, (const bf16*)(F.ws + WS_WIN + WIN_STRIDE), NWIN, MODp + 9 * 6144, 0, (float*)(F.ws + WS_PB) + 9 * NWIN, gw, NGW);
    if (which & 2) bias_section(F, (const bf16*)(F.ws + WS_WUP), 5632, MODp, 3072, (float*)(F.ws + WS_UB), gw, NGW);
    if (which & 4) bias_section(F, (const bf16*)(F.ws + WS_WUP + WUP_STRIDE), 5632, MODp + 9 * 6144, 3072, (float*)(F.ws + WS_UB) + (size_t)9 * 5632, gw, NGW);
}

__device__ __forceinline__ void norm_mod_phase(Frame& F, const float* src_lat, const float* src_ctx, int nrows, const float* g, const float* mod  , int shofs, int scofs, int skip) {
    bf16* XN = (bf16*)(F.ws + WS_XN);
    if (F.bx < skip) return;
    const int gw = (F.bx - skip) * NWAVES + F.wave, NGW = (F.G - skip) * NWAVES;
    constexpr int R = 2;
    f32x4 v[R][4], w[R][4];
#define NM_LOAD(dst, r0_) do { _Pragma("unroll") for (int q = 0; q < R; ++q) { const int row = (r0_) + q * NGW; if (row < nrows) { const float* xr = row < MLAT ? src_lat + (size_t)row * DM : src_ctx + (size_t)(row - MLAT) * DM; \
        _Pragma("unroll") for (int j = 0; j < 4; ++j) dst[q][j] = *(const f32x4*)(xr + 256 * j + 4 * F.lane); } } } while (0)
    NM_LOAD(v, gw);
    for (int row0 = gw; row0 < nrows; row0 += R * NGW) {
        NM_LOAD(w, row0 + R * NGW);
#pragma unroll
        for (int q = 0; q < R; ++q) { const int row = row0 + q * NGW; if (row < nrows) {
            const int r = row < MLAT ? (row >> 11) : 8;
            const float* sh = mod + r * 6144 + shofs; const float* sc = mod + r * 6144 + scofs; float ss = 0.f;
#pragma unroll
            for (int j = 0; j < 4; ++j) ss += (v[q][j][0] * v[q][j][0] + v[q][j][1] * v[q][j][1]) + (v[q][j][2] * v[q][j][2] + v[q][j][3] * v[q][j][3]);
            const float rstd = 1.0f / sqrtf(wave_sum(ss) * (1.0f / DM) + EPS);
#pragma unroll
            for (int j = 0; j < 4; ++j) { const int c = 256 * j + 4 * F.lane; const f32x4 gg = *(const f32x4*)(g + c), s1 = *(const f32x4*)(sc + c), s0 = *(const f32x4*)(sh + c);
                const f32x4 h = (v[q][j] * rstd) * gg * (s1 + 1.0f) + s0;
                v2u o; o.x = pk2(h[0], h[1]); o.y = pk2(h[2], h[3]); *(GAS v2u*)(XN + (size_t)row * DM + c) = o; } } }
#pragma unroll
        for (int q = 0; q < R; ++q)
#pragma unroll
            for (int j = 0; j < 4; ++j) v[q][j] = w[q][j];
    }
#undef NM_LOAD
}
__device__ __forceinline__ void qkv_rows_phase(Frame& F, int l) {
    const bf16* P = (const bf16*)(F.ws + WS_P); bf16* Kb = (bf16*)(F.ws + WS_K); bf16* YC = (bf16*)F.out + (size_t)MT * 768;
    const float* RC = (const float*)(F.ws + WS_ROPE); const float* RS = RC + 1024;
    const float* scw = inptr(F, I_SCW) + l * 3 * 256; const float* scb = inptr(F, I_SCB) + l * 256;
    const int gw = F.vcu * NWAVES + F.wave, NGW = F.G * NWAVES;
    const int nrows_conv = (l == 0) ? MT : MLAT;
    for (int row = gw; row < MT; row += NGW) {
        const bool lat = row < MLAT; const int t = lat ? (row & 2047) : ((row - MLAT) & 255); const int L = lat ? SL : CL;
        const bf16* pr = P + (size_t)row * NIN;
        { const float v = bf2f(pr[640 + F.lane]); const float pv = __shfl_xor(v, 16); float o = v;
          if (lat) { const int j = F.lane, ax = j >> 5, i = j & 15, x2 = (j >> 4) & 1; const int pos = ax ? (t & 63) : (t >> 6); const float c = RC[pos * 16 + i], s = RS[pos * 16 + i];
              o = x2 ? (pv * s + v * c) : (v * c - pv * s); }
          const bf16 ob = (bf16)f2bf(o);
          const int slot = (F.lane & 32) + rope_slot(F.lane & 31);
#pragma unroll
          for (int h = 0; h < 4; ++h) Kb[(size_t)row * 768 + 192 * h + 128 + slot] = ob; }
        if (row < nrows_conv) { const int c = 4 * F.lane;
            const v2u bgv = *(const GAS v2u*)(pr + 1280 + c);
            const v2u cg1 = *(const GAS v2u*)(pr + 1536 + c), xv1 = *(const GAS v2u*)(pr + 1792 + c);
            v2u cg0 = {0u, 0u}, xv0 = {0u, 0u}, cg2 = {0u, 0u}, xv2 = {0u, 0u};
            if (t > 0) { cg0 = *(const GAS v2u*)(pr - NIN + 1536 + c); xv0 = *(const GAS v2u*)(pr - NIN + 1792 + c); }
            if (t < L - 1) { cg2 = *(const GAS v2u*)(pr + NIN + 1536 + c); xv2 = *(const GAS v2u*)(pr + NIN + 1792 + c); }
            const f32x4 w0 = *(const f32x4*)(scw + c), w1 = *(const f32x4*)(scw + 256 + c), w2 = *(const f32x4*)(scw + 512 + c), bb = *(const f32x4*)(scb + c);
            float y[4];
#pragma unroll
            for (int e = 0; e < 4; ++e) { const unsigned sh = (e & 1) * 16; const unsigned m = 0xffffu;
                const unsigned b_ = ((e < 2 ? bgv.x : bgv.y) >> sh) & m;
                const unsigned c0_ = ((e < 2 ? cg0.x : cg0.y) >> sh) & m, x0_ = ((e < 2 ? xv0.x : xv0.y) >> sh) & m;
                const unsigned c1_ = ((e < 2 ? cg1.x : cg1.y) >> sh) & m, x1_ = ((e < 2 ? xv1.x : xv1.y) >> sh) & m;
                const unsigned c2_ = ((e < 2 ? cg2.x : cg2.y) >> sh) & m, x2_ = ((e < 2 ? xv2.x : xv2.y) >> sh) & m;
                const float u0 = bf2f(c0_) * bf2f(x0_), u1 = bf2f(c1_) * bf2f(x1_), u2 = bf2f(c2_) * bf2f(x2_);
                y[e] = bf2f(b_) * (w0[e] * u0 + w1[e] * u1 + w2[e] * u2 + bb[e]); }
            v2u o; o.x = pk2(y[0], y[1]); o.y = pk2(y[2], y[3]); *(GAS v2u*)(YC + (size_t)row * 256 + c) = o; }
    }
}
__device__ __forceinline__ void fnet_fft_unit(Frame& F, int b, int jb) {
    int tid = threadIdx.x; asm volatile("" : "+v"(tid));
    const int w = tid >> 6, l = tid & 63, l15 = l & 15, lq = l >> 4;
    const bf16* P = (const bf16*)(F.ws + WS_P); bf16* YF = (bf16*)(F.ws + WS_YF);
    const bf16* A1g = (const bf16*)(F.ws + WS_FTAB); const bf16* W2g = (const bf16*)(F.ws + WS_FTAB + 32768); const float* TWg = (const float*)(F.ws + WS_FTAB + 40960);
    LAS unsigned char* B1 = F.lds; LAS unsigned char* A1 = F.lds + 69632; LAS unsigned char* TW = F.lds + 104448;
    {
        const int g = jb >> 3, kb = jb & 7;
        const bf16* CTg = (const bf16*)(F.ws + WS_FTAB + 65536) + kb * 1024;
        const pg8::bf16x8 ct0 = *(const GAS pg8::bf16x8*)(CTg + l15 * 64 + 8 * lq), ct1 = *(const GAS pg8::bf16x8*)(CTg + l15 * 64 + 32 + 8 * lq);
#pragma unroll
        for (int i = 0; i < 4; ++i) { const int idx = tid + 512 * i, row = idx >> 4, ch = idx & 15; const v4u v = *(const GAS v4u*)(A1g + row * 128 + ch * 8); *(LAS v4u*)(A1 + row * 272 + ch * 16) = v; }
#pragma unroll
        for (int i = 0; i < 2; ++i) { const int idx = tid + 512 * i; const v4u v = *(const GAS v4u*)(TWg + idx * 4); *(LAS v4u*)(TW + idx * 16) = v; }
#pragma unroll
        for (int hb = 0; hb < 2; ++hb) {
            pg8::bf16x8 uf[8][2];
#pragma unroll
            for (int q = 0; q < 8; ++q) { const int blk = w * 16 + hb * 8 + q; const bf16* src = P + (size_t)(b * SL + 16 * blk + l15) * NIN + 768 + 64 * g + 8 * lq;
                uf[q][0] = *(const GAS pg8::bf16x8*)src; uf[q][1] = *(const GAS pg8::bf16x8*)(src + 32); }
#pragma unroll
            for (int q = 0; q < 8; ++q) { const int blk = w * 16 + hb * 8 + q;
                f32x4 d = (f32x4){0.f, 0.f, 0.f, 0.f};
                d = __builtin_amdgcn_mfma_f32_16x16x32_bf16(ct0, uf[q][0], d, 0, 0, 0); d = __builtin_amdgcn_mfma_f32_16x16x32_bf16(ct1, uf[q][1], d, 0, 0, 0);
                const int r = 16 * (blk & 1) + l15, s = blk >> 1;
                LAS unsigned char* dst = B1 + (32 * 4 * (lq & 1) + r) * 272 + (64 * (lq >> 1) + s) * 2;
                const unsigned p01 = pk2(d[0], d[1]), p23 = pk2(d[2], d[3]);
                *(LAS unsigned short*)(dst + 0 * 8704) = (unsigned short)(p01 & 0xffffu); *(LAS unsigned short*)(dst + 1 * 8704) = (unsigned short)(p01 >> 16);
                *(LAS unsigned short*)(dst + 2 * 8704) = (unsigned short)(p23 & 0xffffu); *(LAS unsigned short*)(dst + 3 * 8704) = (unsigned short)(p23 >> 16); } } }
    pg8::bf16x8 w2[2][2];
#pragma unroll
    for (int ab = 0; ab < 2; ++ab)
#pragma unroll
        for (int ks = 0; ks < 2; ++ks) w2[ab][ks] = *(const GAS pg8::bf16x8*)(W2g + (ab * 16 + l15) * 64 + ks * 32 + 8 * lq);
    __syncthreads();
    f32x4 acc[8][2];
#pragma unroll
    for (int mb = 0; mb < 8; ++mb) { acc[mb][0] = (f32x4){0.f, 0.f, 0.f, 0.f}; acc[mb][1] = (f32x4){0.f, 0.f, 0.f, 0.f}; }
#pragma unroll
    for (int ks = 0; ks < 4; ++ks) {
        const pg8::bf16x8 b0 = *(const LAS pg8::bf16x8*)(B1 + ((2 * w + 0) * 16 + l15) * 272 + ks * 64 + lq * 16);
        const pg8::bf16x8 b1 = *(const LAS pg8::bf16x8*)(B1 + ((2 * w + 1) * 16 + l15) * 272 + ks * 64 + lq * 16);
#pragma unroll
        for (int mb = 0; mb < 8; ++mb) { const pg8::bf16x8 af = *(const LAS pg8::bf16x8*)(A1 + (mb * 16 + l15) * 272 + ks * 64 + lq * 16);
            acc[mb][0] = __builtin_amdgcn_mfma_f32_16x16x32_bf16(af, b0, acc[mb][0], 0, 0, 0);
            acc[mb][1] = __builtin_amdgcn_mfma_f32_16x16x32_bf16(af, b1, acc[mb][1], 0, 0, 0); } }
    __syncthreads();
    LAS unsigned char* B2 = F.lds;
    {
#pragma unroll
      for (int mbp = 0; mbp < 4; ++mbp)
#pragma unroll
        for (int nbl = 0; nbl < 2; ++nbl) { const int r = 16 * nbl + l15;
#pragma unroll
            for (int i = 0; i < 4; ++i) { const int c = mbp * 16 + 4 * lq + i;
                const pg8::f32x2 t = *(const LAS pg8::f32x2*)(TW + (c * 32 + r) * 8);
                const float ar = acc[mbp][nbl][i], ai = acc[mbp + 4][nbl][i];
                const unsigned pk = pk2(ar * t.x - ai * t.y, ar * t.y + ai * t.x);
                LAS unsigned char* d = B2 + (c * 8 + w) * 144 + 2 * (l15 & 7);
                *(LAS unsigned short*)(d + (((r >> 3) ^ (2 * lq)) * 16)) = (unsigned short)(pk & 0xffffu); *(LAS unsigned short*)(d + (((4 + (r >> 3)) ^ (2 * lq)) * 16)) = (unsigned short)(pk >> 16); } } }
    __syncthreads();
    f32x4 y[4][2];
#pragma unroll
    for (int nbp = 0; nbp < 4; ++nbp) { y[nbp][0] = (f32x4){0.f, 0.f, 0.f, 0.f}; y[nbp][1] = (f32x4){0.f, 0.f, 0.f, 0.f}; }
#pragma unroll
    for (int nbp = 0; nbp < 4; ++nbp) { const int sw = 2 * ((2 * w + (nbp >> 1)) & 3);
#pragma unroll
        for (int ks = 0; ks < 2; ++ks) { const pg8::bf16x8 af = *(const LAS pg8::bf16x8*)(B2 + ((4 * w + nbp) * 16 + l15) * 144 + (((ks * 4 + lq) ^ sw) * 16));
            y[nbp][0] = __builtin_amdgcn_mfma_f32_16x16x32_bf16(af, w2[0][ks], y[nbp][0], 0, 0, 0);
            y[nbp][1] = __builtin_amdgcn_mfma_f32_16x16x32_bf16(af, w2[1][ks], y[nbp][1], 0, 0, 0); } }
    constexpr float SC = 0.0027621358640099515f;
#pragma unroll
    for (int nbp = 0; nbp < 4; ++nbp)
#pragma unroll
        for (int ab = 0; ab < 2; ++ab) { const int c = (4 * w + nbp) * 2 + (lq >> 1), a = ab * 16 + l15, p = 64 * a + c;
            v2u o; o.x = pk2(y[nbp][ab][0] * SC, y[nbp][ab][1] * SC); o.y = pk2(y[nbp][ab][2] * SC, y[nbp][ab][3] * SC);
            *(GAS v2u*)(YF + (size_t)(b * SL + p) * 256 + jb * 8 + 4 * (lq & 1)) = o; }
    __syncthreads();
}
__device__ __forceinline__ void zt_phase(Frame& F, int l) {
    const bf16* P = (const bf16*)(F.ws + WS_P);
    LAS bf16* T = (LAS bf16*)(F.lds + F.wave * 16384);
    const int gw = F.vcu * NWAVES + F.wave, NGW = F.G * NWAVES;
    const int nitems = (l == 0 ? 256 : 0);
    for (int it = gw; it < nitems; it += NGW) {
        const bool lat = false; const int r = it;
        const int pb = r >> 3, cb = r & 7;
        const int row0 = (lat ? 0 : MLAT) + 64 * pb; const int L = lat ? SL : CL;
        const int b = lat ? (pb >> 5) : (pb >> 2); const int n0 = (64 * pb) & (L - 1);
        bf16* ZT = lat ? (bf16*)(F.ws + WS_ZT) : (bf16*)(F.ws + WS_ZTC);
#pragma unroll
        for (int i = 0; i < 8; ++i) { const int pos = 8 * i + (F.lane >> 3), ch = F.lane & 7;
            const v4u v = *(const GAS v4u*)(P + (size_t)(row0 + pos) * NIN + 768 + 64 * cb + 8 * ch);
            LAS unsigned* d = (LAS unsigned*)(T + pos * 66 + 8 * ch); d[0] = v.x; d[1] = v.y; d[2] = v.z; d[3] = v.w; }
        LDS_WAIT(); asm volatile("" ::: "memory");
        const int sn = cb >> 2;
#pragma unroll
        for (int j = 0; j < 8; ++j) { const int chl = 8 * j + (F.lane >> 3), pc = F.lane & 7;
            unsigned e[8];
#pragma unroll
            for (int q = 0; q < 8; ++q) e[q] = T[(8 * pc + q) * 66 + chl];
            v4u o; o.x = e[0] | (e[1] << 16); o.y = e[2] | (e[3] << 16); o.z = e[4] | (e[5] << 16); o.w = e[6] | (e[7] << 16);
            const int chg = 64 * (cb & 3) + chl;
            *(GAS v4u*)(ZT + ((size_t)(b * 256 + chg) * 2 + sn) * L + n0 + 8 * pc) = o; }
        LDS_WAIT(); asm volatile("" ::: "memory");
    }
}
__device__ __forceinline__ void ycat_norm_phase(Frame& F, int nrows) {
    bf16* Y = (bf16*)(F.ws + WS_YCAT); const bf16* YC = (const bf16*)F.out + (size_t)MT * 768; const bf16* YF = (const bf16*)(F.ws + WS_YF); const bf16* AT = (const bf16*)((const char*)F.out + OUT_ATT);
    const int gw = F.vcu * NWAVES + F.wave, NGW = F.G * NWAVES;
    constexpr int R = 2;
    for (int row0 = gw; row0 < nrows; row0 += R * NGW) {
        v4u a[R]; v2u c[R]; v2u f[R];
#pragma unroll
        for (int q = 0; q < R; ++q) { const int row = row0 + q * NGW; if (row < nrows) { a[q] = *(const GAS v4u*)(AT + (size_t)row * 512 + 8 * F.lane); c[q] = *(const GAS v2u*)(YC + (size_t)row * 256 + 4 * F.lane);
            f[q] = *(const GAS v2u*)(YF + (size_t)row * 256 + 4 * F.lane); } }
#pragma unroll
        for (int q = 0; q < R; ++q) { const int row = row0 + q * NGW; if (row < nrows) { bf16* yr = Y + (size_t)row * 1024;
            float av[8], fv[4], cv[4];
            fv[0] = bf2f(f[q].x & 0xffffu); fv[1] = bf2f(f[q].x >> 16); fv[2] = bf2f(f[q].y & 0xffffu); fv[3] = bf2f(f[q].y >> 16);
            av[0] = bf2f(a[q].x & 0xffffu); av[1] = bf2f(a[q].x >> 16); av[2] = bf2f(a[q].y & 0xffffu); av[3] = bf2f(a[q].y >> 16); av[4] = bf2f(a[q].z & 0xffffu); av[5] = bf2f(a[q].z >> 16); av[6] = bf2f(a[q].w & 0xffffu); av[7] = bf2f(a[q].w >> 16);
            cv[0] = bf2f(c[q].x & 0xffffu); cv[1] = bf2f(c[q].x >> 16); cv[2] = bf2f(c[q].y & 0xffffu); cv[3] = bf2f(c[q].y >> 16);
            float sa = 0.f, sf = 0.f, sc = 0.f;
#pragma unroll
            for (int e = 0; e < 8; ++e) sa += av[e] * av[e];
#pragma unroll
            for (int e = 0; e < 4; ++e) { sf += fv[e] * fv[e]; sc += cv[e] * cv[e]; }
            const float ra = 1.0f / sqrtf(wave_sum(sa) * (1.0f / 512.0f) + EPS), rf = 1.0f / sqrtf(wave_sum(sf) * (1.0f / 256.0f) + EPS), rc = 1.0f / sqrtf(wave_sum(sc) * (1.0f / 256.0f) + EPS);
            v4u oa; oa.x = pk2(av[0] * ra, av[1] * ra); oa.y = pk2(av[2] * ra, av[3] * ra); oa.z = pk2(av[4] * ra, av[5] * ra); oa.w = pk2(av[6] * ra, av[7] * ra);
            v2u of; of.x = pk2(fv[0] * rf, fv[1] * rf); of.y = pk2(fv[2] * rf, fv[3] * rf);
            v2u oc; oc.x = pk2(cv[0] * rc, cv[1] * rc); oc.y = pk2(cv[2] * rc, cv[3] * rc);
            *(GAS v4u*)(yr + 8 * F.lane) = oa; *(GAS v2u*)(yr + 512 + 4 * F.lane) = of; *(GAS v2u*)(yr + 768 + 4 * F.lane) = oc; } }
    }
}
__device__ __forceinline__ void ctx_combine_phase(Frame& F, const float* base, const float* gp_g, int gp_ofs, int gate_ofs, const float* gn_g, const float* gn_mod, int gn_ofs, int nsl) {
    const bf16* PART = (const bf16*)(F.ws + WS_CPART); bf16* XNp = (bf16*)(F.ws + WS_XN); float* SSXp = (float*)(F.ws + WS_SSX);
    const float* mod0 = (const float*)(F.ws + WS_MOD) + 8 * 6144;
    const int gw = F.vcu * NWAVES + F.wave, NGW = F.G * NWAVES;
    for (int row = gw; row < MCTX; row += NGW) {
        float ss = 0.f; bf16* xr = XNp + (size_t)(MLAT + row) * DM;
#pragma unroll
        for (int j = 0; j < 4; ++j) { const int c = 256 * j + 4 * F.lane; f32x4 x;
            if (base != nullptr) x = *(const f32x4*)(base + (size_t)row * DM + c);
            else { const v2u xw = *(const GAS v2u*)(xr + c); x[0] = bf2f(xw.x & 0xffffu); x[1] = bf2f(xw.x >> 16); x[2] = bf2f(xw.y & 0xffffu); x[3] = bf2f(xw.y >> 16);
                const f32x4 gp = *(const f32x4*)(gp_g + c) * (*(const f32x4*)(mod0 + gp_ofs + c) + 1.0f);
                x[0] = x[0] / gp[0]; x[1] = x[1] / gp[1]; x[2] = x[2] / gp[2]; x[3] = x[3] / gp[3]; }
            f32x4 s = {0.f, 0.f, 0.f, 0.f};
            for (int k = 0; k < nsl; ++k) { const v2u pw = *(const GAS v2u*)(PART + ((size_t)k * MCTX + row) * DM + c); s[0] += bf2f(pw.x & 0xffffu); s[1] += bf2f(pw.x >> 16); s[2] += bf2f(pw.y & 0xffffu); s[3] += bf2f(pw.y >> 16); }
            x = x + *(const f32x4*)(mod0 + gate_ofs + c) * s;
            ss += (x[0] * x[0] + x[1] * x[1]) + (x[2] * x[2] + x[3] * x[3]);
            const f32x4 h = x * (*(const f32x4*)(gn_g + c)) * (*(const f32x4*)(gn_mod + gn_ofs + c) + 1.0f);
            v2u ho; ho.x = pk2(h[0], h[1]); ho.y = pk2(h[2], h[3]); *(GAS v2u*)(xr + c) = ho; }
        ss = wave_sum(ss);
        if (F.lane < 16) SSXp[(size_t)(MLAT + row) * 16 + F.lane] = F.lane == 0 ? ss : 0.f;
    }
}
__device__ __forceinline__ void final_norm_phase(Frame& F, const bf16* xf, const float* g) {
    const int gw = F.vcu * NWAVES + F.wave, NGW = F.G * NWAVES;
    constexpr int R = 2;
    v2u w[R][4], wn[R][4];
#define FN_LOAD(W_, r0_) do { _Pragma("unroll") for (int q = 0; q < R; ++q) { const int row = (r0_) + q * NGW; if (row < MLAT) { \
        _Pragma("unroll") for (int j = 0; j < 4; ++j) W_[q][j] = *(const GAS v2u*)(xf + (size_t)row * DM + 256 * j + 4 * F.lane); } } } while (0)
    FN_LOAD(w, gw);
    for (int row0 = gw; row0 < MLAT; row0 += R * NGW) {
        FN_LOAD(wn, row0 + R * NGW);
#pragma unroll
        for (int q = 0; q < R; ++q) { const int row = row0 + q * NGW; if (row < MLAT) { float* orow = F.out + (size_t)row * DM;
            f32x4 v[4]; float ss = 0.f;
#pragma unroll
            for (int j = 0; j < 4; ++j) { v[j][0] = bf2f(w[q][j].x & 0xffffu); v[j][1] = bf2f(w[q][j].x >> 16); v[j][2] = bf2f(w[q][j].y & 0xffffu); v[j][3] = bf2f(w[q][j].y >> 16);
                ss += (v[j][0] * v[j][0] + v[j][1] * v[j][1]) + (v[j][2] * v[j][2] + v[j][3] * v[j][3]); }
            const float rstd = 1.0f / sqrtf(wave_sum(ss) * (1.0f / DM) + EPS);
#pragma unroll
            for (int j = 0; j < 4; ++j) { const int c = 256 * j + 4 * F.lane; const f32x4 gg = *(const f32x4*)(g + c); *(f32x4*)(orow + c) = (v[j] * rstd) * gg; } } }
#pragma unroll
        for (int q = 0; q < R; ++q)
#pragma unroll
            for (int j = 0; j < 4; ++j) w[q][j] = wn[q][j];
    }
#undef FN_LOAD
}
#ifndef PHMASK
#define PHMASK 0xFFFF
#endif
#define PHON(x) (((PHMASK) >> (x)) & 1)
#ifndef SUBMASK
#define SUBMASK 0xFF
#endif
#define SUBON(x) (rep_ == 0 || (((SUBMASK) >> (x)) & 1))
struct UpOrder : pg8::StaticOrder {
    typedef pg8::UnitUp UnitT; int nrows;
    __device__ __forceinline__ bool next(int i, pg8::UnitUp& u) const {
        if (!next_mn(i, u.pm, u.pn)) return false;
        u.kofs = 0; u.kofb = 0; u.nt = ntk; u.arow = 254 * u.pm - 1; u.nrows = nrows;
        return true;
    }
};

struct SliceOrder0 : pg8::StaticOrder {
    typedef pg8::Unit UnitT; int nsl;
    __device__ __forceinline__ bool next(int i, pg8::Unit& u) const {
        if (i == 0) { if (!next_mn(0, u.pm, u.pn)) return false; u.arow = u.pm * 256; u.kofs = 0; u.kofb = 0; u.nt = ntk; u.aux = 0; return true; }
        const int L = (i - 1) * G + c; if (L >= 32 * nsl) return false;
        const int t = L / nsl, s = L % nsl; u.pm = 64 + (t >> 2); u.pn = t & 3; u.arow = u.pm * 256; u.aux = s;
        if (nsl == 8) { u.kofs = (s < 6 ? 6 * s : 36 + 4 * (s - 6)) * 64; u.nt = s < 6 ? 6 : 4; } else { u.kofs = s * 256; u.nt = 4; }
        u.kofb = u.kofs; return true;
    }
};

struct QkvOrder {
    typedef pg8::Unit UnitT; int G, c, nq;
    __device__ __forceinline__ bool next(int i, pg8::Unit& u) const { const int L = i * G + c; if (L >= 288 + nq) return false;
        if (L < 288) { u.pm = L >> 2; u.pn = 3 + (L & 3); u.kofs = 384; u.nt = 4; } else { const int j = L - 288; u.pm = j / 3; u.pn = j % 3; u.kofs = 0; u.nt = 6; }
        u.kofb = 0; u.arow = u.pm * 256; return true; }
};

struct WinOrder {
    typedef pg8::Unit UnitT; pg8::StaticOrder S; int G, c, l;
    __device__ __forceinline__ void init(int G_, int c_, int l_) { S.init(64, 7, G_, c_, 1024); G = G_; c = c_; l = l_; }
    __device__ __forceinline__ bool next(int i, pg8::Unit& u) const {
        int pm, pn;
        if (S.next_mn(i, pm, pn)) { u.pm = pm; u.pn = pn < 3 ? pn : (pn == 3 ? 8 : pn + 1); }
        else { const long L = (long)i * G + c - 448; const int nctx = (l == 0) ? 64 : 16; if (L < 0 || L >= nctx) return false;
            if (l == 0) { u.pm = 64 + (int)(L >> 3); u.pn = (int)(L & 7); } else { u.pm = 64 + (int)(L >> 1); u.pn = 1 + (int)(L & 1); } }
        u.arow = u.pm * 256; u.kofs = 0; u.kofb = 0; u.nt = 16; u.aux = 0; return true; }
};
struct FnetOrder {
    typedef pg8::Unit UnitT; int G, c;
    __device__ __forceinline__ bool next(int i, pg8::Unit& u) const { const int L = i * G + c; if (L >= 256) return false;
        u.pm = (L >> 3) & 7; u.pn = L & 7; u.arow = u.pm * 256; u.kofs = (L >> 6) * 1024; u.kofb = u.kofs; u.nt = 16; return true; }
};

__global__ void __launch_bounds__(NWAVES * 64, 2) mk_fwd(Args args) {
    extern __shared__ __attribute__((aligned(16))) unsigned char lds[];
    Frame F;
    F.lds = (LAS unsigned char*)lds; F.ldsg = (char*)lds;
    F.MISC = (volatile LAS unsigned*)(F.lds + MISC_OFF);
    F.tid = threadIdx.x; F.lane = F.tid & 63; F.wave = __builtin_amdgcn_readfirstlane(F.tid >> 6);
    F.G = gridDim.x; F.bx = blockIdx.x; F.vcu = (F.G % 8 == 0) ? (F.bx % 8) * (F.G / 8) + F.bx / 8 : F.bx;
    F.ws = args.ws; F.out = args.out;
    for (int u = F.tid; u < (LDS_BYTES - LDSCTL_OFF) / 4; u += NWAVES * 64) ((LAS unsigned*)(F.lds + LDSCTL_OFF))[u] = 0u;
    __syncthreads();
    if (F.tid == 0) { LAS unsigned long long* T = (LAS unsigned long long*)(F.lds + PTR_OFF);
#pragma unroll
        for (int i = 0; i < 22; ++i) T[i] = (unsigned long long)args.in[i]; }
    __syncthreads();
    XcdBarrier bar; bar.bar = (unsigned*)(F.ws + WS_CTL) + CW_BAR; bar.x = 0; bar.st = nullptr;
    if (!MK_SPLIT) bar = xcd_barrier_post((unsigned*)(F.ws + WS_CTL) + CW_BAR, F.MISC + 8);

#define MOD ((float*)(ws + WS_MOD))
#define SSQ ((float*)(ws + WS_SSQ))
#define XN ((bf16*)(ws + WS_XN))
#define P ((bf16*)(ws + WS_P))
#define Qb ((bf16*)F.out)
#define Kb ((bf16*)(ws + WS_K))
#define Vb ((bf16*)(ws + WS_V))
#define YCAT ((bf16*)(ws + WS_YCAT))
#define ATTO ((bf16*)((char*)F.out + OUT_ATT))
#define ACT ((bf16*)(ws + WS_ACT))
#define XCTX ((bf16*)(ws + WS_XCTX))
#define XBL ((bf16*)F.out + (size_t)MLAT * DM)
#define XFIN ((bf16*)(ws + WS_XN))
    LAS unsigned char* ring = F.lds + RING_OFF;

    const int ph_lo = args.ph_lo, ph_hi = args.ph_hi;
#ifndef FFT_RPT
#define FFT_RPT 1
#endif
#ifndef FILL_RPT
#define FILL_RPT 1
#endif
#define PHASE(k) (ph_lo <= (k) && (k) < ph_hi)
#define SEAM(k) do { if (PHASE(k) && PHASE((k) + 1)) xcd_barrier(bar); } while (0)
#ifndef P0SUB
#define P0SUB 0xFF
#endif
#ifndef UPPROBE
#define UPPROBE 0
#endif
#ifndef RPT_PH
#define RPT_PH -1
#endif
#define RELANE() do { int t_ = threadIdx.x; asm volatile("" : "+v"(t_)); F.tid = t_; F.lane = t_ & 63; F.wave = __builtin_amdgcn_readfirstlane(t_ >> 6); } while (0)
    unsigned char* ws = F.ws;
    if (PHASE(0)) for (int rep_ = 0; rep_ < (((0) == RPT_PH) ? 2 : 1); ++rep_) { if (rep_) xcd_barrier(bar); RELANE(); if (PHON(0)) p0_prologue(F, rep_ ? P0SUB : 0xFF, 0, F.vcu * NWAVES + F.wave, F.G * NWAVES); }
    SEAM(0);
    for (int l = 0; l < 2; ++l) {
        const int pb = 1 + 9 * l;
        const int nMall = (l == 0) ? 72 : 64;
        if (PHASE(pb + 0)) for (int rep_ = 0; rep_ < (((pb + 0) == RPT_PH) ? 2 : 1); ++rep_) { if (rep_) xcd_barrier(bar); RELANE();
            if (l == 0 && (rep_ == 0 || (SUBMASK & 1))) { pg8::Gemm g{(const bf16*)(ws + WS_CST), (const bf16*)(ws + WS_WF), 2, 8, 256, 256}; pg8::StaticOrder S; S.init(2, 8, F.G, F.bx, 256);
                pg8::EpiFold E{(bf16*)(ws + WS_WIN), (unsigned)(WIN_STRIDE / 2)};
                pg8::gemm_phase(ring, g, S, E); RELANE(); }
            if (PHON(1) && l == 0 && (rep_ == 0 || (SUBMASK & 2))) norm_mod_phase(F, inptr(F, I_X), inptr(F, I_CTX), MT, inptr(F, I_N1G), MOD, 0, 1024, 16); }
        if (l == 0) SEAM(pb + 0);
        if (PHASE(pb + 1)) for (int rep_ = 0; rep_ < (((pb + 1) == RPT_PH) ? 2 : 1); ++rep_) { if (rep_) xcd_barrier(bar); RELANE();
            if (PHON(2)) { pg8::Gemm g{XN, (const bf16*)(ws + WS_WIN + l * WIN_STRIDE), 72, 9, 1024, 1024}; WinOrder S; S.init(F.G, F.bx, l);
                pg8::EpiWin E{P, NIN, SSQ, l == 1 ? (const float*)(ws + WS_SSX) : nullptr, (const float*)(ws + WS_PB) + 9 * NWIN, (LAS float*)(F.lds + EPIX_OFF)};
                pg8::gemm_phase(ring, g, S, E);
                if (rep_ == 0 && l == 1) {
                    RELANE(); int nb = 464 - F.G; nb = nb < 0 ? 0 : (nb > F.G ? F.G : nb);
                    const bool all = (nb == F.G); if (all || F.bx >= nb) { const int rk = all ? F.bx : F.bx - nb, n = all ? F.G : F.G - nb;
                        bias_phase(F, 4, rk * NWAVES + F.wave, n * NWAVES); } } } }
        SEAM(pb + 1);
        if (PHASE(pb + 2)) for (int rep_ = 0; rep_ < (((pb + 2) == RPT_PH) ? 2 : 1); ++rep_) { if (rep_) xcd_barrier(bar); RELANE();
            if (PHON(3)) {
                if (SUBON(0)) { pg8::Gemm g{P, (const bf16*)(ws + WS_WQKV + l * WQKV_STRIDE), 72, 7, 384, NIN}; QkvOrder S; S.G = F.G; S.c = F.vcu; S.nq = 3 * nMall;
                  pg8::EpiQKV E{Qb, Kb, Vb, SSQ, (const float*)(ws + WS_ROPE), (const float*)(ws + WS_ROPE) + 1024, (LAS float*)(F.lds + EPIX_OFF)};
                  pg8::gemm_phase(ring, g, S, E); }
                if (SUBON(2)) qkv_rows_phase(F, l);
                if (SUBON(3)) zt_phase(F, l);
                } }
        SEAM(pb + 2);
        if (PHASE(pb + 3)) for (int rep_ = 0; rep_ < (((pb + 3) == RPT_PH) ? 2 : 1); ++rep_) { if (rep_) xcd_barrier(bar); RELANE();
            if (PHON(4)) {
                const int NU = 256 + (l == 0 ? 32 : 0);
                for (int u = F.vcu; u < NU; u += F.G) {
                    if (u < 256) { const int bh = u >> 3, qb = u & 7, b = bh >> 2, h = bh & 3; const long q0 = (long)b * SL + qb * 256;
                        att::attn_unit(Qb + q0 * 768 + 192 * h, Kb + 192 * h, Vb + 128 * h, ATTO + q0 * 512 + 128 * h, MLAT + CL * b, 4, SL * b, 36, F.ldsg);
                    } else { const int cu = u - 256, b = cu >> 2, h = cu & 3; const long q0 = MLAT + (long)CL * b;
                        att::attn_unit(Qb + q0 * 768 + 192 * h, Kb + 192 * h, Vb + 128 * h, ATTO + q0 * 512 + 128 * h, (int)q0, 4, 0, 4, F.ldsg); }
                }
                RELANE(); for (int rp_ = 0; rp_ < FFT_RPT; ++rp_) for (int u = F.vcu; u < 256; u += F.G) fnet_fft_unit(F, u >> 5, u & 31);
                RELANE();
                if (l == 0) { pg8::Gemm g{(const bf16*)(ws + WS_DFTC), (const bf16*)(ws + WS_ZTC), 1, 8, 512, 512}; pg8::StaticOrder S; S.init(1, 8, F.G, (F.bx + 128) % F.G, 512);
                  pg8::EpiFnet E{(bf16*)(ws + WS_YF), MLAT, CL, 0.0078125f, (unsigned)(MT * 256)};
                  pg8::gemm_phase(ring, g, S, E); }
                if (l == 0 && rep_ == 0) {
                    RELANE(); const bool all = F.G <= 32; if (all || F.vcu >= 32) { const int rk = all ? F.vcu : F.vcu - 32, n = all ? F.G : F.G - 32;
                        for (int fr_ = 0; fr_ < FILL_RPT; ++fr_) { p0_prologue(F, 0xFF, 1, rk * NWAVES + F.wave, n * NWAVES); bias_phase(F, 1, rk * NWAVES + F.wave, n * NWAVES); } } } } }
        SEAM(pb + 3);
        if (PHASE(pb + 4)) for (int rep_ = 0; rep_ < (((pb + 4) == RPT_PH) ? 2 : 1); ++rep_) { if (rep_) xcd_barrier(bar); RELANE();
            if (PHON(5)) ycat_norm_phase(F, nMall * 256); }
        SEAM(pb + 4);
        if (PHASE(pb + 5)) for (int rep_ = 0; rep_ < (((pb + 5) == RPT_PH) ? 2 : 1); ++rep_) { if (rep_) xcd_barrier(bar); RELANE();
            if (PHON(6)) { pg8::Gemm g{YCAT, (const bf16*)(ws + WS_WOUT + l * WOUT_STRIDE), nMall, 4, 1024, 1024}; pg8::StaticOrder S; S.init(nMall, 4, F.G, F.bx, 1024);
                if (l == 0) { SliceOrder0 S0; S0.init(64, 4, F.G, F.bx, 1024); S0.nsl = 4; pg8::Gemm g0{YCAT, (const bf16*)(ws + WS_WOUT), 64, 4, 1024, 1024};
                    pg8::EpiRes<true> E{inptr(F, I_X), inptr(F, I_CTX), XN, MOD, 2048, nullptr, nullptr, 0, inptr(F, I_N2G), MOD, 4096, (float*)(ws + WS_SSX), rep_ ? 0.f : 1.f, (bf16*)(ws + WS_CPART)};
                    pg8::gemm_phase(ring, g0, S0, E);
                    RELANE(); { int nb = 128; nb = nb > F.G ? F.G : nb; const bool all = (nb == F.G); if (rep_ == 0 && (all || F.bx >= nb)) { const int rk = all ? F.bx : F.bx - nb, n = all ? F.G : F.G - nb; bias_phase(F, 2, rk * NWAVES + F.wave, n * NWAVES); } }
                    xcd_barrier(bar); RELANE();
                    ctx_combine_phase(F, inptr(F, I_CTX), nullptr, 0, 2048, inptr(F, I_N2G), MOD + 8 * 6144, 4096, 4); }
                else { pg8::EpiRes<false> E{nullptr, nullptr, XN, MOD + (size_t)9 * 6144, 2048, inptr(F, I_N1G) + DM, MOD + (size_t)9 * 6144, 1024, inptr(F, I_N2G) + DM, MOD + (size_t)9 * 6144, 4096, (float*)(ws + WS_SSX), rep_ ? 0.f : 1.f, nullptr};
                    pg8::gemm_phase(ring, g, S, E); } } }
        SEAM(pb + 5);
        if (PHASE(pb + 6)) for (int rep_ = 0; rep_ < (((pb + 6) == RPT_PH) ? 2 : 1); ++rep_) { if (rep_) xcd_barrier(bar); RELANE();
            }
        if (PHASE(pb + 7)) for (int rep_ = 0; rep_ < (((pb + 7) == RPT_PH) ? 2 : 1); ++rep_) { if (rep_) xcd_barrier(bar); RELANE();
            if (PHON(8)) { const int nrows = (l == 0) ? MT : MLAT; const int nM = (nrows + 253) / 254;
                pg8::Gemm g{XN, (const bf16*)(ws + WS_WUP + l * WUP_STRIDE), nM, 22, 1024, 1024}; UpOrder S; S.init(nM, 22, F.G, F.bx, 1024); S.nrows = nrows;
                pg8::EpiUp E{ACT, inptr(F, I_FCW) + (size_t)l * 3 * FF, inptr(F, I_FCB) + (size_t)l * FF, (LAS float*)(F.lds + EPIX_OFF), (const float*)(ws + WS_SSX), (const float*)(ws + WS_UB) + (size_t)l * 9 * 5632};
                pg8::gemm_phase(ring, g, S, E);
                if (l == 0 && rep_ == 0) {
                    RELANE(); int nb = nM * 22 - 6 * F.G; nb = nb < 0 ? 0 : (nb > F.G ? F.G : nb);
                    const bool all = (nb == F.G); if (all || F.bx >= nb) { const int rk = all ? F.bx : F.bx - nb, n = all ? F.G : F.G - nb; p0_prologue(F, 0xFF, 2, rk * NWAVES + F.wave, n * NWAVES); } } } }
        SEAM(pb + 7);
        if (PHASE(pb + 8)) for (int rep_ = 0; rep_ < (((pb + 8) == RPT_PH) ? 2 : 1); ++rep_) { if (rep_) xcd_barrier(bar); RELANE();
            if (PHON(6)) {
                if (l == 0) { pg8::Gemm g{ACT, (const bf16*)(ws + WS_WDOWN), 64, 4, FF, FF}; SliceOrder0 S; S.init(64, 4, F.G, F.bx, FF); S.nsl = 8;
                    pg8::EpiRes<false> E{nullptr, nullptr, XN, MOD, 5120, inptr(F, I_N2G), MOD, 4096, inptr(F, I_N1G) + DM, MOD + (size_t)9 * 6144, 1024, (float*)(ws + WS_SSX), rep_ ? 0.f : 1.f, (bf16*)(ws + WS_CPART)};
                    pg8::gemm_phase(ring, g, S, E);
                    xcd_barrier(bar); RELANE();
                    ctx_combine_phase(F, nullptr, inptr(F, I_N2G), 4096, 5120, inptr(F, I_N1G) + DM, MOD + (size_t)9 * 6144 + 8 * 6144, 1024, 8);
                } else { pg8::Gemm g{ACT, (const bf16*)(ws + WS_WDOWN + WDOWN_STRIDE), 64, 4, FF, FF}; pg8::StaticOrder S; S.init(64, 4, F.G, F.bx, FF);
                    pg8::EpiRes<false> E{nullptr, nullptr, XN, MOD + (size_t)9 * 6144, 5120, inptr(F, I_N2G) + DM, MOD + (size_t)9 * 6144, 4096, nullptr, nullptr, 0, nullptr, 1.f, nullptr};
                    pg8::gemm_phase(ring, g, S, E); } } }
        SEAM(pb + 8);
    }
    if (PHASE(NPH - 1)) for (int rep_ = 0; rep_ < (((NPH - 1) == RPT_PH) ? 2 : 1); ++rep_) { if (rep_) xcd_barrier(bar); RELANE(); if (PHON(10)) final_norm_phase(F, XN, inptr(F, I_FING)); }
#undef PHASE
#undef SEAM
#undef RELANE
#undef MOD
#undef SSQ
#undef XN
#undef P
#undef Qb
#undef Kb
#undef Vb
#undef YCAT
#undef ATTO
#undef ACT
#undef XCTX
#undef XBL
#undef XFIN
}

extern "C" void kernel_launch(void* const* d_in, const int* in_sizes, int n_in, void* d_out, int out_size, void* d_ws, size_t ws_size, hipStream_t stream) {
    static int grid = 0;
    if (grid == 0) {
        if (n_in != 22 || out_size != MLAT * DM || ws_size < WS_END) { fprintf(stderr, "kernel_launch: unexpected shapes (n_in %d out %d ws %zu)\n", n_in, out_size, ws_size); grid = -1; return; }
        int dev = 0, cus = 0;
        if (hipGetDevice(&dev) != hipSuccess || hipDeviceGetAttribute(&cus, hipDeviceAttributeMultiprocessorCount, dev) != hipSuccess) { grid = -1; return; }
        if (hipFuncSetAttribute((const void*)mk_fwd, hipFuncAttributeMaxDynamicSharedMemorySize, LDS_BYTES) != hipSuccess) { fprintf(stderr, "kernel_launch: hipFuncSetAttribute failed\n"); grid = -1; return; }
        int per_cu = 0;
        if (hipOccupancyMaxActiveBlocksPerMultiprocessor(&per_cu, (const void*)mk_fwd, NWAVES * 64, LDS_BYTES) != hipSuccess || per_cu < 1) fprintf(stderr, "kernel_launch: occupancy query says %d\n", per_cu);
        (void)hipGetLastError();
        grid = cus;
    }
    if (grid < 0) return;
    if (hipMemsetAsync((char*)d_ws + WS_CTL, 0, CTL_ZERO_BYTES, stream) != hipSuccess) return;
    Args a{};
    for (int i = 0; i < 22; ++i) a.in[i] = (const float*)d_in[i];
    a.out = (float*)d_out; a.ws = (unsigned char*)d_ws;
#if MK_SPLIT
    for (int ph = 0; ph < NPH; ++ph) { a.ph_lo = ph; a.ph_hi = ph + 1; hipLaunchKernelGGL(mk_fwd, dim3(grid), dim3(NWAVES * 64), LDS_BYTES, stream, a); }
#else
    a.ph_lo = 0; a.ph_hi = NPH;
    hipLaunchKernelGGL(mk_fwd, dim3(grid), dim3(NWAVES * 64), LDS_BYTES, stream, a);
#endif
    const hipError_t le = hipPeekAtLastError();
    if (le != hipSuccess) fprintf(stderr, "kernel_launch: launch failed: %s\n", hipGetErrorName(le));
}
```

```cpp
#include <hip/hip_runtime.h>
#include <hip/hip_bf16.h>
#include <cstdio>
#include <cstdint>
#include <cmath>
namespace pg8 {
#define PG8_LAS __attribute__((address_space(3)))
typedef unsigned short bf16_t;
typedef short bf16x8 __attribute__((ext_vector_type(8)));
typedef float f32x4 __attribute__((ext_vector_type(4)));
typedef float f32x2 __attribute__((ext_vector_type(2)));
typedef unsigned u32x4 __attribute__((ext_vector_type(4)));
typedef unsigned u32x2 __attribute__((ext_vector_type(2)));
constexpr int BM = 256, BK = 64, HALF = 128, HTB = HALF * BK * 2  , STAGE_BYTES = 8 * HTB, NXCD = 8, WGM = 8;

__host__ __device__ __forceinline__ int lds_byte(int r, int c) { const int st = (r >> 4) * 2 + (c >> 5), rr = r & 15, cc = c & 31, ob = rr * 64 + cc * 2; return st * 1024 + (ob ^ (((ob >> 9) & 1) << 5)); }
__host__ __device__ __forceinline__ void stage_rc(int b, int& R, int& C) { const int st = b / 1024, sb = b % 1024, swz = sb ^ (((sb >> 9) & 1) << 5); R = (st >> 1) * 16 + swz / 64; C = (st & 1) * 32 + (swz % 64) / 2; }
__host__ __device__ __forceinline__ int perm32(int rho) { const int n = rho >> 4, i = rho & 15; return 8 * (i >> 2) + 4 * n + (i & 3); }

struct Unit { int pm, pn, arow, kofs, kofb, nt, aux; };
struct Gemm { const bf16_t* A; const bf16_t* Bt; int nM, nN, ldb, lda; };

struct StaticOrder {
    int nM, nN, nwg, G, c, ntk;
    __device__ __forceinline__ void init(int nM_, int nN_, int G_, int c_, int K_) { nM = nM_; nN = nN_; nwg = nM * nN; G = G_; c = c_; ntk = K_ / BK; }
    __device__ __forceinline__ bool next_mn(int i, int& pm, int& pn) const {
        const long L = (long)i * G + c; if (L >= nwg) return false;
        int wgid = (int)L; { const int q = nwg / NXCD, r = nwg % NXCD, xcd = wgid % NXCD, off = wgid / NXCD; wgid = (xcd < r ? xcd * (q + 1) : r * (q + 1) + (xcd - r) * q) + off; }
        const int nig = WGM * nN, gid = wgid / nig, fm = gid * WGM, gsz = (nM - fm) < WGM ? (nM - fm) : WGM;
        pm = fm + ((wgid % nig) % gsz); pn = (wgid % nig) / gsz; return true;
    }
    typedef Unit UnitT;
    __device__ __forceinline__ bool next(int i, Unit& u) const { if (!next_mn(i, u.pm, u.pn)) return false; u.arow = u.pm * BM; u.kofs = 0; u.kofb = 0; u.nt = ntk; u.aux = 0; return true; }
};

__device__ __forceinline__ unsigned cvt_pk_bf16(float lo, float hi) { unsigned r; asm volatile("v_cvt_pk_bf16_f32 %0, %1, %2" : "=v"(r) : "v"(lo), "v"(hi)); return r; }

template <class Epi, class Sched>
__device__ __forceinline__ void gemm_phase(PG8_LAS unsigned char* lds, const Gemm g, const Sched& S, const Epi& E) {
    int tid = threadIdx.x; asm volatile("" : "+v"(tid));
    const int wid = __builtin_amdgcn_readfirstlane(tid >> 6), lane = tid & 63, wr = wid >> 2, wc = wid & 3, fr = lane & 15, fq = lane >> 4;
    const int K = g.ldb, lda = g.lda;
    unsigned voffA[2], voffB[2];
#pragma unroll
    for (int i = 0; i < 2; ++i) { int R, C; stage_rc(tid * 16 + i * 8192, R, C); const int Rb = Epi::PERM ? ((R & ~31) + perm32(R & 31)) : R;
        voffA[i] = (unsigned)(R * lda + C) * 2u; voffB[i] = (unsigned)(Rb * K + C) * 2u; }
    const size_t kstep = (size_t)(BK * 2);
    const size_t hstepA = (size_t)HALF * lda * 2, hstepB = (size_t)HALF * K * 2;
    const size_t tstepB = 2 * hstepB;
    const unsigned ldsw = (unsigned)wid * 1024u;
    const int aoff = lds_byte(wr * 64 + fr, fq * 8), boff = lds_byte(wc * 32 + fr, fq * 8);
#define PG8_SA(b, h) (((b) * 2 + (h)) * HTB)
#define PG8_SB(b, h) ((4 + (b) * 2 + (h)) * HTB)
#define PG8_STAGE(bufoff, gbase, voff) do { _Pragma("unroll") for (int _i = 0; _i < 2; ++_i) \
        __builtin_amdgcn_global_load_lds((const unsigned*)((const char*)(gbase) + (voff)[_i]), (PG8_LAS unsigned*)(lds + (bufoff) + ldsw + _i * 8192), 16, 0, 0); } while (0)
#define PG8_LDA(dst, b, h) do { _Pragma("unroll") for (int m = 0; m < 4; ++m) _Pragma("unroll") for (int k = 0; k < 2; ++k) dst[m][k] = *(const PG8_LAS bf16x8*)(lds + PG8_SA(b, h) + aoff + m * 2048 + k * 1024); } while (0)
#define PG8_LDB(dst, b, h) do { _Pragma("unroll") for (int n = 0; n < 2; ++n) _Pragma("unroll") for (int k = 0; k < 2; ++k) dst[n][k] = *(const PG8_LAS bf16x8*)(lds + PG8_SB(b, h) + boff + n * 2048 + k * 1024); } while (0)
#define PG8_MMA(ai, bj, At, Bt) do { __builtin_amdgcn_s_setprio(1); _Pragma("unroll") for (int m = 0; m < 4; ++m) _Pragma("unroll") for (int n = 0; n < 2; ++n) _Pragma("unroll") for (int k = 0; k < 2; ++k) \
        acc[ai][bj][m][n] = __builtin_amdgcn_mfma_f32_16x16x32_bf16(Bt[n][k], At[m][k], acc[ai][bj][m][n], 0, 0, 0); __builtin_amdgcn_s_setprio(0); } while (0)
#define PG8_WAIT_V(n) asm volatile("s_waitcnt vmcnt(" #n ")" ::: "memory")
#define PG8_WAIT_L(n) asm volatile("s_waitcnt lgkmcnt(" #n ")" ::: "memory")
#define PG8_BAR __builtin_amdgcn_s_barrier()
#define PG8_SCHED __builtin_amdgcn_sched_barrier(0)
    typename Sched::UnitT cur, nxt; int ui = 0;
    if (!S.next(0, cur)) return;
    f32x4 acc[2][2][4][2];
#pragma unroll
    for (int a = 0; a < 2; ++a)
#pragma unroll
        for (int b = 0; b < 2; ++b)
#pragma unroll
            for (int m = 0; m < 4; ++m)
#pragma unroll
                for (int n = 0; n < 2; ++n) acc[a][b][m][n] = (f32x4){0.f, 0.f, 0.f, 0.f};
    bf16x8 At[4][2], B0[2][2], B1[2][2];
    const char* cA = (const char*)g.A + (ptrdiff_t)cur.arow * (ptrdiff_t)(lda * 2) + cur.kofs * 2; const char* cB = (const char*)g.Bt + (size_t)cur.pn * tstepB + cur.kofb * 2;
    if constexpr (Epi::PREFETCH) E.prefetch(cur, wid, lane);
    PG8_STAGE(PG8_SB(0, 0), cB, voffB); PG8_STAGE(PG8_SB(0, 1), cB + hstepB, voffB); PG8_STAGE(PG8_SA(0, 0), cA, voffA); PG8_STAGE(PG8_SA(0, 1), cA + hstepA, voffA);
    if (wr == 1) PG8_BAR;
    PG8_WAIT_V(2); PG8_BAR;
    PG8_STAGE(PG8_SB(1, 0), cB + kstep, voffB); PG8_STAGE(PG8_SA(1, 0), cA + kstep, voffA); PG8_STAGE(PG8_SB(1, 1), cB + hstepB + kstep, voffB);
    PG8_WAIT_V(6); PG8_BAR;
    for (;;) {
        const bool has_next = S.next(ui + 1, nxt);
        const char* nA = has_next ? (const char*)g.A + (ptrdiff_t)nxt.arow * (ptrdiff_t)(lda * 2) + nxt.kofs * 2 : cA; const char* nB = has_next ? (const char*)g.Bt + (size_t)nxt.pn * tstepB + nxt.kofb * 2 : cB;
        const int nt = cur.nt;
        for (int t = 0; t < nt; t += 2) {
            const bool last = (t == nt - 2);
            const char* a1 = cA + (size_t)(t + 1) * kstep;
            const char* a2 = last ? nA : cA + (size_t)(t + 2) * kstep; const char* b2 = last ? nB : cB + (size_t)(t + 2) * kstep;
            const char* a3 = a2 + kstep; const char* b3 = b2 + kstep;
            PG8_LDB(B0, 0, 0); PG8_LDB(B1, 0, 1); PG8_SCHED; PG8_LDA(At, 0, 0); PG8_STAGE(PG8_SA(1, 1), a1 + hstepA, voffA);
            PG8_WAIT_V(8); PG8_WAIT_L(0); PG8_BAR; PG8_MMA(0, 0, At, B0); PG8_MMA(0, 1, At, B1); PG8_BAR; PG8_SCHED;
            PG8_LDA(At, 0, 1); PG8_STAGE(PG8_SB(0, 0), b2, voffB); PG8_STAGE(PG8_SB(0, 1), b2 + hstepB, voffB); PG8_STAGE(PG8_SA(0, 0), a2, voffA);
            PG8_WAIT_V(8); PG8_WAIT_L(0); PG8_BAR; PG8_MMA(1, 0, At, B0); PG8_MMA(1, 1, At, B1); PG8_BAR; PG8_SCHED;
            PG8_LDB(B0, 1, 0); PG8_LDB(B1, 1, 1); PG8_SCHED; PG8_LDA(At, 1, 0); PG8_STAGE(PG8_SA(0, 1), a2 + hstepA, voffA);
            PG8_WAIT_V(8); PG8_WAIT_L(0); PG8_BAR; PG8_MMA(0, 0, At, B0); PG8_MMA(0, 1, At, B1); PG8_BAR; PG8_SCHED;
            PG8_LDA(At, 1, 1); PG8_STAGE(PG8_SB(1, 0), b3, voffB); PG8_STAGE(PG8_SB(1, 1), b3 + hstepB, voffB); PG8_STAGE(PG8_SA(1, 0), a3, voffA);
            PG8_WAIT_V(8); PG8_WAIT_L(0); PG8_BAR; PG8_MMA(1, 0, At, B0); PG8_MMA(1, 1, At, B1); PG8_BAR; PG8_SCHED;
        }
        if (wr == 0) PG8_BAR;
        E(acc, cur, wr, wc, fr, fq);
        if (!has_next) break;
        if constexpr (Epi::PREFETCH) E.prefetch(nxt, wid, lane);
#pragma unroll
        for (int a = 0; a < 2; ++a)
#pragma unroll
            for (int b = 0; b < 2; ++b)
#pragma unroll
                for (int m = 0; m < 4; ++m)
#pragma unroll
                    for (int n = 0; n < 2; ++n) acc[a][b][m][n] = (f32x4){0.f, 0.f, 0.f, 0.f};
        cur = nxt; cA = nA; cB = nB; ++ui;
        if (wr == 1) PG8_BAR;
    }
    PG8_WAIT_V(0);
    PG8_BAR;
#undef PG8_SA
#undef PG8_SB
#undef PG8_STAGE
#undef PG8_LDA
#undef PG8_LDB
#undef PG8_MMA
#undef PG8_WAIT_V
#undef PG8_WAIT_L
#undef PG8_BAR
#undef PG8_SCHED
}
}
namespace pg8 {
constexpr float RMS_EPS = 1e-6f;
template <class T> __device__ __forceinline__ T gld(const void* base, unsigned boff) { return *(const T*)((const char*)base + boff); }
template <class T> __device__ __forceinline__ void gst(void* base, unsigned boff, T v) { *(T*)((char*)base + boff) = v; }
constexpr int EX_XF = 0, EX_XL = 512, EX_CW = 1024, EX_RS = 1536, EX_BL = 1792, EX_SSX = 2304, EX_FLOATS = 6400;
constexpr int MLAT_ = 16384;
__device__ __forceinline__ void dma_ssx(const float* ssx, int arow, PG8_LAS float* xb, int wid, int lane) {
#pragma unroll
    for (int i = 0; i < 2; ++i) { const int ch = 2 * wid + i;
        __builtin_amdgcn_global_load_lds((const unsigned*)((const char*)ssx + (ptrdiff_t)arow * 64 + ch * 1024 + lane * 16), (PG8_LAS unsigned*)(xb + EX_SSX + ch * 256), 16, 0, 0); }
}
__device__ __forceinline__ void rs_from_ssx(PG8_LAS float* xb, int t) {
    if (t < 256) { const PG8_LAS f32x4* p = (const PG8_LAS f32x4*)(xb + EX_SSX + t * 16); const f32x4 a = p[0], b = p[1], c = p[2], d = p[3];
        const float ss = (((a[0] + a[1]) + (a[2] + a[3])) + ((b[0] + b[1]) + (b[2] + b[3]))) + (((c[0] + c[1]) + (c[2] + c[3])) + ((d[0] + d[1]) + (d[2] + d[3])));
        xb[EX_RS + t] = __builtin_amdgcn_rsqf(ss * (1.0f / 1024.0f) + RMS_EPS); }
}

struct EpiWin {
    static constexpr bool PERM = true, PREFETCH = true;
    bf16_t* O; int ldc; float* ssq;
    const float* ssx; const float* pb;
    PG8_LAS float* xb;
    __device__ __forceinline__ void prefetch(const Unit& u, int wid, int lane) const {
        if (ssx == nullptr) return;
        dma_ssx(ssx, u.arow, xb, wid, lane);
        if (wid == 0) __builtin_amdgcn_global_load_lds((const unsigned*)(pb + (u.pm < 64 ? (u.pm >> 3) : 8) * 2304 + u.pn * BM + lane * 4), (PG8_LAS unsigned*)(xb + EX_BL), 16, 0, 0);
    }
    __device__ __forceinline__ void operator()(const f32x4 (&acc)[2][2][4][2], const Unit& u, int wr, int wc, int fr_in, int fq_in) const {
        int t_ = threadIdx.x; asm volatile("" : "+v"(t_)); const int fr = t_ & 15, fq = (t_ >> 4) & 3; (void)fr_in; (void)fq_in;
        const int row0 = u.pm * BM + wr * 64 + fr; const int col0 = (u.pn == 8 ? 3 : u.pn) * BM + wc * 32 + 8 * fq; const int tc0 = wc * 32 + 8 * fq;
        const bool fused = ssx != nullptr;
        if (fused) { rs_from_ssx(xb, t_); asm volatile("s_waitcnt lgkmcnt(0)" ::: "memory"); __builtin_amdgcn_s_barrier(); asm volatile("" ::: "memory"); }
        f32x4 bv[2][2];
#pragma unroll
        for (int bj = 0; bj < 2; ++bj)
#pragma unroll
            for (int n = 0; n < 2; ++n) bv[bj][n] = fused ? *(const PG8_LAS f32x4*)(xb + EX_BL + tc0 + bj * HALF + 4 * n) : (f32x4){0.f, 0.f, 0.f, 0.f};
#pragma unroll
        for (int ai = 0; ai < 2; ++ai)
#pragma unroll
            for (int m = 0; m < 4; ++m) { const int tr = ai * HALF + wr * 64 + m * 16 + fr; const int row = u.pm * BM + tr; const unsigned ob = ((unsigned)row * (unsigned)ldc + (unsigned)col0) * 2u;
                const float rs = fused ? xb[EX_RS + tr] : 1.0f;
#pragma unroll
                for (int bj = 0; bj < 2; ++bj) { const f32x4 v0 = acc[ai][bj][m][0] * rs + bv[bj][0], v1 = acc[ai][bj][m][1] * rs + bv[bj][1];
                    u32x4 w; w.x = cvt_pk_bf16(v0[0], v0[1]); w.y = cvt_pk_bf16(v0[2], v0[3]); w.z = cvt_pk_bf16(v1[0], v1[1]); w.w = cvt_pk_bf16(v1[2], v1[3]);
                    gst<u32x4>(O, ob + bj * HALF * 2, w);
                    const int hf = 2 * u.pn + bj;
                    if (hf < 5) {
                        float s = (v0[0] * v0[0] + v0[1] * v0[1]) + (v0[2] * v0[2] + v0[3] * v0[3]) + (v1[0] * v1[0] + v1[1] * v1[1]) + (v1[2] * v1[2] + v1[3] * v1[3]);
                        s += __shfl_xor(s, 16); s += __shfl_xor(s, 32);
                        if (fq == 0) gst<float>(ssq, ((unsigned)row * 20u + hf * 4 + wc) * 4u, s);
                    } }
                if (m & 1) asm volatile("" ::: "memory"); }
        if (fused) { asm volatile("s_waitcnt lgkmcnt(0)" ::: "memory"); __builtin_amdgcn_s_barrier(); asm volatile("" ::: "memory"); }
        (void)row0;
    }
};

struct EpiFold {
    static constexpr bool PERM = true, PREFETCH = false;
    bf16_t* WinT; unsigned lstride;
    __device__ __forceinline__ void operator()(const f32x4 (&acc)[2][2][4][2], const Unit& u, int wr, int wc, int fr_in, int fq_in) const {
        int t_ = threadIdx.x; asm volatile("" : "+v"(t_)); const int fr = t_ & 15, fq = (t_ >> 4) & 3; (void)fr_in; (void)fq_in;
        bf16_t* O = WinT + (size_t)(u.pn >> 2) * lstride;
        const int row0 = 768 + u.pm * BM + wr * 64 + fr; const int col0 = (u.pn & 3) * BM + wc * 32 + 8 * fq;
#pragma unroll
        for (int ai = 0; ai < 2; ++ai)
#pragma unroll
            for (int m = 0; m < 4; ++m) { const unsigned ob = ((unsigned)(row0 + ai * HALF + m * 16) * 1024u + (unsigned)col0) * 2u;
#pragma unroll
                for (int bj = 0; bj < 2; ++bj) { const f32x4 v0 = acc[ai][bj][m][0], v1 = acc[ai][bj][m][1];
                    u32x4 w; w.x = cvt_pk_bf16(v0[0], v0[1]); w.y = cvt_pk_bf16(v0[2], v0[3]); w.z = cvt_pk_bf16(v1[0], v1[1]); w.w = cvt_pk_bf16(v1[2], v1[3]);
                    gst<u32x4>(O, ob + bj * HALF * 2, w); } }
    }
};

struct EpiQKV {
    static constexpr bool PERM = true, PREFETCH = true;
    bf16_t* Q; bf16_t* Kb; bf16_t* Vb; const float* ssq; const float* ropec; const float* ropes; PG8_LAS float* xb;
    __device__ __forceinline__ void prefetch(const Unit& u, int wid, int lane) const {
#pragma unroll
        for (int i = 0; i < 3; ++i) { const int ch = 3 * wid + i;
            if (ch < 20) __builtin_amdgcn_global_load_lds((const unsigned*)((const char*)ssq + (size_t)u.arow * 80 + ch * 1024 + lane * 16), (PG8_LAS unsigned*)(xb + 512 + ch * 256), 16, 0, 0); }
    }
    __device__ __forceinline__ void operator()(const f32x4 (&acc)[2][2][4][2], const Unit& u, int wr, int wc, int fr_in, int fq_in) const {
        int t_ = threadIdx.x; asm volatile("" : "+v"(t_)); const int fr = t_ & 15, fq = (t_ >> 4) & 3; (void)fr_in; (void)fq_in;
        if (t_ < 256) { const PG8_LAS float* p = xb + 512 + t_ * 20; float sq = 0.f, sk = 0.f;
#pragma unroll
            for (int i = 0; i < 12; ++i) sq += p[i];
#pragma unroll
            for (int i = 12; i < 20; ++i) sk += p[i];
            xb[t_] = __builtin_amdgcn_rsqf(sq * (1.0f / 384.0f) + RMS_EPS); xb[256 + t_] = __builtin_amdgcn_rsqf(sk * (1.0f / 256.0f) + RMS_EPS); }
        asm volatile("s_waitcnt lgkmcnt(0)" ::: "memory"); __builtin_amdgcn_s_barrier(); asm volatile("" ::: "memory");
        const int cw = wc * 32 + 8 * fq;
        if (u.pn < 3) {
            const bool lat = u.pm < 64;
#pragma unroll
            for (int ai = 0; ai < 2; ++ai)
#pragma unroll
                for (int m = 0; m < 4; ++m) { const int tr = ai * HALF + wr * 64 + m * 16 + fr; const int row = u.pm * BM + tr; const float rs = xb[tr]; const int t = row & 2047;
#pragma unroll
                    for (int bj = 0; bj < 2; ++bj) { const int gcol = u.pn * BM + bj * HALF + wc * 32;
                        const int w = gcol % 192; f32x4 x1 = acc[ai][bj][m][0] * rs, x2 = acc[ai][bj][m][1] * rs;
                        if (lat && w >= 128) { const int pos = (w >= 160) ? (t & 63) : (t >> 6);
                            const unsigned rb = (unsigned)(pos * 16 + 4 * fq) * 4u; const f32x4 c = gld<f32x4>(ropec, rb), s = gld<f32x4>(ropes, rb);
                            const f32x4 y1 = x1 * c - x2 * s, y2 = x1 * s + x2 * c; x1 = y1; x2 = y2; }
                        u32x4 o; o.x = cvt_pk_bf16(x1[0], x1[1]); o.y = cvt_pk_bf16(x1[2], x1[3]); o.z = cvt_pk_bf16(x2[0], x2[1]); o.w = cvt_pk_bf16(x2[2], x2[3]);
                        gst<u32x4>(Q, ((unsigned)row * 768u + (unsigned)(gcol + 8 * fq)) * 2u, o); }
                    if (m & 1) asm volatile("" ::: "memory"); }
        } else {
            const int h = u.pn - 3;
#pragma unroll
            for (int ai = 0; ai < 2; ++ai)
#pragma unroll
                for (int m = 0; m < 4; ++m) { const int tr = ai * HALF + wr * 64 + m * 16 + fr; const int row = u.pm * BM + tr; const float rs = xb[256 + tr];
#pragma unroll
                    for (int bj = 0; bj < 2; ++bj) { const f32x4 v0 = acc[ai][bj][m][0] * rs, v1 = acc[ai][bj][m][1] * rs;
                        u32x4 w; w.x = cvt_pk_bf16(v0[0], v0[1]); w.y = cvt_pk_bf16(v0[2], v0[3]); w.z = cvt_pk_bf16(v1[0], v1[1]); w.w = cvt_pk_bf16(v1[2], v1[3]);
                        if (bj == 0) gst<u32x4>(Kb, ((unsigned)row * 768u + (unsigned)(192 * h + cw)) * 2u, w);
                        else gst<u32x4>(Vb, ((unsigned)row * 512u + (unsigned)(128 * h + cw)) * 2u, w); }
                    if (m & 1) asm volatile("" ::: "memory"); }
        }
        asm volatile("s_waitcnt lgkmcnt(0)" ::: "memory"); __builtin_amdgcn_s_barrier(); asm volatile("" ::: "memory");
    }
};

struct EpiFnet {
    static constexpr bool PERM = true, PREFETCH = false;
    bf16_t* Y; int rowbase, seqlen; float scale; unsigned slice_stride;
    __device__ __forceinline__ void operator()(const f32x4 (&acc)[2][2][4][2], const Unit& u, int wr, int wc, int fr_in, int fq_in) const {
        int t_ = threadIdx.x; asm volatile("" : "+v"(t_)); const int fr = t_ & 15, fq = (t_ >> 4) & 3; (void)fr_in; (void)fq_in;
        const int k0 = u.pm * BM + wr * 64 + fr; const int cw = wc * 32 + 8 * fq;
        bf16_t* Yb = Y + (size_t)(u.kofs >> 10) * slice_stride;
#pragma unroll
        for (int ai = 0; ai < 2; ++ai)
#pragma unroll
            for (int m = 0; m < 4; ++m) { const int row = rowbase + u.pn * seqlen + k0 + ai * HALF + m * 16; const unsigned yb = ((unsigned)row * 256u + (unsigned)cw) * 2u;
#pragma unroll
                for (int bj = 0; bj < 2; ++bj) { const f32x4 v0 = acc[ai][bj][m][0] * scale, v1 = acc[ai][bj][m][1] * scale;
                    u32x4 w; w.x = cvt_pk_bf16(v0[0], v0[1]); w.y = cvt_pk_bf16(v0[2], v0[3]); w.z = cvt_pk_bf16(v1[0], v1[1]); w.w = cvt_pk_bf16(v1[2], v1[3]);
                    gst<u32x4>(Yb, yb + bj * HALF * 2, w); } }
    }
};

template <bool F32BASE> struct EpiRes {
    static constexpr bool PERM = true, PREFETCH = false;
    const float* base_lat; const float* base_ctx;
    bf16_t* X; const float* mod; int gofs;
    const float* png; const float* pscmod; int pscofs;
    const float* ng; const float* scmod; int scofs; float* ssx;
    float gmul;
    bf16_t* part;
    __device__ __forceinline__ void operator()(const f32x4 (&acc)[2][2][4][2], const Unit& u, int wr, int wc, int fr_in, int fq_in) const {
        int t_ = threadIdx.x; asm volatile("" : "+v"(t_)); const int fr = t_ & 15, fq = (t_ >> 4) & 3; (void)fr_in; (void)fq_in;
        if (part != nullptr && u.pm >= 64) {
            const int sl = u.aux;
            const int prow0 = (u.pm - 64) * BM + wr * 64 + fr; const int pcol0 = u.pn * BM + wc * 32 + 8 * fq; bf16_t* pb_ = part + (size_t)sl * (2048u * 1024u);
#pragma unroll
            for (int ai = 0; ai < 2; ++ai)
#pragma unroll
                for (int m = 0; m < 4; ++m) { const unsigned off = ((unsigned)(prow0 + ai * HALF + m * 16) * 1024u + (unsigned)pcol0) * 2u;
#pragma unroll
                    for (int bj = 0; bj < 2; ++bj) { const f32x4 v0 = acc[ai][bj][m][0], v1 = acc[ai][bj][m][1];
                        u32x4 w; w.x = cvt_pk_bf16(v0[0], v0[1]); w.y = cvt_pk_bf16(v0[2], v0[3]); w.z = cvt_pk_bf16(v1[0], v1[1]); w.w = cvt_pk_bf16(v1[2], v1[3]);
                        gst<u32x4>(pb_, off + (unsigned)(bj * HALF) * 2u, w); } }
            return;
        }
        const bool lat = u.pm < 64; const int r = lat ? (u.pm >> 3) : 8;
        constexpr bool f32base = F32BASE; const float* bf = lat ? base_lat : base_ctx;
        const float* gate = mod + r * 6144 + gofs;
        const int frow0 = (lat ? u.pm : u.pm - 64) * BM + wr * 64 + fr; const int col0 = u.pn * BM + wc * 32 + 8 * fq;
        const int grow0 = u.pm * BM + wr * 64 + fr;
        const bool scaled = ng != nullptr;
        float ss[8];
#pragma unroll
        for (int q = 0; q < 8; ++q) ss[q] = 0.f;
#pragma unroll
        for (int bj = 0; bj < 2; ++bj) {
            f32x4 gv[2], gs[2], gp[2];
#pragma unroll
            for (int n = 0; n < 2; ++n) { const unsigned cb = (unsigned)(col0 + bj * HALF + n * 4) * 4u; gv[n] = gld<f32x4>(gate, cb) * gmul;
                gs[n] = scaled ? gld<f32x4>(ng, cb) * (gld<f32x4>(scmod, (unsigned)(r * 6144 + scofs) * 4u + cb) + 1.0f) : (f32x4){1.f, 1.f, 1.f, 1.f};
                if constexpr (!f32base) { const f32x4 d = gld<f32x4>(png, cb) * (gld<f32x4>(pscmod, (unsigned)(r * 6144 + pscofs) * 4u + cb) + 1.0f);
                    gp[n] = (f32x4){__builtin_amdgcn_rcpf(d[0]), __builtin_amdgcn_rcpf(d[1]), __builtin_amdgcn_rcpf(d[2]), __builtin_amdgcn_rcpf(d[3])}; }
                else gp[n] = (f32x4){1.f, 1.f, 1.f, 1.f}; }
#pragma unroll
            for (int ai = 0; ai < 2; ++ai) {
                f32x4 x0[4], x1[4];
#pragma unroll
                for (int m = 0; m < 4; ++m) { const unsigned o2 = ((unsigned)(grow0 + ai * HALF + m * 16) * 1024u + (unsigned)(col0 + bj * HALF)) * 2u;
                    const unsigned fo = ((unsigned)(frow0 + ai * HALF + m * 16) * 1024u + (unsigned)(col0 + bj * HALF)) * 4u;
                    if constexpr (f32base) { x0[m] = gld<f32x4>(bf, fo); x1[m] = gld<f32x4>(bf, fo + 16u); }
                    else { const u32x4 bw = gld<u32x4>(X, o2); x0[m] = __builtin_bit_cast(f32x4, (u32x4){bw.x << 16, bw.x & 0xffff0000u, bw.y << 16, bw.y & 0xffff0000u});
                        x1[m] = __builtin_bit_cast(f32x4, (u32x4){bw.z << 16, bw.z & 0xffff0000u, bw.w << 16, bw.w & 0xffff0000u}); } }
                asm volatile("" ::: "memory");
#pragma unroll
                for (int m = 0; m < 4; ++m) { const unsigned o2 = ((unsigned)(grow0 + ai * HALF + m * 16) * 1024u + (unsigned)(col0 + bj * HALF)) * 2u;
                    f32x4 y0 = x0[m], y1 = x1[m];
                    if constexpr (!f32base) { y0 = y0 * gp[0]; y1 = y1 * gp[1]; }
                    y0 = y0 + gv[0] * acc[ai][bj][m][0]; y1 = y1 + gv[1] * acc[ai][bj][m][1];
                    ss[ai * 4 + m] += ((y0[0] * y0[0] + y0[1] * y0[1]) + (y0[2] * y0[2] + y0[3] * y0[3])) + ((y1[0] * y1[0] + y1[1] * y1[1]) + (y1[2] * y1[2] + y1[3] * y1[3]));
                    asm volatile("" : "+v"(ss[ai * 4 + m]));
                    const f32x4 h0 = y0 * gs[0], h1 = y1 * gs[1];
                    u32x4 hw; hw.x = cvt_pk_bf16(h0[0], h0[1]); hw.y = cvt_pk_bf16(h0[2], h0[3]); hw.z = cvt_pk_bf16(h1[0], h1[1]); hw.w = cvt_pk_bf16(h1[2], h1[3]);
                    gst<u32x4>(X, o2, hw); }
                asm volatile("" ::: "memory"); }
        }
        if (scaled) {
#pragma unroll
            for (int q = 0; q < 8; ++q) { float s = ss[q]; s += __shfl_xor(s, 16); s += __shfl_xor(s, 32);
                if (fq == 0) gst<float>(ssx, ((unsigned)(grow0 + (q >> 2) * HALF + (q & 3) * 16) * 16u + (unsigned)(4 * u.pn + wc)) * 4u, s); } }
    }
};

#ifndef DPP_UP
#define DPP_UP 0x121
#define DPP_DN 0x12F
#endif
struct UnitUp : Unit { int nrows; };
struct EpiUp {
    static constexpr bool PERM = true, PREFETCH = true;
    bf16_t* act; const float* cw; const float* cb; PG8_LAS float* xb;
    const float* ssx; const float* ub;
    __device__ __forceinline__ void prefetch(const UnitUp& u, int wid, int lane) const {
        dma_ssx(ssx, u.arow, xb, wid, lane);
        { const int arr = wid >> 1, half = wid & 1; const float* src = (arr < 3 ? cw + arr * 2816 : cb) + u.pn * HALF + half * 64 + lane;
          __builtin_amdgcn_global_load_lds((const unsigned*)src, (PG8_LAS unsigned*)(xb + EX_CW + arr * 128 + half * 64), 4, 0, 0); }
        if (wid < 2) { const int a0 = u.arow < 0 ? 0 : u.arow; const int b0 = a0 >= MLAT_ ? 8 : (a0 >> 11); const int bb_ = b0 + wid > 8 ? 8 : b0 + wid;
            __builtin_amdgcn_global_load_lds((const unsigned*)(ub + bb_ * 5632 + u.pn * BM + lane * 4), (PG8_LAS unsigned*)(xb + EX_BL + wid * 256), 16, 0, 0); }
    }
    __device__ __forceinline__ void operator()(f32x4 (&acc)[2][2][4][2], const UnitUp& u, int wr, int wc, int fr_in, int fq_in) const {
        int t_ = threadIdx.x; asm volatile("" : "+v"(t_)); const int fr = t_ & 15, fq = (t_ >> 4) & 3; (void)fr_in; (void)fq_in;
        const int lane = fq * 16 + fr;
        const int ccol = wc * 32 + 8 * fq;
        const int gc = u.pn * HALF + ccol;
        PG8_LAS float* CW = xb + EX_CW;
        unsigned rowflags;
        { unsigned pmask = 0u;
          const int a0 = u.arow < 0 ? 0 : u.arow, e0 = u.arow + 255;
          const int seam = (a0 >= MLAT_) ? (1 << 30) : (((a0 >> 11) + 1) << 11);
          const bool straddle = e0 >= seam;
          const PG8_LAS float* bl = xb + EX_BL + ccol;
          const f32x4 ug0 = *(const PG8_LAS f32x4*)(bl), ug1 = *(const PG8_LAS f32x4*)(bl + 4), uv0 = *(const PG8_LAS f32x4*)(bl + HALF), uv1 = *(const PG8_LAS f32x4*)(bl + HALF + 4);
#pragma unroll
          for (int ai = 0; ai < 2; ++ai)
#pragma unroll
            for (int m = 0; m < 4; ++m) { const int tr = ai * HALF + wr * 64 + m * 16 + fr; const int g = u.arow + tr;
                const int pos = g < MLAT_ ? (g & 2047) : ((g - MLAT_) & 255); const int last = g < MLAT_ ? 2047 : 255;
                if (pos == 0) pmask |= 1u << (4 * ai + m); if (pos == last) pmask |= 256u << (4 * ai + m);
                const f32x4 s4 = *(const PG8_LAS f32x4*)(xb + EX_SSX + tr * 16 + 4 * fq); float ssr = (s4[0] + s4[1]) + (s4[2] + s4[3]); ssr += __shfl_xor(ssr, 16); ssr += __shfl_xor(ssr, 32);
                const float rs = __builtin_amdgcn_rsqf(ssr * (1.0f / 1024.0f) + RMS_EPS);
                acc[ai][0][m][0] = acc[ai][0][m][0] * rs + ug0; acc[ai][0][m][1] = acc[ai][0][m][1] * rs + ug1;
                acc[ai][1][m][0] = acc[ai][1][m][0] * rs + uv0; acc[ai][1][m][1] = acc[ai][1][m][1] * rs + uv1; }
          if (straddle) {
              const f32x4 dg0 = *(const PG8_LAS f32x4*)(bl + 256) - ug0, dg1 = *(const PG8_LAS f32x4*)(bl + 260) - ug1, dv0 = *(const PG8_LAS f32x4*)(bl + 256 + HALF) - uv0, dv1 = *(const PG8_LAS f32x4*)(bl + 260 + HALF) - uv1;
#pragma unroll
              for (int ai = 0; ai < 2; ++ai)
#pragma unroll
                for (int m = 0; m < 4; ++m) { const int g = u.arow + ai * HALF + wr * 64 + m * 16 + fr; const float sel = (g >= seam) ? 1.0f : 0.0f;
                    acc[ai][0][m][0] += dg0 * sel; acc[ai][0][m][1] += dg1 * sel; acc[ai][1][m][0] += dv0 * sel; acc[ai][1][m][1] += dv1 * sel; } }
          rowflags = pmask; }
        PG8_LAS float* XF = xb + EX_XF; PG8_LAS float* XL = xb + EX_XL;
        const bool isF = (fr == 0), isL = (fr == 15);
#pragma unroll
        for (int ai = 0; ai < 2; ++ai) { const int blk = 2 * ai + wr;
            f32x4 s0, s1;
#pragma unroll
            for (int e = 0; e < 4; ++e) { s0[e] = isF ? acc[ai][0][0][0][e] : acc[ai][0][3][0][e]; s1[e] = isF ? acc[ai][0][0][1][e] : acc[ai][0][3][1][e]; }
            PG8_LAS float* dst = xb + (isF ? EX_XF : EX_XL) + blk * 128 + ccol;
            if (isF || isL) { *(PG8_LAS f32x4*)dst = s0; *(PG8_LAS f32x4*)(dst + 4) = s1; } }
        asm volatile("s_waitcnt lgkmcnt(0)" ::: "memory"); __builtin_amdgcn_s_barrier(); asm volatile("" ::: "memory");
        const int lup = (lane & 48) | ((lane - 1) & 15), ldn = (lane & 48) | ((lane + 1) & 15);
#pragma unroll
        for (int ai = 0; ai < 2; ++ai) { const int blk = 2 * ai + wr;
#pragma unroll
            for (int n = 0; n < 2; ++n) {
                const f32x4 w0 = *(const PG8_LAS f32x4*)(CW + ccol + 4 * n), w1 = *(const PG8_LAS f32x4*)(CW + 128 + ccol + 4 * n), w2 = *(const PG8_LAS f32x4*)(CW + 256 + ccol + 4 * n), bb = *(const PG8_LAS f32x4*)(CW + 384 + ccol + 4 * n);
                f32x4 xprev = (f32x4){0.f, 0.f, 0.f, 0.f}, xnext = (f32x4){0.f, 0.f, 0.f, 0.f};
                if (blk > 0) xprev = *(const PG8_LAS f32x4*)(XL + (blk - 1) * 128 + ccol + 4 * n);
                if (blk < 3) xnext = *(const PG8_LAS f32x4*)(XF + (blk + 1) * 128 + ccol + 4 * n);
#pragma unroll
                for (int e = 0; e < 4; ++e) {
                    float cur[4], up[4], dn[4];
#pragma unroll
                    for (int m = 0; m < 4; ++m) cur[m] = acc[ai][0][m][n][e];
#pragma unroll
                    for (int m = 0; m < 4; ++m) {
                        const float tu = isL ? (m > 0 ? cur[m > 0 ? m - 1 : 0] : xprev[e]) : cur[m];
                        const float td = isF ? (m < 3 ? cur[m < 3 ? m + 1 : 3] : xnext[e]) : cur[m];
                        up[m] = __shfl(tu, lup); dn[m] = __shfl(td, ldn); }
                    float rr[4];
#pragma unroll
                    for (int m = 0; m < 4; ++m) { const float upv = ((rowflags >> (4 * ai + m)) & 1u) ? 0.f : up[m], dnv = ((rowflags >> (8 + 4 * ai + m)) & 1u) ? 0.f : dn[m];
                        const float cv = w0[e] * upv + w1[e] * cur[m] + w2[e] * dnv + bb[e];
                        const float sg = cv * __builtin_amdgcn_rcpf(1.0f + __expf(-cv));
                        rr[m] = sg * acc[ai][1][m][n][e]; }
                    asm volatile("" : "+v"(rr[0]), "+v"(rr[1]), "+v"(rr[2]), "+v"(rr[3]));
#pragma unroll
                    for (int m = 0; m < 4; ++m) acc[ai][0][m][n][e] = rr[m];
                }
            }
#pragma unroll
            for (int m = 0; m < 4; ++m) { const int tr = ai * HALF + wr * 64 + m * 16 + fr; const int g = u.arow + tr;
                if (tr >= 1 && tr <= 254 && g < u.nrows) { const f32x4 v0 = acc[ai][0][m][0], v1 = acc[ai][0][m][1];
                    u32x4 w; w.x = cvt_pk_bf16(v0[0], v0[1]); w.y = cvt_pk_bf16(v0[2], v0[3]); w.z = cvt_pk_bf16(v1[0], v1[1]); w.w = cvt_pk_bf16(v1[2], v1[3]);
                    gst<u32x4>(act, ((unsigned)g * 2816u + (unsigned)gc) * 2u, w); } }
            asm volatile("" ::: "memory");
        }
        asm volatile("s_waitcnt lgkmcnt(0)" ::: "memory"); __builtin_amdgcn_s_barrier(); asm volatile("" ::: "memory");
    }
};
}
namespace att {
using bf16x8 = __attribute__((ext_vector_type(8))) short;
using s16x4  = __attribute__((ext_vector_type(4))) short;
using f32x16 = __attribute__((ext_vector_type(16))) float;
using u32x4  = __attribute__((ext_vector_type(4))) unsigned;
typedef unsigned short bf16_t;
constexpr int NW = 8, QBLK = 32, KVBLK = 64;
constexpr int LDQ = 768, LDK = 768, LDV = 512, LDO = 512;
constexpr float SCALE = 0.07216878364870322f;
constexpr float THR = 8.f;
constexpr int SHM_V = KVBLK * 128 * 2, SHM_K = KVBLK * 192 * 2;
constexpr int OFF_V = 0, OFF_K = 2 * SHM_V, OFF_WS = 2 * SHM_V + 2 * SHM_K, OFF_QR = OFF_WS + NW * 64 * 4, SHM_ATTN = OFF_QR + NW * 4096;
#define KSWZ(row, colB) ((row) * 384 + ((colB) ^ (((row) & 7) << 4)))
#define SBAR() __builtin_amdgcn_sched_barrier(0)
__device__ __forceinline__ int crow(int r, int hi) { return (r & 3) + 8 * (r >> 2) + 4 * hi; }
__device__ __forceinline__ unsigned cvtpk(float lo, float hi) { unsigned r; asm volatile("v_cvt_pk_bf16_f32 %0, %1, %2" : "=v"(r) : "v"(lo), "v"(hi)); return r; }

__device__ __forceinline__ void partialSM(f32x16& p0, f32x16& p1, float& m_reg, float& mn, float& alpha) {
  constexpr float C = SCALE * 1.4426950408889634f;
  float pmax = p0[0];
#pragma unroll
  for (int r = 1; r < 16; ++r) pmax = fmaxf(pmax, p0[r]);
#pragma unroll
  for (int r = 0; r < 16; ++r) pmax = fmaxf(pmax, p1[r]);
  { auto rr = __builtin_amdgcn_permlane32_swap(__float_as_uint(pmax), __float_as_uint(pmax), false, false);
    pmax = fmaxf(__uint_as_float(rr[0]), __uint_as_float(rr[1])); }
  if (__builtin_expect(__all(pmax - m_reg <= THR / SCALE), 1)) { mn = m_reg; alpha = 1.f; }
  else { mn = fmaxf(m_reg, pmax); alpha = __builtin_amdgcn_exp2f((m_reg - mn) * C); m_reg = mn; }
  float mnC = -mn * C;
#pragma unroll
  for (int r = 0; r < 16; ++r) p0[r] = fmaf(p0[r], C, mnC);
#pragma unroll
  for (int r = 0; r < 16; ++r) p1[r] = fmaf(p1[r], C, mnC);
#pragma unroll
  for (int r = 0; r < 16; ++r) p0[r] = __builtin_amdgcn_exp2f(p0[r]);
}
__device__ __forceinline__ void finishSM(f32x16& p0, f32x16& p1, float alpha, float& l_reg, bf16x8& pa0, bf16x8& pa1, bf16x8& pa2, bf16x8& pa3) {
#pragma unroll
  for (int r = 0; r < 16; ++r) p1[r] = __builtin_amdgcn_exp2f(p1[r]);
  float ps = 0;
#pragma unroll
  for (int r = 0; r < 16; ++r) ps += p0[r];
#pragma unroll
  for (int r = 0; r < 16; ++r) ps += p1[r];
  { auto rr = __builtin_amdgcn_permlane32_swap(__float_as_uint(ps), __float_as_uint(ps), false, false);
    ps = __uint_as_float(rr[0]) + __uint_as_float(rr[1]); }
  l_reg = l_reg * alpha + ps;
#define PK4(P, BASE, OUT) do { unsigned a0 = cvtpk(P[BASE + 0], P[BASE + 1]), a1 = cvtpk(P[BASE + 2], P[BASE + 3]);   \
    unsigned b0 = cvtpk(P[BASE + 4], P[BASE + 5]), b1 = cvtpk(P[BASE + 6], P[BASE + 7]);                              \
    auto r0 = __builtin_amdgcn_permlane32_swap(a0, b0, false, false); auto r1 = __builtin_amdgcn_permlane32_swap(a1, b1, false, false); \
    u32x4 w = {r0[0], r1[0], r0[1], r1[1]}; OUT = *reinterpret_cast<bf16x8*>(&w); } while (0)
  PK4(p0, 0, pa0); PK4(p0, 8, pa1); PK4(p1, 0, pa2); PK4(p1, 8, pa3);
#undef PK4
}
__device__ __forceinline__ void qkt(f32x16& p0, f32x16& p1, const char* Ks, const bf16x8* qr, const char* Qr, int r32, int hi) {
  p0 = f32x16{}; p1 = f32x16{};
#pragma unroll
  for (int d0 = 0; d0 < 12; ++d0) { int cb = (d0 * 16 + hi * 8) * 2;
    bf16x8 b0 = *reinterpret_cast<const bf16x8*>(Ks + KSWZ(r32, cb));
    bf16x8 b1 = *reinterpret_cast<const bf16x8*>(Ks + KSWZ(32 + r32, cb));
    bf16x8 q;
    if (d0 < 8) q = qr[d0];
    else q = *reinterpret_cast<const bf16x8*>(Qr + r32 * 128 + ((((d0 - 8) * 16 + hi * 8) * 2) ^ ((r32 & 7) << 4)));
    p0 = __builtin_amdgcn_mfma_f32_32x32x16_bf16(b0, q, p0, 0, 0, 0);
    p1 = __builtin_amdgcn_mfma_f32_32x32x16_bf16(b1, q, p1, 0, 0, 0); }
}
__device__ __forceinline__ int v_st(int k, int c) { const int kk = (k & ~0xC) | ((k & 4) << 1) | ((k & 8) >> 1); return ((kk >> 3) * 4 + (c >> 5)) * 512 + ((kk & 7) * 32 + (c & 31)) * 2; }
__device__ __forceinline__ int v_rd_base(int lane) { return ((lane & 3) << 3) | (((lane >> 2) & 3) << 6) | (((lane >> 4) & 1) << 5) | (((lane >> 5) & 1) << 8); }
constexpr int v_rd_off(int d0, int ks, int half) { return d0 * 512 + ks * 4096 + half * 2048; }
template <int OFF> __device__ __forceinline__ s16x4 tr_read(int vb) {
  s16x4 r; asm volatile("ds_read_b64_tr_b16 %0, %1 offset:%2" : "=&v"(r) : "v"(vb), "i"(OFF) : "memory"); return r;
}
template <int D0> __device__ __forceinline__ void pv_one(f32x16& od, int vb, bf16x8 pa0, bf16x8 pa1, bf16x8 pa2, bf16x8 pa3) {
  const s16x4 l0 = tr_read<v_rd_off(D0, 0, 0)>(vb), h0 = tr_read<v_rd_off(D0, 0, 1)>(vb), l1 = tr_read<v_rd_off(D0, 1, 0)>(vb), h1 = tr_read<v_rd_off(D0, 1, 1)>(vb);
  const s16x4 l2 = tr_read<v_rd_off(D0, 2, 0)>(vb), h2 = tr_read<v_rd_off(D0, 2, 1)>(vb), l3 = tr_read<v_rd_off(D0, 3, 0)>(vb), h3 = tr_read<v_rd_off(D0, 3, 1)>(vb);
  asm volatile("s_waitcnt lgkmcnt(0)" ::: "memory"); SBAR();
#define PK(L, H) (bf16x8){L[0], L[1], L[2], L[3], H[0], H[1], H[2], H[3]}
  od = __builtin_amdgcn_mfma_f32_32x32x16_bf16(pa0, PK(l0, h0), od, 0, 0, 0);
  od = __builtin_amdgcn_mfma_f32_32x32x16_bf16(pa1, PK(l1, h1), od, 0, 0, 0);
  od = __builtin_amdgcn_mfma_f32_32x32x16_bf16(pa2, PK(l2, h2), od, 0, 0, 0);
  od = __builtin_amdgcn_mfma_f32_32x32x16_bf16(pa3, PK(l3, h3), od, 0, 0, 0);
#undef PK
}
__device__ __forceinline__ void pv_d0(f32x16* o, int vb, bf16x8 pa0, bf16x8 pa1, bf16x8 pa2, bf16x8 pa3) {
  pv_one<0>(o[0], vb, pa0, pa1, pa2, pa3); pv_one<1>(o[1], vb, pa0, pa1, pa2, pa3); pv_one<2>(o[2], vb, pa0, pa1, pa2, pa3); pv_one<3>(o[3], vb, pa0, pa1, pa2, pa3);
}

__device__ __forceinline__ void attn_unit(const bf16_t* __restrict__ Qb, const bf16_t* __restrict__ Kg, const bf16_t* __restrict__ Vg, bf16_t* __restrict__ Ob,
                                          int r0, int n0, int r1, int NT, char* lds) {
  int tid = threadIdx.x; asm volatile("" : "+v"(tid));
  const int wid = tid >> 6, lane = tid & 63, r32 = lane & 31, hi = lane >> 5;
  char* V_lds = lds + OFF_V; char* K_lds = lds + OFF_K;
  float* ws = (float*)(lds + OFF_WS) + wid * 64; float* li_l = ws; float* al_l = ws + 32;
  float m_reg = -1e30f, l_reg = 0; f32x16 o[4] = {}; bf16x8 qr[8];
  const bf16_t* Qw = Qb + (long)(wid * QBLK + r32) * LDQ + hi * 8;
  char* Qr = lds + OFF_QR + wid * 4096;
#pragma unroll
  for (int d0 = 0; d0 < 8; ++d0) qr[d0] = *reinterpret_cast<const bf16x8*>(Qw + d0 * 16);
#pragma unroll
  for (int d0 = 8; d0 < 12; ++d0) { const bf16x8 q = *reinterpret_cast<const bf16x8*>(Qw + d0 * 16);
    *reinterpret_cast<bf16x8*>(Qr + r32 * 128 + ((((d0 - 8) * 16 + hi * 8) * 2) ^ ((r32 & 7) << 4))) = q; }
  const int sr = tid >> 4, sc = (tid & 15) * 8, vst0 = v_st(sr, sc), vst1 = v_st(32 + sr, sc);
  unsigned kgo[3], kst[3];
#pragma unroll
  for (int i = 0; i < 3; ++i) { const int id = tid + 512 * i, kr_ = id / 24, kc_ = id % 24; kgo[i] = (unsigned)(kr_ * LDK + kc_ * 8) * 2u; kst[i] = (unsigned)KSWZ(kr_, kc_ * 16); }
  const unsigned vgo0 = (unsigned)(sr * LDV + sc) * 2u, vgo1 = vgo0 + 32u * LDV * 2u;
  const int vb0 = (int)(uintptr_t)V_lds + v_rd_base(lane);
  bf16x8 vs0, vs1, ks0, ks1, ks2;
#define TROW(j) ((j) < n0 ? r0 + 64 * (j) : r1 + 64 * ((j) - n0))
#define SLOAD(j) do { const long tr_ = TROW(j); const char* Vt = (const char*)(Vg + tr_ * LDV); const char* Kt = (const char*)(Kg + tr_ * LDK);     \
    vs0 = *reinterpret_cast<const bf16x8*>(Vt + vgo0); vs1 = *reinterpret_cast<const bf16x8*>(Vt + vgo1); \
    ks0 = *reinterpret_cast<const bf16x8*>(Kt + kgo[0]); ks1 = *reinterpret_cast<const bf16x8*>(Kt + kgo[1]); ks2 = *reinterpret_cast<const bf16x8*>(Kt + kgo[2]); } while (0)
#define SWRITE(b) do { *(bf16x8*)(V_lds + (b) * SHM_V + vst0) = vs0; *(bf16x8*)(V_lds + (b) * SHM_V + vst1) = vs1; \
    *(bf16x8*)(K_lds + (b) * SHM_K + kst[0]) = ks0; *(bf16x8*)(K_lds + (b) * SHM_K + kst[1]) = ks1; *(bf16x8*)(K_lds + (b) * SHM_K + kst[2]) = ks2; } while (0)
#define RESC(a) do { if (__any((a) < 1.f)) { if (hi == 0) al_l[r32] = (a); asm volatile("s_waitcnt lgkmcnt(0)" ::: "memory"); \
    _Pragma("unroll") for (int d = 0; d < 4; ++d) _Pragma("unroll") for (int r = 0; r < 16; ++r) o[d][r] *= al_l[crow(r, hi)]; } } while (0)
  f32x16 pA0, pA1, pB0, pB1; float mnA, mnB, alA, alB; bf16x8 pa0, pa1, pa2, pa3;
  SLOAD(0); asm volatile("s_waitcnt vmcnt(0)" ::: "memory"); SWRITE(0); __syncthreads();
  qkt(pA0, pA1, K_lds, qr, Qr, r32, hi); partialSM(pA0, pA1, m_reg, mnA, alA);
  SLOAD(1);
  asm volatile("s_waitcnt vmcnt(0)" ::: "memory"); SWRITE(1); __syncthreads();
  for (int j = 1; j + 1 < NT; j += 2) {
    SBAR(); qkt(pB0, pB1, K_lds + SHM_K, qr, Qr, r32, hi);
    finishSM(pA0, pA1, alA, l_reg, pa0, pa1, pa2, pa3); SBAR();
    SLOAD(j + 1); SBAR();
    pv_d0(o, vb0, pa0, pa1, pa2, pa3); partialSM(pB0, pB1, m_reg, mnB, alB);
    __syncthreads(); asm volatile("s_waitcnt vmcnt(0)" ::: "memory"); SWRITE(0);
    RESC(alB); __syncthreads();
    SBAR(); qkt(pA0, pA1, K_lds, qr, Qr, r32, hi);
    finishSM(pB0, pB1, alB, l_reg, pa0, pa1, pa2, pa3); SBAR();
    SLOAD(j + 2); SBAR();
    pv_d0(o, vb0 + SHM_V, pa0, pa1, pa2, pa3); partialSM(pA0, pA1, m_reg, mnA, alA);
    __syncthreads(); asm volatile("s_waitcnt vmcnt(0)" ::: "memory"); SWRITE(1);
    RESC(alA); __syncthreads();
  }
  SBAR(); qkt(pB0, pB1, K_lds + SHM_K, qr, Qr, r32, hi);
  finishSM(pA0, pA1, alA, l_reg, pa0, pa1, pa2, pa3); SBAR();
  pv_d0(o, vb0, pa0, pa1, pa2, pa3); partialSM(pB0, pB1, m_reg, mnB, alB);
  __syncthreads(); RESC(alB);
  finishSM(pB0, pB1, alB, l_reg, pa0, pa1, pa2, pa3); SBAR();
  pv_d0(o, vb0 + SHM_V, pa0, pa1, pa2, pa3);
  if (hi == 0) li_l[r32] = l_reg; asm volatile("s_waitcnt lgkmcnt(0)" ::: "memory");
  float rli[16];
#pragma unroll
  for (int r = 0; r < 16; ++r) rli[r] = __builtin_amdgcn_rcpf(li_l[crow(r, hi)]);
  __syncthreads();
  { bf16_t* stg = (bf16_t*)(lds + wid * 8192);
#pragma unroll
    for (int r = 0; r < 16; ++r) { const int orow = crow(r, hi);
#pragma unroll
      for (int d0 = 0; d0 < 4; ++d0) { const unsigned pk = cvtpk(o[d0][r] * rli[r], 0.f); stg[orow * 128 + d0 * 32 + r32] = (bf16_t)(pk & 0xffffu); } }
    asm volatile("s_waitcnt lgkmcnt(0)" ::: "memory");
    bf16_t* Ow = Ob + (long)(wid * QBLK) * LDO;
#pragma unroll
    for (int i = 0; i < 8; ++i) { const int row = i * 4 + (lane >> 4), ch = lane & 15; const u32x4 v = *(const u32x4*)(stg + row * 128 + ch * 8); *(u32x4*)(Ow + (long)row * LDO + ch * 8) = v; } }
  __syncthreads();
#undef TROW
#undef SLOAD
#undef SWRITE
#undef RESC
}
#undef KSWZ
#undef SBAR
}
constexpr int NWAVES = 8;
#ifndef MK_SPLIT
#define MK_SPLIT 0
#endif

constexpr int DM = 1024, NB = 8, SL = 2048, CL = 256, MLAT = NB * SL, MCTX = NB * CL, MT = MLAT + MCTX;
constexpr int NIN = 2048;
constexpr int FF = 2816, NUP = 2 * FF;
constexpr int NPH = 20;
constexpr float EPS = 1e-6f;

constexpr size_t MiB = 1u << 20;
constexpr size_t WS_CTL = 0, CTL_ZERO_BYTES = 64 * 1024;
constexpr size_t WS_MOD = 1 * MiB;
constexpr size_t WS_ROPE = 1 * MiB + 512 * 1024;
constexpr size_t WS_SSQ = 2 * MiB;
constexpr int NWIN = 2304;
constexpr size_t WS_WIN = 53 * MiB, WIN_STRIDE = (size_t)NWIN * DM * 2;
constexpr size_t WS_WQKV = 12 * MiB, WQKV_STRIDE = (size_t)1792 * 384 * 2;
constexpr size_t WS_WOUT = 15 * MiB, WOUT_STRIDE = (size_t)DM * DM * 2;
constexpr size_t WS_WUP = 19 * MiB, WUP_STRIDE = (size_t)NUP * DM * 2;
constexpr size_t WS_WDOWN = 41 * MiB, WDOWN_STRIDE = (size_t)DM * FF * 2;
constexpr size_t WS_DFT = 52 * MiB;
constexpr size_t WS_DFTC = 68 * MiB;
constexpr size_t WS_CST = 68 * MiB + 256 * 1024;
constexpr size_t WS_WF = 248 * MiB;
constexpr size_t WS_XCTX = 69 * MiB;
constexpr size_t WS_XN = 77 * MiB;
constexpr size_t WS_Q = WS_XN, WS_YC = WS_XN + 27 * MiB;
constexpr size_t WS_P = 113 * MiB;
constexpr size_t WS_YCAT = WS_P, WS_ACT = WS_P;
constexpr size_t WS_YFP = WS_P + 36 * MiB;
constexpr size_t WS_K = 185 * MiB;
constexpr size_t WS_V = 212 * MiB;
constexpr size_t WS_CPART = 212 * MiB;
constexpr size_t WS_ZT = 230 * MiB;
constexpr size_t WS_ZTC = WS_ZT + 16 * MiB;
constexpr size_t WS_YF = WS_ZT;
constexpr size_t WS_FTAB = WS_DFT;
constexpr size_t OUT_ATT = 36 * MiB;
constexpr size_t WS_SSX = 250 * MiB;
constexpr size_t WS_PB = 252 * MiB;
constexpr size_t WS_UB = 253 * MiB;
constexpr size_t WS_END = 254 * MiB;
static_assert(WS_WQKV + 2 * WQKV_STRIDE <= WS_WOUT && WS_WOUT + 2 * WOUT_STRIDE <= WS_WUP && WS_WUP + 2 * WUP_STRIDE <= WS_WDOWN && WS_WDOWN + 2 * WDOWN_STRIDE <= WS_DFT, "weights map");
static_assert(WS_WIN + 2 * WIN_STRIDE <= 68 * MiB && WS_SSQ + (size_t)MT * 80 <= 4 * MiB && WS_XN + (size_t)MT * DM * 2 <= WS_P && WS_P + (size_t)MT * NIN * 2 <= WS_K && WS_K + (size_t)MT * 768 * 2 <= WS_V && WS_V + (size_t)MT * 512 * 2 <= WS_ZT, "activation map");
static_assert(WS_ACT + (size_t)MT * FF * 2 <= WS_V && WS_YC + (size_t)MT * 256 * 2 <= WS_P, "overlay map");
constexpr int CW_BAR = 4096;

constexpr int RING_OFF = 0, RING_BYTES = 131072;
constexpr int LDSCTL_OFF = RING_BYTES, MISC_OFF = LDSCTL_OFF + 320, PTR_OFF = LDSCTL_OFF + 512, EPIX_OFF = LDSCTL_OFF + 1024;
constexpr int LDS_BYTES = 163840;
static_assert(EPIX_OFF + 6400 * 4 <= LDS_BYTES, "LDS map");

#define GAS __attribute__((address_space(1)))
#define LAS __attribute__((address_space(3)))
typedef unsigned short bf16;
typedef unsigned v4u __attribute__((ext_vector_type(4)));
typedef unsigned v2u __attribute__((ext_vector_type(2)));
typedef float f32x4 __attribute__((ext_vector_type(4)));
typedef GAS unsigned gu32;
#define RLX_AGENT __ATOMIC_RELAXED, __HIP_MEMORY_SCOPE_AGENT
#define LDS_WAIT() asm volatile("s_waitcnt lgkmcnt(0)" ::: "memory")
#define VM_WAIT() asm volatile("s_waitcnt vmcnt(0)" ::: "memory")
__device__ __forceinline__ unsigned f2bf(float f) { unsigned u = __builtin_bit_cast(unsigned, f); return (u + 0x7fffu + ((u >> 16) & 1u)) >> 16; }
__device__ __forceinline__ unsigned pk2(float lo, float hi) { return f2bf(lo) | (f2bf(hi) << 16); }
__device__ __forceinline__ float bf2f(unsigned h) { return __builtin_bit_cast(float, h << 16); }

#define XB_TMO      128
#define XB_XCNT(j)  (256  + 64 * (j))
#define XB_XSUB(j)  (1280 + 64 * (j))
#define XB_XGEN(j)  (2304 + 64 * (j))
#define XB_TOP      3328
#define XB_TOPGEN   3392
#define XCD_BAR_WORDS 3456
#define XB_SPIN_CAP (1u << 20)
__device__ __forceinline__ unsigned xb_ld(unsigned* p)              { return __hip_atomic_load(p, __ATOMIC_RELAXED, __HIP_MEMORY_SCOPE_AGENT); }
__device__ __forceinline__ unsigned xb_add(unsigned* p, unsigned v) { return __hip_atomic_fetch_add(p, v, __ATOMIC_RELAXED, __HIP_MEMORY_SCOPE_AGENT); }
__device__ __forceinline__ unsigned xb_xcc_id() { return (unsigned)__builtin_amdgcn_s_getreg((3 << 11) | 20) & 0xFu; }
#define XB_SPIN(cond, bar) do { unsigned _sp = 0; while (cond) { __builtin_amdgcn_s_sleep(1); \
    if ((++_sp & 255u) == 0u) { if (xb_ld(&(bar)[XB_TMO])) break; if (_sp > XB_SPIN_CAP) { atomicAdd(&(bar)[XB_TMO], 1u); break; } } } } while (0)
struct XcdBarrier { unsigned* bar; unsigned x; volatile LAS unsigned* st; };
__device__ __forceinline__ XcdBarrier xcd_barrier_post(unsigned* bar, volatile LAS unsigned* st) {
    XcdBarrier b; b.bar = bar; b.x = xb_xcc_id(); b.st = st;
    if (threadIdx.x == 0) (void)xb_add(&bar[XB_XCNT(b.x)], 1u);
    return b;
}
__device__ __forceinline__ void xcd_barrier_complete(unsigned* bar, unsigned x, unsigned& nloc, unsigned& nx) {
    const unsigned G = gridDim.x * gridDim.y * gridDim.z;
    unsigned sum, cnt, mine, sp = 0u;
    for (;;) {
        sum = 0u; cnt = 0u; mine = 0u;
#pragma unroll
        for (unsigned j = 0; j < 16; ++j) { const unsigned c = xb_ld(&bar[XB_XCNT(j)]); sum += c; cnt += (c > 0u) ? 1u : 0u; mine = (j == x) ? c : mine; }
        if (sum == G) break;
        __builtin_amdgcn_s_sleep(1);
        if ((++sp & 255u) == 0u) { if (xb_ld(&bar[XB_TMO])) break; if (sp > XB_SPIN_CAP) { atomicAdd(&bar[XB_TMO], 1u); break; } }
    }
    nloc = mine > 0u ? mine : 1u; nx = cnt > 0u ? cnt : 1u;
}
__device__ __forceinline__ void xcd_barrier(const XcdBarrier& b) {
    asm volatile("s_waitcnt vmcnt(0)" ::: "memory");
    __syncthreads();
    if (threadIdx.x == 0) {
        unsigned* bar = b.bar;
        __builtin_amdgcn_s_waitcnt(0);
        unsigned nloc = b.st[0], nx = b.st[1];
        if (nloc == 0u) { xcd_barrier_complete(bar, b.x, nloc, nx); b.st[0] = nloc; b.st[1] = nx; }
        const unsigned old = xb_add(&bar[XB_XSUB(b.x)], 1u);
        const unsigned gen = old / nloc;
        if (old + 1u == (gen + 1u) * nloc) {
            __builtin_amdgcn_fence(__ATOMIC_RELEASE, "agent");
            asm volatile("s_waitcnt vmcnt(0)" ::: "memory");
            const unsigned og = xb_add(&bar[XB_TOP], 1u);
            const unsigned tg = og / nx;
            if (og + 1u == (tg + 1u) * nx) xb_add(&bar[XB_TOPGEN], 1u);
            else XB_SPIN(xb_ld(&bar[XB_TOPGEN]) == tg, bar);
            __builtin_amdgcn_fence(__ATOMIC_ACQUIRE, "agent");
            xb_add(&bar[XB_XGEN(b.x)], 1u);
            asm volatile("s_waitcnt vmcnt(0)" ::: "memory");
        } else {
            XB_SPIN(xb_ld(&bar[XB_XGEN(b.x)]) == gen, bar);
            __builtin_amdgcn_fence(__ATOMIC_ACQUIRE, "agent");
            asm volatile("s_waitcnt vmcnt(0)" ::: "memory");
        }
    }
    __syncthreads();
}

struct Args { const float* in[22]; float* out; unsigned char* ws; int ph_lo, ph_hi; };
enum { I_X = 0, I_C, I_CTX, I_CCTX, I_ADAW, I_ADAB, I_N1G, I_WIN, I_QNG, I_KVNG, I_WUQ, I_WUKV, I_SCW, I_SCB, I_ONG, I_WOUT, I_N2G, I_WUP, I_FCW, I_FCB, I_WDOWN, I_FING };

struct Frame {
    LAS unsigned char* lds; char* ldsg;
    volatile LAS unsigned* MISC;
    int tid, lane, wave, vcu, G, bx;
    unsigned char* ws; float* out;
};

__device__ __forceinline__ const float* inptr(const Frame& F, int i) {
    const LAS unsigned* T = (const LAS unsigned*)(F.lds + PTR_OFF) + 2 * i;
    const unsigned lo = __builtin_amdgcn_readfirstlane(T[0]), hi = __builtin_amdgcn_readfirstlane(T[1]);
    return (const float*)(const GAS float*)(((unsigned long long)hi << 32) | (unsigned long long)lo);
}
__device__ __forceinline__ float wave_sum(float v) {
#pragma unroll
    for (int o = 1; o < 64; o <<= 1) v += __shfl_xor(v, o);
    return v;
}

__device__ __host__ __forceinline__ int rope_slot(int d) { return 8 * ((d & 15) >> 2) + 4 * (d >> 4) + (d & 3); }
__device__ __forceinline__ void tr_item(const float* W, int ldw, int k0, int c0, bf16* WT, int ldt, int r0, const float* ks, LAS float* scr, int lane, bool ropeperm = false) {
    f32x4 v[8];
#pragma unroll
    for (int i = 0; i < 8; ++i) { const int kk = 8 * i + (lane >> 3); v[i] = *(const GAS f32x4*)(W + (size_t)(k0 + kk) * ldw + c0 + 4 * (lane & 7)); }
#pragma unroll
    for (int i = 0; i < 8; ++i) { const int kk = 8 * i + (lane >> 3); const float sc = ks ? ks[k0 + kk] : 1.0f; LAS float* d = scr + kk * 33 + 4 * (lane & 7);
        d[0] = v[i][0] * sc; d[1] = v[i][1] * sc; d[2] = v[i][2] * sc; d[3] = v[i][3] * sc; }
    LDS_WAIT(); asm volatile("" ::: "memory");
    const int c = lane & 7;
#pragma unroll
    for (int j = 0; j < 4; ++j) { const int n = (lane >> 3) + 8 * j; const LAS float* s = scr + (8 * c) * 33 + n;
        v4u o; o.x = pk2(s[0 * 33], s[1 * 33]); o.y = pk2(s[2 * 33], s[3 * 33]); o.z = pk2(s[4 * 33], s[5 * 33]); o.w = pk2(s[6 * 33], s[7 * 33]);
        *(GAS v4u*)(WT + (size_t)(r0 + (ropeperm ? rope_slot(n) : n)) * ldt + k0 + 8 * c) = o; }
    LDS_WAIT(); asm volatile("" ::: "memory");
}
__device__ __forceinline__ void p0_prologue(Frame& F, int sub, int defer, int gw, int NGW) {
    unsigned char* ws = F.ws;
    float* MOD = (float*)(ws + WS_MOD);
    if (F.bx < 192 && (sub & 1) && defer == 0) {
        const int l = F.bx / 96, cb = F.bx % 96;
        LAS float* S = (LAS float*)(F.lds + F.wave * 4608);
        const float* cin = inptr(F, I_C); const float* cctx = inptr(F, I_CCTX);
        for (int i = F.lane; i < 9 * 128; i += 64) { const int r = i >> 7, kk = i & 127, k = 128 * F.wave + kk; const float cv = (r < 8) ? cin[r * 1024 + k] : cctx[k]; S[i] = cv / (1.0f + __expf(-cv)); }
        LDS_WAIT(); asm volatile("" ::: "memory");
        f32x4 acc[9];
#pragma unroll
        for (int r = 0; r < 9; ++r) acc[r] = (f32x4){0.f, 0.f, 0.f, 0.f};
        const int kr = F.lane >> 4, cl = F.lane & 15;
        const float* W = inptr(F, I_ADAW) + (size_t)l * 1024 * 6144 + (size_t)(128 * F.wave) * 6144 + 64 * cb + 4 * cl;
#pragma unroll 8
        for (int i = 0; i < 32; ++i) { const int kk = 4 * i + kr; const f32x4 w = *(const f32x4*)(W + (size_t)kk * 6144);
#pragma unroll
            for (int r = 0; r < 9; ++r) acc[r] += w * S[r * 128 + kk]; }
        LAS float* RED = (LAS float*)(F.lds + 40960);
#pragma unroll
        for (int r = 0; r < 9; ++r)
#pragma unroll
            for (int e = 0; e < 4; ++e) { float v = acc[r][e]; v += __shfl_xor(v, 16); v += __shfl_xor(v, 32); if (kr == 0) RED[(F.wave * 9 + r) * 64 + 4 * cl + e] = v; }
        __syncthreads();
        for (int i = F.tid; i < 576; i += 512) { const int r = i >> 6, col = i & 63; float s = 0.f;
#pragma unroll
            for (int w = 0; w < 8; ++w) s += RED[(w * 9 + r) * 64 + col];
            MOD[(size_t)(l * 9 + r) * 6144 + 64 * cb + col] = s + inptr(F, I_ADAB)[l * 6144 + 64 * cb + col]; }
        __syncthreads();
    }
    if (F.bx == 255 % F.G && defer == 0) {
        float* RC = (float*)(ws + WS_ROPE); float* RS = RC + 1024;
        for (int idx = F.tid; idx < 1024; idx += 512) { const int pos = idx >> 4, i = idx & 15; const float inv = powf(10000.0f, -(float)(2 * i) / 32.0f); const float ang = (float)pos * inv; RC[idx] = cosf(ang); RS[idx] = sinf(ang); }
    }
    LAS float* scr = (LAS float*)(F.lds + F.wave * 16384);
    constexpr int I_WINA = 22 * 16, I_WINB = 24 * 16, I_WINC = 8 * 16, I_PAD = 8, I_FOLD = 64, I_UQ = 6 * 24, I_UKV = 4 * 32, I_OUT = 16 * 32, I_UP = 16 * 176, I_DOWN = 44 * 32;
    constexpr int PER_LAYER = I_WINA + I_WINB + I_WINC + I_PAD + I_FOLD + I_UQ + I_UKV + I_OUT + I_UP + I_DOWN;
    constexpr int I_DFT = 352, I_DFTC = 256, I_CST = 512;
    constexpr int NITEMS = 2 * PER_LAYER + I_DFT + I_DFTC + I_CST;
    for (int it = gw; it < NITEMS; it += NGW) {
        int r = it;
        { int cat = 2; bool early = false; if (r < 2 * PER_LAYER) { const int q = r % PER_LAYER;
              constexpr int W0 = I_WINA + I_WINB + I_WINC + I_PAD; early = r < PER_LAYER && q >= W0 + I_FOLD && q < W0 + I_FOLD + I_UQ + I_UKV;
              cat = q < W0 ? 1 : q < W0 + I_FOLD ? 3 : q < W0 + I_FOLD + I_UQ + I_UKV + I_OUT ? 4 : q < PER_LAYER - I_DOWN ? 5 : 6; }
          if (!((sub >> cat) & 1)) continue;
          const int dcls = (r < 2 * PER_LAYER && cat >= 4 && !early) ? ((r < PER_LAYER && cat < 6) ? 1 : 2) : 0; if (dcls != defer) continue; }
        if (r < 2 * PER_LAYER) {
            const int l = r / PER_LAYER; r -= l * PER_LAYER;
            bf16* WinT = (bf16*)(ws + WS_WIN + l * WIN_STRIDE);
            const float* win = inptr(F, I_WIN) + (size_t)l * 1024 * 1728;
            if (r < I_WINA) { const int kb = r / 22, nb = r % 22; tr_item(win, 1728, 64 * kb, 32 * nb, WinT, 1024, 32 * nb, nullptr, scr, F.lane); continue; } r -= I_WINA;
            if (r < I_WINB) { const int kb = r / 24, nb = r % 24; tr_item(win, 1728, 64 * kb, 960 + 32 * nb, WinT, 1024, 1280 + 32 * nb, nullptr, scr, F.lane); continue; } r -= I_WINB;
            if (r < I_WINC) { const int kb = r / 8, nb = r % 8; tr_item(win, 1728, 64 * kb, 704 + 32 * nb, WinT, 1024, 2048 + 32 * nb, nullptr, scr, F.lane); continue; } r -= I_WINC;
            if (r < I_PAD) { const v4u z = {0u, 0u, 0u, 0u};
#pragma unroll
                for (int j = 0; j < 16; ++j) { const int q = j * 64 + F.lane; *(GAS v4u*)(WinT + (size_t)(704 + 8 * r + (q >> 7)) * 1024 + (q & 127) * 8) = z; } continue; } r -= I_PAD;
            if (r < I_FOLD) { bf16* WF = (bf16*)(ws + WS_WF) + (size_t)l * 1024 * 256;
#pragma unroll 4
                for (int i = 0; i < 16; ++i) { const int k = 16 * r + i; const f32x4 v = *(const GAS f32x4*)(win + (size_t)k * 1728 + 704 + 4 * F.lane);
                    v2u o; o.x = pk2(v[0], v[1]); o.y = pk2(v[2], v[3]); *(GAS v2u*)(WF + (size_t)k * 256 + 4 * F.lane) = o; } continue; } r -= I_FOLD;
            if (r < I_UQ) { const int kb = r / 24, nb = r % 24; tr_item(inptr(F, I_WUQ) + (size_t)l * 384 * 768, 768, 64 * kb, 32 * nb, (bf16*)(ws + WS_WQKV + l * WQKV_STRIDE), 384, 32 * nb, inptr(F, I_QNG) + l * 384, scr, F.lane, (nb % 6) >= 4); continue; } r -= I_UQ;
            if (r < I_UKV) { const int kb = r / 32, nb = r % 32; tr_item(inptr(F, I_WUKV) + (size_t)l * 256 * 1024, 1024, 64 * kb, 32 * nb, (bf16*)(ws + WS_WQKV + l * WQKV_STRIDE) + (size_t)768 * 384, 384, 32 * nb, inptr(F, I_KVNG) + l * 256, scr, F.lane); continue; } r -= I_UKV;
            if (r < I_OUT) { const int kb = r / 32, nb = r % 32; tr_item(inptr(F, I_WOUT) + (size_t)l * 1024 * 1024, 1024, 64 * kb, 32 * nb, (bf16*)(ws + WS_WOUT + l * WOUT_STRIDE), 1024, 32 * nb, inptr(F, I_ONG) + l * 1024, scr, F.lane); continue; } r -= I_OUT;
            if (r < I_UP) { const int kb = r / 176, nb = r % 176;
                const int j = nb >> 3, h = (nb >> 2) & 1, q = nb & 3;
                tr_item(inptr(F, I_WUP) + (size_t)l * 1024 * NUP, NUP, 64 * kb, h * FF + 128 * j + 32 * q, (bf16*)(ws + WS_WUP + l * WUP_STRIDE), 1024, 32 * nb, nullptr, scr, F.lane); continue; } r -= I_UP;
            { const int kb = r / 32, nb = r % 32; tr_item(inptr(F, I_WDOWN) + (size_t)l * FF * 1024, 1024, 64 * kb, 32 * nb, (bf16*)(ws + WS_WDOWN + l * WDOWN_STRIDE), FF, 32 * nb, nullptr, scr, F.lane); continue; }
        }
        r -= 2 * PER_LAYER;
        if (r < I_DFT) {
            if (r < 128) { const int ro = r >> 6, c = r & 63; bf16* D = (bf16*)(ws + WS_FTAB) + (size_t)r * 128; float v[2];
#pragma unroll
                for (int e = 0; e < 2; ++e) { const int k = 2 * F.lane + e, ri = k >> 6, s = k & 63; const float x = (float)((c * s) & 63) * (1.0f / 32.0f); const float C = cospif(x), S = sinpif(x);
                    v[e] = (ro == ri) ? C : (ro == 0 ? -S : S); }
                *(GAS unsigned*)(D + 2 * F.lane) = pk2(v[0], v[1]); continue; }
            if (r < 160) { const int a = r - 128, ro = F.lane >> 5, rr = F.lane & 31; const float x = (float)((a * rr) & 31) * (1.0f / 16.0f); const float v = ro ? -sinpif(x) : cospif(x);
                *(GAS unsigned short*)((bf16*)(ws + WS_FTAB + 32768) + (size_t)a * 64 + F.lane) = (unsigned short)(pk2(v, 0.f) & 0xffffu); continue; }
            if (r >= 224) { const int rr = r - 224, kb = rr >> 4, col = rr & 15, ri = col >> 3, k2 = 8 * kb + (col & 7);
                const float x = (float)((k2 * F.lane) & 63) * (1.0f / 32.0f); const float v = ri ? sinpif(x) : cospif(x);
                *(GAS unsigned short*)((bf16*)(ws + WS_FTAB + 65536) + (size_t)rr * 64 + F.lane) = (unsigned short)(pk2(v, 0.f) & 0xffffu); continue; }
            { const int c = r - 160; if (F.lane < 32) { const float x = (float)(c * F.lane) * (1.0f / 1024.0f); pg8::f32x2 t; t.x = cospif(x); t.y = sinpif(x);
                *(GAS pg8::f32x2*)((float*)(ws + WS_FTAB + 40960) + (size_t)(c * 32 + F.lane) * 2) = t; } }
            continue; }
        r -= I_DFT;
        if (r >= I_DFTC) { r -= I_DFTC;
            const int sn = r >> 8, g = (r >> 6) & 3, k2 = r & 63; float v[4];
#pragma unroll
            for (int e = 0; e < 4; ++e) { const int j = 4 * F.lane + e; const float x = (float)((k2 * (j & 63)) & 63) * (1.0f / 32.0f); v[e] = ((j >> 6) == g) ? (sn ? sinpif(x) : cospif(x)) : 0.0f; }
            v2u o; o.x = pk2(v[0], v[1]); o.y = pk2(v[2], v[3]); *(GAS v2u*)((bf16*)(ws + WS_CST) + (size_t)r * 256 + 4 * F.lane) = o; continue; }
        { const int k1 = r; bf16* D = (bf16*)(ws + WS_DFTC) + (size_t)k1 * 512; const int n0 = 8 * F.lane; float v[8];
#pragma unroll
            for (int e = 0; e < 8; ++e) { const int n = n0 + e, n1 = n & 255; const float x = (float)((k1 * n1) & 255) * (1.0f / 128.0f); v[e] = (n < 256) ? cospif(x) : -sinpif(x); }
            v4u o; o.x = pk2(v[0], v[1]); o.y = pk2(v[2], v[3]); o.z = pk2(v[4], v[5]); o.w = pk2(v[6], v[7]); *(GAS v4u*)(D + n0) = o; }
    }
}

__device__ __forceinline__ void bias_section(Frame& F, const bf16* WT, int nrows, const float* mod, int shofs, float* out, int gw, int NGW) {
    constexpr int RS = 2064, LO = 16 * RS;
    LAS unsigned char* SH = F.lds;
    __syncthreads();
    for (int i = F.tid; i < 16 * 256; i += NWAVES * 64) { const int bb = i >> 8, k4 = i & 255;
        f32x4 v = (f32x4){0.f, 0.f, 0.f, 0.f}; if (bb < 9) v = *(const GAS f32x4*)(mod + bb * 6144 + shofs + 4 * k4);
        const unsigned h0 = f2bf(v[0]), h1 = f2bf(v[1]), h2 = f2bf(v[2]), h3 = f2bf(v[3]);
        v2u hv, lv; hv.x = h0 | (h1 << 16); hv.y = h2 | (h3 << 16); lv.x = pk2(v[0] - bf2f(h0), v[1] - bf2f(h1)); lv.y = pk2(v[2] - bf2f(h2), v[3] - bf2f(h3));
        *(LAS v2u*)(SH + bb * RS + 8 * k4) = hv; *(LAS v2u*)(SH + LO + bb * RS + 8 * k4) = lv; }
    __syncthreads();
    const int l15 = F.lane & 15, lq = F.lane >> 4;
    const LAS unsigned char* shp = SH + l15 * RS + 16 * lq;
    for (int ps = gw; ps < (nrows >> 4); ps += NGW) { const int n0 = 16 * ps;
        f32x4 d = (f32x4){0.f, 0.f, 0.f, 0.f};
        const bf16* wrow = WT + (size_t)(n0 + l15) * 1024 + 8 * lq;
#pragma unroll 1
        for (int kb = 0; kb < 4; ++kb) { pg8::bf16x8 wv[8];
#pragma unroll
            for (int j = 0; j < 8; ++j) wv[j] = *(const GAS pg8::bf16x8*)(wrow + 32 * (8 * kb + j));
#pragma unroll
            for (int j = 0; j < 8; ++j) { const int ks = 8 * kb + j;
                const pg8::bf16x8 sh = *(const LAS pg8::bf16x8*)(shp + 64 * ks), sl = *(const LAS pg8::bf16x8*)(shp + LO + 64 * ks);
                d = __builtin_amdgcn_mfma_f32_16x16x32_bf16(wv[j], sh, d, 0, 0, 0); d = __builtin_amdgcn_mfma_f32_16x16x32_bf16(wv[j], sl, d, 0, 0, 0); } }
        if (l15 < 9) {
#pragma unroll
            for (int i = 0; i < 4; ++i) out[(size_t)l15 * nrows + n0 + 4 * lq + i] = d[i]; }
    }
    __syncthreads();
}
__device__ __forceinline__ void bias_phase(Frame& F, int which, int gw, int NGW) {
    const float* MODp = (const float*)(F.ws + WS_MOD);
    if (which & 1) bias_section(F, (const bf16*)(F.ws + WS_WIN + WIN_STRIDE), NWIN, MODp + 9 * 6144, 0, (float*)(F.ws + WS_PB) + 9 * NWIN, gw, NGW);
    if (which & 2) bias_section(F, (const bf16*)(F.ws + WS_WUP), 5632, MODp, 3072, (float*)(F.ws + WS_UB), gw, NGW);
    if (which & 4) bias_section(F, (const bf16*)(F.ws + WS_WUP + WUP_STRIDE), 5632, MODp + 9 * 6144, 3072, (float*)(F.ws + WS_UB) + (size_t)9 * 5632, gw, NGW);
}

__device__ __forceinline__ void norm_mod_phase(Frame& F, const float* src_lat, const float* src_ctx, int nrows, const float* g, const float* mod  , int shofs, int scofs, int skip) {
    bf16* XN = (bf16*)(F.ws + WS_XN);
    if (F.bx < skip) return;
    const int gw = (F.bx - skip) * NWAVES + F.wave, NGW = (F.G - skip) * NWAVES;
    constexpr int R = 2;
    f32x4 v[R][4], w[R][4];
#define NM_LOAD(dst, r0_) do { _Pragma("unroll") for (int q = 0; q < R; ++q) { const int row = (r0_) + q * NGW; if (row < nrows) { const float* xr = row < MLAT ? src_lat + (size_t)row * DM : src_ctx + (size_t)(row - MLAT) * DM; \
        _Pragma("unroll") for (int j = 0; j < 4; ++j) dst[q][j] = *(const f32x4*)(xr + 256 * j + 4 * F.lane); } } } while (0)
    NM_LOAD(v, gw);
    for (int row0 = gw; row0 < nrows; row0 += R * NGW) {
        NM_LOAD(w, row0 + R * NGW);
#pragma unroll
        for (int q = 0; q < R; ++q) { const int row = row0 + q * NGW; if (row < nrows) {
            const int r = row < MLAT ? (row >> 11) : 8;
            const float* sh = mod + r * 6144 + shofs; const float* sc = mod + r * 6144 + scofs; float ss = 0.f;
#pragma unroll
            for (int j = 0; j < 4; ++j) ss += (v[q][j][0] * v[q][j][0] + v[q][j][1] * v[q][j][1]) + (v[q][j][2] * v[q][j][2] + v[q][j][3] * v[q][j][3]);
            const float rstd = 1.0f / sqrtf(wave_sum(ss) * (1.0f / DM) + EPS);
#pragma unroll
            for (int j = 0; j < 4; ++j) { const int c = 256 * j + 4 * F.lane; const f32x4 gg = *(const f32x4*)(g + c), s1 = *(const f32x4*)(sc + c), s0 = *(const f32x4*)(sh + c);
                const f32x4 h = (v[q][j] * rstd) * gg * (s1 + 1.0f) + s0;
                v2u o; o.x = pk2(h[0], h[1]); o.y = pk2(h[2], h[3]); *(GAS v2u*)(XN + (size_t)row * DM + c) = o; } } }
#pragma unroll
        for (int q = 0; q < R; ++q)
#pragma unroll
            for (int j = 0; j < 4; ++j) v[q][j] = w[q][j];
    }
#undef NM_LOAD
}
__device__ __forceinline__ void qkv_rows_phase(Frame& F, int l) {
    const bf16* P = (const bf16*)(F.ws + WS_P); bf16* Kb = (bf16*)(F.ws + WS_K); bf16* YC = (bf16*)F.out + (size_t)MT * 768;
    const float* RC = (const float*)(F.ws + WS_ROPE); const float* RS = RC + 1024;
    const float* scw = inptr(F, I_SCW) + l * 3 * 256; const float* scb = inptr(F, I_SCB) + l * 256;
    const int gw = F.vcu * NWAVES + F.wave, NGW = F.G * NWAVES;
    const int nrows_conv = (l == 0) ? MT : MLAT;
    for (int row = gw; row < MT; row += NGW) {
        const bool lat = row < MLAT; const int t = lat ? (row & 2047) : ((row - MLAT) & 255); const int L = lat ? SL : CL;
        const bf16* pr = P + (size_t)row * NIN;
        { const float v = bf2f(pr[640 + F.lane]); const float pv = __shfl_xor(v, 16); float o = v;
          if (lat) { const int j = F.lane, ax = j >> 5, i = j & 15, x2 = (j >> 4) & 1; const int pos = ax ? (t & 63) : (t >> 6); const float c = RC[pos * 16 + i], s = RS[pos * 16 + i];
              o = x2 ? (pv * s + v * c) : (v * c - pv * s); }
          const bf16 ob = (bf16)f2bf(o);
          const int slot = (F.lane & 32) + rope_slot(F.lane & 31);
#pragma unroll
          for (int h = 0; h < 4; ++h) Kb[(size_t)row * 768 + 192 * h + 128 + slot] = ob; }
        if (row < nrows_conv) { const int c = 4 * F.lane;
            const v2u bgv = *(const GAS v2u*)(pr + 1280 + c);
            const v2u cg1 = *(const GAS v2u*)(pr + 1536 + c), xv1 = *(const GAS v2u*)(pr + 1792 + c);
            v2u cg0 = {0u, 0u}, xv0 = {0u, 0u}, cg2 = {0u, 0u}, xv2 = {0u, 0u};
            if (t > 0) { cg0 = *(const GAS v2u*)(pr - NIN + 1536 + c); xv0 = *(const GAS v2u*)(pr - NIN + 1792 + c); }
            if (t < L - 1) { cg2 = *(const GAS v2u*)(pr + NIN + 1536 + c); xv2 = *(const GAS v2u*)(pr + NIN + 1792 + c); }
            const f32x4 w0 = *(const f32x4*)(scw + c), w1 = *(const f32x4*)(scw + 256 + c), w2 = *(const f32x4*)(scw + 512 + c), bb = *(const f32x4*)(scb + c);
            float y[4];
#pragma unroll
            for (int e = 0; e < 4; ++e) { const unsigned sh = (e & 1) * 16; const unsigned m = 0xffffu;
                const unsigned b_ = ((e < 2 ? bgv.x : bgv.y) >> sh) & m;
                const unsigned c0_ = ((e < 2 ? cg0.x : cg0.y) >> sh) & m, x0_ = ((e < 2 ? xv0.x : xv0.y) >> sh) & m;
                const unsigned c1_ = ((e < 2 ? cg1.x : cg1.y) >> sh) & m, x1_ = ((e < 2 ? xv1.x : xv1.y) >> sh) & m;
                const unsigned c2_ = ((e < 2 ? cg2.x : cg2.y) >> sh) & m, x2_ = ((e < 2 ? xv2.x : xv2.y) >> sh) & m;
                const float u0 = bf2f(c0_) * bf2f(x0_), u1 = bf2f(c1_) * bf2f(x1_), u2 = bf2f(c2_) * bf2f(x2_);
                y[e] = bf2f(b_) * (w0[e] * u0 + w1[e] * u1 + w2[e] * u2 + bb[e]); }
            v2u o; o.x = pk2(y[0], y[1]); o.y = pk2(y[2], y[3]); *(GAS v2u*)(YC + (size_t)row * 256 + c) = o; }
    }
}
__device__ __forceinline__ void fnet_fft_unit(Frame& F, int b, int jb) {
    int tid = threadIdx.x; asm volatile("" : "+v"(tid));
    const int w = tid >> 6, l = tid & 63, l15 = l & 15, lq = l >> 4;
    const bf16* P = (const bf16*)(F.ws + WS_P); bf16* YF = (bf16*)(F.ws + WS_YF);
    const bf16* A1g = (const bf16*)(F.ws + WS_FTAB); const bf16* W2g = (const bf16*)(F.ws + WS_FTAB + 32768); const float* TWg = (const float*)(F.ws + WS_FTAB + 40960);
    LAS unsigned char* B1 = F.lds; LAS unsigned char* A1 = F.lds + 69632; LAS unsigned char* TW = F.lds + 104448;
    {
        const int g = jb >> 3, kb = jb & 7;
        const bf16* CTg = (const bf16*)(F.ws + WS_FTAB + 65536) + kb * 1024;
        const pg8::bf16x8 ct0 = *(const GAS pg8::bf16x8*)(CTg + l15 * 64 + 8 * lq), ct1 = *(const GAS pg8::bf16x8*)(CTg + l15 * 64 + 32 + 8 * lq);
#pragma unroll
        for (int i = 0; i < 4; ++i) { const int idx = tid + 512 * i, row = idx >> 4, ch = idx & 15; const v4u v = *(const GAS v4u*)(A1g + row * 128 + ch * 8); *(LAS v4u*)(A1 + row * 272 + ch * 16) = v; }
#pragma unroll
        for (int i = 0; i < 2; ++i) { const int idx = tid + 512 * i; const v4u v = *(const GAS v4u*)(TWg + idx * 4); *(LAS v4u*)(TW + idx * 16) = v; }
#pragma unroll
        for (int hb = 0; hb < 2; ++hb) {
            pg8::bf16x8 uf[8][2];
#pragma unroll
            for (int q = 0; q < 8; ++q) { const int blk = w * 16 + hb * 8 + q; const bf16* src = P + (size_t)(b * SL + 16 * blk + l15) * NIN + 768 + 64 * g + 8 * lq;
                uf[q][0] = *(const GAS pg8::bf16x8*)src; uf[q][1] = *(const GAS pg8::bf16x8*)(src + 32); }
#pragma unroll
            for (int q = 0; q < 8; ++q) { const int blk = w * 16 + hb * 8 + q;
                f32x4 d = (f32x4){0.f, 0.f, 0.f, 0.f};
                d = __builtin_amdgcn_mfma_f32_16x16x32_bf16(ct0, uf[q][0], d, 0, 0, 0); d = __builtin_amdgcn_mfma_f32_16x16x32_bf16(ct1, uf[q][1], d, 0, 0, 0);
                const int r = 16 * (blk & 1) + l15, s = blk >> 1;
                LAS unsigned char* dst = B1 + (32 * 4 * (lq & 1) + r) * 272 + (64 * (lq >> 1) + s) * 2;
                const unsigned p01 = pk2(d[0], d[1]), p23 = pk2(d[2], d[3]);
                *(LAS unsigned short*)(dst + 0 * 8704) = (unsigned short)(p01 & 0xffffu); *(LAS unsigned short*)(dst + 1 * 8704) = (unsigned short)(p01 >> 16);
                *(LAS unsigned short*)(dst + 2 * 8704) = (unsigned short)(p23 & 0xffffu); *(LAS unsigned short*)(dst + 3 * 8704) = (unsigned short)(p23 >> 16); } } }
    pg8::bf16x8 w2[2][2];
#pragma unroll
    for (int ab = 0; ab < 2; ++ab)
#pragma unroll
        for (int ks = 0; ks < 2; ++ks) w2[ab][ks] = *(const GAS pg8::bf16x8*)(W2g + (ab * 16 + l15) * 64 + ks * 32 + 8 * lq);
    __syncthreads();
    f32x4 acc[8][2];
#pragma unroll
    for (int mb = 0; mb < 8; ++mb) { acc[mb][0] = (f32x4){0.f, 0.f, 0.f, 0.f}; acc[mb][1] = (f32x4){0.f, 0.f, 0.f, 0.f}; }
#pragma unroll
    for (int ks = 0; ks < 4; ++ks) {
        const pg8::bf16x8 b0 = *(const LAS pg8::bf16x8*)(B1 + ((2 * w + 0) * 16 + l15) * 272 + ks * 64 + lq * 16);
        const pg8::bf16x8 b1 = *(const LAS pg8::bf16x8*)(B1 + ((2 * w + 1) * 16 + l15) * 272 + ks * 64 + lq * 16);
#pragma unroll
        for (int mb = 0; mb < 8; ++mb) { const pg8::bf16x8 af = *(const LAS pg8::bf16x8*)(A1 + (mb * 16 + l15) * 272 + ks * 64 + lq * 16);
            acc[mb][0] = __builtin_amdgcn_mfma_f32_16x16x32_bf16(af, b0, acc[mb][0], 0, 0, 0);
            acc[mb][1] = __builtin_amdgcn_mfma_f32_16x16x32_bf16(af, b1, acc[mb][1], 0, 0, 0); } }
    __syncthreads();
    LAS unsigned char* B2 = F.lds;
    {
#pragma unroll
      for (int mbp = 0; mbp < 4; ++mbp)
#pragma unroll
        for (int nbl = 0; nbl < 2; ++nbl) { const int r = 16 * nbl + l15;
#pragma unroll
            for (int i = 0; i < 4; ++i) { const int c = mbp * 16 + 4 * lq + i;
                const pg8::f32x2 t = *(const LAS pg8::f32x2*)(TW + (c * 32 + r) * 8);
                const float ar = acc[mbp][nbl][i], ai = acc[mbp + 4][nbl][i];
                const unsigned pk = pk2(ar * t.x - ai * t.y, ar * t.y + ai * t.x);
                LAS unsigned char* d = B2 + (c * 8 + w) * 144 + 2 * (l15 & 7);
                *(LAS unsigned short*)(d + (((r >> 3) ^ (2 * lq)) * 16)) = (unsigned short)(pk & 0xffffu); *(LAS unsigned short*)(d + (((4 + (r >> 3)) ^ (2 * lq)) * 16)) = (unsigned short)(pk >> 16); } } }
    __syncthreads();
    f32x4 y[4][2];
#pragma unroll
    for (int nbp = 0; nbp < 4; ++nbp) { y[nbp][0] = (f32x4){0.f, 0.f, 0.f, 0.f}; y[nbp][1] = (f32x4){0.f, 0.f, 0.f, 0.f}; }
#pragma unroll
    for (int nbp = 0; nbp < 4; ++nbp) { const int sw = 2 * ((2 * w + (nbp >> 1)) & 3);
#pragma unroll
        for (int ks = 0; ks < 2; ++ks) { const pg8::bf16x8 af = *(const LAS pg8::bf16x8*)(B2 + ((4 * w + nbp) * 16 + l15) * 144 + (((ks * 4 + lq) ^ sw) * 16));
            y[nbp][0] = __builtin_amdgcn_mfma_f32_16x16x32_bf16(af, w2[0][ks], y[nbp][0], 0, 0, 0);
            y[nbp][1] = __builtin_amdgcn_mfma_f32_16x16x32_bf16(af, w2[1][ks], y[nbp][1], 0, 0, 0); } }
    constexpr float SC = 0.0027621358640099515f;
#pragma unroll
    for (int nbp = 0; nbp < 4; ++nbp)
#pragma unroll
        for (int ab = 0; ab < 2; ++ab) { const int c = (4 * w + nbp) * 2 + (lq >> 1), a = ab * 16 + l15, p = 64 * a + c;
            v2u o; o.x = pk2(y[nbp][ab][0] * SC, y[nbp][ab][1] * SC); o.y = pk2(y[nbp][ab][2] * SC, y[nbp][ab][3] * SC);
            *(GAS v2u*)(YF + (size_t)(b * SL + p) * 256 + jb * 8 + 4 * (lq & 1)) = o; }
    __syncthreads();
}
__device__ __forceinline__ void zt_phase(Frame& F, int l) {
    const bf16* P = (const bf16*)(F.ws + WS_P);
    LAS bf16* T = (LAS bf16*)(F.lds + F.wave * 16384);
    const int gw = F.vcu * NWAVES + F.wave, NGW = F.G * NWAVES;
    const int nitems = (l == 0 ? 256 : 0);
    for (int it = gw; it < nitems; it += NGW) {
        const bool lat = false; const int r = it;
        const int pb = r >> 3, cb = r & 7;
        const int row0 = (lat ? 0 : MLAT) + 64 * pb; const int L = lat ? SL : CL;
        const int b = lat ? (pb >> 5) : (pb >> 2); const int n0 = (64 * pb) & (L - 1);
        bf16* ZT = lat ? (bf16*)(F.ws + WS_ZT) : (bf16*)(F.ws + WS_ZTC);
#pragma unroll
        for (int i = 0; i < 8; ++i) { const int pos = 8 * i + (F.lane >> 3), ch = F.lane & 7;
            const v4u v = *(const GAS v4u*)(P + (size_t)(row0 + pos) * NIN + 768 + 64 * cb + 8 * ch);
            LAS unsigned* d = (LAS unsigned*)(T + pos * 66 + 8 * ch); d[0] = v.x; d[1] = v.y; d[2] = v.z; d[3] = v.w; }
        LDS_WAIT(); asm volatile("" ::: "memory");
        const int sn = cb >> 2;
#pragma unroll
        for (int j = 0; j < 8; ++j) { const int chl = 8 * j + (F.lane >> 3), pc = F.lane & 7;
            unsigned e[8];
#pragma unroll
            for (int q = 0; q < 8; ++q) e[q] = T[(8 * pc + q) * 66 + chl];
            v4u o; o.x = e[0] | (e[1] << 16); o.y = e[2] | (e[3] << 16); o.z = e[4] | (e[5] << 16); o.w = e[6] | (e[7] << 16);
            const int chg = 64 * (cb & 3) + chl;
            *(GAS v4u*)(ZT + ((size_t)(b * 256 + chg) * 2 + sn) * L + n0 + 8 * pc) = o; }
        LDS_WAIT(); asm volatile("" ::: "memory");
    }
}
__device__ __forceinline__ void ycat_norm_phase(Frame& F, int nrows) {
    bf16* Y = (bf16*)(F.ws + WS_YCAT); const bf16* YC = (const bf16*)F.out + (size_t)MT * 768; const bf16* YF = (const bf16*)(F.ws + WS_YF); const bf16* AT = (const bf16*)((const char*)F.out + OUT_ATT);
    const int gw = F.vcu * NWAVES + F.wave, NGW = F.G * NWAVES;
    constexpr int R = 2;
    for (int row0 = gw; row0 < nrows; row0 += R * NGW) {
        v4u a[R]; v2u c[R]; v2u f[R];
#pragma unroll
        for (int q = 0; q < R; ++q) { const int row = row0 + q * NGW; if (row < nrows) { a[q] = *(const GAS v4u*)(AT + (size_t)row * 512 + 8 * F.lane); c[q] = *(const GAS v2u*)(YC + (size_t)row * 256 + 4 * F.lane);
            f[q] = *(const GAS v2u*)(YF + (size_t)row * 256 + 4 * F.lane); } }
#pragma unroll
        for (int q = 0; q < R; ++q) { const int row = row0 + q * NGW; if (row < nrows) { bf16* yr = Y + (size_t)row * 1024;
            float av[8], fv[4], cv[4];
            fv[0] = bf2f(f[q].x & 0xffffu); fv[1] = bf2f(f[q].x >> 16); fv[2] = bf2f(f[q].y & 0xffffu); fv[3] = bf2f(f[q].y >> 16);
            av[0] = bf2f(a[q].x & 0xffffu); av[1] = bf2f(a[q].x >> 16); av[2] = bf2f(a[q].y & 0xffffu); av[3] = bf2f(a[q].y >> 16); av[4] = bf2f(a[q].z & 0xffffu); av[5] = bf2f(a[q].z >> 16); av[6] = bf2f(a[q].w & 0xffffu); av[7] = bf2f(a[q].w >> 16);
            cv[0] = bf2f(c[q].x & 0xffffu); cv[1] = bf2f(c[q].x >> 16); cv[2] = bf2f(c[q].y & 0xffffu); cv[3] = bf2f(c[q].y >> 16);
            float sa = 0.f, sf = 0.f, sc = 0.f;
#pragma unroll
            for (int e = 0; e < 8; ++e) sa += av[e] * av[e];
#pragma unroll
            for (int e = 0; e < 4; ++e) { sf += fv[e] * fv[e]; sc += cv[e] * cv[e]; }
            const float ra = 1.0f / sqrtf(wave_sum(sa) * (1.0f / 512.0f) + EPS), rf = 1.0f / sqrtf(wave_sum(sf) * (1.0f / 256.0f) + EPS), rc = 1.0f / sqrtf(wave_sum(sc) * (1.0f / 256.0f) + EPS);
            v4u oa; oa.x = pk2(av[0] * ra, av[1] * ra); oa.y = pk2(av[2] * ra, av[3] * ra); oa.z = pk2(av[4] * ra, av[5] * ra); oa.w = pk2(av[6] * ra, av[7] * ra);
            v2u of; of.x = pk2(fv[0] * rf, fv[1] * rf); of.y = pk2(fv[2] * rf, fv[3] * rf);
            v2u oc; oc.x = pk2(cv[0] * rc, cv[1] * rc); oc.y = pk2(cv[2] * rc, cv[3] * rc);
            *(GAS v4u*)(yr + 8 * F.lane) = oa; *(GAS v2u*)(yr + 512 + 4 * F.lane) = of; *(GAS v2u*)(yr + 768 + 4 * F.lane) = oc; } }
    }
}
__device__ __forceinline__ void ctx_combine_phase(Frame& F, const float* base, const float* gp_g, int gp_ofs, int gate_ofs, const float* gn_g, const float* gn_mod, int gn_ofs, int nsl) {
    const bf16* PART = (const bf16*)(F.ws + WS_CPART); bf16* XNp = (bf16*)(F.ws + WS_XN); float* SSXp = (float*)(F.ws + WS_SSX);
    const float* mod0 = (const float*)(F.ws + WS_MOD) + 8 * 6144;
    const int gw = F.vcu * NWAVES + F.wave, NGW = F.G * NWAVES;
    for (int row = gw; row < MCTX; row += NGW) {
        float ss = 0.f; bf16* xr = XNp + (size_t)(MLAT + row) * DM;
#pragma unroll
        for (int j = 0; j < 4; ++j) { const int c = 256 * j + 4 * F.lane; f32x4 x;
            if (base != nullptr) x = *(const f32x4*)(base + (size_t)row * DM + c);
            else { const v2u xw = *(const GAS v2u*)(xr + c); x[0] = bf2f(xw.x & 0xffffu); x[1] = bf2f(xw.x >> 16); x[2] = bf2f(xw.y & 0xffffu); x[3] = bf2f(xw.y >> 16);
                const f32x4 gp = *(const f32x4*)(gp_g + c) * (*(const f32x4*)(mod0 + gp_ofs + c) + 1.0f);
                x[0] = x[0] / gp[0]; x[1] = x[1] / gp[1]; x[2] = x[2] / gp[2]; x[3] = x[3] / gp[3]; }
            f32x4 s = {0.f, 0.f, 0.f, 0.f};
            for (int k = 0; k < nsl; ++k) { const v2u pw = *(const GAS v2u*)(PART + ((size_t)k * MCTX + row) * DM + c); s[0] += bf2f(pw.x & 0xffffu); s[1] += bf2f(pw.x >> 16); s[2] += bf2f(pw.y & 0xffffu); s[3] += bf2f(pw.y >> 16); }
            x = x + *(const f32x4*)(mod0 + gate_ofs + c) * s;
            ss += (x[0] * x[0] + x[1] * x[1]) + (x[2] * x[2] + x[3] * x[3]);
            const f32x4 h = x * (*(const f32x4*)(gn_g + c)) * (*(const f32x4*)(gn_mod + gn_ofs + c) + 1.0f);
            v2u ho; ho.x = pk2(h[0], h[1]); ho.y = pk2(h[2], h[3]); *(GAS v2u*)(xr + c) = ho; }
        ss = wave_sum(ss);
        if (F.lane < 16) SSXp[(size_t)(MLAT + row) * 16 + F.lane] = F.lane == 0 ? ss : 0.f;
    }
}
__device__ __forceinline__ void final_norm_phase(Frame& F, const bf16* xf, const float* g) {
    const int gw = F.vcu * NWAVES + F.wave, NGW = F.G * NWAVES;
    constexpr int R = 2;
    v2u w[R][4], wn[R][4];
#define FN_LOAD(W_, r0_) do { _Pragma("unroll") for (int q = 0; q < R; ++q) { const int row = (r0_) + q * NGW; if (row < MLAT) { \
        _Pragma("unroll") for (int j = 0; j < 4; ++j) W_[q][j] = *(const GAS v2u*)(xf + (size_t)row * DM + 256 * j + 4 * F.lane); } } } while (0)
    FN_LOAD(w, gw);
    for (int row0 = gw; row0 < MLAT; row0 += R * NGW) {
        FN_LOAD(wn, row0 + R * NGW);
#pragma unroll
        for (int q = 0; q < R; ++q) { const int row = row0 + q * NGW; if (row < MLAT) { float* orow = F.out + (size_t)row * DM;
            f32x4 v[4]; float ss = 0.f;
#pragma unroll
            for (int j = 0; j < 4; ++j) { v[j][0] = bf2f(w[q][j].x & 0xffffu); v[j][1] = bf2f(w[q][j].x >> 16); v[j][2] = bf2f(w[q][j].y & 0xffffu); v[j][3] = bf2f(w[q][j].y >> 16);
                ss += (v[j][0] * v[j][0] + v[j][1] * v[j][1]) + (v[j][2] * v[j][2] + v[j][3] * v[j][3]); }
            const float rstd = 1.0f / sqrtf(wave_sum(ss) * (1.0f / DM) + EPS);
#pragma unroll
            for (int j = 0; j < 4; ++j) { const int c = 256 * j + 4 * F.lane; const f32x4 gg = *(const f32x4*)(g + c); *(f32x4*)(orow + c) = (v[j] * rstd) * gg; } } }
#pragma unroll
        for (int q = 0; q < R; ++q)
#pragma unroll
            for (int j = 0; j < 4; ++j) w[q][j] = wn[q][j];
    }
#undef FN_LOAD
}
#ifndef PHMASK
#define PHMASK 0xFFFF
#endif
#define PHON(x) (((PHMASK) >> (x)) & 1)
#ifndef SUBMASK
#define SUBMASK 0xFF
#endif
#define SUBON(x) (rep_ == 0 || (((SUBMASK) >> (x)) & 1))
struct UpOrder : pg8::StaticOrder {
    typedef pg8::UnitUp UnitT; int nrows;
    __device__ __forceinline__ bool next(int i, pg8::UnitUp& u) const {
        if (!next_mn(i, u.pm, u.pn)) return false;
        u.kofs = 0; u.kofb = 0; u.nt = ntk; u.arow = 254 * u.pm - 1; u.nrows = nrows;
        return true;
    }
};

struct SliceOrder0 : pg8::StaticOrder {
    typedef pg8::Unit UnitT; int nsl;
    __device__ __forceinline__ bool next(int i, pg8::Unit& u) const {
        if (i == 0) { if (!next_mn(0, u.pm, u.pn)) return false; u.arow = u.pm * 256; u.kofs = 0; u.kofb = 0; u.nt = ntk; u.aux = 0; return true; }
        const int L = (i - 1) * G + c; if (L >= 32 * nsl) return false;
        const int t = L / nsl, s = L % nsl; u.pm = 64 + (t >> 2); u.pn = t & 3; u.arow = u.pm * 256; u.aux = s;
        if (nsl == 8) { u.kofs = (s < 6 ? 6 * s : 36 + 4 * (s - 6)) * 64; u.nt = s < 6 ? 6 : 4; } else { u.kofs = s * 256; u.nt = 4; }
        u.kofb = u.kofs; return true;
    }
};

struct QkvOrder {
    typedef pg8::Unit UnitT; int G, c, nq;
    __device__ __forceinline__ bool next(int i, pg8::Unit& u) const { const int L = i * G + c; if (L >= 288 + nq) return false;
        if (L < 288) { u.pm = L >> 2; u.pn = 3 + (L & 3); u.kofs = 384; u.nt = 4; } else { const int j = L - 288; u.pm = j / 3; u.pn = j % 3; u.kofs = 0; u.nt = 6; }
        u.kofb = 0; u.arow = u.pm * 256; return true; }
};

struct WinOrder {
    typedef pg8::Unit UnitT; pg8::StaticOrder S; int G, c, l;
    __device__ __forceinline__ void init(int G_, int c_, int l_) { S.init(64, 7, G_, c_, 1024); G = G_; c = c_; l = l_; }
    __device__ __forceinline__ bool next(int i, pg8::Unit& u) const {
        int pm, pn;
        if (S.next_mn(i, pm, pn)) { u.pm = pm; u.pn = pn < 3 ? pn : (pn == 3 ? 8 : pn + 1); }
        else { const long L = (long)i * G + c - 448; const int nctx = (l == 0) ? 64 : 16; if (L < 0 || L >= nctx) return false;
            if (l == 0) { u.pm = 64 + (int)(L >> 3); u.pn = (int)(L & 7); } else { u.pm = 64 + (int)(L >> 1); u.pn = 1 + (int)(L & 1); } }
        u.arow = u.pm * 256; u.kofs = 0; u.kofb = 0; u.nt = 16; u.aux = 0; return true; }
};
struct FnetOrder {
    typedef pg8::Unit UnitT; int G, c;
    __device__ __forceinline__ bool next(int i, pg8::Unit& u) const { const int L = i * G + c; if (L >= 256) return false;
        u.pm = (L >> 3) & 7; u.pn = L & 7; u.arow = u.pm * 256; u.kofs = (L >> 6) * 1024; u.kofb = u.kofs; u.nt = 16; return true; }
};

__global__ void __launch_bounds__(NWAVES * 64, 2) mk_fwd(Args args) {
    extern __shared__ __attribute__((aligned(16))) unsigned char lds[];
    Frame F;
    F.lds = (LAS unsigned char*)lds; F.ldsg = (char*)lds;
    F.MISC = (volatile LAS unsigned*)(F.lds + MISC_OFF);
    F.tid = threadIdx.x; F.lane = F.tid & 63; F.wave = __builtin_amdgcn_readfirstlane(F.tid >> 6);
    F.G = gridDim.x; F.bx = blockIdx.x; F.vcu = (F.G % 8 == 0) ? (F.bx % 8) * (F.G / 8) + F.bx / 8 : F.bx;
    F.ws = args.ws; F.out = args.out;
    for (int u = F.tid; u < (LDS_BYTES - LDSCTL_OFF) / 4; u += NWAVES * 64) ((LAS unsigned*)(F.lds + LDSCTL_OFF))[u] = 0u;
    __syncthreads();
    if (F.tid == 0) { LAS unsigned long long* T = (LAS unsigned long long*)(F.lds + PTR_OFF);
#pragma unroll
        for (int i = 0; i < 22; ++i) T[i] = (unsigned long long)args.in[i]; }
    __syncthreads();
    XcdBarrier bar; bar.bar = (unsigned*)(F.ws + WS_CTL) + CW_BAR; bar.x = 0; bar.st = nullptr;
    if (!MK_SPLIT) bar = xcd_barrier_post((unsigned*)(F.ws + WS_CTL) + CW_BAR, F.MISC + 8);

#define MOD ((float*)(ws + WS_MOD))
#define SSQ ((float*)(ws + WS_SSQ))
#define XN ((bf16*)(ws + WS_XN))
#define P ((bf16*)(ws + WS_P))
#define Qb ((bf16*)F.out)
#define Kb ((bf16*)(ws + WS_K))
#define Vb ((bf16*)(ws + WS_V))
#define YCAT ((bf16*)(ws + WS_YCAT))
#define ATTO ((bf16*)((char*)F.out + OUT_ATT))
#define ACT ((bf16*)(ws + WS_ACT))
#define XCTX ((bf16*)(ws + WS_XCTX))
#define XBL ((bf16*)F.out + (size_t)MLAT * DM)
#define XFIN ((bf16*)(ws + WS_XN))
    LAS unsigned char* ring = F.lds + RING_OFF;

    const int ph_lo = args.ph_lo, ph_hi = args.ph_hi;
#ifndef FFT_RPT
#define FFT_RPT 1
#endif
#ifndef FILL_RPT
#define FILL_RPT 1
#endif
#define PHASE(k) (ph_lo <= (k) && (k) < ph_hi)
#define SEAM(k) do { if (PHASE(k) && PHASE((k) + 1)) xcd_barrier(bar); } while (0)
#ifndef P0SUB
#define P0SUB 0xFF
#endif
#ifndef UPPROBE
#define UPPROBE 0
#endif
#ifndef RPT_PH
#define RPT_PH -1
#endif
#define RELANE() do { int t_ = threadIdx.x; asm volatile("" : "+v"(t_)); F.tid = t_; F.lane = t_ & 63; F.wave = __builtin_amdgcn_readfirstlane(t_ >> 6); } while (0)
    unsigned char* ws = F.ws;
    if (PHASE(0)) for (int rep_ = 0; rep_ < (((0) == RPT_PH) ? 2 : 1); ++rep_) { if (rep_) xcd_barrier(bar); RELANE(); if (PHON(0)) p0_prologue(F, rep_ ? P0SUB : 0xFF, 0, F.vcu * NWAVES + F.wave, F.G * NWAVES); }
    SEAM(0);
    for (int l = 0; l < 2; ++l) {
        const int pb = 1 + 9 * l;
        const int nMall = (l == 0) ? 72 : 64;
        if (PHASE(pb + 0)) for (int rep_ = 0; rep_ < (((pb + 0) == RPT_PH) ? 2 : 1); ++rep_) { if (rep_) xcd_barrier(bar); RELANE();
            if (l == 0 && (rep_ == 0 || (SUBMASK & 1))) { pg8::Gemm g{(const bf16*)(ws + WS_CST), (const bf16*)(ws + WS_WF), 2, 8, 256, 256}; pg8::StaticOrder S; S.init(2, 8, F.G, F.bx, 256);
                pg8::EpiFold E{(bf16*)(ws + WS_WIN), (unsigned)(WIN_STRIDE / 2)};
                pg8::gemm_phase(ring, g, S, E); RELANE(); }
            if (PHON(1) && l == 0 && (rep_ == 0 || (SUBMASK & 2))) norm_mod_phase(F, inptr(F, I_X), inptr(F, I_CTX), MT, inptr(F, I_N1G), MOD, 0, 1024, 16); }
        if (l == 0) SEAM(pb + 0);
        if (PHASE(pb + 1)) for (int rep_ = 0; rep_ < (((pb + 1) == RPT_PH) ? 2 : 1); ++rep_) { if (rep_) xcd_barrier(bar); RELANE();
            if (PHON(2)) { pg8::Gemm g{XN, (const bf16*)(ws + WS_WIN + l * WIN_STRIDE), 72, 9, 1024, 1024}; WinOrder S; S.init(F.G, F.bx, l);
                pg8::EpiWin E{P, NIN, SSQ, l == 1 ? (const float*)(ws + WS_SSX) : nullptr, (const float*)(ws + WS_PB) + 9 * NWIN, (LAS float*)(F.lds + EPIX_OFF)};
                pg8::gemm_phase(ring, g, S, E);
                if (rep_ == 0 && l == 1) {
                    RELANE(); int nb = 464 - F.G; nb = nb < 0 ? 0 : (nb > F.G ? F.G : nb);
                    const bool all = (nb == F.G); if (all || F.bx >= nb) { const int rk = all ? F.bx : F.bx - nb, n = all ? F.G : F.G - nb;
                        bias_phase(F, 4, rk * NWAVES + F.wave, n * NWAVES); } } } }
        SEAM(pb + 1);
        if (PHASE(pb + 2)) for (int rep_ = 0; rep_ < (((pb + 2) == RPT_PH) ? 2 : 1); ++rep_) { if (rep_) xcd_barrier(bar); RELANE();
            if (PHON(3)) {
                if (SUBON(0)) { pg8::Gemm g{P, (const bf16*)(ws + WS_WQKV + l * WQKV_STRIDE), 72, 7, 384, NIN}; QkvOrder S; S.G = F.G; S.c = F.vcu; S.nq = 3 * nMall;
                  pg8::EpiQKV E{Qb, Kb, Vb, SSQ, (const float*)(ws + WS_ROPE), (const float*)(ws + WS_ROPE) + 1024, (LAS float*)(F.lds + EPIX_OFF)};
                  pg8::gemm_phase(ring, g, S, E); }
                if (SUBON(2)) qkv_rows_phase(F, l);
                if (SUBON(3)) zt_phase(F, l);
                } }
        SEAM(pb + 2);
        if (PHASE(pb + 3)) for (int rep_ = 0; rep_ < (((pb + 3) == RPT_PH) ? 2 : 1); ++rep_) { if (rep_) xcd_barrier(bar); RELANE();
            if (PHON(4)) {
                const int NU = 256 + (l == 0 ? 32 : 0);
                for (int u = F.vcu; u < NU; u += F.G) {
                    if (u < 256) { const int bh = u >> 3, qb = u & 7, b = bh >> 2, h = bh & 3; const long q0 = (long)b * SL + qb * 256;
                        att::attn_unit(Qb + q0 * 768 + 192 * h, Kb + 192 * h, Vb + 128 * h, ATTO + q0 * 512 + 128 * h, MLAT + CL * b, 4, SL * b, 36, F.ldsg);
                    } else { const int cu = u - 256, b = cu >> 2, h = cu & 3; const long q0 = MLAT + (long)CL * b;
                        att::attn_unit(Qb + q0 * 768 + 192 * h, Kb + 192 * h, Vb + 128 * h, ATTO + q0 * 512 + 128 * h, (int)q0, 4, 0, 4, F.ldsg); }
                }
                RELANE(); for (int rp_ = 0; rp_ < FFT_RPT; ++rp_) for (int u = F.vcu; u < 256; u += F.G) fnet_fft_unit(F, u >> 5, u & 31);
                RELANE();
                if (l == 0) { pg8::Gemm g{(const bf16*)(ws + WS_DFTC), (const bf16*)(ws + WS_ZTC), 1, 8, 512, 512}; pg8::StaticOrder S; S.init(1, 8, F.G, (F.bx + 128) % F.G, 512);
                  pg8::EpiFnet E{(bf16*)(ws + WS_YF), MLAT, CL, 0.0078125f, (unsigned)(MT * 256)};
                  pg8::gemm_phase(ring, g, S, E); }
                if (l == 0 && rep_ == 0) {
                    RELANE(); const bool all = F.G <= 32; if (all || F.vcu >= 32) { const int rk = all ? F.vcu : F.vcu - 32, n = all ? F.G : F.G - 32;
                        for (int fr_ = 0; fr_ < FILL_RPT; ++fr_) { p0_prologue(F, 0xFF, 1, rk * NWAVES + F.wave, n * NWAVES); bias_phase(F, 1, rk * NWAVES + F.wave, n * NWAVES); } } } } }
        SEAM(pb + 3);
        if (PHASE(pb + 4)) for (int rep_ = 0; rep_ < (((pb + 4) == RPT_PH) ? 2 : 1); ++rep_) { if (rep_) xcd_barrier(bar); RELANE();
            if (PHON(5)) ycat_norm_phase(F, nMall * 256); }
        SEAM(pb + 4);
        if (PHASE(pb + 5)) for (int rep_ = 0; rep_ < (((pb + 5) == RPT_PH) ? 2 : 1); ++rep_) { if (rep_) xcd_barrier(bar); RELANE();
            if (PHON(6)) { pg8::Gemm g{YCAT, (const bf16*)(ws + WS_WOUT + l * WOUT_STRIDE), nMall, 4, 1024, 1024}; pg8::StaticOrder S; S.init(nMall, 4, F.G, F.bx, 1024);
                if (l == 0) { SliceOrder0 S0; S0.init(64, 4, F.G, F.bx, 1024); S0.nsl = 4; pg8::Gemm g0{YCAT, (const bf16*)(ws + WS_WOUT), 64, 4, 1024, 1024};
                    pg8::EpiRes<true> E{inptr(F, I_X), inptr(F, I_CTX), XN, MOD, 2048, nullptr, nullptr, 0, inptr(F, I_N2G), MOD, 4096, (float*)(ws + WS_SSX), rep_ ? 0.f : 1.f, (bf16*)(ws + WS_CPART)};
                    pg8::gemm_phase(ring, g0, S0, E);
                    RELANE(); { int nb = 128; nb = nb > F.G ? F.G : nb; const bool all = (nb == F.G); if (rep_ == 0 && (all || F.bx >= nb)) { const int rk = all ? F.bx : F.bx - nb, n = all ? F.G : F.G - nb; bias_phase(F, 2, rk * NWAVES + F.wave, n * NWAVES); } }
                    xcd_barrier(bar); RELANE();
                    ctx_combine_phase(F, inptr(F, I_CTX), nullptr, 0, 2048, inptr(F, I_N2G), MOD + 8 * 6144, 4096, 4); }
                else { pg8::EpiRes<false> E{nullptr, nullptr, XN, MOD + (size_t)9 * 6144, 2048, inptr(F, I_N1G) + DM, MOD + (size_t)9 * 6144, 1024, inptr(F, I_N2G) + DM, MOD + (size_t)9 * 6144, 4096, (float*)(ws + WS_SSX), rep_ ? 0.f : 1.f, nullptr};
                    pg8::gemm_phase(ring, g, S, E); } } }
        SEAM(pb + 5);
        if (PHASE(pb + 6)) for (int rep_ = 0; rep_ < (((pb + 6) == RPT_PH) ? 2 : 1); ++rep_) { if (rep_) xcd_barrier(bar); RELANE();
            }
        if (PHASE(pb + 7)) for (int rep_ = 0; rep_ < (((pb + 7) == RPT_PH) ? 2 : 1); ++rep_) { if (rep_) xcd_barrier(bar); RELANE();
            if (PHON(8)) { const int nrows = (l == 0) ? MT : MLAT; const int nM = (nrows + 253) / 254;
                pg8::Gemm g{XN, (const bf16*)(ws + WS_WUP + l * WUP_STRIDE), nM, 22, 1024, 1024}; UpOrder S; S.init(nM, 22, F.G, F.bx, 1024); S.nrows = nrows;
                pg8::EpiUp E{ACT, inptr(F, I_FCW) + (size_t)l * 3 * FF, inptr(F, I_FCB) + (size_t)l * FF, (LAS float*)(F.lds + EPIX_OFF), (const float*)(ws + WS_SSX), (const float*)(ws + WS_UB) + (size_t)l * 9 * 5632};
                pg8::gemm_phase(ring, g, S, E);
                if (l == 0 && rep_ == 0) {
                    RELANE(); int nb = nM * 22 - 6 * F.G; nb = nb < 0 ? 0 : (nb > F.G ? F.G : nb);
                    const bool all = (nb == F.G); if (all || F.bx >= nb) { const int rk = all ? F.bx : F.bx - nb, n = all ? F.G : F.G - nb; p0_prologue(F, 0xFF, 2, rk * NWAVES + F.wave, n * NWAVES); } } } }
        SEAM(pb + 7);
        if (PHASE(pb + 8)) for (int rep_ = 0; rep_ < (((pb + 8) == RPT_PH) ? 2 : 1); ++rep_) { if (rep_) xcd_barrier(bar); RELANE();
            if (PHON(6)) {
                if (l == 0) { pg8::Gemm g{ACT, (const bf16*)(ws + WS_WDOWN), 64, 4, FF, FF}; SliceOrder0 S; S.init(64, 4, F.G, F.bx, FF); S.nsl = 8;
                    pg8::EpiRes<false> E{nullptr, nullptr, XN, MOD, 5120, inptr(F, I_N2G), MOD, 4096, inptr(F, I_N1G) + DM, MOD + (size_t)9 * 6144, 1024, (float*)(ws + WS_SSX), rep_ ? 0.f : 1.f, (bf16*)(ws + WS_CPART)};
                    pg8::gemm_phase(ring, g, S, E);
                    xcd_barrier(bar); RELANE();
                    ctx_combine_phase(F, nullptr, inptr(F, I_N2G), 4096, 5120, inptr(F, I_N1G) + DM, MOD + (size_t)9 * 6144 + 8 * 6144, 1024, 8);
                } else { pg8::Gemm g{ACT, (const bf16*)(ws + WS_WDOWN + WDOWN_STRIDE), 64, 4, FF, FF}; pg8::StaticOrder S; S.init(64, 4, F.G, F.bx, FF);
                    pg8::EpiRes<false> E{nullptr, nullptr, XN, MOD + (size_t)9 * 6144, 5120, inptr(F, I_N2G) + DM, MOD + (size_t)9 * 6144, 4096, nullptr, nullptr, 0, nullptr, 1.f, nullptr};
                    pg8::gemm_phase(ring, g, S, E); } } }
        SEAM(pb + 8);
    }
    if (PHASE(NPH - 1)) for (int rep_ = 0; rep_ < (((NPH - 1) == RPT_PH) ? 2 : 1); ++rep_) { if (rep_) xcd_barrier(bar); RELANE(); if (PHON(10)) final_norm_phase(F, XN, inptr(F, I_FING)); }
#undef PHASE
#undef SEAM
#undef RELANE
#undef MOD
#undef SSQ
#undef XN
#undef P
#undef Qb
#undef Kb
#undef Vb
#undef YCAT
#undef ATTO
#undef ACT
#undef XCTX
#undef XBL
#undef XFIN
}

extern "C" void kernel_launch(void* const* d_in, const int* in_sizes, int n_in, void* d_out, int out_size, void* d_ws, size_t ws_size, hipStream_t stream) {
    static int grid = 0;
    if (grid == 0) {
        if (n_in != 22 || out_size != MLAT * DM || ws_size < WS_END) { fprintf(stderr, "kernel_launch: unexpected shapes (n_in %d out %d ws %zu)\n", n_in, out_size, ws_size); grid = -1; return; }
        int dev = 0, cus = 0;
        if (hipGetDevice(&dev) != hipSuccess || hipDeviceGetAttribute(&cus, hipDeviceAttributeMultiprocessorCount, dev) != hipSuccess) { grid = -1; return; }
        if (hipFuncSetAttribute((const void*)mk_fwd, hipFuncAttributeMaxDynamicSharedMemorySize, LDS_BYTES) != hipSuccess) { fprintf(stderr, "kernel_launch: hipFuncSetAttribute failed\n"); grid = -1; return; }
        int per_cu = 0;
        if (hipOccupancyMaxActiveBlocksPerMultiprocessor(&per_cu, (const void*)mk_fwd, NWAVES * 64, LDS_BYTES) != hipSuccess || per_cu < 1) fprintf(stderr, "kernel_launch: occupancy query says %d\n", per_cu);
        (void)hipGetLastError();
        grid = cus;
    }
    if (grid < 0) return;
    if (hipMemsetAsync((char*)d_ws + WS_CTL, 0, CTL_ZERO_BYTES, stream) != hipSuccess) return;
    Args a{};
    for (int i = 0; i < 22; ++i) a.in[i] = (const float*)d_in[i];
    a.out = (float*)d_out; a.ws = (unsigned char*)d_ws;
#if MK_SPLIT
    for (int ph = 0; ph < NPH; ++ph) { a.ph_lo = ph; a.ph_hi = ph + 1; hipLaunchKernelGGL(mk_fwd, dim3(grid), dim3(NWAVES * 64), LDS_BYTES, stream, a); }
#else
    a.ph_lo = 0; a.ph_hi = NPH;
    hipLaunchKernelGGL(mk_fwd, dim3(grid), dim3(NWAVES * 64), LDS_BYTES, stream, a);
#endif
    const hipError_t le = hipPeekAtLastError();
    if (le != hipSuccess) fprintf(stderr, "kernel_launch: launch failed: %s\n", hipGetErrorName(le));
}
```

```cpp
#include <hip/hip_runtime.h>
#include <hip/hip_bf16.h>
#include <cstdio>
#include <cstdint>
#include <cmath>
namespace pg8 {
#define PG8_LAS __attribute__((address_space(3)))
typedef unsigned short bf16_t;
typedef short bf16x8 __attribute__((ext_vector_type(8)));
typedef float f32x4 __attribute__((ext_vector_type(4)));
typedef float f32x2 __attribute__((ext_vector_type(2)));
typedef unsigned u32x4 __attribute__((ext_vector_type(4)));
typedef unsigned u32x2 __attribute__((ext_vector_type(2)));
constexpr int BM = 256, BK = 64, HALF = 128, HTB = HALF * BK * 2  , STAGE_BYTES = 8 * HTB, NXCD = 8, WGM = 8;

__host__ __device__ __forceinline__ int lds_byte(int r, int c) { const int st = (r >> 4) * 2 + (c >> 5), rr = r & 15, cc = c & 31, ob = rr * 64 + cc * 2; return st * 1024 + (ob ^ (((ob >> 9) & 1) << 5)); }
__host__ __device__ __forceinline__ void stage_rc(int b, int& R, int& C) { const int st = b / 1024, sb = b % 1024, swz = sb ^ (((sb >> 9) & 1) << 5); R = (st >> 1) * 16 + swz / 64; C = (st & 1) * 32 + (swz % 64) / 2; }
__host__ __device__ __forceinline__ int perm32(int rho) { const int n = rho >> 4, i = rho & 15; return 8 * (i >> 2) + 4 * n + (i & 3); }

struct Unit { int pm, pn, arow, kofs, kofb, nt, aux; };
struct Gemm { const bf16_t* A; const bf16_t* Bt; int nM, nN, ldb, lda; };

struct StaticOrder {
    int nM, nN, nwg, G, c, ntk;
    __device__ __forceinline__ void init(int nM_, int nN_, int G_, int c_, int K_) { nM = nM_; nN = nN_; nwg = nM * nN; G = G_; c = c_; ntk = K_ / BK; }
    __device__ __forceinline__ bool next_mn(int i, int& pm, int& pn) const {
        const long L = (long)i * G + c; if (L >= nwg) return false;
        int wgid = (int)L; { const int q = nwg / NXCD, r = nwg % NXCD, xcd = wgid % NXCD, off = wgid / NXCD; wgid = (xcd < r ? xcd * (q + 1) : r * (q + 1) + (xcd - r) * q) + off; }
        const int nig = WGM * nN, gid = wgid / nig, fm = gid * WGM, gsz = (nM - fm) < WGM ? (nM - fm) : WGM;
        pm = fm + ((wgid % nig) % gsz); pn = (wgid % nig) / gsz; return true;
    }
    typedef Unit UnitT;
    __device__ __forceinline__ bool next(int i, Unit& u) const { if (!next_mn(i, u.pm, u.pn)) return false; u.arow = u.pm * BM; u.kofs = 0; u.kofb = 0; u.nt = ntk; u.aux = 0; return true; }
};

__device__ __forceinline__ unsigned cvt_pk_bf16(float lo, float hi) { unsigned r; asm volatile("v_cvt_pk_bf16_f32 %0, %1, %2" : "=v"(r) : "v"(lo), "v"(hi)); return r; }

template <class Epi, class Sched>
__device__ __forceinline__ void gemm_phase(PG8_LAS unsigned char* lds, const Gemm g, const Sched& S, const Epi& E) {
    int tid = threadIdx.x; asm volatile("" : "+v"(tid));
    const int wid = __builtin_amdgcn_readfirstlane(tid >> 6), lane = tid & 63, wr = wid >> 2, wc = wid & 3, fr = lane & 15, fq = lane >> 4;
    const int K = g.ldb, lda = g.lda;
    unsigned voffA[2], voffB[2];
#pragma unroll
    for (int i = 0; i < 2; ++i) { int R, C; stage_rc(tid * 16 + i * 8192, R, C); const int Rb = Epi::PERM ? ((R & ~31) + perm32(R & 31)) : R;
        voffA[i] = (unsigned)(R * lda + C) * 2u; voffB[i] = (unsigned)(Rb * K + C) * 2u; }
    const size_t kstep = (size_t)(BK * 2);
    const size_t hstepA = (size_t)HALF * lda * 2, hstepB = (size_t)HALF * K * 2;
    const size_t tstepB = 2 * hstepB;
    const unsigned ldsw = (unsigned)wid * 1024u;
    const int aoff = lds_byte(wr * 64 + fr, fq * 8), boff = lds_byte(wc * 32 + fr, fq * 8);
#define PG8_SA(b, h) (((b) * 2 + (h)) * HTB)
#define PG8_SB(b, h) ((4 + (b) * 2 + (h)) * HTB)
#define PG8_STAGE(bufoff, gbase, voff) do { _Pragma("unroll") for (int _i = 0; _i < 2; ++_i) \
        __builtin_amdgcn_global_load_lds((const unsigned*)((const char*)(gbase) + (voff)[_i]), (PG8_LAS unsigned*)(lds + (bufoff) + ldsw + _i * 8192), 16, 0, 0); } while (0)
#define PG8_LDA(dst, b, h) do { _Pragma("unroll") for (int m = 0; m < 4; ++m) _Pragma("unroll") for (int k = 0; k < 2; ++k) dst[m][k] = *(const PG8_LAS bf16x8*)(lds + PG8_SA(b, h) + aoff + m * 2048 + k * 1024); } while (0)
#define PG8_LDB(dst, b, h) do { _Pragma("unroll") for (int n = 0; n < 2; ++n) _Pragma("unroll") for (int k = 0; k < 2; ++k) dst[n][k] = *(const PG8_LAS bf16x8*)(lds + PG8_SB(b, h) + boff + n * 2048 + k * 1024); } while (0)
#define PG8_MMA(ai, bj, At, Bt) do { __builtin_amdgcn_s_setprio(1); _Pragma("unroll") for (int m = 0; m < 4; ++m) _Pragma("unroll") for (int n = 0; n < 2; ++n) _Pragma("unroll") for (int k = 0; k < 2; ++k) \
        acc[ai][bj][m][n] = __builtin_amdgcn_mfma_f32_16x16x32_bf16(Bt[n][k], At[m][k], acc[ai][bj][m][n], 0, 0, 0); __builtin_amdgcn_s_setprio(0); } while (0)
#define PG8_WAIT_V(n) asm volatile("s_waitcnt vmcnt(" #n ")" ::: "memory")
#define PG8_WAIT_L(n) asm volatile("s_waitcnt lgkmcnt(" #n ")" ::: "memory")
#define PG8_BAR __builtin_amdgcn_s_barrier()
#define PG8_SCHED __builtin_amdgcn_sched_barrier(0)
    typename Sched::UnitT cur, nxt; int ui = 0;
    if (!S.next(0, cur)) return;
    f32x4 acc[2][2][4][2];
#pragma unroll
    for (int a = 0; a < 2; ++a)
#pragma unroll
        for (int b = 0; b < 2; ++b)
#pragma unroll
            for (int m = 0; m < 4; ++m)
#pragma unroll
                for (int n = 0; n < 2; ++n) acc[a][b][m][n] = (f32x4){0.f, 0.f, 0.f, 0.f};
    bf16x8 At[4][2], B0[2][2], B1[2][2];
    const char* cA = (const char*)g.A + (ptrdiff_t)cur.arow * (ptrdiff_t)(lda * 2) + cur.kofs * 2; const char* cB = (const char*)g.Bt + (size_t)cur.pn * tstepB + cur.kofb * 2;
    if constexpr (Epi::PREFETCH) E.prefetch(cur, wid, lane);
    PG8_STAGE(PG8_SB(0, 0), cB, voffB); PG8_STAGE(PG8_SB(0, 1), cB + hstepB, voffB); PG8_STAGE(PG8_SA(0, 0), cA, voffA); PG8_STAGE(PG8_SA(0, 1), cA + hstepA, voffA);
    if (wr == 1) PG8_BAR;
    PG8_WAIT_V(2); PG8_BAR;
    PG8_STAGE(PG8_SB(1, 0), cB + kstep, voffB); PG8_STAGE(PG8_SA(1, 0), cA + kstep, voffA); PG8_STAGE(PG8_SB(1, 1), cB + hstepB + kstep, voffB);
    PG8_WAIT_V(6); PG8_BAR;
    for (;;) {
        const bool has_next = S.next(ui + 1, nxt);
        const char* nA = has_next ? (const char*)g.A + (ptrdiff_t)nxt.arow * (ptrdiff_t)(lda * 2) + nxt.kofs * 2 : cA; const char* nB = has_next ? (const char*)g.Bt + (size_t)nxt.pn * tstepB + nxt.kofb * 2 : cB;
        const int nt = cur.nt;
        for (int t = 0; t < nt; t += 2) {
            const bool last = (t == nt - 2);
            const char* a1 = cA + (size_t)(t + 1) * kstep;
            const char* a2 = last ? nA : cA + (size_t)(t + 2) * kstep; const char* b2 = last ? nB : cB + (size_t)(t + 2) * kstep;
            const char* a3 = a2 + kstep; const char* b3 = b2 + kstep;
            PG8_LDB(B0, 0, 0); PG8_LDB(B1, 0, 1); PG8_SCHED; PG8_LDA(At, 0, 0); PG8_STAGE(PG8_SA(1, 1), a1 + hstepA, voffA);
            PG8_WAIT_V(8); PG8_WAIT_L(0); PG8_BAR; PG8_MMA(0, 0, At, B0); PG8_MMA(0, 1, At, B1); PG8_BAR; PG8_SCHED;
            PG8_LDA(At, 0, 1); PG8_STAGE(PG8_SB(0, 0), b2, voffB); PG8_STAGE(PG8_SB(0, 1), b2 + hstepB, voffB); PG8_STAGE(PG8_SA(0, 0), a2, voffA);
            PG8_WAIT_V(8); PG8_WAIT_L(0); PG8_BAR; PG8_MMA(1, 0, At, B0); PG8_MMA(1, 1, At, B1); PG8_BAR; PG8_SCHED;
            PG8_LDB(B0, 1, 0); PG8_LDB(B1, 1, 1); PG8_SCHED; PG8_LDA(At, 1, 0); PG8_STAGE(PG8_SA(0, 1), a2 + hstepA, voffA);
            PG8_WAIT_V(8); PG8_WAIT_L(0); PG8_BAR; PG8_MMA(0, 0, At, B0); PG8_MMA(0, 1, At, B1); PG8_BAR; PG8_SCHED;
            PG8_LDA(At, 1, 1); PG8_STAGE(PG8_SB(1, 0), b3, voffB); PG8_STAGE(PG8_SB(1, 1), b3 + hstepB, voffB); PG8_STAGE(PG8_SA(1, 0), a3, voffA);
            PG8_WAIT_V(8); PG8_WAIT_L(0); PG8_BAR; PG8_MMA(1, 0, At, B0); PG8_MMA(1, 1, At, B1); PG8_BAR; PG8_SCHED;
        }
        if (wr == 0) PG8_BAR;
        E(acc, cur, wr, wc, fr, fq);
        if (!has_next) break;
        if constexpr (Epi::PREFETCH) E.prefetch(nxt, wid, lane);
#pragma unroll
        for (int a = 0; a < 2; ++a)
#pragma unroll
            for (int b = 0; b < 2; ++b)
#pragma unroll
                for (int m = 0; m < 4; ++m)
#pragma unroll
                    for (int n = 0; n < 2; ++n) acc[a][b][m][n] = (f32x4){0.f, 0.f, 0.f, 0.f};
        cur = nxt; cA = nA; cB = nB; ++ui;
        if (wr == 1) PG8_BAR;
    }
    PG8_WAIT_V(0);
    PG8_BAR;
#undef PG8_SA
#undef PG8_SB
#undef PG8_STAGE
#undef PG8_LDA
#undef PG8_LDB
#undef PG8_MMA
#undef PG8_WAIT_V
#undef PG8_WAIT_L
#undef PG8_BAR
#undef PG8_SCHED
}
}
namespace pg8 {
constexpr float RMS_EPS = 1e-6f;
template <class T> __device__ __forceinline__ T gld(const void* base, unsigned boff) { return *(const T*)((const char*)base + boff); }
template <class T> __device__ __forceinline__ void gst(void* base, unsigned boff, T v) { *(T*)((char*)base + boff) = v; }
constexpr int EX_XF = 0, EX_XL = 512, EX_CW = 1024, EX_RS = 1536, EX_BL = 1792, EX_SSX = 2304, EX_FLOATS = 6400;
constexpr int MLAT_ = 16384;
__device__ __forceinline__ void dma_ssx(const float* ssx, int arow, PG8_LAS float* xb, int wid, int lane) {
#pragma unroll
    for (int i = 0; i < 2; ++i) { const int ch = 2 * wid + i;
        __builtin_amdgcn_global_load_lds((const unsigned*)((const char*)ssx + (ptrdiff_t)arow * 64 + ch * 1024 + lane * 16), (PG8_LAS unsigned*)(xb + EX_SSX + ch * 256), 16, 0, 0); }
}
__device__ __forceinline__ void rs_from_ssx(PG8_LAS float* xb, int t) {
    if (t < 256) { const PG8_LAS f32x4* p = (const PG8_LAS f32x4*)(xb + EX_SSX + t * 16); const f32x4 a = p[0], b = p[1], c = p[2], d = p[3];
        const float ss = (((a[0] + a[1]) + (a[2] + a[3])) + ((b[0] + b[1]) + (b[2] + b[3]))) + (((c[0] + c[1]) + (c[2] + c[3])) + ((d[0] + d[1]) + (d[2] + d[3])));
        xb[EX_RS + t] = __builtin_amdgcn_rsqf(ss * (1.0f / 1024.0f) + RMS_EPS); }
}

struct EpiWin {
    static constexpr bool PERM = true, PREFETCH = true;
    bf16_t* O; int ldc; float* ssq;
    const float* ssx; const float* pb;
    PG8_LAS float* xb;
    __device__ __forceinline__ void prefetch(const Unit& u, int wid, int lane) const {
        if (ssx == nullptr) return;
        dma_ssx(ssx, u.arow, xb, wid, lane);
        if (wid == 0) __builtin_amdgcn_global_load_lds((const unsigned*)(pb + (u.pm < 64 ? (u.pm >> 3) : 8) * 2304 + u.pn * BM + lane * 4), (PG8_LAS unsigned*)(xb + EX_BL), 16, 0, 0);
    }
    __device__ __forceinline__ void operator()(const f32x4 (&acc)[2][2][4][2], const Unit& u, int wr, int wc, int fr_in, int fq_in) const {
        int t_ = threadIdx.x; asm volatile("" : "+v"(t_)); const int fr = t_ & 15, fq = (t_ >> 4) & 3; (void)fr_in; (void)fq_in;
        const int row0 = u.pm * BM + wr * 64 + fr; const int col0 = (u.pn == 8 ? 3 : u.pn) * BM + wc * 32 + 8 * fq; const int tc0 = wc * 32 + 8 * fq;
        const bool fused = ssx != nullptr;
        if (fused) { rs_from_ssx(xb, t_); asm volatile("s_waitcnt lgkmcnt(0)" ::: "memory"); __builtin_amdgcn_s_barrier(); asm volatile("" ::: "memory"); }
        f32x4 bv[2][2];
#pragma unroll
        for (int bj = 0; bj < 2; ++bj)
#pragma unroll
            for (int n = 0; n < 2; ++n) bv[bj][n] = fused ? *(const PG8_LAS f32x4*)(xb + EX_BL + tc0 + bj * HALF + 4 * n) : (f32x4){0.f, 0.f, 0.f, 0.f};
#pragma unroll
        for (int ai = 0; ai < 2; ++ai)
#pragma unroll
            for (int m = 0; m < 4; ++m) { const int tr = ai * HALF + wr * 64 + m * 16 + fr; const int row = u.pm * BM + tr; const unsigned ob = ((unsigned)row * (unsigned)ldc + (unsigned)col0) * 2u;
                const float rs = fused ? xb[EX_RS + tr] : 1.0f;
#pragma unroll
                for (int bj = 0; bj < 2; ++bj) { const f32x4 v0 = acc[ai][bj][m][0] * rs + bv[bj][0], v1 = acc[ai][bj][m][1] * rs + bv[bj][1];
                    u32x4 w; w.x = cvt_pk_bf16(v0[0], v0[1]); w.y = cvt_pk_bf16(v0[2], v0[3]); w.z = cvt_pk_bf16(v1[0], v1[1]); w.w = cvt_pk_bf16(v1[2], v1[3]);
                    gst<u32x4>(O, ob + bj * HALF * 2, w);
                    const int hf = 2 * u.pn + bj;
                    if (hf < 5) {
                        float s = (v0[0] * v0[0] + v0[1] * v0[1]) + (v0[2] * v0[2] + v0[3] * v0[3]) + (v1[0] * v1[0] + v1[1] * v1[1]) + (v1[2] * v1[2] + v1[3] * v1[3]);
                        s += __shfl_xor(s, 16); s += __shfl_xor(s, 32);
                        if (fq == 0) gst<float>(ssq, ((unsigned)row * 20u + hf * 4 + wc) * 4u, s);
                    } }
                if (m & 1) asm volatile("" ::: "memory"); }
        if (fused) { asm volatile("s_waitcnt lgkmcnt(0)" ::: "memory"); __builtin_amdgcn_s_barrier(); asm volatile("" ::: "memory"); }
        (void)row0;
    }
};

struct EpiFold {
    static constexpr bool PERM = true, PREFETCH = false;
    bf16_t* WinT; unsigned lstride;
    __device__ __forceinline__ void operator()(const f32x4 (&acc)[2][2][4][2], const Unit& u, int wr, int wc, int fr_in, int fq_in) const {
        int t_ = threadIdx.x; asm volatile("" : "+v"(t_)); const int fr = t_ & 15, fq = (t_ >> 4) & 3; (void)fr_in; (void)fq_in;
        bf16_t* O = WinT + (size_t)(u.pn >> 2) * lstride;
        const int row0 = 768 + u.pm * BM + wr * 64 + fr; const int col0 = (u.pn & 3) * BM + wc * 32 + 8 * fq;
#pragma unroll
        for (int ai = 0; ai < 2; ++ai)
#pragma unroll
            for (int m = 0; m < 4; ++m) { const unsigned ob = ((unsigned)(row0 + ai * HALF + m * 16) * 1024u + (unsigned)col0) * 2u;
#pragma unroll
                for (int bj = 0; bj < 2; ++bj) { const f32x4 v0 = acc[ai][bj][m][0], v1 = acc[ai][bj][m][1];
                    u32x4 w; w.x = cvt_pk_bf16(v0[0], v0[1]); w.y = cvt_pk_bf16(v0[2], v0[3]); w.z = cvt_pk_bf16(v1[0], v1[1]); w.w = cvt_pk_bf16(v1[2], v1[3]);
                    gst<u32x4>(O, ob + bj * HALF * 2, w); } }
    }
};

struct EpiQKV {
    static constexpr bool PERM = true, PREFETCH = true;
    bf16_t* Q; bf16_t* Kb; bf16_t* Vb; const float* ssq; const float* ropec; const float* ropes; PG8_LAS float* xb;
    __device__ __forceinline__ void prefetch(const Unit& u, int wid, int lane) const {
#pragma unroll
        for (int i = 0; i < 3; ++i) { const int ch = 3 * wid + i;
            if (ch < 20) __builtin_amdgcn_global_load_lds((const unsigned*)((const char*)ssq + (size_t)u.arow * 80 + ch * 1024 + lane * 16), (PG8_LAS unsigned*)(xb + 512 + ch * 256), 16, 0, 0); }
    }
    __device__ __forceinline__ void operator()(const f32x4 (&acc)[2][2][4][2], const Unit& u, int wr, int wc, int fr_in, int fq_in) const {
        int t_ = threadIdx.x; asm volatile("" : "+v"(t_)); const int fr = t_ & 15, fq = (t_ >> 4) & 3; (void)fr_in; (void)fq_in;
        if (t_ < 256) { const PG8_LAS float* p = xb + 512 + t_ * 20; float sq = 0.f, sk = 0.f;
#pragma unroll
            for (int i = 0; i < 12; ++i) sq += p[i];
#pragma unroll
            for (int i = 12; i < 20; ++i) sk += p[i];
            xb[t_] = __builtin_amdgcn_rsqf(sq * (1.0f / 384.0f) + RMS_EPS); xb[256 + t_] = __builtin_amdgcn_rsqf(sk * (1.0f / 256.0f) + RMS_EPS); }
        asm volatile("s_waitcnt lgkmcnt(0)" ::: "memory"); __builtin_amdgcn_s_barrier(); asm volatile("" ::: "memory");
        const int cw = wc * 32 + 8 * fq;
        if (u.pn < 3) {
            const bool lat = u.pm < 64;
#pragma unroll
            for (int ai = 0; ai < 2; ++ai)
#pragma unroll
                for (int m = 0; m < 4; ++m) { const int tr = ai * HALF + wr * 64 + m * 16 + fr; const int row = u.pm * BM + tr; const float rs = xb[tr]; const int t = row & 2047;
#pragma unroll
                    for (int bj = 0; bj < 2; ++bj) { const int gcol = u.pn * BM + bj * HALF + wc * 32;
                        const int w = gcol % 192; f32x4 x1 = acc[ai][bj][m][0] * rs, x2 = acc[ai][bj][m][1] * rs;
                        if (lat && w >= 128) { const int pos = (w >= 160) ? (t & 63) : (t >> 6);
                            const unsigned rb = (unsigned)(pos * 16 + 4 * fq) * 4u; const f32x4 c = gld<f32x4>(ropec, rb), s = gld<f32x4>(ropes, rb);
                            const f32x4 y1 = x1 * c - x2 * s, y2 = x1 * s + x2 * c; x1 = y1; x2 = y2; }
                        u32x4 o; o.x = cvt_pk_bf16(x1[0], x1[1]); o.y = cvt_pk_bf16(x1[2], x1[3]); o.z = cvt_pk_bf16(x2[0], x2[1]); o.w = cvt_pk_bf16(x2[2], x2[3]);
                        gst<u32x4>(Q, ((unsigned)row * 768u + (unsigned)(gcol + 8 * fq)) * 2u, o); }
                    if (m & 1) asm volatile("" ::: "memory"); }
        } else {
            const int h = u.pn - 3;
#pragma unroll
            for (int ai = 0; ai < 2; ++ai)
#pragma unroll
                for (int m = 0; m < 4; ++m) { const int tr = ai * HALF + wr * 64 + m * 16 + fr; const int row = u.pm * BM + tr; const float rs = xb[256 + tr];
#pragma unroll
                    for (int bj = 0; bj < 2; ++bj) { const f32x4 v0 = acc[ai][bj][m][0] * rs, v1 = acc[ai][bj][m][1] * rs;
                        u32x4 w; w.x = cvt_pk_bf16(v0[0], v0[1]); w.y = cvt_pk_bf16(v0[2], v0[3]); w.z = cvt_pk_bf16(v1[0], v1[1]); w.w = cvt_pk_bf16(v1[2], v1[3]);
                        if (bj == 0) gst<u32x4>(Kb, ((unsigned)row * 768u + (unsigned)(192 * h + cw)) * 2u, w);
                        else gst<u32x4>(Vb, ((unsigned)row * 512u + (unsigned)(128 * h + cw)) * 2u, w); }
                    if (m & 1) asm volatile("" ::: "memory"); }
        }
        asm volatile("s_waitcnt lgkmcnt(0)" ::: "memory"); __builtin_amdgcn_s_barrier(); asm volatile("" ::: "memory");
    }
};

struct EpiFnet {
    static constexpr bool PERM = true, PREFETCH = false;
    bf16_t* Y; int rowbase, seqlen; float scale; unsigned slice_stride;
    __device__ __forceinline__ void operator()(const f32x4 (&acc)[2][2][4][2], const Unit& u, int wr, int wc, int fr_in, int fq_in) const {
        int t_ = threadIdx.x; asm volatile("" : "+v"(t_)); const int fr = t_ & 15, fq = (t_ >> 4) & 3; (void)fr_in; (void)fq_in;
        const int k0 = u.pm * BM + wr * 64 + fr; const int cw = wc * 32 + 8 * fq;
        bf16_t* Yb = Y + (size_t)(u.kofs >> 10) * slice_stride;
#pragma unroll
        for (int ai = 0; ai < 2; ++ai)
#pragma unroll
            for (int m = 0; m < 4; ++m) { const int row = rowbase + u.pn * seqlen + k0 + ai * HALF + m * 16; const unsigned yb = ((unsigned)row * 256u + (unsigned)cw) * 2u;
#pragma unroll
                for (int bj = 0; bj < 2; ++bj) { const f32x4 v0 = acc[ai][bj][m][0] * scale, v1 = acc[ai][bj][m][1] * scale;
                    u32x4 w; w.x = cvt_pk_bf16(v0[0], v0[1]); w.y = cvt_pk_bf16(v0[2], v0[3]); w.z = cvt_pk_bf16(v1[0], v1[1]); w.w = cvt_pk_bf16(v1[2], v1[3]);
                    gst<u32x4>(Yb, yb + bj * HALF * 2, w); } }
    }
};

template <bool F32BASE> struct EpiRes {
    static constexpr bool PERM = true, PREFETCH = false;
    const float* base_lat; const float* base_ctx;
    bf16_t* X; const float* mod; int gofs;
    const float* png; const float* pscmod; int pscofs;
    const float* ng; const float* scmod; int scofs; float* ssx;
    float gmul;
    bf16_t* part;
    __device__ __forceinline__ void operator()(const f32x4 (&acc)[2][2][4][2], const Unit& u, int wr, int wc, int fr_in, int fq_in) const {
        int t_ = threadIdx.x; asm volatile("" : "+v"(t_)); const int fr = t_ & 15, fq = (t_ >> 4) & 3; (void)fr_in; (void)fq_in;
        if (part != nullptr && u.pm >= 64) {
            const int sl = u.aux;
            const int prow0 = (u.pm - 64) * BM + wr * 64 + fr; const int pcol0 = u.pn * BM + wc * 32 + 8 * fq; bf16_t* pb_ = part + (size_t)sl * (2048u * 1024u);
#pragma unroll
            for (int ai = 0; ai < 2; ++ai)
#pragma unroll
                for (int m = 0; m < 4; ++m) { const unsigned off = ((unsigned)(prow0 + ai * HALF + m * 16) * 1024u + (unsigned)pcol0) * 2u;
#pragma unroll
                    for (int bj = 0; bj < 2; ++bj) { const f32x4 v0 = acc[ai][bj][m][0], v1 = acc[ai][bj][m][1];
                        u32x4 w; w.x = cvt_pk_bf16(v0[0], v0[1]); w.y = cvt_pk_bf16(v0[2], v0[3]); w.z = cvt_pk_bf16(v1[0], v1[1]); w.w = cvt_pk_bf16(v1[2], v1[3]);
                        gst<u32x4>(pb_, off + (unsigned)(bj * HALF) * 2u, w); } }
            return;
        }
        const bool lat = u.pm < 64; const int r = lat ? (u.pm >> 3) : 8;
        constexpr bool f32base = F32BASE; const float* bf = lat ? base_lat : base_ctx;
        const float* gate = mod + r * 6144 + gofs;
        const int frow0 = (lat ? u.pm : u.pm - 64) * BM + wr * 64 + fr; const int col0 = u.pn * BM + wc * 32 + 8 * fq;
        const int grow0 = u.pm * BM + wr * 64 + fr;
        const bool scaled = ng != nullptr;
        float ss[8];
#pragma unroll
        for (int q = 0; q < 8; ++q) ss[q] = 0.f;
#pragma unroll
        for (int bj = 0; bj < 2; ++bj) {
            f32x4 gv[2], gs[2], gp[2];
#pragma unroll
            for (int n = 0; n < 2; ++n) { const unsigned cb = (unsigned)(col0 + bj * HALF + n * 4) * 4u; gv[n] = gld<f32x4>(gate, cb) * gmul;
                gs[n] = scaled ? gld<f32x4>(ng, cb) * (gld<f32x4>(scmod, (unsigned)(r * 6144 + scofs) * 4u + cb) + 1.0f) : (f32x4){1.f, 1.f, 1.f, 1.f};
                if constexpr (!f32base) { const f32x4 d = gld<f32x4>(png, cb) * (gld<f32x4>(pscmod, (unsigned)(r * 6144 + pscofs) * 4u + cb) + 1.0f);
                    gp[n] = (f32x4){__builtin_amdgcn_rcpf(d[0]), __builtin_amdgcn_rcpf(d[1]), __builtin_amdgcn_rcpf(d[2]), __builtin_amdgcn_rcpf(d[3])}; }
                else gp[n] = (f32x4){1.f, 1.f, 1.f, 1.f}; }
#pragma unroll
            for (int ai = 0; ai < 2; ++ai) {
                f32x4 x0[4], x1[4];
#pragma unroll
                for (int m = 0; m < 4; ++m) { const unsigned o2 = ((unsigned)(grow0 + ai * HALF + m * 16) * 1024u + (unsigned)(col0 + bj * HALF)) * 2u;
                    const unsigned fo = ((unsigned)(frow0 + ai * HALF + m * 16) * 1024u + (unsigned)(col0 + bj * HALF)) * 4u;
                    if constexpr (f32base) { x0[m] = gld<f32x4>(bf, fo); x1[m] = gld<f32x4>(bf, fo + 16u); }
                    else { const u32x4 bw = gld<u32x4>(X, o2); x0[m] = __builtin_bit_cast(f32x4, (u32x4){bw.x << 16, bw.x & 0xffff0000u, bw.y << 16, bw.y & 0xffff0000u});
                        x1[m] = __builtin_bit_cast(f32x4, (u32x4){bw.z << 16, bw.z & 0xffff0000u, bw.w << 16, bw.w & 0xffff0000u}); } }
                asm volatile("" ::: "memory");
#pragma unroll
                for (int m = 0; m < 4; ++m) { const unsigned o2 = ((unsigned)(grow0 + ai * HALF + m * 16) * 1024u + (unsigned)(col0 + bj * HALF)) * 2u;
                    f32x4 y0 = x0[m], y1 = x1[m];
                    if constexpr (!f32base) { y0 = y0 * gp[0]; y1 = y1 * gp[1]; }
                    y0 = y0 + gv[0] * acc[ai][bj][m][0]; y1 = y1 + gv[1] * acc[ai][bj][m][1];
                    ss[ai * 4 + m] += ((y0[0] * y0[0] + y0[1] * y0[1]) + (y0[2] * y0[2] + y0[3] * y0[3])) + ((y1[0] * y1[0] + y1[1] * y1[1]) + (y1[2] * y1[2] + y1[3] * y1[3]));
                    asm volatile("" : "+v"(ss[ai * 4 + m]));
                    const f32x4 h0 = y0 * gs[0], h1 = y1 * gs[1];
                    u32x4 hw; hw.x = cvt_pk_bf16(h0[0], h0[1]); hw.y = cvt_pk_bf16(h0[2], h0[3]); hw.z = cvt_pk_bf16(h1[0], h1[1]); hw.w = cvt_pk_bf16(h1[2], h1[3]);
                    gst<u32x4>(X, o2, hw); }
                asm volatile("" ::: "memory"); }
        }
        if (scaled) {
#pragma unroll
            for (int q = 0; q < 8; ++q) { float s = ss[q]; s += __shfl_xor(s, 16); s += __shfl_xor(s, 32);
                if (fq == 0) gst<float>(ssx, ((unsigned)(grow0 + (q >> 2) * HALF + (q & 3) * 16) * 16u + (unsigned)(4 * u.pn + wc)) * 4u, s); } }
    }
};

#ifndef DPP_UP
#define DPP_UP 0x121
#define DPP_DN 0x12F
#endif
struct UnitUp : Unit { int nrows; };
struct EpiUp {
    static constexpr bool PERM = true, PREFETCH = true;
    bf16_t* act; const float* cw; const float* cb; PG8_LAS float* xb;
    const float* ssx; const float* ub;
    __device__ __forceinline__ void prefetch(const UnitUp& u, int wid, int lane) const {
        dma_ssx(ssx, u.arow, xb, wid, lane);
        { const int arr = wid >> 1, half = wid & 1; const float* src = (arr < 3 ? cw + arr * 2816 : cb) + u.pn * HALF + half * 64 + lane;
          __builtin_amdgcn_global_load_lds((const unsigned*)src, (PG8_LAS unsigned*)(xb + EX_CW + arr * 128 + half * 64), 4, 0, 0); }
        if (wid < 2) { const int a0 = u.arow < 0 ? 0 : u.arow; const int b0 = a0 >= MLAT_ ? 8 : (a0 >> 11); const int bb_ = b0 + wid > 8 ? 8 : b0 + wid;
            __builtin_amdgcn_global_load_lds((const unsigned*)(ub + bb_ * 5632 + u.pn * BM + lane * 4), (PG8_LAS unsigned*)(xb + EX_BL + wid * 256), 16, 0, 0); }
    }
    __device__ __forceinline__ void operator()(f32x4 (&acc)[2][2][4][2], const UnitUp& u, int wr, int wc, int fr_in, int fq_in) const {
        int t_ = threadIdx.x; asm volatile("" : "+v"(t_)); const int fr = t_ & 15, fq = (t_ >> 4) & 3; (void)fr_in; (void)fq_in;
        const int lane = fq * 16 + fr;
        const int ccol = wc * 32 + 8 * fq;
        const int gc = u.pn * HALF + ccol;
        PG8_LAS float* CW = xb + EX_CW;
        unsigned rowflags;
        { unsigned pmask = 0u;
          const int a0 = u.arow < 0 ? 0 : u.arow, e0 = u.arow + 255;
          const int seam = (a0 >= MLAT_) ? (1 << 30) : (((a0 >> 11) + 1) << 11);
          const bool straddle = e0 >= seam;
          const PG8_LAS float* bl = xb + EX_BL + ccol;
          const f32x4 ug0 = *(const PG8_LAS f32x4*)(bl), ug1 = *(const PG8_LAS f32x4*)(bl + 4), uv0 = *(const PG8_LAS f32x4*)(bl + HALF), uv1 = *(const PG8_LAS f32x4*)(bl + HALF + 4);
#pragma unroll
          for (int ai = 0; ai < 2; ++ai)
#pragma unroll
            for (int m = 0; m < 4; ++m) { const int tr = ai * HALF + wr * 64 + m * 16 + fr; const int g = u.arow + tr;
                const int pos = g < MLAT_ ? (g & 2047) : ((g - MLAT_) & 255); const int last = g < MLAT_ ? 2047 : 255;
                if (pos == 0) pmask |= 1u << (4 * ai + m); if (pos == last) pmask |= 256u << (4 * ai + m);
                const f32x4 s4 = *(const PG8_LAS f32x4*)(xb + EX_SSX + tr * 16 + 4 * fq); float ssr = (s4[0] + s4[1]) + (s4[2] + s4[3]); ssr += __shfl_xor(ssr, 16); ssr += __shfl_xor(ssr, 32);
                const float rs = __builtin_amdgcn_rsqf(ssr * (1.0f / 1024.0f) + RMS_EPS);
                acc[ai][0][m][0] = acc[ai][0][m][0] * rs + ug0; acc[ai][0][m][1] = acc[ai][0][m][1] * rs + ug1;
                acc[ai][1][m][0] = acc[ai][1][m][0] * rs + uv0; acc[ai][1][m][1] = acc[ai][1][m][1] * rs + uv1; }
          if (straddle) {
              const f32x4 dg0 = *(const PG8_LAS f32x4*)(bl + 256) - ug0, dg1 = *(const PG8_LAS f32x4*)(bl + 260) - ug1, dv0 = *(const PG8_LAS f32x4*)(bl + 256 + HALF) - uv0, dv1 = *(const PG8_LAS f32x4*)(bl + 260 + HALF) - uv1;
#pragma unroll
              for (int ai = 0; ai < 2; ++ai)
#pragma unroll
                for (int m = 0; m < 4; ++m) { const int g = u.arow + ai * HALF + wr * 64 + m * 16 + fr; const float sel = (g >= seam) ? 1.0f : 0.0f;
                    acc[ai][0][m][0] += dg0 * sel; acc[ai][0][m][1] += dg1 * sel; acc[ai][1][m][0] += dv0 * sel; acc[ai][1][m][1] += dv1 * sel; } }
          rowflags = pmask; }
        PG8_LAS float* XF = xb + EX_XF; PG8_LAS float* XL = xb + EX_XL;
        const bool isF = (fr == 0), isL = (fr == 15);
#pragma unroll
        for (int ai = 0; ai < 2; ++ai) { const int blk = 2 * ai + wr;
            f32x4 s0, s1;
#pragma unroll
            for (int e = 0; e < 4; ++e) { s0[e] = isF ? acc[ai][0][0][0][e] : acc[ai][0][3][0][e]; s1[e] = isF ? acc[ai][0][0][1][e] : acc[ai][0][3][1][e]; }
            PG8_LAS float* dst = xb + (isF ? EX_XF : EX_XL) + blk * 128 + ccol;
            if (isF || isL) { *(PG8_LAS f32x4*)dst = s0; *(PG8_LAS f32x4*)(dst + 4) = s1; } }
        asm volatile("s_waitcnt lgkmcnt(0)" ::: "memory"); __builtin_amdgcn_s_barrier(); asm volatile("" ::: "memory");
        const int lup = (lane & 48) | ((lane - 1) & 15), ldn = (lane & 48) | ((lane + 1) & 15);
#pragma unroll
        for (int ai = 0; ai < 2; ++ai) { const int blk = 2 * ai + wr;
#pragma unroll
            for (int n = 0; n < 2; ++n) {
                const f32x4 w0 = *(const PG8_LAS f32x4*)(CW + ccol + 4 * n), w1 = *(const PG8_LAS f32x4*)(CW + 128 + ccol + 4 * n), w2 = *(const PG8_LAS f32x4*)(CW + 256 + ccol + 4 * n), bb = *(const PG8_LAS f32x4*)(CW + 384 + ccol + 4 * n);
                f32x4 xprev = (f32x4){0.f, 0.f, 0.f, 0.f}, xnext = (f32x4){0.f, 0.f, 0.f, 0.f};
                if (blk > 0) xprev = *(const PG8_LAS f32x4*)(XL + (blk - 1) * 128 + ccol + 4 * n);
                if (blk < 3) xnext = *(const PG8_LAS f32x4*)(XF + (blk + 1) * 128 + ccol + 4 * n);
#pragma unroll
                for (int e = 0; e < 4; ++e) {
                    float cur[4], up[4], dn[4];
#pragma unroll
                    for (int m = 0; m < 4; ++m) cur[m] = acc[ai][0][m][n][e];
#pragma unroll
                    for (int m = 0; m < 4; ++m) {
                        const float tu = isL ? (m > 0 ? cur[m > 0 ? m - 1 : 0] : xprev[e]) : cur[m];
                        const float td = isF ? (m < 3 ? cur[m < 3 ? m + 1 : 3] : xnext[e]) : cur[m];
                        up[m] = __shfl(tu, lup); dn[m] = __shfl(td, ldn); }
                    float rr[4];
#pragma unroll
                    for (int m = 0; m < 4; ++m) { const float upv = ((rowflags >> (4 * ai + m)) & 1u) ? 0.f : up[m], dnv = ((rowflags >> (8 + 4 * ai + m)) & 1u) ? 0.f : dn[m];
                        const float cv = w0[e] * upv + w1[e] * cur[m] + w2[e] * dnv + bb[e];
                        const float sg = cv * __builtin_amdgcn_rcpf(1.0f + __expf(-cv));
                        rr[m] = sg * acc[ai][1][m][n][e]; }
                    asm volatile("" : "+v"(rr[0]), "+v"(rr[1]), "+v"(rr[2]), "+v"(rr[3]));
#pragma unroll
                    for (int m = 0; m < 4; ++m) acc[ai][0][m][n][e] = rr[m];
                }
            }
#pragma unroll
            for (int m = 0; m < 4; ++m) { const int tr = ai * HALF + wr * 64 + m * 16 + fr; const int g = u.arow + tr;
                if (tr >= 1 && tr <= 254 && g < u.nrows) { const f32x4 v0 = acc[ai][0][m][0], v1 = acc[ai][0][m][1];
                    u32x4 w; w.x = cvt_pk_bf16(v0[0], v0[1]); w.y = cvt_pk_bf16(v0[2], v0[3]); w.z = cvt_pk_bf16(v1[0], v1[1]); w.w = cvt_pk_bf16(v1[2], v1[3]);
                    gst<u32x4>(act, ((unsigned)g * 2816u + (unsigned)gc) * 2u, w); } }
            asm volatile("" ::: "memory");
        }
        asm volatile("s_waitcnt lgkmcnt(0)" ::: "memory"); __builtin_amdgcn_s_barrier(); asm volatile("" ::: "memory");
    }
};
}
namespace att {
using bf16x8 = __attribute__((ext_vector_type(8))) short;
using s16x4  = __attribute__((ext_vector_type(4))) short;
using f32x16 = __attribute__((ext_vector_type(16))) float;
using u32x4  = __attribute__((ext_vector_type(4))) unsigned;
typedef unsigned short bf16_t;
constexpr int NW = 8, QBLK = 32, KVBLK = 64;
constexpr int LDQ = 768, LDK = 768, LDV = 512, LDO = 512;
constexpr float SCALE = 0.07216878364870322f;
constexpr float THR = 8.f;
constexpr int SHM_V = KVBLK * 128 * 2, SHM_K = KVBLK * 192 * 2;
constexpr int OFF_V = 0, OFF_K = 2 * SHM_V, OFF_WS = 2 * SHM_V + 2 * SHM_K, OFF_QR = OFF_WS + NW * 64 * 4, SHM_ATTN = OFF_QR + NW * 4096;
#define KSWZ(row, colB) ((row) * 384 + ((colB) ^ (((row) & 7) << 4)))
#define SBAR() __builtin_amdgcn_sched_barrier(0)
__device__ __forceinline__ int crow(int r, int hi) { return (r & 3) + 8 * (r >> 2) + 4 * hi; }
__device__ __forceinline__ unsigned cvtpk(float lo, float hi) { unsigned r; asm volatile("v_cvt_pk_bf16_f32 %0, %1, %2" : "=v"(r) : "v"(lo), "v"(hi)); return r; }

__device__ __forceinline__ void partialSM(f32x16& p0, f32x16& p1, float& m_reg, float& mn, float& alpha) {
  constexpr float C = SCALE * 1.4426950408889634f;
  float pmax = p0[0];
#pragma unroll
  for (int r = 1; r < 16; ++r) pmax = fmaxf(pmax, p0[r]);
#pragma unroll
  for (int r = 0; r < 16; ++r) pmax = fmaxf(pmax, p1[r]);
  { auto rr = __builtin_amdgcn_permlane32_swap(__float_as_uint(pmax), __float_as_uint(pmax), false, false);
    pmax = fmaxf(__uint_as_float(rr[0]), __uint_as_float(rr[1])); }
  if (__builtin_expect(__all(pmax - m_reg <= THR / SCALE), 1)) { mn = m_reg; alpha = 1.f; }
  else { mn = fmaxf(m_reg, pmax); alpha = __builtin_amdgcn_exp2f((m_reg - mn) * C); m_reg = mn; }
  float mnC = -mn * C;
#pragma unroll
  for (int r = 0; r < 16; ++r) p0[r] = fmaf(p0[r], C, mnC);
#pragma unroll
  for (int r = 0; r < 16; ++r) p1[r] = fmaf(p1[r], C, mnC);
#pragma unroll
  for (int r = 0; r < 16; ++r) p0[r] = __builtin_amdgcn_exp2f(p0[r]);
}
__device__ __forceinline__ void finishSM(f32x16& p0, f32x16& p1, float alpha, float& l_reg, bf16x8& pa0, bf16x8& pa1, bf16x8& pa2, bf16x8& pa3) {
#pragma unroll
  for (int r = 0; r < 16; ++r) p1[r] = __builtin_amdgcn_exp2f(p1[r]);
  float ps = 0;
#pragma unroll
  for (int r = 0; r < 16; ++r) ps += p0[r];
#pragma unroll
  for (int r = 0; r < 16; ++r) ps += p1[r];
  { auto rr = __builtin_amdgcn_permlane32_swap(__float_as_uint(ps), __float_as_uint(ps), false, false);
    ps = __uint_as_float(rr[0]) + __uint_as_float(rr[1]); }
  l_reg = l_reg * alpha + ps;
#define PK4(P, BASE, OUT) do { unsigned a0 = cvtpk(P[BASE + 0], P[BASE + 1]), a1 = cvtpk(P[BASE + 2], P[BASE + 3]);   \
    unsigned b0 = cvtpk(P[BASE + 4], P[BASE + 5]), b1 = cvtpk(P[BASE + 6], P[BASE + 7]);                              \
    auto r0 = __builtin_amdgcn_permlane32_swap(a0, b0, false, false); auto r1 = __builtin_amdgcn_permlane32_swap(a1, b1, false, false); \
    u32x4 w = {r0[0], r1[0], r0[1], r1[1]}; OUT = *reinterpret_cast<bf16x8*>(&w); } while (0)
  PK4(p0, 0, pa0); PK4(p0, 8, pa1); PK4(p1, 0, pa2); PK4(p1, 8, pa3);
#undef PK4
}
__device__ __forceinline__ void qkt(f32x16& p0, f32x16& p1, const char* Ks, const bf16x8* qr, const char* Qr, int r32, int hi) {
  p0 = f32x16{}; p1 = f32x16{};
#pragma unroll
  for (int d0 = 0; d0 < 12; ++d0) { int cb = (d0 * 16 + hi * 8) * 2;
    bf16x8 b0 = *reinterpret_cast<const bf16x8*>(Ks + KSWZ(r32, cb));
    bf16x8 b1 = *reinterpret_cast<const bf16x8*>(Ks + KSWZ(32 + r32, cb));
    bf16x8 q;
    if (d0 < 8) q = qr[d0];
    else q = *reinterpret_cast<const bf16x8*>(Qr + r32 * 128 + ((((d0 - 8) * 16 + hi * 8) * 2) ^ ((r32 & 7) << 4)));
    p0 = __builtin_amdgcn_mfma_f32_32x32x16_bf16(b0, q, p0, 0, 0, 0);
    p1 = __builtin_amdgcn_mfma_f32_32x32x16_bf16(b1, q, p1, 0, 0, 0); }
}
__device__ __forceinline__ int v_st(int k, int c) { const int kk = (k & ~0xC) | ((k & 4) << 1) | ((k & 8) >> 1); return ((kk >> 3) * 4 + (c >> 5)) * 512 + ((kk & 7) * 32 + (c & 31)) * 2; }
__device__ __forceinline__ int v_rd_base(int lane) { return ((lane & 3) << 3) | (((lane >> 2) & 3) << 6) | (((lane >> 4) & 1) << 5) | (((lane >> 5) & 1) << 8); }
constexpr int v_rd_off(int d0, int ks, int half) { return d0 * 512 + ks * 4096 + half * 2048; }
template <int OFF> __device__ __forceinline__ s16x4 tr_read(int vb) {
  s16x4 r; asm volatile("ds_read_b64_tr_b16 %0, %1 offset:%2" : "=&v"(r) : "v"(vb), "i"(OFF) : "memory"); return r;
}
template <int D0> __device__ __forceinline__ void pv_one(f32x16& od, int vb, bf16x8 pa0, bf16x8 pa1, bf16x8 pa2, bf16x8 pa3) {
  const s16x4 l0 = tr_read<v_rd_off(D0, 0, 0)>(vb), h0 = tr_read<v_rd_off(D0, 0, 1)>(vb), l1 = tr_read<v_rd_off(D0, 1, 0)>(vb), h1 = tr_read<v_rd_off(D0, 1, 1)>(vb);
  const s16x4 l2 = tr_read<v_rd_off(D0, 2, 0)>(vb), h2 = tr_read<v_rd_off(D0, 2, 1)>(vb), l3 = tr_read<v_rd_off(D0, 3, 0)>(vb), h3 = tr_read<v_rd_off(D0, 3, 1)>(vb);
  asm volatile("s_waitcnt lgkmcnt(0)" ::: "memory"); SBAR();
#define PK(L, H) (bf16x8){L[0], L[1], L[2], L[3], H[0], H[1], H[2], H[3]}
  od = __builtin_amdgcn_mfma_f32_32x32x16_bf16(pa0, PK(l0, h0), od, 0, 0, 0);
  od = __builtin_amdgcn_mfma_f32_32x32x16_bf16(pa1, PK(l1, h1), od, 0, 0, 0);
  od = __builtin_amdgcn_mfma_f32_32x32x16_bf16(pa2, PK(l2, h2), od, 0, 0, 0);
  od = __builtin_amdgcn_mfma_f32_32x32x16_bf16(pa3, PK(l3, h3), od, 0, 0, 0);
#undef PK
}
__device__ __forceinline__ void pv_d0(f32x16* o, int vb, bf16x8 pa0, bf16x8 pa1, bf16x8 pa2, bf16x8 pa3) {
  pv_one<0>(o[0], vb, pa0, pa1, pa2, pa3); pv_one<1>(o[1], vb, pa0, pa1, pa2, pa3); pv_one<2>(o[2], vb, pa0, pa1, pa2, pa3); pv_one<3>(o[3], vb, pa0, pa1, pa2, pa3);
}

__device__ __forceinline__ void attn_unit(const bf16_t* __restrict__ Qb, const bf16_t* __restrict__ Kg, const bf16_t* __restrict__ Vg, bf16_t* __restrict__ Ob,
                                          int r0, int n0, int r1, int NT, char* lds) {
  int tid = threadIdx.x; asm volatile("" : "+v"(tid));
  const int wid = tid >> 6, lane = tid & 63, r32 = lane & 31, hi = lane >> 5;
  char* V_lds = lds + OFF_V; char* K_lds = lds + OFF_K;
  float* ws = (float*)(lds + OFF_WS) + wid * 64; float* li_l = ws; float* al_l = ws + 32;
  float m_reg = -1e30f, l_reg = 0; f32x16 o[4] = {}; bf16x8 qr[8];
  const bf16_t* Qw = Qb + (long)(wid * QBLK + r32) * LDQ + hi * 8;
  char* Qr = lds + OFF_QR + wid * 4096;
#pragma unroll
  for (int d0 = 0; d0 < 8; ++d0) qr[d0] = *reinterpret_cast<const bf16x8*>(Qw + d0 * 16);
#pragma unroll
  for (int d0 = 8; d0 < 12; ++d0) { const bf16x8 q = *reinterpret_cast<const bf16x8*>(Qw + d0 * 16);
    *reinterpret_cast<bf16x8*>(Qr + r32 * 128 + ((((d0 - 8) * 16 + hi * 8) * 2) ^ ((r32 & 7) << 4))) = q; }
  const int sr = tid >> 4, sc = (tid & 15) * 8, vst0 = v_st(sr, sc), vst1 = v_st(32 + sr, sc);
  unsigned kgo[3], kst[3];
#pragma unroll
  for (int i = 0; i < 3; ++i) { const int id = tid + 512 * i, kr_ = id / 24, kc_ = id % 24; kgo[i] = (unsigned)(kr_ * LDK + kc_ * 8) * 2u; kst[i] = (unsigned)KSWZ(kr_, kc_ * 16); }
  const unsigned vgo0 = (unsigned)(sr * LDV + sc) * 2u, vgo1 = vgo0 + 32u * LDV * 2u;
  const int vb0 = (int)(uintptr_t)V_lds + v_rd_base(lane);
  bf16x8 vs0, vs1, ks0, ks1, ks2;
#define TROW(j) ((j) < n0 ? r0 + 64 * (j) : r1 + 64 * ((j) - n0))
#define SLOAD(j) do { const long tr_ = TROW(j); const char* Vt = (const char*)(Vg + tr_ * LDV); const char* Kt = (const char*)(Kg + tr_ * LDK);     \
    vs0 = *reinterpret_cast<const bf16x8*>(Vt + vgo0); vs1 = *reinterpret_cast<const bf16x8*>(Vt + vgo1); \
    ks0 = *reinterpret_cast<const bf16x8*>(Kt + kgo[0]); ks1 = *reinterpret_cast<const bf16x8*>(Kt + kgo[1]); ks2 = *reinterpret_cast<const bf16x8*>(Kt + kgo[2]); } while (0)
#define SWRITE(b) do { *(bf16x8*)(V_lds + (b) * SHM_V + vst0) = vs0; *(bf16x8*)(V_lds + (b) * SHM_V + vst1) = vs1; \
    *(bf16x8*)(K_lds + (b) * SHM_K + kst[0]) = ks0; *(bf16x8*)(K_lds + (b) * SHM_K + kst[1]) = ks1; *(bf16x8*)(K_lds + (b) * SHM_K + kst[2]) = ks2; } while (0)
#define RESC(a) do { if (__any((a) < 1.f)) { if (hi == 0) al_l[r32] = (a); asm volatile("s_waitcnt lgkmcnt(0)" ::: "memory"); \
    _Pragma("unroll") for (int d = 0; d < 4; ++d) _Pragma("unroll") for (int r = 0; r < 16; ++r) o[d][r] *= al_l[crow(r, hi)]; } } while (0)
  f32x16 pA0, pA1, pB0, pB1; float mnA, mnB, alA, alB; bf16x8 pa0, pa1, pa2, pa3;
  SLOAD(0); asm volatile("s_waitcnt vmcnt(0)" ::: "memory"); SWRITE(0); __syncthreads();
  qkt(pA0, pA1, K_lds, qr, Qr, r32, hi); partialSM(pA0, pA1, m_reg, mnA, alA);
  SLOAD(1);
  asm volatile("s_waitcnt vmcnt(0)" ::: "memory"); SWRITE(1); __syncthreads();
  for (int j = 1; j + 1 < NT; j += 2) {
    SBAR(); qkt(pB0, pB1, K_lds + SHM_K, qr, Qr, r32, hi);
    finishSM(pA0, pA1, alA, l_reg, pa0, pa1, pa2, pa3); SBAR();
    SLOAD(j + 1); SBAR();
    pv_d0(o, vb0, pa0, pa1, pa2, pa3); partialSM(pB0, pB1, m_reg, mnB, alB);
    __syncthreads(); asm volatile("s_waitcnt vmcnt(0)" ::: "memory"); SWRITE(0);
    RESC(alB); __syncthreads();
    SBAR(); qkt(pA0, pA1, K_lds, qr, Qr, r32, hi);
    finishSM(pB0, pB1, alB, l_reg, pa0, pa1, pa2, pa3); SBAR();
    SLOAD(j + 2); SBAR();
    pv_d0(o, vb0 + SHM_V, pa0, pa1, pa2, pa3); partialSM(pA0, pA1, m_reg, mnA, alA);
    __syncthreads(); asm volatile("s_waitcnt vmcnt(0)" ::: "memory"); SWRITE(1);
    RESC(alA); __syncthreads();
  }
  SBAR(); qkt(pB0, pB1, K_lds + SHM_K, qr, Qr, r32, hi);
  finishSM(pA0, pA1, alA, l_reg, pa0, pa1, pa2, pa3); SBAR();
  pv_d0(o, vb0, pa0, pa1, pa2, pa3); partialSM(pB0, pB1, m_reg, mnB, alB);
  __syncthreads(); RESC(alB);
  finishSM(pB0, pB1, alB, l_reg, pa0, pa1, pa2, pa3); SBAR();
  pv_d0(o, vb0 + SHM_V, pa0, pa1, pa2, pa3);
  if (hi == 0) li_l[r32] = l_reg; asm volatile("s_waitcnt lgkmcnt(0)" ::: "memory");
  float rli[16];
#pragma unroll
  for (int r = 0; r < 16; ++r) rli[r] = __builtin_amdgcn_rcpf(li_l[crow(r, hi)]);
  __syncthreads();
  { bf16_t* stg = (bf16_t*)(lds + wid * 8192);
#pragma unroll
    for (int r = 0; r < 16; ++r) { const int orow = crow(r, hi);
#pragma unroll
      for (int d0 = 0; d0 < 4; ++d0) { const unsigned pk = cvtpk(o[d0][r] * rli[r], 0.f); stg[orow * 128 + d0 * 32 + r32] = (bf16_t)(pk & 0xffffu); } }
    asm volatile("s_waitcnt lgkmcnt(0)" ::: "memory");
    bf16_t* Ow = Ob + (long)(wid * QBLK) * LDO;
#pragma unroll
    for (int i = 0; i < 8; ++i) { const int row = i * 4 + (lane >> 4), ch = lane & 15; const u32x4 v = *(const u32x4*)(stg + row * 128 + ch * 8); *(u32x4*)(Ow + (long)row * LDO + ch * 8) = v; } }
  __syncthreads();
#undef TROW
#undef SLOAD
#undef SWRITE
#undef RESC
}
#undef KSWZ
#undef SBAR
}
constexpr int NWAVES = 8;
#ifndef MK_SPLIT
#define MK_SPLIT 0
#endif

constexpr int DM = 1024, NB = 8, SL = 2048, CL = 256, MLAT = NB * SL, MCTX = NB * CL, MT = MLAT + MCTX;
constexpr int NIN = 2048;
constexpr int FF = 2816, NUP = 2 * FF;
constexpr int NPH = 20;
constexpr float EPS = 1e-6f;

constexpr size_t MiB = 1u << 20;
constexpr size_t WS_CTL = 0, CTL_ZERO_BYTES = 64 * 1024;
constexpr size_t WS_MOD = 1 * MiB;
constexpr size_t WS_ROPE = 1 * MiB + 512 * 1024;
constexpr size_t WS_SSQ = 2 * MiB;
constexpr int NWIN = 2304;
constexpr size_t WS_WIN = 53 * MiB, WIN_STRIDE = (size_t)NWIN * DM * 2;
constexpr size_t WS_WQKV = 12 * MiB, WQKV_STRIDE = (size_t)1792 * 384 * 2;
constexpr size_t WS_WOUT = 15 * MiB, WOUT_STRIDE = (size_t)DM * DM * 2;
constexpr size_t WS_WUP = 19 * MiB, WUP_STRIDE = (size_t)NUP * DM * 2;
constexpr size_t WS_WDOWN = 41 * MiB, WDOWN_STRIDE = (size_t)DM * FF * 2;
constexpr size_t WS_DFT = 52 * MiB;
constexpr size_t WS_DFTC = 68 * MiB;
constexpr size_t WS_CST = 68 * MiB + 256 * 1024;
constexpr size_t WS_WF = 248 * MiB;
constexpr size_t WS_XCTX = 69 * MiB;
constexpr size_t WS_XN = 77 * MiB;
constexpr size_t WS_Q = WS_XN, WS_YC = WS_XN + 27 * MiB;
constexpr size_t WS_P = 113 * MiB;
constexpr size_t WS_YCAT = WS_P, WS_ACT = WS_P;
constexpr size_t WS_YFP = WS_P + 36 * MiB;
constexpr size_t WS_K = 185 * MiB;
constexpr size_t WS_V = 212 * MiB;
constexpr size_t WS_CPART = 212 * MiB;
constexpr size_t WS_ZT = 230 * MiB;
constexpr size_t WS_ZTC = WS_ZT + 16 * MiB;
constexpr size_t WS_YF = WS_ZT;
constexpr size_t WS_FTAB = WS_DFT;
constexpr size_t OUT_ATT = 36 * MiB;
constexpr size_t WS_SSX = 250 * MiB;
constexpr size_t WS_PB = 252 * MiB;
constexpr size_t WS_UB = 253 * MiB;
constexpr size_t WS_END = 254 * MiB;
static_assert(WS_WQKV + 2 * WQKV_STRIDE <= WS_WOUT && WS_WOUT + 2 * WOUT_STRIDE <= WS_WUP && WS_WUP + 2 * WUP_STRIDE <= WS_WDOWN && WS_WDOWN + 2 * WDOWN_STRIDE <= WS_DFT, "weights map");
static_assert(WS_WIN + 2 * WIN_STRIDE <= 68 * MiB && WS_SSQ + (size_t)MT * 80 <= 4 * MiB && WS_XN + (size_t)MT * DM * 2 <= WS_P && WS_P + (size_t)MT * NIN * 2 <= WS_K && WS_K + (size_t)MT * 768 * 2 <= WS_V && WS_V + (size_t)MT * 512 * 2 <= WS_ZT, "activation map");
static_assert(WS_ACT + (size_t)MT * FF * 2 <= WS_V && WS_YC + (size_t)MT * 256 * 2 <= WS_P, "overlay map");
constexpr int CW_BAR = 4096;

constexpr int RING_OFF = 0, RING_BYTES = 131072;
constexpr int LDSCTL_OFF = RING_BYTES, MISC_OFF = LDSCTL_OFF + 320, PTR_OFF = LDSCTL_OFF + 512, EPIX_OFF = LDSCTL_OFF + 1024;
constexpr int LDS_BYTES = 163840;
static_assert(EPIX_OFF + 6400 * 4 <= LDS_BYTES, "LDS map");

#define GAS __attribute__((address_space(1)))
#define LAS __attribute__((address_space(3)))
typedef unsigned short bf16;
typedef unsigned v4u __attribute__((ext_vector_type(4)));
typedef unsigned v2u __attribute__((ext_vector_type(2)));
typedef float f32x4 __attribute__((ext_vector_type(4)));
typedef GAS unsigned gu32;
#define RLX_AGENT __ATOMIC_RELAXED, __HIP_MEMORY_SCOPE_AGENT
#define LDS_WAIT() asm volatile("s_waitcnt lgkmcnt(0)" ::: "memory")
#define VM_WAIT() asm volatile("s_waitcnt vmcnt(0)" ::: "memory")
__device__ __forceinline__ unsigned f2bf(float f) { unsigned u = __builtin_bit_cast(unsigned, f); return (u + 0x7fffu + ((u >> 16) & 1u)) >> 16; }
__device__ __forceinline__ unsigned pk2(float lo, float hi) { return f2bf(lo) | (f2bf(hi) << 16); }
__device__ __forceinline__ float bf2f(unsigned h) { return __builtin_bit_cast(float, h << 16); }

#define XB_TMO      128
#define XB_XCNT(j)  (256  + 64 * (j))
#define XB_XSUB(j)  (1280 + 64 * (j))
#define XB_XGEN(j)  (2304 + 64 * (j))
#define XB_TOP      3328
#define XB_TOPGEN   3392
#define XCD_BAR_WORDS 3456
#define XB_SPIN_CAP (1u << 20)
__device__ __forceinline__ unsigned xb_ld(unsigned* p)              { return __hip_atomic_load(p, __ATOMIC_RELAXED, __HIP_MEMORY_SCOPE_AGENT); }
__device__ __forceinline__ unsigned xb_add(unsigned* p, unsigned v) { return __hip_atomic_fetch_add(p, v, __ATOMIC_RELAXED, __HIP_MEMORY_SCOPE_AGENT); }
__device__ __forceinline__ unsigned xb_xcc_id() { return (unsigned)__builtin_amdgcn_s_getreg((3 << 11) | 20) & 0xFu; }
#define XB_SPIN(cond, bar) do { unsigned _sp = 0; while (cond) { __builtin_amdgcn_s_sleep(1); \
    if ((++_sp & 255u) == 0u) { if (xb_ld(&(bar)[XB_TMO])) break; if (_sp > XB_SPIN_CAP) { atomicAdd(&(bar)[XB_TMO], 1u); break; } } } } while (0)
struct XcdBarrier { unsigned* bar; unsigned x; volatile LAS unsigned* st; };
__device__ __forceinline__ XcdBarrier xcd_barrier_post(unsigned* bar, volatile LAS unsigned* st) {
    XcdBarrier b; b.bar = bar; b.x = xb_xcc_id(); b.st = st;
    if (threadIdx.x == 0) (void)xb_add(&bar[XB_XCNT(b.x)], 1u);
    return b;
}
__device__ __forceinline__ void xcd_barrier_complete(unsigned* bar, unsigned x, unsigned& nloc, unsigned& nx) {
    const unsigned G = gridDim.x * gridDim.y * gridDim.z;
    unsigned sum, cnt, mine, sp = 0u;
    for (;;) {
        sum = 0u; cnt = 0u; mine = 0u;
#pragma unroll
        for (unsigned j = 0; j < 16; ++j) { const unsigned c = xb_ld(&bar[XB_XCNT(j)]); sum += c; cnt += (c > 0u) ? 1u : 0u; mine = (j == x) ? c : mine; }
        if (sum == G) break;
        __builtin_amdgcn_s_sleep(1);
        if ((++sp & 255u) == 0u) { if (xb_ld(&bar[XB_TMO])) break; if (sp > XB_SPIN_CAP) { atomicAdd(&bar[XB_TMO], 1u); break; } }
    }
    nloc = mine > 0u ? mine : 1u; nx = cnt > 0u ? cnt : 1u;
}
__device__ __forceinline__ void xcd_barrier(const XcdBarrier& b) {
    asm volatile("s_waitcnt vmcnt(0)" ::: "memory");
    __syncthreads();
    if (threadIdx.x == 0) {
        unsigned* bar = b.bar;
        __builtin_amdgcn_s_waitcnt(0);
        unsigned nloc = b.st[0], nx = b.st[1];
        if (nloc == 0u) { xcd_barrier_complete(bar, b.x, nloc, nx); b.st[0] = nloc; b.st[1] = nx; }
        const unsigned old = xb_add(&bar[XB_XSUB(b.x)], 1u);
        const unsigned gen = old / nloc;
        if (old + 1u == (gen + 1u) * nloc) {
            __builtin_amdgcn_fence(__ATOMIC_RELEASE, "agent");
            asm volatile("s_waitcnt vmcnt(0)" ::: "memory");
            const unsigned og = xb_add(&bar[XB_TOP], 1u);
            const unsigned tg = og / nx;
            if (og + 1u == (tg + 1u) * nx) xb_add(&bar[XB_TOPGEN], 1u);
            else XB_SPIN(xb_ld(&bar[XB_TOPGEN]) == tg, bar);
            __builtin_amdgcn_fence(__ATOMIC_ACQUIRE, "agent");
            xb_add(&bar[XB_XGEN(b.x)], 1u);
            asm volatile("s_waitcnt vmcnt(0)" ::: "memory");
        } else {
            XB_SPIN(xb_ld(&bar[XB_XGEN(b.x)]) == gen, bar);
            __builtin_amdgcn_fence(__ATOMIC_ACQUIRE, "agent");
            asm volatile("s_waitcnt vmcnt(0)" ::: "memory");
        }
    }
    __syncthreads();
}

struct Args { const float* in[22]; float* out; unsigned char* ws; int ph_lo, ph_hi; };
enum { I_X = 0, I_C, I_CTX, I_CCTX, I_ADAW, I_ADAB, I_N1G, I_WIN, I_QNG, I_KVNG, I_WUQ, I_WUKV, I_SCW, I_SCB, I_ONG, I_WOUT, I_N2G, I_WUP, I_FCW, I_FCB, I_WDOWN, I_FING };

struct Frame {
    LAS unsigned char* lds; char* ldsg;
    volatile LAS unsigned* MISC;
    int tid, lane, wave, vcu, G, bx;
    unsigned char* ws; float* out;
};

__device__ __forceinline__ const float* inptr(const Frame& F, int i) {
    const LAS unsigned* T = (const LAS unsigned*)(F.lds + PTR_OFF) + 2 * i;
    const unsigned lo = __builtin_amdgcn_readfirstlane(T[0]), hi = __builtin_amdgcn_readfirstlane(T[1]);
    return (const float*)(const GAS float*)(((unsigned long long)hi << 32) | (unsigned long long)lo);
}
__device__ __forceinline__ float wave_sum(float v) {
#pragma unroll
    for (int o = 1; o < 64; o <<= 1) v += __shfl_xor(v, o);
    return v;
}

__device__ __host__ __forceinline__ int rope_slot(int d) { return 8 * ((d & 15) >> 2) + 4 * (d >> 4) + (d & 3); }
__device__ __forceinline__ void tr_item(const float* W, int ldw, int k0, int c0, bf16* WT, int ldt, int r0, const float* ks, LAS float* scr, int lane, bool ropeperm = false) {
    f32x4 v[8];
#pragma unroll
    for (int i = 0; i < 8; ++i) { const int kk = 8 * i + (lane >> 3); v[i] = *(const GAS f32x4*)(W + (size_t)(k0 + kk) * ldw + c0 + 4 * (lane & 7)); }
#pragma unroll
    for (int i = 0; i < 8; ++i) { const int kk = 8 * i + (lane >> 3); const float sc = ks ? ks[k0 + kk] : 1.0f; LAS float* d = scr + kk * 33 + 4 * (lane & 7);
        d[0] = v[i][0] * sc; d[1] = v[i][1] * sc; d[2] = v[i][2] * sc; d[3] = v[i][3] * sc; }
    LDS_WAIT(); asm volatile("" ::: "memory");
    const int c = lane & 7;
#pragma unroll
    for (int j = 0; j < 4; ++j) { const int n = (lane >> 3) + 8 * j; const LAS float* s = scr + (8 * c) * 33 + n;
        v4u o; o.x = pk2(s[0 * 33], s[1 * 33]); o.y = pk2(s[2 * 33], s[3 * 33]); o.z = pk2(s[4 * 33], s[5 * 33]); o.w = pk2(s[6 * 33], s[7 * 33]);
        *(GAS v4u*)(WT + (size_t)(r0 + (ropeperm ? rope_slot(n) : n)) * ldt + k0 + 8 * c) = o; }
    LDS_WAIT(); asm volatile("" ::: "memory");
}
__device__ __forceinline__ void p0_prologue(Frame& F, int sub, int defer, int gw, int NGW) {
    unsigned char* ws = F.ws;
    float* MOD = (float*)(ws + WS_MOD);
    if (F.bx < 192 && (sub & 1) && defer == 0) {
        const int l = F.bx / 96, cb = F.bx % 96;
        LAS float* S = (LAS float*)(F.lds + F.wave * 4608);
        const float* cin = inptr(F, I_C); const float* cctx = inptr(F, I_CCTX);
        for (int i = F.lane; i < 9 * 128; i += 64) { const int r = i >> 7, kk = i & 127, k = 128 * F.wave + kk; const float cv = (r < 8) ? cin[r * 1024 + k] : cctx[k]; S[i] = cv / (1.0f + __expf(-cv)); }
        LDS_WAIT(); asm volatile("" ::: "memory");
        f32x4 acc[9];
#pragma unroll
        for (int r = 0; r < 9; ++r) acc[r] = (f32x4){0.f, 0.f, 0.f, 0.f};
        const int kr = F.lane >> 4, cl = F.lane & 15;
        const float* W = inptr(F, I_ADAW) + (size_t)l * 1024 * 6144 + (size_t)(128 * F.wave) * 6144 + 64 * cb + 4 * cl;
#pragma unroll 8
        for (int i = 0; i < 32; ++i) { const int kk = 4 * i + kr; const f32x4 w = __builtin_nontemporal_load((const f32x4*)(W + (size_t)kk * 6144));
#pragma unroll
            for (int r = 0; r < 9; ++r) acc[r] += w * S[r * 128 + kk]; }
        LAS float* RED = (LAS float*)(F.lds + 40960);
#pragma unroll
        for (int r = 0; r < 9; ++r)
#pragma unroll
            for (int e = 0; e < 4; ++e) { float v = acc[r][e]; v += __shfl_xor(v, 16); v += __shfl_xor(v, 32); if (kr == 0) RED[(F.wave * 9 + r) * 64 + 4 * cl + e] = v; }
        __syncthreads();
        for (int i = F.tid; i < 576; i += 512) { const int r = i >> 6, col = i & 63; float s = 0.f;
#pragma unroll
            for (int w = 0; w < 8; ++w) s += RED[(w * 9 + r) * 64 + col];
            MOD[(size_t)(l * 9 + r) * 6144 + 64 * cb + col] = s + inptr(F, I_ADAB)[l * 6144 + 64 * cb + col]; }
        __syncthreads();
    }
    if (F.bx == 255 % F.G && defer == 0) {
        float* RC = (float*)(ws + WS_ROPE); float* RS = RC + 1024;
        for (int idx = F.tid; idx < 1024; idx += 512) { const int pos = idx >> 4, i = idx & 15; const float inv = powf(10000.0f, -(float)(2 * i) / 32.0f); const float ang = (float)pos * inv; RC[idx] = cosf(ang); RS[idx] = sinf(ang); }
    }
    LAS float* scr = (LAS float*)(F.lds + F.wave * 16384);
    constexpr int I_WINA = 22 * 16, I_WINB = 24 * 16, I_WINC = 8 * 16, I_PAD = 8, I_FOLD = 64, I_UQ = 6 * 24, I_UKV = 4 * 32, I_OUT = 16 * 32, I_UP = 16 * 176, I_DOWN = 44 * 32;
    constexpr int PER_LAYER = I_WINA + I_WINB + I_WINC + I_PAD + I_FOLD + I_UQ + I_UKV + I_OUT + I_UP + I_DOWN;
    constexpr int I_DFT = 352, I_DFTC = 256, I_CST = 512;
    constexpr int NITEMS = 2 * PER_LAYER + I_DFT + I_DFTC + I_CST;
    for (int it = gw; it < NITEMS; it += NGW) {
        int r = it;
        { int cat = 2; bool early = false; if (r < 2 * PER_LAYER) { const int q = r % PER_LAYER;
              constexpr int W0 = I_WINA + I_WINB + I_WINC + I_PAD; early = r < PER_LAYER && q >= W0 + I_FOLD && q < W0 + I_FOLD + I_UQ + I_UKV;
              cat = q < W0 ? 1 : q < W0 + I_FOLD ? 3 : q < W0 + I_FOLD + I_UQ + I_UKV + I_OUT ? 4 : q < PER_LAYER - I_DOWN ? 5 : 6; }
          if (!((sub >> cat) & 1)) continue;
          const int dcls = (r < 2 * PER_LAYER && cat >= 4 && !early) ? ((r < PER_LAYER && cat < 6) ? 1 : 2) : 0; if (dcls != defer) continue; }
        if (r < 2 * PER_LAYER) {
            const int l = r / PER_LAYER; r -= l * PER_LAYER;
            bf16* WinT = (bf16*)(ws + WS_WIN + l * WIN_STRIDE);
            const float* win = inptr(F, I_WIN) + (size_t)l * 1024 * 1728;
            if (r < I_WINA) { const int kb = r / 22, nb = r % 22; tr_item(win, 1728, 64 * kb, 32 * nb, WinT, 1024, 32 * nb, nullptr, scr, F.lane); continue; } r -= I_WINA;
            if (r < I_WINB) { const int kb = r / 24, nb = r % 24; tr_item(win, 1728, 64 * kb, 960 + 32 * nb, WinT, 1024, 1280 + 32 * nb, nullptr, scr, F.lane); continue; } r -= I_WINB;
            if (r < I_WINC) { const int kb = r / 8, nb = r % 8; tr_item(win, 1728, 64 * kb, 704 + 32 * nb, WinT, 1024, 2048 + 32 * nb, nullptr, scr, F.lane); continue; } r -= I_WINC;
            if (r < I_PAD) { const v4u z = {0u, 0u, 0u, 0u};
#pragma unroll
                for (int j = 0; j < 16; ++j) { const int q = j * 64 + F.lane; *(GAS v4u*)(WinT + (size_t)(704 + 8 * r + (q >> 7)) * 1024 + (q & 127) * 8) = z; } continue; } r -= I_PAD;
            if (r < I_FOLD) { bf16* WF = (bf16*)(ws + WS_WF) + (size_t)l * 1024 * 256;
#pragma unroll 4
                for (int i = 0; i < 16; ++i) { const int k = 16 * r + i; const f32x4 v = *(const GAS f32x4*)(win + (size_t)k * 1728 + 704 + 4 * F.lane);
                    v2u o; o.x = pk2(v[0], v[1]); o.y = pk2(v[2], v[3]); *(GAS v2u*)(WF + (size_t)k * 256 + 4 * F.lane) = o; } continue; } r -= I_FOLD;
            if (r < I_UQ) { const int kb = r / 24, nb = r % 24; tr_item(inptr(F, I_WUQ) + (size_t)l * 384 * 768, 768, 64 * kb, 32 * nb, (bf16*)(ws + WS_WQKV + l * WQKV_STRIDE), 384, 32 * nb, inptr(F, I_QNG) + l * 384, scr, F.lane, (nb % 6) >= 4); continue; } r -= I_UQ;
            if (r < I_UKV) { const int kb = r / 32, nb = r % 32; tr_item(inptr(F, I_WUKV) + (size_t)l * 256 * 1024, 1024, 64 * kb, 32 * nb, (bf16*)(ws + WS_WQKV + l * WQKV_STRIDE) + (size_t)768 * 384, 384, 32 * nb, inptr(F, I_KVNG) + l * 256, scr, F.lane); continue; } r -= I_UKV;
            if (r < I_OUT) { const int kb = r / 32, nb = r % 32; tr_item(inptr(F, I_WOUT) + (size_t)l * 1024 * 1024, 1024, 64 * kb, 32 * nb, (bf16*)(ws + WS_WOUT + l * WOUT_STRIDE), 1024, 32 * nb, inptr(F, I_ONG) + l * 1024, scr, F.lane); continue; } r -= I_OUT;
            if (r < I_UP) { const int kb = r / 176, nb = r % 176;
                const int j = nb >> 3, h = (nb >> 2) & 1, q = nb & 3;
                tr_item(inptr(F, I_WUP) + (size_t)l * 1024 * NUP, NUP, 64 * kb, h * FF + 128 * j + 32 * q, (bf16*)(ws + WS_WUP + l * WUP_STRIDE), 1024, 32 * nb, nullptr, scr, F.lane); continue; } r -= I_UP;
            { const int kb = r / 32, nb = r % 32; tr_item(inptr(F, I_WDOWN) + (size_t)l * FF * 1024, 1024, 64 * kb, 32 * nb, (bf16*)(ws + WS_WDOWN + l * WDOWN_STRIDE), FF, 32 * nb, nullptr, scr, F.lane); continue; }
        }
        r -= 2 * PER_LAYER;
        if (r < I_DFT) {
            if (r < 128) { const int ro = r >> 6, c = r & 63; bf16* D = (bf16*)(ws + WS_FTAB) + (size_t)r * 128; float v[2];
#pragma unroll
                for (int e = 0; e < 2; ++e) { const int k = 2 * F.lane + e, ri = k >> 6, s = k & 63; const float x = (float)((c * s) & 63) * (1.0f / 32.0f); const float C = cospif(x), S = sinpif(x);
                    v[e] = (ro == ri) ? C : (ro == 0 ? -S : S); }
                *(GAS unsigned*)(D + 2 * F.lane) = pk2(v[0], v[1]); continue; }
            if (r < 160) { const int a = r - 128, ro = F.lane >> 5, rr = F.lane & 31; const float x = (float)((a * rr) & 31) * (1.0f / 16.0f); const float v = ro ? -sinpif(x) : cospif(x);
                *(GAS unsigned short*)((bf16*)(ws + WS_FTAB + 32768) + (size_t)a * 64 + F.lane) = (unsigned short)(pk2(v, 0.f) & 0xffffu); continue; }
            if (r >= 224) { const int rr = r - 224, kb = rr >> 4, col = rr & 15, ri = col >> 3, k2 = 8 * kb + (col & 7);
                const float x = (float)((k2 * F.lane) & 63) * (1.0f / 32.0f); const float v = ri ? sinpif(x) : cospif(x);
                *(GAS unsigned short*)((bf16*)(ws + WS_FTAB + 65536) + (size_t)rr * 64 + F.lane) = (unsigned short)(pk2(v, 0.f) & 0xffffu); continue; }
            { const int c = r - 160; if (F.lane < 32) { const float x = (float)(c * F.lane) * (1.0f / 1024.0f); pg8::f32x2 t; t.x = cospif(x); t.y = sinpif(x);
                *(GAS pg8::f32x2*)((float*)(ws + WS_FTAB + 40960) + (size_t)(c * 32 + F.lane) * 2) = t; } }
            continue; }
        r -= I_DFT;
        if (r >= I_DFTC) { r -= I_DFTC;
            const int sn = r >> 8, g = (r >> 6) & 3, k2 = r & 63; float v[4];
#pragma unroll
            for (int e = 0; e < 4; ++e) { const int j = 4 * F.lane + e; const float x = (float)((k2 * (j & 63)) & 63) * (1.0f / 32.0f); v[e] = ((j >> 6) == g) ? (sn ? sinpif(x) : cospif(x)) : 0.0f; }
            v2u o; o.x = pk2(v[0], v[1]); o.y = pk2(v[2], v[3]); *(GAS v2u*)((bf16*)(ws + WS_CST) + (size_t)r * 256 + 4 * F.lane) = o; continue; }
        { const int k1 = r; bf16* D = (bf16*)(ws + WS_DFTC) + (size_t)k1 * 512; const int n0 = 8 * F.lane; float v[8];
#pragma unroll
            for (int e = 0; e < 8; ++e) { const int n = n0 + e, n1 = n & 255; const float x = (float)((k1 * n1) & 255) * (1.0f / 128.0f); v[e] = (n < 256) ? cospif(x) : -sinpif(x); }
            v4u o; o.x = pk2(v[0], v[1]); o.y = pk2(v[2], v[3]); o.z = pk2(v[4], v[5]); o.w = pk2(v[6], v[7]); *(GAS v4u*)(D + n0) = o; }
    }
}

__device__ __forceinline__ void bias_section(Frame& F, const bf16* WT, int nrows, const float* mod, int shofs, float* out, int gw, int NGW) {
    constexpr int RS = 2064, LO = 16 * RS;
    LAS unsigned char* SH = F.lds;
    __syncthreads();
    for (int i = F.tid; i < 16 * 256; i += NWAVES * 64) { const int bb = i >> 8, k4 = i & 255;
        f32x4 v = (f32x4){0.f, 0.f, 0.f, 0.f}; if (bb < 9) v = *(const GAS f32x4*)(mod + bb * 6144 + shofs + 4 * k4);
        const unsigned h0 = f2bf(v[0]), h1 = f2bf(v[1]), h2 = f2bf(v[2]), h3 = f2bf(v[3]);
        v2u hv, lv; hv.x = h0 | (h1 << 16); hv.y = h2 | (h3 << 16); lv.x = pk2(v[0] - bf2f(h0), v[1] - bf2f(h1)); lv.y = pk2(v[2] - bf2f(h2), v[3] - bf2f(h3));
        *(LAS v2u*)(SH + bb * RS + 8 * k4) = hv; *(LAS v2u*)(SH + LO + bb * RS + 8 * k4) = lv; }
    __syncthreads();
    const int l15 = F.lane & 15, lq = F.lane >> 4;
    const LAS unsigned char* shp = SH + l15 * RS + 16 * lq;
    for (int ps = gw; ps < (nrows >> 4); ps += NGW) { const int n0 = 16 * ps;
        f32x4 d = (f32x4){0.f, 0.f, 0.f, 0.f};
        const bf16* wrow = WT + (size_t)(n0 + l15) * 1024 + 8 * lq;
#pragma unroll 1
        for (int kb = 0; kb < 4; ++kb) { pg8::bf16x8 wv[8];
#pragma unroll
            for (int j = 0; j < 8; ++j) wv[j] = *(const GAS pg8::bf16x8*)(wrow + 32 * (8 * kb + j));
#pragma unroll
            for (int j = 0; j < 8; ++j) { const int ks = 8 * kb + j;
                const pg8::bf16x8 sh = *(const LAS pg8::bf16x8*)(shp + 64 * ks), sl = *(const LAS pg8::bf16x8*)(shp + LO + 64 * ks);
                d = __builtin_amdgcn_mfma_f32_16x16x32_bf16(wv[j], sh, d, 0, 0, 0); d = __builtin_amdgcn_mfma_f32_16x16x32_bf16(wv[j], sl, d, 0, 0, 0); } }
        if (l15 < 9) {
#pragma unroll
            for (int i = 0; i < 4; ++i) out[(size_t)l15 * nrows + n0 + 4 * lq + i] = d[i]; }
    }
    __syncthreads();
}
__device__ __forceinline__ void bias_phase(Frame& F, int which, int gw, int NGW) {
    const float* MODp = (const float*)(F.ws + WS_MOD);
    if (which & 1) bias_section(F, (const bf16*)(F.ws + WS_WIN + WIN_STRIDE), NWIN, MODp + 9 * 6144, 0, (float*)(F.ws + WS_PB) + 9 * NWIN, gw, NGW);
    if (which & 2) bias_section(F, (const bf16*)(F.ws + WS_WUP), 5632, MODp, 3072, (float*)(F.ws + WS_UB), gw, NGW);
    if (which & 4) bias_section(F, (const bf16*)(F.ws + WS_WUP + WUP_STRIDE), 5632, MODp + 9 * 6144, 3072, (float*)(F.ws + WS_UB) + (size_t)9 * 5632, gw, NGW);
}

__device__ __forceinline__ void norm_mod_phase(Frame& F, const float* src_lat, const float* src_ctx, int nrows, const float* g, const float* mod  , int shofs, int scofs, int skip) {
    bf16* XN = (bf16*)(F.ws + WS_XN);
    if (F.bx < skip) return;
    const int gw = (F.bx - skip) * NWAVES + F.wave, NGW = (F.G - skip) * NWAVES;
    constexpr int R = 2;
    f32x4 v[R][4], w[R][4];
#define NM_LOAD(dst, r0_) do { _Pragma("unroll") for (int q = 0; q < R; ++q) { const int row = (r0_) + q * NGW; if (row < nrows) { const float* xr = row < MLAT ? src_lat + (size_t)row * DM : src_ctx + (size_t)(row - MLAT) * DM; \
        _Pragma("unroll") for (int j = 0; j < 4; ++j) dst[q][j] = *(const f32x4*)(xr + 256 * j + 4 * F.lane); } } } while (0)
    NM_LOAD(v, gw);
    for (int row0 = gw; row0 < nrows; row0 += R * NGW) {
        NM_LOAD(w, row0 + R * NGW);
#pragma unroll
        for (int q = 0; q < R; ++q) { const int row = row0 + q * NGW; if (row < nrows) {
            const int r = row < MLAT ? (row >> 11) : 8;
            const float* sh = mod + r * 6144 + shofs; const float* sc = mod + r * 6144 + scofs; float ss = 0.f;
#pragma unroll
            for (int j = 0; j < 4; ++j) ss += (v[q][j][0] * v[q][j][0] + v[q][j][1] * v[q][j][1]) + (v[q][j][2] * v[q][j][2] + v[q][j][3] * v[q][j][3]);
            const float rstd = 1.0f / sqrtf(wave_sum(ss) * (1.0f / DM) + EPS);
#pragma unroll
            for (int j = 0; j < 4; ++j) { const int c = 256 * j + 4 * F.lane; const f32x4 gg = *(const f32x4*)(g + c), s1 = *(const f32x4*)(sc + c), s0 = *(const f32x4*)(sh + c);
                const f32x4 h = (v[q][j] * rstd) * gg * (s1 + 1.0f) + s0;
                v2u o; o.x = pk2(h[0], h[1]); o.y = pk2(h[2], h[3]); *(GAS v2u*)(XN + (size_t)row * DM + c) = o; } } }
#pragma unroll
        for (int q = 0; q < R; ++q)
#pragma unroll
            for (int j = 0; j < 4; ++j) v[q][j] = w[q][j];
    }
#undef NM_LOAD
}
__device__ __forceinline__ void qkv_rows_phase(Frame& F, int l) {
    const bf16* P = (const bf16*)(F.ws + WS_P); bf16* Kb = (bf16*)(F.ws + WS_K); bf16* YC = (bf16*)F.out + (size_t)MT * 768;
    const float* RC = (const float*)(F.ws + WS_ROPE); const float* RS = RC + 1024;
    const float* scw = inptr(F, I_SCW) + l * 3 * 256; const float* scb = inptr(F, I_SCB) + l * 256;
    const int gw = F.vcu * NWAVES + F.wave, NGW = F.G * NWAVES;
    const int nrows_conv = (l == 0) ? MT : MLAT;
    for (int row = gw; row < MT; row += NGW) {
        const bool lat = row < MLAT; const int t = lat ? (row & 2047) : ((row - MLAT) & 255); const int L = lat ? SL : CL;
        const bf16* pr = P + (size_t)row * NIN;
        { const float v = bf2f(pr[640 + F.lane]); const float pv = __shfl_xor(v, 16); float o = v;
          if (lat) { const int j = F.lane, ax = j >> 5, i = j & 15, x2 = (j >> 4) & 1; const int pos = ax ? (t & 63) : (t >> 6); const float c = RC[pos * 16 + i], s = RS[pos * 16 + i];
              o = x2 ? (pv * s + v * c) : (v * c - pv * s); }
          const bf16 ob = (bf16)f2bf(o);
          const int slot = (F.lane & 32) + rope_slot(F.lane & 31);
#pragma unroll
          for (int h = 0; h < 4; ++h) Kb[(size_t)row * 768 + 192 * h + 128 + slot] = ob; }
        if (row < nrows_conv) { const int c = 4 * F.lane;
            const v2u bgv = *(const GAS v2u*)(pr + 1280 + c);
            const v2u cg1 = *(const GAS v2u*)(pr + 1536 + c), xv1 = *(const GAS v2u*)(pr + 1792 + c);
            v2u cg0 = {0u, 0u}, xv0 = {0u, 0u}, cg2 = {0u, 0u}, xv2 = {0u, 0u};
            if (t > 0) { cg0 = *(const GAS v2u*)(pr - NIN + 1536 + c); xv0 = *(const GAS v2u*)(pr - NIN + 1792 + c); }
            if (t < L - 1) { cg2 = *(const GAS v2u*)(pr + NIN + 1536 + c); xv2 = *(const GAS v2u*)(pr + NIN + 1792 + c); }
            const f32x4 w0 = *(const f32x4*)(scw + c), w1 = *(const f32x4*)(scw + 256 + c), w2 = *(const f32x4*)(scw + 512 + c), bb = *(const f32x4*)(scb + c);
            float y[4];
#pragma unroll
            for (int e = 0; e < 4; ++e) { const unsigned sh = (e & 1) * 16; const unsigned m = 0xffffu;
                const unsigned b_ = ((e < 2 ? bgv.x : bgv.y) >> sh) & m;
                const unsigned c0_ = ((e < 2 ? cg0.x : cg0.y) >> sh) & m, x0_ = ((e < 2 ? xv0.x : xv0.y) >> sh) & m;
                const unsigned c1_ = ((e < 2 ? cg1.x : cg1.y) >> sh) & m, x1_ = ((e < 2 ? xv1.x : xv1.y) >> sh) & m;
                const unsigned c2_ = ((e < 2 ? cg2.x : cg2.y) >> sh) & m, x2_ = ((e < 2 ? xv2.x : xv2.y) >> sh) & m;
                const float u0 = bf2f(c0_) * bf2f(x0_), u1 = bf2f(c1_) * bf2f(x1_), u2 = bf2f(c2_) * bf2f(x2_);
                y[e] = bf2f(b_) * (w0[e] * u0 + w1[e] * u1 + w2[e] * u2 + bb[e]); }
            v2u o; o.x = pk2(y[0], y[1]); o.y = pk2(y[2], y[3]); *(GAS v2u*)(YC + (size_t)row * 256 + c) = o; }
    }
}
__device__ __forceinline__ void fnet_fft_unit(Frame& F, int b, int jb) {
    int tid = threadIdx.x; asm volatile("" : "+v"(tid));
    const int w = tid >> 6, l = tid & 63, l15 = l & 15, lq = l >> 4;
    const bf16* P = (const bf16*)(F.ws + WS_P); bf16* YF = (bf16*)(F.ws + WS_YF);
    const bf16* A1g = (const bf16*)(F.ws + WS_FTAB); const bf16* W2g = (const bf16*)(F.ws + WS_FTAB + 32768); const float* TWg = (const float*)(F.ws + WS_FTAB + 40960);
    LAS unsigned char* B1 = F.lds; LAS unsigned char* A1 = F.lds + 69632; LAS unsigned char* TW = F.lds + 104448;
    {
        const int g = jb >> 3, kb = jb & 7;
        const bf16* CTg = (const bf16*)(F.ws + WS_FTAB + 65536) + kb * 1024;
        const pg8::bf16x8 ct0 = *(const GAS pg8::bf16x8*)(CTg + l15 * 64 + 8 * lq), ct1 = *(const GAS pg8::bf16x8*)(CTg + l15 * 64 + 32 + 8 * lq);
#pragma unroll
        for (int i = 0; i < 4; ++i) { const int idx = tid + 512 * i, row = idx >> 4, ch = idx & 15; const v4u v = *(const GAS v4u*)(A1g + row * 128 + ch * 8); *(LAS v4u*)(A1 + row * 272 + ch * 16) = v; }
#pragma unroll
        for (int i = 0; i < 2; ++i) { const int idx = tid + 512 * i; const v4u v = *(const GAS v4u*)(TWg + idx * 4); *(LAS v4u*)(TW + idx * 16) = v; }
#pragma unroll
        for (int hb = 0; hb < 2; ++hb) {
            pg8::bf16x8 uf[8][2];
#pragma unroll
            for (int q = 0; q < 8; ++q) { const int blk = w * 16 + hb * 8 + q; const bf16* src = P + (size_t)(b * SL + 16 * blk + l15) * NIN + 768 + 64 * g + 8 * lq;
                uf[q][0] = *(const GAS pg8::bf16x8*)src; uf[q][1] = *(const GAS pg8::bf16x8*)(src + 32); }
#pragma unroll
            for (int q = 0; q < 8; ++q) { const int blk = w * 16 + hb * 8 + q;
                f32x4 d = (f32x4){0.f, 0.f, 0.f, 0.f};
                d = __builtin_amdgcn_mfma_f32_16x16x32_bf16(ct0, uf[q][0], d, 0, 0, 0); d = __builtin_amdgcn_mfma_f32_16x16x32_bf16(ct1, uf[q][1], d, 0, 0, 0);
                const int r = 16 * (blk & 1) + l15, s = blk >> 1;
                LAS unsigned char* dst = B1 + (32 * 4 * (lq & 1) + r) * 272 + (64 * (lq >> 1) + s) * 2;
                const unsigned p01 = pk2(d[0], d[1]), p23 = pk2(d[2], d[3]);
                *(LAS unsigned short*)(dst + 0 * 8704) = (unsigned short)(p01 & 0xffffu); *(LAS unsigned short*)(dst + 1 * 8704) = (unsigned short)(p01 >> 16);
                *(LAS unsigned short*)(dst + 2 * 8704) = (unsigned short)(p23 & 0xffffu); *(LAS unsigned short*)(dst + 3 * 8704) = (unsigned short)(p23 >> 16); } } }
    pg8::bf16x8 w2[2][2];
#pragma unroll
    for (int ab = 0; ab < 2; ++ab)
#pragma unroll
        for (int ks = 0; ks < 2; ++ks) w2[ab][ks] = *(const GAS pg8::bf16x8*)(W2g + (ab * 16 + l15) * 64 + ks * 32 + 8 * lq);
    __syncthreads();
    f32x4 acc[8][2];
#pragma unroll
    for (int mb = 0; mb < 8; ++mb) { acc[mb][0] = (f32x4){0.f, 0.f, 0.f, 0.f}; acc[mb][1] = (f32x4){0.f, 0.f, 0.f, 0.f}; }
#pragma unroll
    for (int ks = 0; ks < 4; ++ks) {
        const pg8::bf16x8 b0 = *(const LAS pg8::bf16x8*)(B1 + ((2 * w + 0) * 16 + l15) * 272 + ks * 64 + lq * 16);
        const pg8::bf16x8 b1 = *(const LAS pg8::bf16x8*)(B1 + ((2 * w + 1) * 16 + l15) * 272 + ks * 64 + lq * 16);
#pragma unroll
        for (int mb = 0; mb < 8; ++mb) { const pg8::bf16x8 af = *(const LAS pg8::bf16x8*)(A1 + (mb * 16 + l15) * 272 + ks * 64 + lq * 16);
            acc[mb][0] = __builtin_amdgcn_mfma_f32_16x16x32_bf16(af, b0, acc[mb][0], 0, 0, 0);
            acc[mb][1] = __builtin_amdgcn_mfma_f32_16x16x32_bf16(af, b1, acc[mb][1], 0, 0, 0); } }
    __syncthreads();
    LAS unsigned char* B2 = F.lds;
    {
#pragma unroll
      for (int mbp = 0; mbp < 4; ++mbp)
#pragma unroll
        for (int nbl = 0; nbl < 2; ++nbl) { const int r = 16 * nbl + l15;
#pragma unroll
            for (int i = 0; i < 4; ++i) { const int c = mbp * 16 + 4 * lq + i;
                const pg8::f32x2 t = *(const LAS pg8::f32x2*)(TW + (c * 32 + r) * 8);
                const float ar = acc[mbp][nbl][i], ai = acc[mbp + 4][nbl][i];
                const unsigned pk = pk2(ar * t.x - ai * t.y, ar * t.y + ai * t.x);
                LAS unsigned char* d = B2 + (c * 8 + w) * 144 + 2 * (l15 & 7);
                *(LAS unsigned short*)(d + (((r >> 3) ^ (2 * lq)) * 16)) = (unsigned short)(pk & 0xffffu); *(LAS unsigned short*)(d + (((4 + (r >> 3)) ^ (2 * lq)) * 16)) = (unsigned short)(pk >> 16); } } }
    __syncthreads();
    f32x4 y[4][2];
#pragma unroll
    for (int nbp = 0; nbp < 4; ++nbp) { y[nbp][0] = (f32x4){0.f, 0.f, 0.f, 0.f}; y[nbp][1] = (f32x4){0.f, 0.f, 0.f, 0.f}; }
#pragma unroll
    for (int nbp = 0; nbp < 4; ++nbp) { const int sw = 2 * ((2 * w + (nbp >> 1)) & 3);
#pragma unroll
        for (int ks = 0; ks < 2; ++ks) { const pg8::bf16x8 af = *(const LAS pg8::bf16x8*)(B2 + ((4 * w + nbp) * 16 + l15) * 144 + (((ks * 4 + lq) ^ sw) * 16));
            y[nbp][0] = __builtin_amdgcn_mfma_f32_16x16x32_bf16(af, w2[0][ks], y[nbp][0], 0, 0, 0);
            y[nbp][1] = __builtin_amdgcn_mfma_f32_16x16x32_bf16(af, w2[1][ks], y[nbp][1], 0, 0, 0); } }
    constexpr float SC = 0.0027621358640099515f;
#pragma unroll
    for (int nbp = 0; nbp < 4; ++nbp)
#pragma unroll
        for (int ab = 0; ab < 2; ++ab) { const int c = (4 * w + nbp) * 2 + (lq >> 1), a = ab * 16 + l15, p = 64 * a + c;
            v2u o; o.x = pk2(y[nbp][ab][0] * SC, y[nbp][ab][1] * SC); o.y = pk2(y[nbp][ab][2] * SC, y[nbp][ab][3] * SC);
            *(GAS v2u*)(YF + (size_t)(b * SL + p) * 256 + jb * 8 + 4 * (lq & 1)) = o; }
    __syncthreads();
}
__device__ __forceinline__ void zt_phase(Frame& F, int l) {
    const bf16* P = (const bf16*)(F.ws + WS_P);
    LAS bf16* T = (LAS bf16*)(F.lds + F.wave * 16384);
    const int gw = F.vcu * NWAVES + F.wave, NGW = F.G * NWAVES;
    const int nitems = (l == 0 ? 256 : 0);
    for (int it = gw; it < nitems; it += NGW) {
        const bool lat = false; const int r = it;
        const int pb = r >> 3, cb = r & 7;
        const int row0 = (lat ? 0 : MLAT) + 64 * pb; const int L = lat ? SL : CL;
        const int b = lat ? (pb >> 5) : (pb >> 2); const int n0 = (64 * pb) & (L - 1);
        bf16* ZT = lat ? (bf16*)(F.ws + WS_ZT) : (bf16*)(F.ws + WS_ZTC);
#pragma unroll
        for (int i = 0; i < 8; ++i) { const int pos = 8 * i + (F.lane >> 3), ch = F.lane & 7;
            const v4u v = *(const GAS v4u*)(P + (size_t)(row0 + pos) * NIN + 768 + 64 * cb + 8 * ch);
            LAS unsigned* d = (LAS unsigned*)(T + pos * 66 + 8 * ch); d[0] = v.x; d[1] = v.y; d[2] = v.z; d[3] = v.w; }
        LDS_WAIT(); asm volatile("" ::: "memory");
        const int sn = cb >> 2;
#pragma unroll
        for (int j = 0; j < 8; ++j) { const int chl = 8 * j + (F.lane >> 3), pc = F.lane & 7;
            unsigned e[8];
#pragma unroll
            for (int q = 0; q < 8; ++q) e[q] = T[(8 * pc + q) * 66 + chl];
            v4u o; o.x = e[0] | (e[1] << 16); o.y = e[2] | (e[3] << 16); o.z = e[4] | (e[5] << 16); o.w = e[6] | (e[7] << 16);
            const int chg = 64 * (cb & 3) + chl;
            *(GAS v4u*)(ZT + ((size_t)(b * 256 + chg) * 2 + sn) * L + n0 + 8 * pc) = o; }
        LDS_WAIT(); asm volatile("" ::: "memory");
    }
}
__device__ __forceinline__ void ycat_norm_phase(Frame& F, int nrows) {
    bf16* Y = (bf16*)(F.ws + WS_YCAT); const bf16* YC = (const bf16*)F.out + (size_t)MT * 768; const bf16* YF = (const bf16*)(F.ws + WS_YF); const bf16* AT = (const bf16*)((const char*)F.out + OUT_ATT);
    const int gw = F.vcu * NWAVES + F.wave, NGW = F.G * NWAVES;
    constexpr int R = 2;
    for (int row0 = gw; row0 < nrows; row0 += R * NGW) {
        v4u a[R]; v2u c[R]; v2u f[R];
#pragma unroll
        for (int q = 0; q < R; ++q) { const int row = row0 + q * NGW; if (row < nrows) { a[q] = *(const GAS v4u*)(AT + (size_t)row * 512 + 8 * F.lane); c[q] = *(const GAS v2u*)(YC + (size_t)row * 256 + 4 * F.lane);
            f[q] = *(const GAS v2u*)(YF + (size_t)row * 256 + 4 * F.lane); } }
#pragma unroll
        for (int q = 0; q < R; ++q) { const int row = row0 + q * NGW; if (row < nrows) { bf16* yr = Y + (size_t)row * 1024;
            float av[8], fv[4], cv[4];
            fv[0] = bf2f(f[q].x & 0xffffu); fv[1] = bf2f(f[q].x >> 16); fv[2] = bf2f(f[q].y & 0xffffu); fv[3] = bf2f(f[q].y >> 16);
            av[0] = bf2f(a[q].x & 0xffffu); av[1] = bf2f(a[q].x >> 16); av[2] = bf2f(a[q].y & 0xffffu); av[3] = bf2f(a[q].y >> 16); av[4] = bf2f(a[q].z & 0xffffu); av[5] = bf2f(a[q].z >> 16); av[6] = bf2f(a[q].w & 0xffffu); av[7] = bf2f(a[q].w >> 16);
            cv[0] = bf2f(c[q].x & 0xffffu); cv[1] = bf2f(c[q].x >> 16); cv[2] = bf2f(c[q].y & 0xffffu); cv[3] = bf2f(c[q].y >> 16);
            float sa = 0.f, sf = 0.f, sc = 0.f;
#pragma unroll
            for (int e = 0; e < 8; ++e) sa += av[e] * av[e];
#pragma unroll
            for (int e = 0; e < 4; ++e) { sf += fv[e] * fv[e]; sc += cv[e] * cv[e]; }
            const float ra = 1.0f / sqrtf(wave_sum(sa) * (1.0f / 512.0f) + EPS), rf = 1.0f / sqrtf(wave_sum(sf) * (1.0f / 256.0f) + EPS), rc = 1.0f / sqrtf(wave_sum(sc) * (1.0f / 256.0f) + EPS);
            v4u oa; oa.x = pk2(av[0] * ra, av[1] * ra); oa.y = pk2(av[2] * ra, av[3] * ra); oa.z = pk2(av[4] * ra, av[5] * ra); oa.w = pk2(av[6] * ra, av[7] * ra);
            v2u of; of.x = pk2(fv[0] * rf, fv[1] * rf); of.y = pk2(fv[2] * rf, fv[3] * rf);
            v2u oc; oc.x = pk2(cv[0] * rc, cv[1] * rc); oc.y = pk2(cv[2] * rc, cv[3] * rc);
            *(GAS v4u*)(yr + 8 * F.lane) = oa; *(GAS v2u*)(yr + 512 + 4 * F.lane) = of; *(GAS v2u*)(yr + 768 + 4 * F.lane) = oc; } }
    }
}
__device__ __forceinline__ void ctx_combine_phase(Frame& F, const float* base, const float* gp_g, int gp_ofs, int gate_ofs, const float* gn_g, const float* gn_mod, int gn_ofs, int nsl) {
    const bf16* PART = (const bf16*)(F.ws + WS_CPART); bf16* XNp = (bf16*)(F.ws + WS_XN); float* SSXp = (float*)(F.ws + WS_SSX);
    const float* mod0 = (const float*)(F.ws + WS_MOD) + 8 * 6144;
    const int gw = F.vcu * NWAVES + F.wave, NGW = F.G * NWAVES;
    for (int row = gw; row < MCTX; row += NGW) {
        float ss = 0.f; bf16* xr = XNp + (size_t)(MLAT + row) * DM;
#pragma unroll
        for (int j = 0; j < 4; ++j) { const int c = 256 * j + 4 * F.lane; f32x4 x;
            if (base != nullptr) x = *(const f32x4*)(base + (size_t)row * DM + c);
            else { const v2u xw = *(const GAS v2u*)(xr + c); x[0] = bf2f(xw.x & 0xffffu); x[1] = bf2f(xw.x >> 16); x[2] = bf2f(xw.y & 0xffffu); x[3] = bf2f(xw.y >> 16);
                const f32x4 gp = *(const f32x4*)(gp_g + c) * (*(const f32x4*)(mod0 + gp_ofs + c) + 1.0f);
                x[0] = x[0] / gp[0]; x[1] = x[1] / gp[1]; x[2] = x[2] / gp[2]; x[3] = x[3] / gp[3]; }
            f32x4 s = {0.f, 0.f, 0.f, 0.f};
            for (int k = 0; k < nsl; ++k) { const v2u pw = *(const GAS v2u*)(PART + ((size_t)k * MCTX + row) * DM + c); s[0] += bf2f(pw.x & 0xffffu); s[1] += bf2f(pw.x >> 16); s[2] += bf2f(pw.y & 0xffffu); s[3] += bf2f(pw.y >> 16); }
            x = x + *(const f32x4*)(mod0 + gate_ofs + c) * s;
            ss += (x[0] * x[0] + x[1] * x[1]) + (x[2] * x[2] + x[3] * x[3]);
            const f32x4 h = x * (*(const f32x4*)(gn_g + c)) * (*(const f32x4*)(gn_mod + gn_ofs + c) + 1.0f);
            v2u ho; ho.x = pk2(h[0], h[1]); ho.y = pk2(h[2], h[3]); *(GAS v2u*)(xr + c) = ho; }
        ss = wave_sum(ss);
        if (F.lane < 16) SSXp[(size_t)(MLAT + row) * 16 + F.lane] = F.lane == 0 ? ss : 0.f;
    }
}
__device__ __forceinline__ void final_norm_phase(Frame& F, const bf16* xf, const float* g) {
    const int gw = F.vcu * NWAVES + F.wave, NGW = F.G * NWAVES;
    constexpr int R = 2;
    v2u w[R][4], wn[R][4];
#define FN_LOAD(W_, r0_) do { _Pragma("unroll") for (int q = 0; q < R; ++q) { const int row = (r0_) + q * NGW; if (row < MLAT) { \
        _Pragma("unroll") for (int j = 0; j < 4; ++j) W_[q][j] = *(const GAS v2u*)(xf + (size_t)row * DM + 256 * j + 4 * F.lane); } } } while (0)
    FN_LOAD(w, gw);
    for (int row0 = gw; row0 < MLAT; row0 += R * NGW) {
        FN_LOAD(wn, row0 + R * NGW);
#pragma unroll
        for (int q = 0; q < R; ++q) { const int row = row0 + q * NGW; if (row < MLAT) { float* orow = F.out + (size_t)row * DM;
            f32x4 v[4]; float ss = 0.f;
#pragma unroll
            for (int j = 0; j < 4; ++j) { v[j][0] = bf2f(w[q][j].x & 0xffffu); v[j][1] = bf2f(w[q][j].x >> 16); v[j][2] = bf2f(w[q][j].y & 0xffffu); v[j][3] = bf2f(w[q][j].y >> 16);
                ss += (v[j][0] * v[j][0] + v[j][1] * v[j][1]) + (v[j][2] * v[j][2] + v[j][3] * v[j][3]); }
            const float rstd = 1.0f / sqrtf(wave_sum(ss) * (1.0f / DM) + EPS);
#pragma unroll
            for (int j = 0; j < 4; ++j) { const int c = 256 * j + 4 * F.lane; const f32x4 gg = *(const f32x4*)(g + c); *(f32x4*)(orow + c) = (v[j] * rstd) * gg; } } }
#pragma unroll
        for (int q = 0; q < R; ++q)
#pragma unroll
            for (int j = 0; j < 4; ++j) w[q][j] = wn[q][j];
    }
#undef FN_LOAD
}
#ifndef PHMASK
#define PHMASK 0xFFFF
#endif
#define PHON(x) (((PHMASK) >> (x)) & 1)
#ifndef SUBMASK
#define SUBMASK 0xFF
#endif
#define SUBON(x) (rep_ == 0 || (((SUBMASK) >> (x)) & 1))
struct UpOrder : pg8::StaticOrder {
    typedef pg8::UnitUp UnitT; int nrows;
    __device__ __forceinline__ bool next(int i, pg8::UnitUp& u) const {
        if (!next_mn(i, u.pm, u.pn)) return false;
        u.kofs = 0; u.kofb = 0; u.nt = ntk; u.arow = 254 * u.pm - 1; u.nrows = nrows;
        return true;
    }
};

struct SliceOrder0 : pg8::StaticOrder {
    typedef pg8::Unit UnitT; int nsl;
    __device__ __forceinline__ bool next(int i, pg8::Unit& u) const {
        if (i == 0) { if (!next_mn(0, u.pm, u.pn)) return false; u.arow = u.pm * 256; u.kofs = 0; u.kofb = 0; u.nt = ntk; u.aux = 0; return true; }
        const int L = (i - 1) * G + c; if (L >= 32 * nsl) return false;
        const int t = L / nsl, s = L % nsl; u.pm = 64 + (t >> 2); u.pn = t & 3; u.arow = u.pm * 256; u.aux = s;
        if (nsl == 8) { u.kofs = (s < 6 ? 6 * s : 36 + 4 * (s - 6)) * 64; u.nt = s < 6 ? 6 : 4; } else { u.kofs = s * 256; u.nt = 4; }
        u.kofb = u.kofs; return true;
    }
};

struct QkvOrder {
    typedef pg8::Unit UnitT; int G, c, nq;
    __device__ __forceinline__ bool next(int i, pg8::Unit& u) const { const int L = i * G + c; if (L >= 288 + nq) return false;
        if (L < 288) { u.pm = L >> 2; u.pn = 3 + (L & 3); u.kofs = 384; u.nt = 4; } else { const int j = L - 288; u.pm = j / 3; u.pn = j % 3; u.kofs = 0; u.nt = 6; }
        u.kofb = 0; u.arow = u.pm * 256; return true; }
};

struct WinOrder {
    typedef pg8::Unit UnitT; pg8::StaticOrder S; int G, c, l;
    __device__ __forceinline__ void init(int G_, int c_, int l_) { S.init(64, 7, G_, c_, 1024); G = G_; c = c_; l = l_; }
    __device__ __forceinline__ bool next(int i, pg8::Unit& u) const {
        int pm, pn;
        if (S.next_mn(i, pm, pn)) { u.pm = pm; u.pn = pn < 3 ? pn : (pn == 3 ? 8 : pn + 1); }
        else { const long L = (long)i * G + c - 448; const int nctx = (l == 0) ? 64 : 16; if (L < 0 || L >= nctx) return false;
            if (l == 0) { u.pm = 64 + (int)(L >> 3); u.pn = (int)(L & 7); } else { u.pm = 64 + (int)(L >> 1); u.pn = 1 + (int)(L & 1); } }
        u.arow = u.pm * 256; u.kofs = 0; u.kofb = 0; u.nt = 16; u.aux = 0; return true; }
};
struct FnetOrder {
    typedef pg8::Unit UnitT; int G, c;
    __device__ __forceinline__ bool next(int i, pg8::Unit& u) const { const int L = i * G + c; if (L >= 256) return false;
        u.pm = (L >> 3) & 7; u.pn = L & 7; u.arow = u.pm * 256; u.kofs = (L >> 6) * 1024; u.kofb = u.kofs; u.nt = 16; return true; }
};

__global__ void __launch_bounds__(NWAVES * 64, 2) mk_fwd(Args args) {
    extern __shared__ __attribute__((aligned(16))) unsigned char lds[];
    Frame F;
    F.lds = (LAS unsigned char*)lds; F.ldsg = (char*)lds;
    F.MISC = (volatile LAS unsigned*)(F.lds + MISC_OFF);
    F.tid = threadIdx.x; F.lane = F.tid & 63; F.wave = __builtin_amdgcn_readfirstlane(F.tid >> 6);
    F.G = gridDim.x; F.bx = blockIdx.x; F.vcu = (F.G % 8 == 0) ? (F.bx % 8) * (F.G / 8) + F.bx / 8 : F.bx;
    F.ws = args.ws; F.out = args.out;
    for (int u = F.tid; u < (LDS_BYTES - LDSCTL_OFF) / 4; u += NWAVES * 64) ((LAS unsigned*)(F.lds + LDSCTL_OFF))[u] = 0u;
    __syncthreads();
    if (F.tid == 0) { LAS unsigned long long* T = (LAS unsigned long long*)(F.lds + PTR_OFF);
#pragma unroll
        for (int i = 0; i < 22; ++i) T[i] = (unsigned long long)args.in[i]; }
    __syncthreads();
    XcdBarrier bar; bar.bar = (unsigned*)(F.ws + WS_CTL) + CW_BAR; bar.x = 0; bar.st = nullptr;
    if (!MK_SPLIT) bar = xcd_barrier_post((unsigned*)(F.ws + WS_CTL) + CW_BAR, F.MISC + 8);

#define MOD ((float*)(ws + WS_MOD))
#define SSQ ((float*)(ws + WS_SSQ))
#define XN ((bf16*)(ws + WS_XN))
#define P ((bf16*)(ws + WS_P))
#define Qb ((bf16*)F.out)
#define Kb ((bf16*)(ws + WS_K))
#define Vb ((bf16*)(ws + WS_V))
#define YCAT ((bf16*)(ws + WS_YCAT))
#define ATTO ((bf16*)((char*)F.out + OUT_ATT))
#define ACT ((bf16*)(ws + WS_ACT))
#define XCTX ((bf16*)(ws + WS_XCTX))
#define XBL ((bf16*)F.out + (size_t)MLAT * DM)
#define XFIN ((bf16*)(ws + WS_XN))
    LAS unsigned char* ring = F.lds + RING_OFF;

    const int ph_lo = args.ph_lo, ph_hi = args.ph_hi;
#ifndef FFT_RPT
#define FFT_RPT 1
#endif
#ifndef FILL2_RPT
#define FILL2_RPT 1
#endif
#ifndef FILL_RPT
#define FILL_RPT 1
#endif
#define PHASE(k) (ph_lo <= (k) && (k) < ph_hi)
#define SEAM(k) do { if (PHASE(k) && PHASE((k) + 1)) xcd_barrier(bar); } while (0)
#ifndef P0SUB
#define P0SUB 0xFF
#endif
#ifndef UPPROBE
#define UPPROBE 0
#endif
#ifndef RPT_PH
#define RPT_PH -1
#endif
#define RELANE() do { int t_ = threadIdx.x; asm volatile("" : "+v"(t_)); F.tid = t_; F.lane = t_ & 63; F.wave = __builtin_amdgcn_readfirstlane(t_ >> 6); } while (0)
    unsigned char* ws = F.ws;
    if (PHASE(0)) for (int rep_ = 0; rep_ < (((0) == RPT_PH) ? 2 : 1); ++rep_) { if (rep_) xcd_barrier(bar); RELANE(); if (PHON(0)) p0_prologue(F, rep_ ? P0SUB : 0xFF, 0, F.vcu * NWAVES + F.wave, F.G * NWAVES); }
    SEAM(0);
    for (int l = 0; l < 2; ++l) {
        const int pb = 1 + 9 * l;
        const int nMall = (l == 0) ? 72 : 64;
        if (PHASE(pb + 0)) for (int rep_ = 0; rep_ < (((pb + 0) == RPT_PH) ? 2 : 1); ++rep_) { if (rep_) xcd_barrier(bar); RELANE();
            if (l == 0 && (rep_ == 0 || (SUBMASK & 1))) { pg8::Gemm g{(const bf16*)(ws + WS_CST), (const bf16*)(ws + WS_WF), 2, 8, 256, 256}; pg8::StaticOrder S; S.init(2, 8, F.G, F.bx, 256);
                pg8::EpiFold E{(bf16*)(ws + WS_WIN), (unsigned)(WIN_STRIDE / 2)};
                pg8::gemm_phase(ring, g, S, E); RELANE(); }
            if (PHON(1) && l == 0 && (rep_ == 0 || (SUBMASK & 2))) norm_mod_phase(F, inptr(F, I_X), inptr(F, I_CTX), MT, inptr(F, I_N1G), MOD, 0, 1024, 16); }
        if (l == 0) SEAM(pb + 0);
        if (PHASE(pb + 1)) for (int rep_ = 0; rep_ < (((pb + 1) == RPT_PH) ? 2 : 1); ++rep_) { if (rep_) xcd_barrier(bar); RELANE();
            if (PHON(2)) { pg8::Gemm g{XN, (const bf16*)(ws + WS_WIN + l * WIN_STRIDE), 72, 9, 1024, 1024}; WinOrder S; S.init(F.G, F.bx, l);
                pg8::EpiWin E{P, NIN, SSQ, l == 1 ? (const float*)(ws + WS_SSX) : nullptr, (const float*)(ws + WS_PB) + 9 * NWIN, (LAS float*)(F.lds + EPIX_OFF)};
                pg8::gemm_phase(ring, g, S, E);
                if (rep_ == 0 && l == 1) {
                    RELANE(); int nb = 464 - F.G; nb = nb < 0 ? 0 : (nb > F.G ? F.G : nb);
                    const bool all = (nb == F.G); if (all || F.bx >= nb) { const int rk = all ? F.bx : F.bx - nb, n = all ? F.G : F.G - nb;
                        bias_phase(F, 4, rk * NWAVES + F.wave, n * NWAVES); } } } }
        SEAM(pb + 1);
        if (PHASE(pb + 2)) for (int rep_ = 0; rep_ < (((pb + 2) == RPT_PH) ? 2 : 1); ++rep_) { if (rep_) xcd_barrier(bar); RELANE();
            if (PHON(3)) {
                if (SUBON(0)) { pg8::Gemm g{P, (const bf16*)(ws + WS_WQKV + l * WQKV_STRIDE), 72, 7, 384, NIN}; QkvOrder S; S.G = F.G; S.c = F.vcu; S.nq = 3 * nMall;
                  pg8::EpiQKV E{Qb, Kb, Vb, SSQ, (const float*)(ws + WS_ROPE), (const float*)(ws + WS_ROPE) + 1024, (LAS float*)(F.lds + EPIX_OFF)};
                  pg8::gemm_phase(ring, g, S, E); }
                if (SUBON(2)) qkv_rows_phase(F, l);
                if (SUBON(3)) zt_phase(F, l);
                } }
        SEAM(pb + 2);
        if (PHASE(pb + 3)) for (int rep_ = 0; rep_ < (((pb + 3) == RPT_PH) ? 2 : 1); ++rep_) { if (rep_) xcd_barrier(bar); RELANE();
            if (PHON(4)) {
                const int NU = 256 + (l == 0 ? 32 : 0);
                for (int u = F.vcu; u < NU; u += F.G) {
                    if (u < 256) { const int bh = u >> 3, qb = u & 7, b = bh >> 2, h = bh & 3; const long q0 = (long)b * SL + qb * 256;
                        att::attn_unit(Qb + q0 * 768 + 192 * h, Kb + 192 * h, Vb + 128 * h, ATTO + q0 * 512 + 128 * h, MLAT + CL * b, 4, SL * b, 36, F.ldsg);
                    } else { const int cu = u - 256, b = cu >> 2, h = cu & 3; const long q0 = MLAT + (long)CL * b;
                        att::attn_unit(Qb + q0 * 768 + 192 * h, Kb + 192 * h, Vb + 128 * h, ATTO + q0 * 512 + 128 * h, (int)q0, 4, 0, 4, F.ldsg); }
                }
                RELANE(); for (int rp_ = 0; rp_ < FFT_RPT; ++rp_) for (int u = F.vcu; u < 256; u += F.G) fnet_fft_unit(F, u >> 5, u & 31);
                RELANE();
                if (l == 0) { pg8::Gemm g{(const bf16*)(ws + WS_DFTC), (const bf16*)(ws + WS_ZTC), 1, 8, 512, 512}; pg8::StaticOrder S; S.init(1, 8, F.G, (F.bx + 128) % F.G, 512);
                  pg8::EpiFnet E{(bf16*)(ws + WS_YF), MLAT, CL, 0.0078125f, (unsigned)(MT * 256)};
                  pg8::gemm_phase(ring, g, S, E); }
                if (l == 0 && rep_ == 0) {
                    RELANE(); const bool all = F.G <= 32; if (all || F.vcu >= 32) { const int rk = all ? F.vcu : F.vcu - 32, n = all ? F.G : F.G - 32;
                        for (int fr_ = 0; fr_ < FILL_RPT; ++fr_) { p0_prologue(F, 0xFF, 1, rk * NWAVES + F.wave, n * NWAVES); bias_phase(F, 1, rk * NWAVES + F.wave, n * NWAVES); } } } } }
        SEAM(pb + 3);
        if (PHASE(pb + 4)) for (int rep_ = 0; rep_ < (((pb + 4) == RPT_PH) ? 2 : 1); ++rep_) { if (rep_) xcd_barrier(bar); RELANE();
            if (PHON(5)) ycat_norm_phase(F, nMall * 256); }
        SEAM(pb + 4);
        if (PHASE(pb + 5)) for (int rep_ = 0; rep_ < (((pb + 5) == RPT_PH) ? 2 : 1); ++rep_) { if (rep_) xcd_barrier(bar); RELANE();
            if (PHON(6)) { pg8::Gemm g{YCAT, (const bf16*)(ws + WS_WOUT + l * WOUT_STRIDE), nMall, 4, 1024, 1024}; pg8::StaticOrder S; S.init(nMall, 4, F.G, F.bx, 1024);
                if (l == 0) { SliceOrder0 S0; S0.init(64, 4, F.G, F.bx, 1024); S0.nsl = 4; pg8::Gemm g0{YCAT, (const bf16*)(ws + WS_WOUT), 64, 4, 1024, 1024};
                    pg8::EpiRes<true> E{inptr(F, I_X), inptr(F, I_CTX), XN, MOD, 2048, nullptr, nullptr, 0, inptr(F, I_N2G), MOD, 4096, (float*)(ws + WS_SSX), rep_ ? 0.f : 1.f, (bf16*)(ws + WS_CPART)};
                    pg8::gemm_phase(ring, g0, S0, E);
                    RELANE(); { int nb = 128; nb = nb > F.G ? F.G : nb; const bool all = (nb == F.G); if (rep_ == 0 && (all || F.bx >= nb)) { const int rk = all ? F.bx : F.bx - nb, n = all ? F.G : F.G - nb; bias_phase(F, 2, rk * NWAVES + F.wave, n * NWAVES); } }
                    xcd_barrier(bar); RELANE();
                    ctx_combine_phase(F, inptr(F, I_CTX), nullptr, 0, 2048, inptr(F, I_N2G), MOD + 8 * 6144, 4096, 4); }
                else { pg8::EpiRes<false> E{nullptr, nullptr, XN, MOD + (size_t)9 * 6144, 2048, inptr(F, I_N1G) + DM, MOD + (size_t)9 * 6144, 1024, inptr(F, I_N2G) + DM, MOD + (size_t)9 * 6144, 4096, (float*)(ws + WS_SSX), rep_ ? 0.f : 1.f, nullptr};
                    pg8::gemm_phase(ring, g, S, E); } } }
        SEAM(pb + 5);
        if (PHASE(pb + 6)) for (int rep_ = 0; rep_ < (((pb + 6) == RPT_PH) ? 2 : 1); ++rep_) { if (rep_) xcd_barrier(bar); RELANE();
            }
        if (PHASE(pb + 7)) for (int rep_ = 0; rep_ < (((pb + 7) == RPT_PH) ? 2 : 1); ++rep_) { if (rep_) xcd_barrier(bar); RELANE();
            if (PHON(8)) { const int nrows = (l == 0) ? MT : MLAT; const int nM = (nrows + 253) / 254;
                pg8::Gemm g{XN, (const bf16*)(ws + WS_WUP + l * WUP_STRIDE), nM, 22, 1024, 1024}; UpOrder S; S.init(nM, 22, F.G, F.bx, 1024); S.nrows = nrows;
                pg8::EpiUp E{ACT, inptr(F, I_FCW) + (size_t)l * 3 * FF, inptr(F, I_FCB) + (size_t)l * FF, (LAS float*)(F.lds + EPIX_OFF), (const float*)(ws + WS_SSX), (const float*)(ws + WS_UB) + (size_t)l * 9 * 5632};
                pg8::gemm_phase(ring, g, S, E);
                if (l == 0 && rep_ == 0) {
                    RELANE(); int nb = nM * 22 - 6 * F.G; nb = nb < 0 ? 0 : (nb > F.G ? F.G : nb);
                    const bool all = (nb == F.G); if (all || F.bx >= nb) { const int rk = all ? F.bx : F.bx - nb, n = all ? F.G : F.G - nb; for (int fr_ = 0; fr_ < FILL2_RPT; ++fr_) p0_prologue(F, 0xFF, 2, rk * NWAVES + F.wave, n * NWAVES); } } } }
        SEAM(pb + 7);
        if (PHASE(pb + 8)) for (int rep_ = 0; rep_ < (((pb + 8) == RPT_PH) ? 2 : 1); ++rep_) { if (rep_) xcd_barrier(bar); RELANE();
            if (PHON(6)) {
                if (l == 0) { pg8::Gemm g{ACT, (const bf16*)(ws + WS_WDOWN), 64, 4, FF, FF}; SliceOrder0 S; S.init(64, 4, F.G, F.bx, FF); S.nsl = 8;
                    pg8::EpiRes<false> E{nullptr, nullptr, XN, MOD, 5120, inptr(F, I_N2G), MOD, 4096, inptr(F, I_N1G) + DM, MOD + (size_t)9 * 6144, 1024, (float*)(ws + WS_SSX), rep_ ? 0.f : 1.f, (bf16*)(ws + WS_CPART)};
                    pg8::gemm_phase(ring, g, S, E);
                    xcd_barrier(bar); RELANE();
                    ctx_combine_phase(F, nullptr, inptr(F, I_N2G), 4096, 5120, inptr(F, I_N1G) + DM, MOD + (size_t)9 * 6144 + 8 * 6144, 1024, 8);
                } else { pg8::Gemm g{ACT, (const bf16*)(ws + WS_WDOWN + WDOWN_STRIDE), 64, 4, FF, FF}; pg8::StaticOrder S; S.init(64, 4, F.G, F.bx, FF);
                    pg8::EpiRes<false> E{nullptr, nullptr, XN, MOD + (size_t)9 * 6144, 5120, inptr(F, I_N2G) + DM, MOD + (size_t)9 * 6144, 4096, nullptr, nullptr, 0, nullptr, 1.f, nullptr};
                    pg8::gemm_phase(ring, g, S, E); } } }
        SEAM(pb + 8);
    }
    if (PHASE(NPH - 1)) for (int rep_ = 0; rep_ < (((NPH - 1) == RPT_PH) ? 2 : 1); ++rep_) { if (rep_) xcd_barrier(bar); RELANE(); if (PHON(10)) final_norm_phase(F, XN, inptr(F, I_FING)); }
#undef PHASE
#undef SEAM
#undef RELANE
#undef MOD
#undef SSQ
#undef XN
#undef P
#undef Qb
#undef Kb
#undef Vb
#undef YCAT
#undef ATTO
#undef ACT
#undef XCTX
#undef XBL
#undef XFIN
}

extern "C" void kernel_launch(void* const* d_in, const int* in_sizes, int n_in, void* d_out, int out_size, void* d_ws, size_t ws_size, hipStream_t stream) {
    static int grid = 0;
    if (grid == 0) {
        if (n_in != 22 || out_size != MLAT * DM || ws_size < WS_END) { fprintf(stderr, "kernel_launch: unexpected shapes (n_in %d out %d ws %zu)\n", n_in, out_size, ws_size); grid = -1; return; }
        int dev = 0, cus = 0;
        if (hipGetDevice(&dev) != hipSuccess || hipDeviceGetAttribute(&cus, hipDeviceAttributeMultiprocessorCount, dev) != hipSuccess) { grid = -1; return; }
        if (hipFuncSetAttribute((const void*)mk_fwd, hipFuncAttributeMaxDynamicSharedMemorySize, LDS_BYTES) != hipSuccess) { fprintf(stderr, "kernel_launch: hipFuncSetAttribute failed\n"); grid = -1; return; }
        int per_cu = 0;
        if (hipOccupancyMaxActiveBlocksPerMultiprocessor(&per_cu, (const void*)mk_fwd, NWAVES * 64, LDS_BYTES) != hipSuccess || per_cu < 1) fprintf(stderr, "kernel_launch: occupancy query says %d\n", per_cu);
        (void)hipGetLastError();
        grid = cus;
    }
    if (grid < 0) return;
    if (hipMemsetAsync((char*)d_ws + WS_CTL, 0, CTL_ZERO_BYTES, stream) != hipSuccess) return;
    Args a{};
    for (int i = 0; i < 22; ++i) a.in[i] = (const float*)d_in[i];
    a.out = (float*)d_out; a.ws = (unsigned char*)d_ws;
#if MK_SPLIT
    for (int ph = 0; ph < NPH; ++ph) { a.ph_lo = ph; a.ph_hi = ph + 1; hipLaunchKernelGGL(mk_fwd, dim3(grid), dim3(NWAVES * 64), LDS_BYTES, stream, a); }
#else
    a.ph_lo = 0; a.ph_hi = NPH;
    hipLaunchKernelGGL(mk_fwd, dim3(grid), dim3(NWAVES * 64), LDS_BYTES, stream, a);
#endif
    const hipError_t le = hipPeekAtLastError();
    if (le != hipSuccess) fprintf(stderr, "kernel_launch: launch failed: %s\n", hipGetErrorName(le));
}
```

```cpp
#include <hip/hip_runtime.h>
#include <hip/hip_bf16.h>
#include <cstdio>
#include <cstdint>
#include <cmath>
namespace pg8 {
#define PG8_LAS __attribute__((address_space(3)))
typedef unsigned short bf16_t;
typedef short bf16x8 __attribute__((ext_vector_type(8)));
typedef float f32x4 __attribute__((ext_vector_type(4)));
typedef float f32x2 __attribute__((ext_vector_type(2)));
typedef unsigned u32x4 __attribute__((ext_vector_type(4)));
typedef unsigned u32x2 __attribute__((ext_vector_type(2)));
constexpr int BM = 256, BK = 64, HALF = 128, HTB = HALF * BK * 2  , STAGE_BYTES = 8 * HTB, NXCD = 8, WGM = 8;

__host__ __device__ __forceinline__ int lds_byte(int r, int c) { const int st = (r >> 4) * 2 + (c >> 5), rr = r & 15, cc = c & 31, ob = rr * 64 + cc * 2; return st * 1024 + (ob ^ (((ob >> 9) & 1) << 5)); }
__host__ __device__ __forceinline__ void stage_rc(int b, int& R, int& C) { const int st = b / 1024, sb = b % 1024, swz = sb ^ (((sb >> 9) & 1) << 5); R = (st >> 1) * 16 + swz / 64; C = (st & 1) * 32 + (swz % 64) / 2; }
__host__ __device__ __forceinline__ int perm32(int rho) { const int n = rho >> 4, i = rho & 15; return 8 * (i >> 2) + 4 * n + (i & 3); }

struct Unit { int pm, pn, arow, kofs, kofb, nt, aux; };
struct Gemm { const bf16_t* A; const bf16_t* Bt; int nM, nN, ldb, lda; };

struct StaticOrder {
    int nM, nN, nwg, G, c, ntk;
    __device__ __forceinline__ void init(int nM_, int nN_, int G_, int c_, int K_) { nM = nM_; nN = nN_; nwg = nM * nN; G = G_; c = c_; ntk = K_ / BK; }
    __device__ __forceinline__ bool next_mn(int i, int& pm, int& pn) const {
        const long L = (long)i * G + c; if (L >= nwg) return false;
        int wgid = (int)L; { const int q = nwg / NXCD, r = nwg % NXCD, xcd = wgid % NXCD, off = wgid / NXCD; wgid = (xcd < r ? xcd * (q + 1) : r * (q + 1) + (xcd - r) * q) + off; }
        const int nig = WGM * nN, gid = wgid / nig, fm = gid * WGM, gsz = (nM - fm) < WGM ? (nM - fm) : WGM;
        pm = fm + ((wgid % nig) % gsz); pn = (wgid % nig) / gsz; return true;
    }
    typedef Unit UnitT;
    __device__ __forceinline__ bool next(int i, Unit& u) const { if (!next_mn(i, u.pm, u.pn)) return false; u.arow = u.pm * BM; u.kofs = 0; u.kofb = 0; u.nt = ntk; u.aux = 0; return true; }
};

__device__ __forceinline__ unsigned cvt_pk_bf16(float lo, float hi) { unsigned r; asm volatile("v_cvt_pk_bf16_f32 %0, %1, %2" : "=v"(r) : "v"(lo), "v"(hi)); return r; }

template <class Epi, class Sched>
__device__ __forceinline__ void gemm_phase(PG8_LAS unsigned char* lds, const Gemm g, const Sched& S, const Epi& E) {
    int tid = threadIdx.x; asm volatile("" : "+v"(tid));
    const int wid = __builtin_amdgcn_readfirstlane(tid >> 6), lane = tid & 63, wr = wid >> 2, wc = wid & 3, fr = lane & 15, fq = lane >> 4;
    const int K = g.ldb, lda = g.lda;
    unsigned voffA[2], voffB[2];
#pragma unroll
    for (int i = 0; i < 2; ++i) { int R, C; stage_rc(tid * 16 + i * 8192, R, C); const int Rb = Epi::PERM ? ((R & ~31) + perm32(R & 31)) : R;
        voffA[i] = (unsigned)(R * lda + C) * 2u; voffB[i] = (unsigned)(Rb * K + C) * 2u; }
    const size_t kstep = (size_t)(BK * 2);
    const size_t hstepA = (size_t)HALF * lda * 2, hstepB = (size_t)HALF * K * 2;
    const size_t tstepB = 2 * hstepB;
    const unsigned ldsw = (unsigned)wid * 1024u;
    const int aoff = lds_byte(wr * 64 + fr, fq * 8), boff = lds_byte(wc * 32 + fr, fq * 8);
#define PG8_SA(b, h) (((b) * 2 + (h)) * HTB)
#define PG8_SB(b, h) ((4 + (b) * 2 + (h)) * HTB)
#define PG8_STAGE(bufoff, gbase, voff) do { _Pragma("unroll") for (int _i = 0; _i < 2; ++_i) \
        __builtin_amdgcn_global_load_lds((const unsigned*)((const char*)(gbase) + (voff)[_i]), (PG8_LAS unsigned*)(lds + (bufoff) + ldsw + _i * 8192), 16, 0, 0); } while (0)
#define PG8_LDA(dst, b, h) do { _Pragma("unroll") for (int m = 0; m < 4; ++m) _Pragma("unroll") for (int k = 0; k < 2; ++k) dst[m][k] = *(const PG8_LAS bf16x8*)(lds + PG8_SA(b, h) + aoff + m * 2048 + k * 1024); } while (0)
#define PG8_LDB(dst, b, h) do { _Pragma("unroll") for (int n = 0; n < 2; ++n) _Pragma("unroll") for (int k = 0; k < 2; ++k) dst[n][k] = *(const PG8_LAS bf16x8*)(lds + PG8_SB(b, h) + boff + n * 2048 + k * 1024); } while (0)
#define PG8_MMA(ai, bj, At, Bt) do { __builtin_amdgcn_s_setprio(1); _Pragma("unroll") for (int m = 0; m < 4; ++m) _Pragma("unroll") for (int n = 0; n < 2; ++n) _Pragma("unroll") for (int k = 0; k < 2; ++k) \
        acc[ai][bj][m][n] = __builtin_amdgcn_mfma_f32_16x16x32_bf16(Bt[n][k], At[m][k], acc[ai][bj][m][n], 0, 0, 0); __builtin_amdgcn_s_setprio(0); } while (0)
#define PG8_WAIT_V(n) asm volatile("s_waitcnt vmcnt(" #n ")" ::: "memory")
#define PG8_WAIT_L(n) asm volatile("s_waitcnt lgkmcnt(" #n ")" ::: "memory")
#define PG8_BAR __builtin_amdgcn_s_barrier()
#define PG8_SCHED __builtin_amdgcn_sched_barrier(0)
    typename Sched::UnitT cur, nxt; int ui = 0;
    if (!S.next(0, cur)) return;
    f32x4 acc[2][2][4][2];
#pragma unroll
    for (int a = 0; a < 2; ++a)
#pragma unroll
        for (int b = 0; b < 2; ++b)
#pragma unroll
            for (int m = 0; m < 4; ++m)
#pragma unroll
                for (int n = 0; n < 2; ++n) acc[a][b][m][n] = (f32x4){0.f, 0.f, 0.f, 0.f};
    bf16x8 At[4][2], B0[2][2], B1[2][2];
    const char* cA = (const char*)g.A + (ptrdiff_t)cur.arow * (ptrdiff_t)(lda * 2) + cur.kofs * 2; const char* cB = (const char*)g.Bt + (size_t)cur.pn * tstepB + cur.kofb * 2;
    if constexpr (Epi::PREFETCH) E.prefetch(cur, wid, lane);
    PG8_STAGE(PG8_SB(0, 0), cB, voffB); PG8_STAGE(PG8_SB(0, 1), cB + hstepB, voffB); PG8_STAGE(PG8_SA(0, 0), cA, voffA); PG8_STAGE(PG8_SA(0, 1), cA + hstepA, voffA);
    if (wr == 1) PG8_BAR;
    PG8_WAIT_V(2); PG8_BAR;
    PG8_STAGE(PG8_SB(1, 0), cB + kstep, voffB); PG8_STAGE(PG8_SA(1, 0), cA + kstep, voffA); PG8_STAGE(PG8_SB(1, 1), cB + hstepB + kstep, voffB);
    PG8_WAIT_V(6); PG8_BAR;
    for (;;) {
        const bool has_next = S.next(ui + 1, nxt);
        const char* nA = has_next ? (const char*)g.A + (ptrdiff_t)nxt.arow * (ptrdiff_t)(lda * 2) + nxt.kofs * 2 : cA; const char* nB = has_next ? (const char*)g.Bt + (size_t)nxt.pn * tstepB + nxt.kofb * 2 : cB;
        const int nt = cur.nt;
        for (int t = 0; t < nt; t += 2) {
            const bool last = (t == nt - 2);
            const char* a1 = cA + (size_t)(t + 1) * kstep;
            const char* a2 = last ? nA : cA + (size_t)(t + 2) * kstep; const char* b2 = last ? nB : cB + (size_t)(t + 2) * kstep;
            const char* a3 = a2 + kstep; const char* b3 = b2 + kstep;
            PG8_LDB(B0, 0, 0); PG8_LDB(B1, 0, 1); PG8_SCHED; PG8_LDA(At, 0, 0); PG8_STAGE(PG8_SA(1, 1), a1 + hstepA, voffA);
            PG8_WAIT_V(8); PG8_WAIT_L(0); PG8_BAR; PG8_MMA(0, 0, At, B0); PG8_MMA(0, 1, At, B1); PG8_BAR; PG8_SCHED;
            PG8_LDA(At, 0, 1); PG8_STAGE(PG8_SB(0, 0), b2, voffB); PG8_STAGE(PG8_SB(0, 1), b2 + hstepB, voffB); PG8_STAGE(PG8_SA(0, 0), a2, voffA);
            PG8_WAIT_V(8); PG8_WAIT_L(0); PG8_BAR; PG8_MMA(1, 0, At, B0); PG8_MMA(1, 1, At, B1); PG8_BAR; PG8_SCHED;
            PG8_LDB(B0, 1, 0); PG8_LDB(B1, 1, 1); PG8_SCHED; PG8_LDA(At, 1, 0); PG8_STAGE(PG8_SA(0, 1), a2 + hstepA, voffA);
            PG8_WAIT_V(8); PG8_WAIT_L(0); PG8_BAR; PG8_MMA(0, 0, At, B0); PG8_MMA(0, 1, At, B1); PG8_BAR; PG8_SCHED;
            PG8_LDA(At, 1, 1); PG8_STAGE(PG8_SB(1, 0), b3, voffB); PG8_STAGE(PG8_SB(1, 1), b3 + hstepB, voffB); PG8_STAGE(PG8_SA(1, 0), a3, voffA);
            PG8_WAIT_V(8); PG8_WAIT_L(0); PG8_BAR; PG8_MMA(1, 0, At, B0); PG8_MMA(1, 1, At, B1); PG8_BAR; PG8_SCHED;
        }
        if (wr == 0) PG8_BAR;
        E(acc, cur, wr, wc, fr, fq);
        if (!has_next) break;
        if constexpr (Epi::PREFETCH) E.prefetch(nxt, wid, lane);
#pragma unroll
        for (int a = 0; a < 2; ++a)
#pragma unroll
            for (int b = 0; b < 2; ++b)
#pragma unroll
                for (int m = 0; m < 4; ++m)
#pragma unroll
                    for (int n = 0; n < 2; ++n) acc[a][b][m][n] = (f32x4){0.f, 0.f, 0.f, 0.f};
        cur = nxt; cA = nA; cB = nB; ++ui;
        if (wr == 1) PG8_BAR;
    }
    PG8_WAIT_V(0);
    PG8_BAR;
#undef PG8_SA
#undef PG8_SB
#undef PG8_STAGE
#undef PG8_LDA
#undef PG8_LDB
#undef PG8_MMA
#undef PG8_WAIT_V
#undef PG8_WAIT_L
#undef PG8_BAR
#undef PG8_SCHED
}
}
namespace pg8 {
constexpr float RMS_EPS = 1e-6f;
template <class T> __device__ __forceinline__ T gld(const void* base, unsigned boff) { return *(const T*)((const char*)base + boff); }
template <class T> __device__ __forceinline__ T gldnt(const void* base, unsigned boff) { return __builtin_nontemporal_load((const T*)((const char*)base + boff)); }
template <class T> __device__ __forceinline__ void gst(void* base, unsigned boff, T v) { *(T*)((char*)base + boff) = v; }
template <class T> __device__ __forceinline__ void gstnt(void* base, unsigned boff, T v) { __builtin_nontemporal_store(v, (T*)((char*)base + boff)); }
constexpr int EX_XF = 0, EX_XL = 512, EX_CW = 1024, EX_RS = 1536, EX_BL = 1792, EX_SSX = 2304, EX_FLOATS = 6400;
constexpr int MLAT_ = 16384;
__device__ __forceinline__ void dma_ssx(const float* ssx, int arow, PG8_LAS float* xb, int wid, int lane) {
#pragma unroll
    for (int i = 0; i < 2; ++i) { const int ch = 2 * wid + i;
        __builtin_amdgcn_global_load_lds((const unsigned*)((const char*)ssx + (ptrdiff_t)arow * 64 + ch * 1024 + lane * 16), (PG8_LAS unsigned*)(xb + EX_SSX + ch * 256), 16, 0, 0); }
}
__device__ __forceinline__ void rs_from_ssx(PG8_LAS float* xb, int t) {
    if (t < 256) { const PG8_LAS f32x4* p = (const PG8_LAS f32x4*)(xb + EX_SSX + t * 16); const f32x4 a = p[0], b = p[1], c = p[2], d = p[3];
        const float ss = (((a[0] + a[1]) + (a[2] + a[3])) + ((b[0] + b[1]) + (b[2] + b[3]))) + (((c[0] + c[1]) + (c[2] + c[3])) + ((d[0] + d[1]) + (d[2] + d[3])));
        xb[EX_RS + t] = __builtin_amdgcn_rsqf(ss * (1.0f / 1024.0f) + RMS_EPS); }
}

struct EpiWin {
    static constexpr bool PERM = true, PREFETCH = true;
    bf16_t* O; int ldc; float* ssq;
    const float* ssx; const float* pb;
    PG8_LAS float* xb;
    __device__ __forceinline__ void prefetch(const Unit& u, int wid, int lane) const {
        if (ssx == nullptr) return;
        dma_ssx(ssx, u.arow, xb, wid, lane);
        if (wid == 0) __builtin_amdgcn_global_load_lds((const unsigned*)(pb + (u.pm < 64 ? (u.pm >> 3) : 8) * 2304 + u.pn * BM + lane * 4), (PG8_LAS unsigned*)(xb + EX_BL), 16, 0, 0);
    }
    __device__ __forceinline__ void operator()(const f32x4 (&acc)[2][2][4][2], const Unit& u, int wr, int wc, int fr_in, int fq_in) const {
        int t_ = threadIdx.x; asm volatile("" : "+v"(t_)); const int fr = t_ & 15, fq = (t_ >> 4) & 3; (void)fr_in; (void)fq_in;
        const int row0 = u.pm * BM + wr * 64 + fr; const int col0 = (u.pn == 8 ? 3 : u.pn) * BM + wc * 32 + 8 * fq; const int tc0 = wc * 32 + 8 * fq;
        const bool fused = ssx != nullptr;
        if (fused) { rs_from_ssx(xb, t_); asm volatile("s_waitcnt lgkmcnt(0)" ::: "memory"); __builtin_amdgcn_s_barrier(); asm volatile("" ::: "memory"); }
        f32x4 bv[2][2];
#pragma unroll
        for (int bj = 0; bj < 2; ++bj)
#pragma unroll
            for (int n = 0; n < 2; ++n) bv[bj][n] = fused ? *(const PG8_LAS f32x4*)(xb + EX_BL + tc0 + bj * HALF + 4 * n) : (f32x4){0.f, 0.f, 0.f, 0.f};
#pragma unroll
        for (int ai = 0; ai < 2; ++ai)
#pragma unroll
            for (int m = 0; m < 4; ++m) { const int tr = ai * HALF + wr * 64 + m * 16 + fr; const int row = u.pm * BM + tr; const unsigned ob = ((unsigned)row * (unsigned)ldc + (unsigned)col0) * 2u;
                const float rs = fused ? xb[EX_RS + tr] : 1.0f;
#pragma unroll
                for (int bj = 0; bj < 2; ++bj) { const f32x4 v0 = acc[ai][bj][m][0] * rs + bv[bj][0], v1 = acc[ai][bj][m][1] * rs + bv[bj][1];
                    u32x4 w; w.x = cvt_pk_bf16(v0[0], v0[1]); w.y = cvt_pk_bf16(v0[2], v0[3]); w.z = cvt_pk_bf16(v1[0], v1[1]); w.w = cvt_pk_bf16(v1[2], v1[3]);
                    gst<u32x4>(O, ob + bj * HALF * 2, w);
                    const int hf = 2 * u.pn + bj;
                    if (hf < 5) {
                        float s = (v0[0] * v0[0] + v0[1] * v0[1]) + (v0[2] * v0[2] + v0[3] * v0[3]) + (v1[0] * v1[0] + v1[1] * v1[1]) + (v1[2] * v1[2] + v1[3] * v1[3]);
                        s += __shfl_xor(s, 16); s += __shfl_xor(s, 32);
                        if (fq == 0) gst<float>(ssq, ((unsigned)row * 20u + hf * 4 + wc) * 4u, s);
                    } }
                if (m & 1) asm volatile("" ::: "memory"); }
        if (fused) { asm volatile("s_waitcnt lgkmcnt(0)" ::: "memory"); __builtin_amdgcn_s_barrier(); asm volatile("" ::: "memory"); }
        (void)row0;
    }
};

struct EpiFold {
    static constexpr bool PERM = true, PREFETCH = false;
    bf16_t* WinT; unsigned lstride;
    __device__ __forceinline__ void operator()(const f32x4 (&acc)[2][2][4][2], const Unit& u, int wr, int wc, int fr_in, int fq_in) const {
        int t_ = threadIdx.x; asm volatile("" : "+v"(t_)); const int fr = t_ & 15, fq = (t_ >> 4) & 3; (void)fr_in; (void)fq_in;
        bf16_t* O = WinT + (size_t)(u.pn >> 2) * lstride;
        const int row0 = 768 + u.pm * BM + wr * 64 + fr; const int col0 = (u.pn & 3) * BM + wc * 32 + 8 * fq;
#pragma unroll
        for (int ai = 0; ai < 2; ++ai)
#pragma unroll
            for (int m = 0; m < 4; ++m) { const unsigned ob = ((unsigned)(row0 + ai * HALF + m * 16) * 1024u + (unsigned)col0) * 2u;
#pragma unroll
                for (int bj = 0; bj < 2; ++bj) { const f32x4 v0 = acc[ai][bj][m][0], v1 = acc[ai][bj][m][1];
                    u32x4 w; w.x = cvt_pk_bf16(v0[0], v0[1]); w.y = cvt_pk_bf16(v0[2], v0[3]); w.z = cvt_pk_bf16(v1[0], v1[1]); w.w = cvt_pk_bf16(v1[2], v1[3]);
                    gst<u32x4>(O, ob + bj * HALF * 2, w); } }
    }
};

struct EpiQKV {
    static constexpr bool PERM = true, PREFETCH = true;
    bf16_t* Q; bf16_t* Kb; bf16_t* Vb; const float* ssq; const float* ropec; const float* ropes; PG8_LAS float* xb;
    __device__ __forceinline__ void prefetch(const Unit& u, int wid, int lane) const {
#pragma unroll
        for (int i = 0; i < 3; ++i) { const int ch = 3 * wid + i;
            if (ch < 20) __builtin_amdgcn_global_load_lds((const unsigned*)((const char*)ssq + (size_t)u.arow * 80 + ch * 1024 + lane * 16), (PG8_LAS unsigned*)(xb + 512 + ch * 256), 16, 0, 0); }
    }
    __device__ __forceinline__ void operator()(const f32x4 (&acc)[2][2][4][2], const Unit& u, int wr, int wc, int fr_in, int fq_in) const {
        int t_ = threadIdx.x; asm volatile("" : "+v"(t_)); const int fr = t_ & 15, fq = (t_ >> 4) & 3; (void)fr_in; (void)fq_in;
        if (t_ < 256) { const PG8_LAS float* p = xb + 512 + t_ * 20; float sq = 0.f, sk = 0.f;
#pragma unroll
            for (int i = 0; i < 12; ++i) sq += p[i];
#pragma unroll
            for (int i = 12; i < 20; ++i) sk += p[i];
            xb[t_] = __builtin_amdgcn_rsqf(sq * (1.0f / 384.0f) + RMS_EPS); xb[256 + t_] = __builtin_amdgcn_rsqf(sk * (1.0f / 256.0f) + RMS_EPS); }
        asm volatile("s_waitcnt lgkmcnt(0)" ::: "memory"); __builtin_amdgcn_s_barrier(); asm volatile("" ::: "memory");
        const int cw = wc * 32 + 8 * fq;
        if (u.pn < 3) {
            const bool lat = u.pm < 64;
#pragma unroll
            for (int ai = 0; ai < 2; ++ai)
#pragma unroll
                for (int m = 0; m < 4; ++m) { const int tr = ai * HALF + wr * 64 + m * 16 + fr; const int row = u.pm * BM + tr; const float rs = xb[tr]; const int t = row & 2047;
#pragma unroll
                    for (int bj = 0; bj < 2; ++bj) { const int gcol = u.pn * BM + bj * HALF + wc * 32;
                        const int w = gcol % 192; f32x4 x1 = acc[ai][bj][m][0] * rs, x2 = acc[ai][bj][m][1] * rs;
                        if (lat && w >= 128) { const int pos = (w >= 160) ? (t & 63) : (t >> 6);
                            const unsigned rb = (unsigned)(pos * 16 + 4 * fq) * 4u; const f32x4 c = gld<f32x4>(ropec, rb), s = gld<f32x4>(ropes, rb);
                            const f32x4 y1 = x1 * c - x2 * s, y2 = x1 * s + x2 * c; x1 = y1; x2 = y2; }
                        u32x4 o; o.x = cvt_pk_bf16(x1[0], x1[1]); o.y = cvt_pk_bf16(x1[2], x1[3]); o.z = cvt_pk_bf16(x2[0], x2[1]); o.w = cvt_pk_bf16(x2[2], x2[3]);
                        gst<u32x4>(Q, ((unsigned)row * 768u + (unsigned)(gcol + 8 * fq)) * 2u, o); }
                    if (m & 1) asm volatile("" ::: "memory"); }
        } else {
            const int h = u.pn - 3;
#pragma unroll
            for (int ai = 0; ai < 2; ++ai)
#pragma unroll
                for (int m = 0; m < 4; ++m) { const int tr = ai * HALF + wr * 64 + m * 16 + fr; const int row = u.pm * BM + tr; const float rs = xb[256 + tr];
#pragma unroll
                    for (int bj = 0; bj < 2; ++bj) { const f32x4 v0 = acc[ai][bj][m][0] * rs, v1 = acc[ai][bj][m][1] * rs;
                        u32x4 w; w.x = cvt_pk_bf16(v0[0], v0[1]); w.y = cvt_pk_bf16(v0[2], v0[3]); w.z = cvt_pk_bf16(v1[0], v1[1]); w.w = cvt_pk_bf16(v1[2], v1[3]);
                        if (bj == 0) gst<u32x4>(Kb, ((unsigned)row * 768u + (unsigned)(192 * h + cw)) * 2u, w);
                        else gst<u32x4>(Vb, ((unsigned)row * 512u + (unsigned)(128 * h + cw)) * 2u, w); }
                    if (m & 1) asm volatile("" ::: "memory"); }
        }
        asm volatile("s_waitcnt lgkmcnt(0)" ::: "memory"); __builtin_amdgcn_s_barrier(); asm volatile("" ::: "memory");
    }
};

struct EpiFnet {
    static constexpr bool PERM = true, PREFETCH = false;
    bf16_t* Y; int rowbase, seqlen; float scale; unsigned slice_stride;
    __device__ __forceinline__ void operator()(const f32x4 (&acc)[2][2][4][2], const Unit& u, int wr, int wc, int fr_in, int fq_in) const {
        int t_ = threadIdx.x; asm volatile("" : "+v"(t_)); const int fr = t_ & 15, fq = (t_ >> 4) & 3; (void)fr_in; (void)fq_in;
        const int k0 = u.pm * BM + wr * 64 + fr; const int cw = wc * 32 + 8 * fq;
        bf16_t* Yb = Y + (size_t)(u.kofs >> 10) * slice_stride;
#pragma unroll
        for (int ai = 0; ai < 2; ++ai)
#pragma unroll
            for (int m = 0; m < 4; ++m) { const int row = rowbase + u.pn * seqlen + k0 + ai * HALF + m * 16; const unsigned yb = ((unsigned)row * 256u + (unsigned)cw) * 2u;
#pragma unroll
                for (int bj = 0; bj < 2; ++bj) { const f32x4 v0 = acc[ai][bj][m][0] * scale, v1 = acc[ai][bj][m][1] * scale;
                    u32x4 w; w.x = cvt_pk_bf16(v0[0], v0[1]); w.y = cvt_pk_bf16(v0[2], v0[3]); w.z = cvt_pk_bf16(v1[0], v1[1]); w.w = cvt_pk_bf16(v1[2], v1[3]);
                    gst<u32x4>(Yb, yb + bj * HALF * 2, w); } }
    }
};

template <bool F32BASE> struct EpiRes {
    static constexpr bool PERM = true, PREFETCH = false;
    const float* base_lat; const float* base_ctx;
    bf16_t* X; const float* mod; int gofs;
    const float* png; const float* pscmod; int pscofs;
    const float* ng; const float* scmod; int scofs; float* ssx;
    float gmul;
    bf16_t* part;
    __device__ __forceinline__ void operator()(const f32x4 (&acc)[2][2][4][2], const Unit& u, int wr, int wc, int fr_in, int fq_in) const {
        int t_ = threadIdx.x; asm volatile("" : "+v"(t_)); const int fr = t_ & 15, fq = (t_ >> 4) & 3; (void)fr_in; (void)fq_in;
        if (part != nullptr && u.pm >= 64) {
            const int sl = u.aux;
            const int prow0 = (u.pm - 64) * BM + wr * 64 + fr; const int pcol0 = u.pn * BM + wc * 32 + 8 * fq; bf16_t* pb_ = part + (size_t)sl * (2048u * 1024u);
#pragma unroll
            for (int ai = 0; ai < 2; ++ai)
#pragma unroll
                for (int m = 0; m < 4; ++m) { const unsigned off = ((unsigned)(prow0 + ai * HALF + m * 16) * 1024u + (unsigned)pcol0) * 2u;
#pragma unroll
                    for (int bj = 0; bj < 2; ++bj) { const f32x4 v0 = acc[ai][bj][m][0], v1 = acc[ai][bj][m][1];
                        u32x4 w; w.x = cvt_pk_bf16(v0[0], v0[1]); w.y = cvt_pk_bf16(v0[2], v0[3]); w.z = cvt_pk_bf16(v1[0], v1[1]); w.w = cvt_pk_bf16(v1[2], v1[3]);
                        gst<u32x4>(pb_, off + (unsigned)(bj * HALF) * 2u, w); } }
            return;
        }
        const bool lat = u.pm < 64; const int r = lat ? (u.pm >> 3) : 8;
        constexpr bool f32base = F32BASE; const float* bf = lat ? base_lat : base_ctx;
        const float* gate = mod + r * 6144 + gofs;
        const int frow0 = (lat ? u.pm : u.pm - 64) * BM + wr * 64 + fr; const int col0 = u.pn * BM + wc * 32 + 8 * fq;
        const int grow0 = u.pm * BM + wr * 64 + fr;
        const bool scaled = ng != nullptr;
        float ss[8];
#pragma unroll
        for (int q = 0; q < 8; ++q) ss[q] = 0.f;
#pragma unroll
        for (int bj = 0; bj < 2; ++bj) {
            f32x4 gv[2], gs[2], gp[2];
#pragma unroll
            for (int n = 0; n < 2; ++n) { const unsigned cb = (unsigned)(col0 + bj * HALF + n * 4) * 4u; gv[n] = gld<f32x4>(gate, cb) * gmul;
                gs[n] = scaled ? gld<f32x4>(ng, cb) * (gld<f32x4>(scmod, (unsigned)(r * 6144 + scofs) * 4u + cb) + 1.0f) : (f32x4){1.f, 1.f, 1.f, 1.f};
                if constexpr (!f32base) { const f32x4 d = gld<f32x4>(png, cb) * (gld<f32x4>(pscmod, (unsigned)(r * 6144 + pscofs) * 4u + cb) + 1.0f);
                    gp[n] = (f32x4){__builtin_amdgcn_rcpf(d[0]), __builtin_amdgcn_rcpf(d[1]), __builtin_amdgcn_rcpf(d[2]), __builtin_amdgcn_rcpf(d[3])}; }
                else gp[n] = (f32x4){1.f, 1.f, 1.f, 1.f}; }
#pragma unroll
            for (int ai = 0; ai < 2; ++ai) {
                f32x4 x0[4], x1[4];
#pragma unroll
                for (int m = 0; m < 4; ++m) { const unsigned o2 = ((unsigned)(grow0 + ai * HALF + m * 16) * 1024u + (unsigned)(col0 + bj * HALF)) * 2u;
                    const unsigned fo = ((unsigned)(frow0 + ai * HALF + m * 16) * 1024u + (unsigned)(col0 + bj * HALF)) * 4u;
                    if constexpr (f32base) { x0[m] = gldnt<f32x4>(bf, fo); x1[m] = gldnt<f32x4>(bf, fo + 16u); }
                    else { const u32x4 bw = gldnt<u32x4>(X, o2); x0[m] = __builtin_bit_cast(f32x4, (u32x4){bw.x << 16, bw.x & 0xffff0000u, bw.y << 16, bw.y & 0xffff0000u});
                        x1[m] = __builtin_bit_cast(f32x4, (u32x4){bw.z << 16, bw.z & 0xffff0000u, bw.w << 16, bw.w & 0xffff0000u}); } }
                asm volatile("" ::: "memory");
#pragma unroll
                for (int m = 0; m < 4; ++m) { const unsigned o2 = ((unsigned)(grow0 + ai * HALF + m * 16) * 1024u + (unsigned)(col0 + bj * HALF)) * 2u;
                    f32x4 y0 = x0[m], y1 = x1[m];
                    if constexpr (!f32base) { y0 = y0 * gp[0]; y1 = y1 * gp[1]; }
                    y0 = y0 + gv[0] * acc[ai][bj][m][0]; y1 = y1 + gv[1] * acc[ai][bj][m][1];
                    ss[ai * 4 + m] += ((y0[0] * y0[0] + y0[1] * y0[1]) + (y0[2] * y0[2] + y0[3] * y0[3])) + ((y1[0] * y1[0] + y1[1] * y1[1]) + (y1[2] * y1[2] + y1[3] * y1[3]));
                    asm volatile("" : "+v"(ss[ai * 4 + m]));
                    const f32x4 h0 = y0 * gs[0], h1 = y1 * gs[1];
                    u32x4 hw; hw.x = cvt_pk_bf16(h0[0], h0[1]); hw.y = cvt_pk_bf16(h0[2], h0[3]); hw.z = cvt_pk_bf16(h1[0], h1[1]); hw.w = cvt_pk_bf16(h1[2], h1[3]);
                    gst<u32x4>(X, o2, hw); }
                asm volatile("" ::: "memory"); }
        }
        if (scaled) {
#pragma unroll
            for (int q = 0; q < 8; ++q) { float s = ss[q]; s += __shfl_xor(s, 16); s += __shfl_xor(s, 32);
                if (fq == 0) gst<float>(ssx, ((unsigned)(grow0 + (q >> 2) * HALF + (q & 3) * 16) * 16u + (unsigned)(4 * u.pn + wc)) * 4u, s); } }
    }
};

#ifndef DPP_UP
#define DPP_UP 0x121
#define DPP_DN 0x12F
#endif
struct UnitUp : Unit { int nrows; };
struct EpiUp {
    static constexpr bool PERM = true, PREFETCH = true;
    bf16_t* act; const float* cw; const float* cb; PG8_LAS float* xb;
    const float* ssx; const float* ub;
    __device__ __forceinline__ void prefetch(const UnitUp& u, int wid, int lane) const {
        dma_ssx(ssx, u.arow, xb, wid, lane);
        { const int arr = wid >> 1, half = wid & 1; const float* src = (arr < 3 ? cw + arr * 2816 : cb) + u.pn * HALF + half * 64 + lane;
          __builtin_amdgcn_global_load_lds((const unsigned*)src, (PG8_LAS unsigned*)(xb + EX_CW + arr * 128 + half * 64), 4, 0, 0); }
        if (wid < 2) { const int a0 = u.arow < 0 ? 0 : u.arow; const int b0 = a0 >= MLAT_ ? 8 : (a0 >> 11); const int bb_ = b0 + wid > 8 ? 8 : b0 + wid;
            __builtin_amdgcn_global_load_lds((const unsigned*)(ub + bb_ * 5632 + u.pn * BM + lane * 4), (PG8_LAS unsigned*)(xb + EX_BL + wid * 256), 16, 0, 0); }
    }
    __device__ __forceinline__ void operator()(f32x4 (&acc)[2][2][4][2], const UnitUp& u, int wr, int wc, int fr_in, int fq_in) const {
        int t_ = threadIdx.x; asm volatile("" : "+v"(t_)); const int fr = t_ & 15, fq = (t_ >> 4) & 3; (void)fr_in; (void)fq_in;
        const int lane = fq * 16 + fr;
        const int ccol = wc * 32 + 8 * fq;
        const int gc = u.pn * HALF + ccol;
        PG8_LAS float* CW = xb + EX_CW;
        unsigned rowflags;
        { unsigned pmask = 0u;
          const int a0 = u.arow < 0 ? 0 : u.arow, e0 = u.arow + 255;
          const int seam = (a0 >= MLAT_) ? (1 << 30) : (((a0 >> 11) + 1) << 11);
          const bool straddle = e0 >= seam;
          const PG8_LAS float* bl = xb + EX_BL + ccol;
          const f32x4 ug0 = *(const PG8_LAS f32x4*)(bl), ug1 = *(const PG8_LAS f32x4*)(bl + 4), uv0 = *(const PG8_LAS f32x4*)(bl + HALF), uv1 = *(const PG8_LAS f32x4*)(bl + HALF + 4);
#pragma unroll
          for (int ai = 0; ai < 2; ++ai)
#pragma unroll
            for (int m = 0; m < 4; ++m) { const int tr = ai * HALF + wr * 64 + m * 16 + fr; const int g = u.arow + tr;
                const int pos = g < MLAT_ ? (g & 2047) : ((g - MLAT_) & 255); const int last = g < MLAT_ ? 2047 : 255;
                if (pos == 0) pmask |= 1u << (4 * ai + m); if (pos == last) pmask |= 256u << (4 * ai + m);
                const f32x4 s4 = *(const PG8_LAS f32x4*)(xb + EX_SSX + tr * 16 + 4 * fq); float ssr = (s4[0] + s4[1]) + (s4[2] + s4[3]); ssr += __shfl_xor(ssr, 16); ssr += __shfl_xor(ssr, 32);
                const float rs = __builtin_amdgcn_rsqf(ssr * (1.0f / 1024.0f) + RMS_EPS);
                acc[ai][0][m][0] = acc[ai][0][m][0] * rs + ug0; acc[ai][0][m][1] = acc[ai][0][m][1] * rs + ug1;
                acc[ai][1][m][0] = acc[ai][1][m][0] * rs + uv0; acc[ai][1][m][1] = acc[ai][1][m][1] * rs + uv1; }
          if (straddle) {
              const f32x4 dg0 = *(const PG8_LAS f32x4*)(bl + 256) - ug0, dg1 = *(const PG8_LAS f32x4*)(bl + 260) - ug1, dv0 = *(const PG8_LAS f32x4*)(bl + 256 + HALF) - uv0, dv1 = *(const PG8_LAS f32x4*)(bl + 260 + HALF) - uv1;
#pragma unroll
              for (int ai = 0; ai < 2; ++ai)
#pragma unroll
                for (int m = 0; m < 4; ++m) { const int g = u.arow + ai * HALF + wr * 64 + m * 16 + fr; const float sel = (g >= seam) ? 1.0f : 0.0f;
                    acc[ai][0][m][0] += dg0 * sel; acc[ai][0][m][1] += dg1 * sel; acc[ai][1][m][0] += dv0 * sel; acc[ai][1][m][1] += dv1 * sel; } }
          rowflags = pmask; }
        PG8_LAS float* XF = xb + EX_XF; PG8_LAS float* XL = xb + EX_XL;
        const bool isF = (fr == 0), isL = (fr == 15);
#pragma unroll
        for (int ai = 0; ai < 2; ++ai) { const int blk = 2 * ai + wr;
            f32x4 s0, s1;
#pragma unroll
            for (int e = 0; e < 4; ++e) { s0[e] = isF ? acc[ai][0][0][0][e] : acc[ai][0][3][0][e]; s1[e] = isF ? acc[ai][0][0][1][e] : acc[ai][0][3][1][e]; }
            PG8_LAS float* dst = xb + (isF ? EX_XF : EX_XL) + blk * 128 + ccol;
            if (isF || isL) { *(PG8_LAS f32x4*)dst = s0; *(PG8_LAS f32x4*)(dst + 4) = s1; } }
        asm volatile("s_waitcnt lgkmcnt(0)" ::: "memory"); __builtin_amdgcn_s_barrier(); asm volatile("" ::: "memory");
        const int lup = (lane & 48) | ((lane - 1) & 15), ldn = (lane & 48) | ((lane + 1) & 15);
#pragma unroll
        for (int ai = 0; ai < 2; ++ai) { const int blk = 2 * ai + wr;
#pragma unroll
            for (int n = 0; n < 2; ++n) {
                const f32x4 w0 = *(const PG8_LAS f32x4*)(CW + ccol + 4 * n), w1 = *(const PG8_LAS f32x4*)(CW + 128 + ccol + 4 * n), w2 = *(const PG8_LAS f32x4*)(CW + 256 + ccol + 4 * n), bb = *(const PG8_LAS f32x4*)(CW + 384 + ccol + 4 * n);
                f32x4 xprev = (f32x4){0.f, 0.f, 0.f, 0.f}, xnext = (f32x4){0.f, 0.f, 0.f, 0.f};
                if (blk > 0) xprev = *(const PG8_LAS f32x4*)(XL + (blk - 1) * 128 + ccol + 4 * n);
                if (blk < 3) xnext = *(const PG8_LAS f32x4*)(XF + (blk + 1) * 128 + ccol + 4 * n);
#pragma unroll
                for (int e = 0; e < 4; ++e) {
                    float cur[4], up[4], dn[4];
#pragma unroll
                    for (int m = 0; m < 4; ++m) cur[m] = acc[ai][0][m][n][e];
#pragma unroll
                    for (int m = 0; m < 4; ++m) {
                        const float tu = isL ? (m > 0 ? cur[m > 0 ? m - 1 : 0] : xprev[e]) : cur[m];
                        const float td = isF ? (m < 3 ? cur[m < 3 ? m + 1 : 3] : xnext[e]) : cur[m];
                        up[m] = __shfl(tu, lup); dn[m] = __shfl(td, ldn); }
                    float rr[4];
#pragma unroll
                    for (int m = 0; m < 4; ++m) { const float upv = ((rowflags >> (4 * ai + m)) & 1u) ? 0.f : up[m], dnv = ((rowflags >> (8 + 4 * ai + m)) & 1u) ? 0.f : dn[m];
                        const float cv = w0[e] * upv + w1[e] * cur[m] + w2[e] * dnv + bb[e];
                        const float sg = cv * __builtin_amdgcn_rcpf(1.0f + __expf(-cv));
                        rr[m] = sg * acc[ai][1][m][n][e]; }
                    asm volatile("" : "+v"(rr[0]), "+v"(rr[1]), "+v"(rr[2]), "+v"(rr[3]));
#pragma unroll
                    for (int m = 0; m < 4; ++m) acc[ai][0][m][n][e] = rr[m];
                }
            }
#pragma unroll
            for (int m = 0; m < 4; ++m) { const int tr = ai * HALF + wr * 64 + m * 16 + fr; const int g = u.arow + tr;
                if (tr >= 1 && tr <= 254 && g < u.nrows) { const f32x4 v0 = acc[ai][0][m][0], v1 = acc[ai][0][m][1];
                    u32x4 w; w.x = cvt_pk_bf16(v0[0], v0[1]); w.y = cvt_pk_bf16(v0[2], v0[3]); w.z = cvt_pk_bf16(v1[0], v1[1]); w.w = cvt_pk_bf16(v1[2], v1[3]);
                    gst<u32x4>(act, ((unsigned)g * 2816u + (unsigned)gc) * 2u, w); } }
            asm volatile("" ::: "memory");
        }
        asm volatile("s_waitcnt lgkmcnt(0)" ::: "memory"); __builtin_amdgcn_s_barrier(); asm volatile("" ::: "memory");
    }
};
}
namespace att {
using bf16x8 = __attribute__((ext_vector_type(8))) short;
using s16x4  = __attribute__((ext_vector_type(4))) short;
using f32x16 = __attribute__((ext_vector_type(16))) float;
using u32x4  = __attribute__((ext_vector_type(4))) unsigned;
typedef unsigned short bf16_t;
constexpr int NW = 8, QBLK = 32, KVBLK = 64;
constexpr int LDQ = 768, LDK = 768, LDV = 512, LDO = 512;
constexpr float SCALE = 0.07216878364870322f;
constexpr float THR = 8.f;
constexpr int SHM_V = KVBLK * 128 * 2, SHM_K = KVBLK * 192 * 2;
constexpr int OFF_V = 0, OFF_K = 2 * SHM_V, OFF_WS = 2 * SHM_V + 2 * SHM_K, OFF_QR = OFF_WS + NW * 64 * 4, SHM_ATTN = OFF_QR + NW * 4096;
#define KSWZ(row, colB) ((row) * 384 + ((colB) ^ (((row) & 7) << 4)))
#define SBAR() __builtin_amdgcn_sched_barrier(0)
__device__ __forceinline__ int crow(int r, int hi) { return (r & 3) + 8 * (r >> 2) + 4 * hi; }
__device__ __forceinline__ unsigned cvtpk(float lo, float hi) { unsigned r; asm volatile("v_cvt_pk_bf16_f32 %0, %1, %2" : "=v"(r) : "v"(lo), "v"(hi)); return r; }

__device__ __forceinline__ void partialSM(f32x16& p0, f32x16& p1, float& m_reg, float& mn, float& alpha) {
  constexpr float C = SCALE * 1.4426950408889634f;
  float pmax = p0[0];
#pragma unroll
  for (int r = 1; r < 16; ++r) pmax = fmaxf(pmax, p0[r]);
#pragma unroll
  for (int r = 0; r < 16; ++r) pmax = fmaxf(pmax, p1[r]);
  { auto rr = __builtin_amdgcn_permlane32_swap(__float_as_uint(pmax), __float_as_uint(pmax), false, false);
    pmax = fmaxf(__uint_as_float(rr[0]), __uint_as_float(rr[1])); }
  if (__builtin_expect(__all(pmax - m_reg <= THR / SCALE), 1)) { mn = m_reg; alpha = 1.f; }
  else { mn = fmaxf(m_reg, pmax); alpha = __builtin_amdgcn_exp2f((m_reg - mn) * C); m_reg = mn; }
  float mnC = -mn * C;
#pragma unroll
  for (int r = 0; r < 16; ++r) p0[r] = fmaf(p0[r], C, mnC);
#pragma unroll
  for (int r = 0; r < 16; ++r) p1[r] = fmaf(p1[r], C, mnC);
#pragma unroll
  for (int r = 0; r < 16; ++r) p0[r] = __builtin_amdgcn_exp2f(p0[r]);
}
__device__ __forceinline__ void finishSM(f32x16& p0, f32x16& p1, float alpha, float& l_reg, bf16x8& pa0, bf16x8& pa1, bf16x8& pa2, bf16x8& pa3) {
#pragma unroll
  for (int r = 0; r < 16; ++r) p1[r] = __builtin_amdgcn_exp2f(p1[r]);
  float ps = 0;
#pragma unroll
  for (int r = 0; r < 16; ++r) ps += p0[r];
#pragma unroll
  for (int r = 0; r < 16; ++r) ps += p1[r];
  { auto rr = __builtin_amdgcn_permlane32_swap(__float_as_uint(ps), __float_as_uint(ps), false, false);
    ps = __uint_as_float(rr[0]) + __uint_as_float(rr[1]); }
  l_reg = l_reg * alpha + ps;
#define PK4(P, BASE, OUT) do { unsigned a0 = cvtpk(P[BASE + 0], P[BASE + 1]), a1 = cvtpk(P[BASE + 2], P[BASE + 3]);   \
    unsigned b0 = cvtpk(P[BASE + 4], P[BASE + 5]), b1 = cvtpk(P[BASE + 6], P[BASE + 7]);                              \
    auto r0 = __builtin_amdgcn_permlane32_swap(a0, b0, false, false); auto r1 = __builtin_amdgcn_permlane32_swap(a1, b1, false, false); \
    u32x4 w = {r0[0], r1[0], r0[1], r1[1]}; OUT = *reinterpret_cast<bf16x8*>(&w); } while (0)
  PK4(p0, 0, pa0); PK4(p0, 8, pa1); PK4(p1, 0, pa2); PK4(p1, 8, pa3);
#undef PK4
}
__device__ __forceinline__ void qkt(f32x16& p0, f32x16& p1, const char* Ks, const bf16x8* qr, const char* Qr, int r32, int hi) {
  p0 = f32x16{}; p1 = f32x16{};
#pragma unroll
  for (int d0 = 0; d0 < 12; ++d0) { int cb = (d0 * 16 + hi * 8) * 2;
    bf16x8 b0 = *reinterpret_cast<const bf16x8*>(Ks + KSWZ(r32, cb));
    bf16x8 b1 = *reinterpret_cast<const bf16x8*>(Ks + KSWZ(32 + r32, cb));
    bf16x8 q;
    if (d0 < 8) q = qr[d0];
    else q = *reinterpret_cast<const bf16x8*>(Qr + r32 * 128 + ((((d0 - 8) * 16 + hi * 8) * 2) ^ ((r32 & 7) << 4)));
    p0 = __builtin_amdgcn_mfma_f32_32x32x16_bf16(b0, q, p0, 0, 0, 0);
    p1 = __builtin_amdgcn_mfma_f32_32x32x16_bf16(b1, q, p1, 0, 0, 0); }
}
__device__ __forceinline__ int v_st(int k, int c) { const int kk = (k & ~0xC) | ((k & 4) << 1) | ((k & 8) >> 1); return ((kk >> 3) * 4 + (c >> 5)) * 512 + ((kk & 7) * 32 + (c & 31)) * 2; }
__device__ __forceinline__ int v_rd_base(int lane) { return ((lane & 3) << 3) | (((lane >> 2) & 3) << 6) | (((lane >> 4) & 1) << 5) | (((lane >> 5) & 1) << 8); }
constexpr int v_rd_off(int d0, int ks, int half) { return d0 * 512 + ks * 4096 + half * 2048; }
template <int OFF> __device__ __forceinline__ s16x4 tr_read(int vb) {
  s16x4 r; asm volatile("ds_read_b64_tr_b16 %0, %1 offset:%2" : "=&v"(r) : "v"(vb), "i"(OFF) : "memory"); return r;
}
template <int D0> __device__ __forceinline__ void pv_one(f32x16& od, int vb, bf16x8 pa0, bf16x8 pa1, bf16x8 pa2, bf16x8 pa3) {
  const s16x4 l0 = tr_read<v_rd_off(D0, 0, 0)>(vb), h0 = tr_read<v_rd_off(D0, 0, 1)>(vb), l1 = tr_read<v_rd_off(D0, 1, 0)>(vb), h1 = tr_read<v_rd_off(D0, 1, 1)>(vb);
  const s16x4 l2 = tr_read<v_rd_off(D0, 2, 0)>(vb), h2 = tr_read<v_rd_off(D0, 2, 1)>(vb), l3 = tr_read<v_rd_off(D0, 3, 0)>(vb), h3 = tr_read<v_rd_off(D0, 3, 1)>(vb);
  asm volatile("s_waitcnt lgkmcnt(0)" ::: "memory"); SBAR();
#define PK(L, H) (bf16x8){L[0], L[1], L[2], L[3], H[0], H[1], H[2], H[3]}
  od = __builtin_amdgcn_mfma_f32_32x32x16_bf16(pa0, PK(l0, h0), od, 0, 0, 0);
  od = __builtin_amdgcn_mfma_f32_32x32x16_bf16(pa1, PK(l1, h1), od, 0, 0, 0);
  od = __builtin_amdgcn_mfma_f32_32x32x16_bf16(pa2, PK(l2, h2), od, 0, 0, 0);
  od = __builtin_amdgcn_mfma_f32_32x32x16_bf16(pa3, PK(l3, h3), od, 0, 0, 0);
#undef PK
}
__device__ __forceinline__ void pv_d0(f32x16* o, int vb, bf16x8 pa0, bf16x8 pa1, bf16x8 pa2, bf16x8 pa3) {
  pv_one<0>(o[0], vb, pa0, pa1, pa2, pa3); pv_one<1>(o[1], vb, pa0, pa1, pa2, pa3); pv_one<2>(o[2], vb, pa0, pa1, pa2, pa3); pv_one<3>(o[3], vb, pa0, pa1, pa2, pa3);
}

__device__ __forceinline__ void attn_unit(const bf16_t* __restrict__ Qb, const bf16_t* __restrict__ Kg, const bf16_t* __restrict__ Vg, bf16_t* __restrict__ Ob,
                                          int r0, int n0, int r1, int NT, char* lds) {
  int tid = threadIdx.x; asm volatile("" : "+v"(tid));
  const int wid = tid >> 6, lane = tid & 63, r32 = lane & 31, hi = lane >> 5;
  char* V_lds = lds + OFF_V; char* K_lds = lds + OFF_K;
  float* ws = (float*)(lds + OFF_WS) + wid * 64; float* li_l = ws; float* al_l = ws + 32;
  float m_reg = -1e30f, l_reg = 0; f32x16 o[4] = {}; bf16x8 qr[8];
  const bf16_t* Qw = Qb + (long)(wid * QBLK + r32) * LDQ + hi * 8;
  char* Qr = lds + OFF_QR + wid * 4096;
#pragma unroll
  for (int d0 = 0; d0 < 8; ++d0) qr[d0] = *reinterpret_cast<const bf16x8*>(Qw + d0 * 16);
#pragma unroll
  for (int d0 = 8; d0 < 12; ++d0) { const bf16x8 q = *reinterpret_cast<const bf16x8*>(Qw + d0 * 16);
    *reinterpret_cast<bf16x8*>(Qr + r32 * 128 + ((((d0 - 8) * 16 + hi * 8) * 2) ^ ((r32 & 7) << 4))) = q; }
  const int sr = tid >> 4, sc = (tid & 15) * 8, vst0 = v_st(sr, sc), vst1 = v_st(32 + sr, sc);
  unsigned kgo[3], kst[3];
#pragma unroll
  for (int i = 0; i < 3; ++i) { const int id = tid + 512 * i, kr_ = id / 24, kc_ = id % 24; kgo[i] = (unsigned)(kr_ * LDK + kc_ * 8) * 2u; kst[i] = (unsigned)KSWZ(kr_, kc_ * 16); }
  const unsigned vgo0 = (unsigned)(sr * LDV + sc) * 2u, vgo1 = vgo0 + 32u * LDV * 2u;
  const int vb0 = (int)(uintptr_t)V_lds + v_rd_base(lane);
  bf16x8 vs0, vs1, ks0, ks1, ks2;
#define TROW(j) ((j) < n0 ? r0 + 64 * (j) : r1 + 64 * ((j) - n0))
#define SLOAD(j) do { const long tr_ = TROW(j); const char* Vt = (const char*)(Vg + tr_ * LDV); const char* Kt = (const char*)(Kg + tr_ * LDK);     \
    vs0 = *reinterpret_cast<const bf16x8*>(Vt + vgo0); vs1 = *reinterpret_cast<const bf16x8*>(Vt + vgo1); \
    ks0 = *reinterpret_cast<const bf16x8*>(Kt + kgo[0]); ks1 = *reinterpret_cast<const bf16x8*>(Kt + kgo[1]); ks2 = *reinterpret_cast<const bf16x8*>(Kt + kgo[2]); } while (0)
#define SWRITE(b) do { *(bf16x8*)(V_lds + (b) * SHM_V + vst0) = vs0; *(bf16x8*)(V_lds + (b) * SHM_V + vst1) = vs1; \
    *(bf16x8*)(K_lds + (b) * SHM_K + kst[0]) = ks0; *(bf16x8*)(K_lds + (b) * SHM_K + kst[1]) = ks1; *(bf16x8*)(K_lds + (b) * SHM_K + kst[2]) = ks2; } while (0)
#define RESC(a) do { if (__any((a) < 1.f)) { if (hi == 0) al_l[r32] = (a); asm volatile("s_waitcnt lgkmcnt(0)" ::: "memory"); \
    _Pragma("unroll") for (int d = 0; d < 4; ++d) _Pragma("unroll") for (int r = 0; r < 16; ++r) o[d][r] *= al_l[crow(r, hi)]; } } while (0)
  f32x16 pA0, pA1, pB0, pB1; float mnA, mnB, alA, alB; bf16x8 pa0, pa1, pa2, pa3;
  SLOAD(0); asm volatile("s_waitcnt vmcnt(0)" ::: "memory"); SWRITE(0); __syncthreads();
  qkt(pA0, pA1, K_lds, qr, Qr, r32, hi); partialSM(pA0, pA1, m_reg, mnA, alA);
  SLOAD(1);
  asm volatile("s_waitcnt vmcnt(0)" ::: "memory"); SWRITE(1); __syncthreads();
  for (int j = 1; j + 1 < NT; j += 2) {
    SBAR(); qkt(pB0, pB1, K_lds + SHM_K, qr, Qr, r32, hi);
    finishSM(pA0, pA1, alA, l_reg, pa0, pa1, pa2, pa3); SBAR();
    SLOAD(j + 1); SBAR();
    pv_d0(o, vb0, pa0, pa1, pa2, pa3); partialSM(pB0, pB1, m_reg, mnB, alB);
    __syncthreads(); asm volatile("s_waitcnt vmcnt(0)" ::: "memory"); SWRITE(0);
    RESC(alB); __syncthreads();
    SBAR(); qkt(pA0, pA1, K_lds, qr, Qr, r32, hi);
    finishSM(pB0, pB1, alB, l_reg, pa0, pa1, pa2, pa3); SBAR();
    SLOAD(j + 2); SBAR();
    pv_d0(o, vb0 + SHM_V, pa0, pa1, pa2, pa3); partialSM(pA0, pA1, m_reg, mnA, alA);
    __syncthreads(); asm volatile("s_waitcnt vmcnt(0)" ::: "memory"); SWRITE(1);
    RESC(alA); __syncthreads();
  }
  SBAR(); qkt(pB0, pB1, K_lds + SHM_K, qr, Qr, r32, hi);
  finishSM(pA0, pA1, alA, l_reg, pa0, pa1, pa2, pa3); SBAR();
  pv_d0(o, vb0, pa0, pa1, pa2, pa3); partialSM(pB0, pB1, m_reg, mnB, alB);
  __syncthreads(); RESC(alB);
  finishSM(pB0, pB1, alB, l_reg, pa0, pa1, pa2, pa3); SBAR();
  pv_d0(o, vb0 + SHM_V, pa0, pa1, pa2, pa3);
  if (hi == 0) li_l[r32] = l_reg; asm volatile("s_waitcnt lgkmcnt(0)" ::: "memory");
  float rli[16];
#pragma unroll
  for (int r = 0; r < 16; ++r) rli[r] = __builtin_amdgcn_rcpf(li_l[crow(r, hi)]);
  __syncthreads();
  { bf16_t* stg = (bf16_t*)(lds + wid * 8192);
#pragma unroll
    for (int r = 0; r < 16; ++r) { const int orow = crow(r, hi);
#pragma unroll
      for (int d0 = 0; d0 < 4; ++d0) { const unsigned pk = cvtpk(o[d0][r] * rli[r], 0.f); stg[orow * 128 + d0 * 32 + r32] = (bf16_t)(pk & 0xffffu); } }
    asm volatile("s_waitcnt lgkmcnt(0)" ::: "memory");
    bf16_t* Ow = Ob + (long)(wid * QBLK) * LDO;
#pragma unroll
    for (int i = 0; i < 8; ++i) { const int row = i * 4 + (lane >> 4), ch = lane & 15; const u32x4 v = *(const u32x4*)(stg + row * 128 + ch * 8); *(u32x4*)(Ow + (long)row * LDO + ch * 8) = v; } }
  __syncthreads();
#undef TROW
#undef SLOAD
#undef SWRITE
#undef RESC
}
#undef KSWZ
#undef SBAR
}
constexpr int NWAVES = 8;
#ifndef MK_SPLIT
#define MK_SPLIT 0
#endif

constexpr int DM = 1024, NB = 8, SL = 2048, CL = 256, MLAT = NB * SL, MCTX = NB * CL, MT = MLAT + MCTX;
constexpr int NIN = 2048;
constexpr int FF = 2816, NUP = 2 * FF;
constexpr int NPH = 20;
constexpr float EPS = 1e-6f;

constexpr size_t MiB = 1u << 20;
constexpr size_t WS_CTL = 0, CTL_ZERO_BYTES = 64 * 1024;
constexpr size_t WS_MOD = 1 * MiB;
constexpr size_t WS_ROPE = 1 * MiB + 512 * 1024;
constexpr size_t WS_SSQ = 2 * MiB;
constexpr int NWIN = 2304;
constexpr size_t WS_WIN = 53 * MiB, WIN_STRIDE = (size_t)NWIN * DM * 2;
constexpr size_t WS_WQKV = 12 * MiB, WQKV_STRIDE = (size_t)1792 * 384 * 2;
constexpr size_t WS_WOUT = 15 * MiB, WOUT_STRIDE = (size_t)DM * DM * 2;
constexpr size_t WS_WUP = 19 * MiB, WUP_STRIDE = (size_t)NUP * DM * 2;
constexpr size_t WS_WDOWN = 41 * MiB, WDOWN_STRIDE = (size_t)DM * FF * 2;
constexpr size_t WS_DFT = 52 * MiB;
constexpr size_t WS_DFTC = 68 * MiB;
constexpr size_t WS_CST = 68 * MiB + 256 * 1024;
constexpr size_t WS_WF = 248 * MiB;
constexpr size_t WS_XCTX = 69 * MiB;
constexpr size_t WS_XN = 77 * MiB;
constexpr size_t WS_Q = WS_XN, WS_YC = WS_XN + 27 * MiB;
constexpr size_t WS_P = 113 * MiB;
constexpr size_t WS_YCAT = WS_P, WS_ACT = WS_P;
constexpr size_t WS_YFP = WS_P + 36 * MiB;
constexpr size_t WS_K = 185 * MiB;
constexpr size_t WS_V = 212 * MiB;
constexpr size_t WS_CPART = 212 * MiB;
constexpr size_t WS_ZT = 230 * MiB;
constexpr size_t WS_ZTC = WS_ZT + 16 * MiB;
constexpr size_t WS_YF = WS_ZT;
constexpr size_t WS_FTAB = WS_DFT;
constexpr size_t OUT_ATT = 36 * MiB;
constexpr size_t WS_SSX = 250 * MiB;
constexpr size_t WS_PB = 252 * MiB;
constexpr size_t WS_UB = 253 * MiB;
constexpr size_t WS_END = 254 * MiB;
static_assert(WS_WQKV + 2 * WQKV_STRIDE <= WS_WOUT && WS_WOUT + 2 * WOUT_STRIDE <= WS_WUP && WS_WUP + 2 * WUP_STRIDE <= WS_WDOWN && WS_WDOWN + 2 * WDOWN_STRIDE <= WS_DFT, "weights map");
static_assert(WS_WIN + 2 * WIN_STRIDE <= 68 * MiB && WS_SSQ + (size_t)MT * 80 <= 4 * MiB && WS_XN + (size_t)MT * DM * 2 <= WS_P && WS_P + (size_t)MT * NIN * 2 <= WS_K && WS_K + (size_t)MT * 768 * 2 <= WS_V && WS_V + (size_t)MT * 512 * 2 <= WS_ZT, "activation map");
static_assert(WS_ACT + (size_t)MT * FF * 2 <= WS_V && WS_YC + (size_t)MT * 256 * 2 <= WS_P, "overlay map");
constexpr int CW_BAR = 4096;

constexpr int RING_OFF = 0, RING_BYTES = 131072;
constexpr int LDSCTL_OFF = RING_BYTES, MISC_OFF = LDSCTL_OFF + 320, PTR_OFF = LDSCTL_OFF + 512, EPIX_OFF = LDSCTL_OFF + 1024;
constexpr int LDS_BYTES = 163840;
static_assert(EPIX_OFF + 6400 * 4 <= LDS_BYTES, "LDS map");

#define GAS __attribute__((address_space(1)))
#define LAS __attribute__((address_space(3)))
typedef unsigned short bf16;
typedef unsigned v4u __attribute__((ext_vector_type(4)));
typedef unsigned v2u __attribute__((ext_vector_type(2)));
typedef float f32x4 __attribute__((ext_vector_type(4)));
typedef GAS unsigned gu32;
#define RLX_AGENT __ATOMIC_RELAXED, __HIP_MEMORY_SCOPE_AGENT
#define LDS_WAIT() asm volatile("s_waitcnt lgkmcnt(0)" ::: "memory")
#define VM_WAIT() asm volatile("s_waitcnt vmcnt(0)" ::: "memory")
__device__ __forceinline__ unsigned f2bf(float f) { unsigned u = __builtin_bit_cast(unsigned, f); return (u + 0x7fffu + ((u >> 16) & 1u)) >> 16; }
__device__ __forceinline__ unsigned pk2(float lo, float hi) { return f2bf(lo) | (f2bf(hi) << 16); }
__device__ __forceinline__ float bf2f(unsigned h) { return __builtin_bit_cast(float, h << 16); }

#define XB_TMO      128
#define XB_XCNT(j)  (256  + 64 * (j))
#define XB_XSUB(j)  (1280 + 64 * (j))
#define XB_XGEN(j)  (2304 + 64 * (j))
#define XB_TOP      3328
#define XB_TOPGEN   3392
#define XCD_BAR_WORDS 3456
#define XB_SPIN_CAP (1u << 20)
__device__ __forceinline__ unsigned xb_ld(unsigned* p)              { return __hip_atomic_load(p, __ATOMIC_RELAXED, __HIP_MEMORY_SCOPE_AGENT); }
__device__ __forceinline__ unsigned xb_add(unsigned* p, unsigned v) { return __hip_atomic_fetch_add(p, v, __ATOMIC_RELAXED, __HIP_MEMORY_SCOPE_AGENT); }
__device__ __forceinline__ unsigned xb_xcc_id() { return (unsigned)__builtin_amdgcn_s_getreg((3 << 11) | 20) & 0xFu; }
#define XB_SPIN(cond, bar) do { unsigned _sp = 0; while (cond) { __builtin_amdgcn_s_sleep(1); \
    if ((++_sp & 255u) == 0u) { if (xb_ld(&(bar)[XB_TMO])) break; if (_sp > XB_SPIN_CAP) { atomicAdd(&(bar)[XB_TMO], 1u); break; } } } } while (0)
struct XcdBarrier { unsigned* bar; unsigned x; volatile LAS unsigned* st; };
__device__ __forceinline__ XcdBarrier xcd_barrier_post(unsigned* bar, volatile LAS unsigned* st) {
    XcdBarrier b; b.bar = bar; b.x = xb_xcc_id(); b.st = st;
    if (threadIdx.x == 0) (void)xb_add(&bar[XB_XCNT(b.x)], 1u);
    return b;
}
__device__ __forceinline__ void xcd_barrier_complete(unsigned* bar, unsigned x, unsigned& nloc, unsigned& nx) {
    const unsigned G = gridDim.x * gridDim.y * gridDim.z;
    unsigned sum, cnt, mine, sp = 0u;
    for (;;) {
        sum = 0u; cnt = 0u; mine = 0u;
#pragma unroll
        for (unsigned j = 0; j < 16; ++j) { const unsigned c = xb_ld(&bar[XB_XCNT(j)]); sum += c; cnt += (c > 0u) ? 1u : 0u; mine = (j == x) ? c : mine; }
        if (sum == G) break;
        __builtin_amdgcn_s_sleep(1);
        if ((++sp & 255u) == 0u) { if (xb_ld(&bar[XB_TMO])) break; if (sp > XB_SPIN_CAP) { atomicAdd(&bar[XB_TMO], 1u); break; } }
    }
    nloc = mine > 0u ? mine : 1u; nx = cnt > 0u ? cnt : 1u;
}
__device__ __forceinline__ void xcd_barrier(const XcdBarrier& b) {
    asm volatile("s_waitcnt vmcnt(0)" ::: "memory");
    __syncthreads();
    if (threadIdx.x == 0) {
        unsigned* bar = b.bar;
        __builtin_amdgcn_s_waitcnt(0);
        unsigned nloc = b.st[0], nx = b.st[1];
        if (nloc == 0u) { xcd_barrier_complete(bar, b.x, nloc, nx); b.st[0] = nloc; b.st[1] = nx; }
        const unsigned old = xb_add(&bar[XB_XSUB(b.x)], 1u);
        const unsigned gen = old / nloc;
        if (old + 1u == (gen + 1u) * nloc) {
            __builtin_amdgcn_fence(__ATOMIC_RELEASE, "agent");
            asm volatile("s_waitcnt vmcnt(0)" ::: "memory");
            const unsigned og = xb_add(&bar[XB_TOP], 1u);
            const unsigned tg = og / nx;
            if (og + 1u == (tg + 1u) * nx) xb_add(&bar[XB_TOPGEN], 1u);
            else XB_SPIN(xb_ld(&bar[XB_TOPGEN]) == tg, bar);
            __builtin_amdgcn_fence(__ATOMIC_ACQUIRE, "agent");
            xb_add(&bar[XB_XGEN(b.x)], 1u);
            asm volatile("s_waitcnt vmcnt(0)" ::: "memory");
        } else {
            XB_SPIN(xb_ld(&bar[XB_XGEN(b.x)]) == gen, bar);
            __builtin_amdgcn_fence(__ATOMIC_ACQUIRE, "agent");
            asm volatile("s_waitcnt vmcnt(0)" ::: "memory");
        }
    }
    __syncthreads();
}

struct Args { const float* in[22]; float* out; unsigned char* ws; int ph_lo, ph_hi; };
enum { I_X = 0, I_C, I_CTX, I_CCTX, I_ADAW, I_ADAB, I_N1G, I_WIN, I_QNG, I_KVNG, I_WUQ, I_WUKV, I_SCW, I_SCB, I_ONG, I_WOUT, I_N2G, I_WUP, I_FCW, I_FCB, I_WDOWN, I_FING };

struct Frame {
    LAS unsigned char* lds; char* ldsg;
    volatile LAS unsigned* MISC;
    int tid, lane, wave, vcu, G, bx;
    unsigned char* ws; float* out;
};

__device__ __forceinline__ const float* inptr(const Frame& F, int i) {
    const LAS unsigned* T = (const LAS unsigned*)(F.lds + PTR_OFF) + 2 * i;
    const unsigned lo = __builtin_amdgcn_readfirstlane(T[0]), hi = __builtin_amdgcn_readfirstlane(T[1]);
    return (const float*)(const GAS float*)(((unsigned long long)hi << 32) | (unsigned long long)lo);
}
__device__ __forceinline__ float wave_sum(float v) {
#pragma unroll
    for (int o = 1; o < 64; o <<= 1) v += __shfl_xor(v, o);
    return v;
}

__device__ __host__ __forceinline__ int rope_slot(int d) { return 8 * ((d & 15) >> 2) + 4 * (d >> 4) + (d & 3); }
__device__ __forceinline__ void tr_item(const float* W, int ldw, int k0, int c0, bf16* WT, int ldt, int r0, const float* ks, LAS float* scr, int lane, bool ropeperm = false) {
    f32x4 v[8];
#pragma unroll
    for (int i = 0; i < 8; ++i) { const int kk = 8 * i + (lane >> 3); v[i] = __builtin_nontemporal_load((const GAS f32x4*)(W + (size_t)(k0 + kk) * ldw + c0 + 4 * (lane & 7))); }
#pragma unroll
    for (int i = 0; i < 8; ++i) { const int kk = 8 * i + (lane >> 3); const float sc = ks ? ks[k0 + kk] : 1.0f; LAS float* d = scr + kk * 33 + 4 * (lane & 7);
        d[0] = v[i][0] * sc; d[1] = v[i][1] * sc; d[2] = v[i][2] * sc; d[3] = v[i][3] * sc; }
    LDS_WAIT(); asm volatile("" ::: "memory");
    const int c = lane & 7;
#pragma unroll
    for (int j = 0; j < 4; ++j) { const int n = (lane >> 3) + 8 * j; const LAS float* s = scr + (8 * c) * 33 + n;
        v4u o; o.x = pk2(s[0 * 33], s[1 * 33]); o.y = pk2(s[2 * 33], s[3 * 33]); o.z = pk2(s[4 * 33], s[5 * 33]); o.w = pk2(s[6 * 33], s[7 * 33]);
        *(GAS v4u*)(WT + (size_t)(r0 + (ropeperm ? rope_slot(n) : n)) * ldt + k0 + 8 * c) = o; }
    LDS_WAIT(); asm volatile("" ::: "memory");
}
__device__ __forceinline__ void p0_prologue(Frame& F, int sub, int defer, int gw, int NGW) {
    unsigned char* ws = F.ws;
    float* MOD = (float*)(ws + WS_MOD);
    if (F.bx < 192 && (sub & 1) && defer == 0) {
        const int l = F.bx / 96, cb = F.bx % 96;
        LAS float* S = (LAS float*)(F.lds + F.wave * 4608);
        const float* cin = inptr(F, I_C); const float* cctx = inptr(F, I_CCTX);
        for (int i = F.lane; i < 9 * 128; i += 64) { const int r = i >> 7, kk = i & 127, k = 128 * F.wave + kk; const float cv = (r < 8) ? cin[r * 1024 + k] : cctx[k]; S[i] = cv / (1.0f + __expf(-cv)); }
        LDS_WAIT(); asm volatile("" ::: "memory");
        f32x4 acc[9];
#pragma unroll
        for (int r = 0; r < 9; ++r) acc[r] = (f32x4){0.f, 0.f, 0.f, 0.f};
        const int kr = F.lane >> 4, cl = F.lane & 15;
        const float* W = inptr(F, I_ADAW) + (size_t)l * 1024 * 6144 + (size_t)(128 * F.wave) * 6144 + 64 * cb + 4 * cl;
#pragma unroll 8
        for (int i = 0; i < 32; ++i) { const int kk = 4 * i + kr; const f32x4 w = __builtin_nontemporal_load((const f32x4*)(W + (size_t)kk * 6144));
#pragma unroll
            for (int r = 0; r < 9; ++r) acc[r] += w * S[r * 128 + kk]; }
        LAS float* RED = (LAS float*)(F.lds + 40960);
#pragma unroll
        for (int r = 0; r < 9; ++r)
#pragma unroll
            for (int e = 0; e < 4; ++e) { float v = acc[r][e]; v += __shfl_xor(v, 16); v += __shfl_xor(v, 32); if (kr == 0) RED[(F.wave * 9 + r) * 64 + 4 * cl + e] = v; }
        __syncthreads();
        for (int i = F.tid; i < 576; i += 512) { const int r = i >> 6, col = i & 63; float s = 0.f;
#pragma unroll
            for (int w = 0; w < 8; ++w) s += RED[(w * 9 + r) * 64 + col];
            MOD[(size_t)(l * 9 + r) * 6144 + 64 * cb + col] = s + inptr(F, I_ADAB)[l * 6144 + 64 * cb + col]; }
        __syncthreads();
    }
    if (F.bx == 255 % F.G && defer == 0) {
        float* RC = (float*)(ws + WS_ROPE); float* RS = RC + 1024;
        for (int idx = F.tid; idx < 1024; idx += 512) { const int pos = idx >> 4, i = idx & 15; const float inv = powf(10000.0f, -(float)(2 * i) / 32.0f); const float ang = (float)pos * inv; RC[idx] = cosf(ang); RS[idx] = sinf(ang); }
    }
    LAS float* scr = (LAS float*)(F.lds + F.wave * 16384);
    constexpr int I_WINA = 22 * 16, I_WINB = 24 * 16, I_WINC = 8 * 16, I_PAD = 8, I_FOLD = 64, I_UQ = 6 * 24, I_UKV = 4 * 32, I_OUT = 16 * 32, I_UP = 16 * 176, I_DOWN = 44 * 32;
    constexpr int PER_LAYER = I_WINA + I_WINB + I_WINC + I_PAD + I_FOLD + I_UQ + I_UKV + I_OUT + I_UP + I_DOWN;
    constexpr int I_DFT = 352, I_DFTC = 256, I_CST = 512;
    constexpr int NITEMS = 2 * PER_LAYER + I_DFT + I_DFTC + I_CST;
    for (int it = gw; it < NITEMS; it += NGW) {
        int r = it;
        { int cat = 2; bool early = false; if (r < 2 * PER_LAYER) { const int q = r % PER_LAYER;
              constexpr int W0 = I_WINA + I_WINB + I_WINC + I_PAD; early = r < PER_LAYER && q >= W0 + I_FOLD && q < W0 + I_FOLD + I_UQ + I_UKV;
              cat = q < W0 ? 1 : q < W0 + I_FOLD ? 3 : q < W0 + I_FOLD + I_UQ + I_UKV + I_OUT ? 4 : q < PER_LAYER - I_DOWN ? 5 : 6; }
          if (!((sub >> cat) & 1)) continue;
          const int dcls = (r < 2 * PER_LAYER && cat >= 4 && !early) ? ((r < PER_LAYER && cat < 6) ? 1 : 2) : 0; if (dcls != defer) continue; }
        if (r < 2 * PER_LAYER) {
            const int l = r / PER_LAYER; r -= l * PER_LAYER;
            bf16* WinT = (bf16*)(ws + WS_WIN + l * WIN_STRIDE);
            const float* win = inptr(F, I_WIN) + (size_t)l * 1024 * 1728;
            if (r < I_WINA) { const int kb = r / 22, nb = r % 22; tr_item(win, 1728, 64 * kb, 32 * nb, WinT, 1024, 32 * nb, nullptr, scr, F.lane); continue; } r -= I_WINA;
            if (r < I_WINB) { const int kb = r / 24, nb = r % 24; tr_item(win, 1728, 64 * kb, 960 + 32 * nb, WinT, 1024, 1280 + 32 * nb, nullptr, scr, F.lane); continue; } r -= I_WINB;
            if (r < I_WINC) { const int kb = r / 8, nb = r % 8; tr_item(win, 1728, 64 * kb, 704 + 32 * nb, WinT, 1024, 2048 + 32 * nb, nullptr, scr, F.lane); continue; } r -= I_WINC;
            if (r < I_PAD) { const v4u z = {0u, 0u, 0u, 0u};
#pragma unroll
                for (int j = 0; j < 16; ++j) { const int q = j * 64 + F.lane; *(GAS v4u*)(WinT + (size_t)(704 + 8 * r + (q >> 7)) * 1024 + (q & 127) * 8) = z; } continue; } r -= I_PAD;
            if (r < I_FOLD) { bf16* WF = (bf16*)(ws + WS_WF) + (size_t)l * 1024 * 256;
#pragma unroll 4
                for (int i = 0; i < 16; ++i) { const int k = 16 * r + i; const f32x4 v = *(const GAS f32x4*)(win + (size_t)k * 1728 + 704 + 4 * F.lane);
                    v2u o; o.x = pk2(v[0], v[1]); o.y = pk2(v[2], v[3]); *(GAS v2u*)(WF + (size_t)k * 256 + 4 * F.lane) = o; } continue; } r -= I_FOLD;
            if (r < I_UQ) { const int kb = r / 24, nb = r % 24; tr_item(inptr(F, I_WUQ) + (size_t)l * 384 * 768, 768, 64 * kb, 32 * nb, (bf16*)(ws + WS_WQKV + l * WQKV_STRIDE), 384, 32 * nb, inptr(F, I_QNG) + l * 384, scr, F.lane, (nb % 6) >= 4); continue; } r -= I_UQ;
            if (r < I_UKV) { const int kb = r / 32, nb = r % 32; tr_item(inptr(F, I_WUKV) + (size_t)l * 256 * 1024, 1024, 64 * kb, 32 * nb, (bf16*)(ws + WS_WQKV + l * WQKV_STRIDE) + (size_t)768 * 384, 384, 32 * nb, inptr(F, I_KVNG) + l * 256, scr, F.lane); continue; } r -= I_UKV;
            if (r < I_OUT) { const int kb = r / 32, nb = r % 32; tr_item(inptr(F, I_WOUT) + (size_t)l * 1024 * 1024, 1024, 64 * kb, 32 * nb, (bf16*)(ws + WS_WOUT + l * WOUT_STRIDE), 1024, 32 * nb, inptr(F, I_ONG) + l * 1024, scr, F.lane); continue; } r -= I_OUT;
            if (r < I_UP) { const int kb = r / 176, nb = r % 176;
                const int j = nb >> 3, h = (nb >> 2) & 1, q = nb & 3;
                tr_item(inptr(F, I_WUP) + (size_t)l * 1024 * NUP, NUP, 64 * kb, h * FF + 128 * j + 32 * q, (bf16*)(ws + WS_WUP + l * WUP_STRIDE), 1024, 32 * nb, nullptr, scr, F.lane); continue; } r -= I_UP;
            { const int kb = r / 32, nb = r % 32; tr_item(inptr(F, I_WDOWN) + (size_t)l * FF * 1024, 1024, 64 * kb, 32 * nb, (bf16*)(ws + WS_WDOWN + l * WDOWN_STRIDE), FF, 32 * nb, nullptr, scr, F.lane); continue; }
        }
        r -= 2 * PER_LAYER;
        if (r < I_DFT) {
            if (r < 128) { const int ro = r >> 6, c = r & 63; bf16* D = (bf16*)(ws + WS_FTAB) + (size_t)r * 128; float v[2];
#pragma unroll
                for (int e = 0; e < 2; ++e) { const int k = 2 * F.lane + e, ri = k >> 6, s = k & 63; const float x = (float)((c * s) & 63) * (1.0f / 32.0f); const float C = cospif(x), S = sinpif(x);
                    v[e] = (ro == ri) ? C : (ro == 0 ? -S : S); }
                *(GAS unsigned*)(D + 2 * F.lane) = pk2(v[0], v[1]); continue; }
            if (r < 160) { const int a = r - 128, ro = F.lane >> 5, rr = F.lane & 31; const float x = (float)((a * rr) & 31) * (1.0f / 16.0f); const float v = ro ? -sinpif(x) : cospif(x);
                *(GAS unsigned short*)((bf16*)(ws + WS_FTAB + 32768) + (size_t)a * 64 + F.lane) = (unsigned short)(pk2(v, 0.f) & 0xffffu); continue; }
            if (r >= 224) { const int rr = r - 224, kb = rr >> 4, col = rr & 15, ri = col >> 3, k2 = 8 * kb + (col & 7);
                const float x = (float)((k2 * F.lane) & 63) * (1.0f / 32.0f); const float v = ri ? sinpif(x) : cospif(x);
                *(GAS unsigned short*)((bf16*)(ws + WS_FTAB + 65536) + (size_t)rr * 64 + F.lane) = (unsigned short)(pk2(v, 0.f) & 0xffffu); continue; }
            { const int c = r - 160; if (F.lane < 32) { const float x = (float)(c * F.lane) * (1.0f / 1024.0f); pg8::f32x2 t; t.x = cospif(x); t.y = sinpif(x);
                *(GAS pg8::f32x2*)((float*)(ws + WS_FTAB + 40960) + (size_t)(c * 32 + F.lane) * 2) = t; } }
            continue; }
        r -= I_DFT;
        if (r >= I_DFTC) { r -= I_DFTC;
            const int sn = r >> 8, g = (r >> 6) & 3, k2 = r & 63; float v[4];
#pragma unroll
            for (int e = 0; e < 4; ++e) { const int j = 4 * F.lane + e; const float x = (float)((k2 * (j & 63)) & 63) * (1.0f / 32.0f); v[e] = ((j >> 6) == g) ? (sn ? sinpif(x) : cospif(x)) : 0.0f; }
            v2u o; o.x = pk2(v[0], v[1]); o.y = pk2(v[2], v[3]); *(GAS v2u*)((bf16*)(ws + WS_CST) + (size_t)r * 256 + 4 * F.lane) = o; continue; }
        { const int k1 = r; bf16* D = (bf16*)(ws + WS_DFTC) + (size_t)k1 * 512; const int n0 = 8 * F.lane; float v[8];
#pragma unroll
            for (int e = 0; e < 8; ++e) { const int n = n0 + e, n1 = n & 255; const float x = (float)((k1 * n1) & 255) * (1.0f / 128.0f); v[e] = (n < 256) ? cospif(x) : -sinpif(x); }
            v4u o; o.x = pk2(v[0], v[1]); o.y = pk2(v[2], v[3]); o.z = pk2(v[4], v[5]); o.w = pk2(v[6], v[7]); *(GAS v4u*)(D + n0) = o; }
    }
}

__device__ __forceinline__ void bias_section(Frame& F, const bf16* WT, int nrows, const float* mod, int shofs, float* out, int gw, int NGW) {
    constexpr int RS = 2064, LO = 16 * RS;
    LAS unsigned char* SH = F.lds;
    __syncthreads();
    for (int i = F.tid; i < 16 * 256; i += NWAVES * 64) { const int bb = i >> 8, k4 = i & 255;
        f32x4 v = (f32x4){0.f, 0.f, 0.f, 0.f}; if (bb < 9) v = *(const GAS f32x4*)(mod + bb * 6144 + shofs + 4 * k4);
        const unsigned h0 = f2bf(v[0]), h1 = f2bf(v[1]), h2 = f2bf(v[2]), h3 = f2bf(v[3]);
        v2u hv, lv; hv.x = h0 | (h1 << 16); hv.y = h2 | (h3 << 16); lv.x = pk2(v[0] - bf2f(h0), v[1] - bf2f(h1)); lv.y = pk2(v[2] - bf2f(h2), v[3] - bf2f(h3));
        *(LAS v2u*)(SH + bb * RS + 8 * k4) = hv; *(LAS v2u*)(SH + LO + bb * RS + 8 * k4) = lv; }
    __syncthreads();
    const int l15 = F.lane & 15, lq = F.lane >> 4;
    const LAS unsigned char* shp = SH + l15 * RS + 16 * lq;
    for (int ps = gw; ps < (nrows >> 4); ps += NGW) { const int n0 = 16 * ps;
        f32x4 d = (f32x4){0.f, 0.f, 0.f, 0.f};
        const bf16* wrow = WT + (size_t)(n0 + l15) * 1024 + 8 * lq;
#pragma unroll 1
        for (int kb = 0; kb < 4; ++kb) { pg8::bf16x8 wv[8];
#pragma unroll
            for (int j = 0; j < 8; ++j) wv[j] = *(const GAS pg8::bf16x8*)(wrow + 32 * (8 * kb + j));
#pragma unroll
            for (int j = 0; j < 8; ++j) { const int ks = 8 * kb + j;
                const pg8::bf16x8 sh = *(const LAS pg8::bf16x8*)(shp + 64 * ks), sl = *(const LAS pg8::bf16x8*)(shp + LO + 64 * ks);
                d = __builtin_amdgcn_mfma_f32_16x16x32_bf16(wv[j], sh, d, 0, 0, 0); d = __builtin_amdgcn_mfma_f32_16x16x32_bf16(wv[j], sl, d, 0, 0, 0); } }
        if (l15 < 9) {
#pragma unroll
            for (int i = 0; i < 4; ++i) out[(size_t)l15 * nrows + n0 + 4 * lq + i] = d[i]; }
    }
    __syncthreads();
}
__device__ __forceinline__ void bias_phase(Frame& F, int which, int gw, int NGW) {
    const float* MODp = (const float*)(F.ws + WS_MOD);
    if (which & 1) bias_section(F, (const bf16*)(F.ws + WS_WIN + WIN_STRIDE), NWIN, MODp + 9 * 6144, 0, (float*)(F.ws + WS_PB) + 9 * NWIN, gw, NGW);
    if (which & 2) bias_section(F, (const bf16*)(F.ws + WS_WUP), 5632, MODp, 3072, (float*)(F.ws + WS_UB), gw, NGW);
    if (which & 4) bias_section(F, (const bf16*)(F.ws + WS_WUP + WUP_STRIDE), 5632, MODp + 9 * 6144, 3072, (float*)(F.ws + WS_UB) + (size_t)9 * 5632, gw, NGW);
}

__device__ __forceinline__ void norm_mod_phase(Frame& F, const float* src_lat, const float* src_ctx, int nrows, const float* g, const float* mod  , int shofs, int scofs, int skip) {
    bf16* XN = (bf16*)(F.ws + WS_XN);
    if (F.bx < skip) return;
    const int gw = (F.bx - skip) * NWAVES + F.wave, NGW = (F.G - skip) * NWAVES;
    constexpr int R = 2;
    f32x4 v[R][4], w[R][4];
#define NM_LOAD(dst, r0_) do { _Pragma("unroll") for (int q = 0; q < R; ++q) { const int row = (r0_) + q * NGW; if (row < nrows) { const float* xr = row < MLAT ? src_lat + (size_t)row * DM : src_ctx + (size_t)(row - MLAT) * DM; \
        _Pragma("unroll") for (int j = 0; j < 4; ++j) dst[q][j] = __builtin_nontemporal_load((const f32x4*)(xr + 256 * j + 4 * F.lane)); } } } while (0)
    NM_LOAD(v, gw);
    for (int row0 = gw; row0 < nrows; row0 += R * NGW) {
        NM_LOAD(w, row0 + R * NGW);
#pragma unroll
        for (int q = 0; q < R; ++q) { const int row = row0 + q * NGW; if (row < nrows) {
            const int r = row < MLAT ? (row >> 11) : 8;
            const float* sh = mod + r * 6144 + shofs; const float* sc = mod + r * 6144 + scofs; float ss = 0.f;
#pragma unroll
            for (int j = 0; j < 4; ++j) ss += (v[q][j][0] * v[q][j][0] + v[q][j][1] * v[q][j][1]) + (v[q][j][2] * v[q][j][2] + v[q][j][3] * v[q][j][3]);
            const float rstd = 1.0f / sqrtf(wave_sum(ss) * (1.0f / DM) + EPS);
#pragma unroll
            for (int j = 0; j < 4; ++j) { const int c = 256 * j + 4 * F.lane; const f32x4 gg = *(const f32x4*)(g + c), s1 = *(const f32x4*)(sc + c), s0 = *(const f32x4*)(sh + c);
                const f32x4 h = (v[q][j] * rstd) * gg * (s1 + 1.0f) + s0;
                v2u o; o.x = pk2(h[0], h[1]); o.y = pk2(h[2], h[3]); *(GAS v2u*)(XN + (size_t)row * DM + c) = o; } } }
#pragma unroll
        for (int q = 0; q < R; ++q)
#pragma unroll
            for (int j = 0; j < 4; ++j) v[q][j] = w[q][j];
    }
#undef NM_LOAD
}
__device__ __forceinline__ void qkv_rows_phase(Frame& F, int l) {
    const bf16* P = (const bf16*)(F.ws + WS_P); bf16* Kb = (bf16*)(F.ws + WS_K); bf16* YC = (bf16*)F.out + (size_t)MT * 768;
    const float* RC = (const float*)(F.ws + WS_ROPE); const float* RS = RC + 1024;
    const float* scw = inptr(F, I_SCW) + l * 3 * 256; const float* scb = inptr(F, I_SCB) + l * 256;
    const int gw = F.vcu * NWAVES + F.wave, NGW = F.G * NWAVES;
    const int nrows_conv = (l == 0) ? MT : MLAT;
    for (int row = gw; row < MT; row += NGW) {
        const bool lat = row < MLAT; const int t = lat ? (row & 2047) : ((row - MLAT) & 255); const int L = lat ? SL : CL;
        const bf16* pr = P + (size_t)row * NIN;
        { const float v = bf2f(pr[640 + F.lane]); const float pv = __shfl_xor(v, 16); float o = v;
          if (lat) { const int j = F.lane, ax = j >> 5, i = j & 15, x2 = (j >> 4) & 1; const int pos = ax ? (t & 63) : (t >> 6); const float c = RC[pos * 16 + i], s = RS[pos * 16 + i];
              o = x2 ? (pv * s + v * c) : (v * c - pv * s); }
          const bf16 ob = (bf16)f2bf(o);
          const int slot = (F.lane & 32) + rope_slot(F.lane & 31);
#pragma unroll
          for (int h = 0; h < 4; ++h) Kb[(size_t)row * 768 + 192 * h + 128 + slot] = ob; }
        if (row < nrows_conv) { const int c = 4 * F.lane;
            const v2u bgv = *(const GAS v2u*)(pr + 1280 + c);
            const v2u cg1 = *(const GAS v2u*)(pr + 1536 + c), xv1 = *(const GAS v2u*)(pr + 1792 + c);
            v2u cg0 = {0u, 0u}, xv0 = {0u, 0u}, cg2 = {0u, 0u}, xv2 = {0u, 0u};
            if (t > 0) { cg0 = *(const GAS v2u*)(pr - NIN + 1536 + c); xv0 = *(const GAS v2u*)(pr - NIN + 1792 + c); }
            if (t < L - 1) { cg2 = *(const GAS v2u*)(pr + NIN + 1536 + c); xv2 = *(const GAS v2u*)(pr + NIN + 1792 + c); }
            const f32x4 w0 = *(const f32x4*)(scw + c), w1 = *(const f32x4*)(scw + 256 + c), w2 = *(const f32x4*)(scw + 512 + c), bb = *(const f32x4*)(scb + c);
            float y[4];
#pragma unroll
            for (int e = 0; e < 4; ++e) { const unsigned sh = (e & 1) * 16; const unsigned m = 0xffffu;
                const unsigned b_ = ((e < 2 ? bgv.x : bgv.y) >> sh) & m;
                const unsigned c0_ = ((e < 2 ? cg0.x : cg0.y) >> sh) & m, x0_ = ((e < 2 ? xv0.x : xv0.y) >> sh) & m;
                const unsigned c1_ = ((e < 2 ? cg1.x : cg1.y) >> sh) & m, x1_ = ((e < 2 ? xv1.x : xv1.y) >> sh) & m;
                const unsigned c2_ = ((e < 2 ? cg2.x : cg2.y) >> sh) & m, x2_ = ((e < 2 ? xv2.x : xv2.y) >> sh) & m;
                const float u0 = bf2f(c0_) * bf2f(x0_), u1 = bf2f(c1_) * bf2f(x1_), u2 = bf2f(c2_) * bf2f(x2_);
                y[e] = bf2f(b_) * (w0[e] * u0 + w1[e] * u1 + w2[e] * u2 + bb[e]); }
            v2u o; o.x = pk2(y[0], y[1]); o.y = pk2(y[2], y[3]); *(GAS v2u*)(YC + (size_t)row * 256 + c) = o; }
    }
}
__device__ __forceinline__ void fnet_fft_unit(Frame& F, int b, int jb) {
    int tid = threadIdx.x; asm volatile("" : "+v"(tid));
    const int w = tid >> 6, l = tid & 63, l15 = l & 15, lq = l >> 4;
    const bf16* P = (const bf16*)(F.ws + WS_P); bf16* YF = (bf16*)(F.ws + WS_YF);
    const bf16* A1g = (const bf16*)(F.ws + WS_FTAB); const bf16* W2g = (const bf16*)(F.ws + WS_FTAB + 32768); const float* TWg = (const float*)(F.ws + WS_FTAB + 40960);
    LAS unsigned char* B1 = F.lds; LAS unsigned char* A1 = F.lds + 69632; LAS unsigned char* TW = F.lds + 104448;
    {
        const int g = jb >> 3, kb = jb & 7;
        const bf16* CTg = (const bf16*)(F.ws + WS_FTAB + 65536) + kb * 1024;
        const pg8::bf16x8 ct0 = *(const GAS pg8::bf16x8*)(CTg + l15 * 64 + 8 * lq), ct1 = *(const GAS pg8::bf16x8*)(CTg + l15 * 64 + 32 + 8 * lq);
#pragma unroll
        for (int i = 0; i < 4; ++i) { const int idx = tid + 512 * i, row = idx >> 4, ch = idx & 15; const v4u v = *(const GAS v4u*)(A1g + row * 128 + ch * 8); *(LAS v4u*)(A1 + row * 272 + ch * 16) = v; }
#pragma unroll
        for (int i = 0; i < 2; ++i) { const int idx = tid + 512 * i; const v4u v = *(const GAS v4u*)(TWg + idx * 4); *(LAS v4u*)(TW + idx * 16) = v; }
#pragma unroll
        for (int hb = 0; hb < 2; ++hb) {
            pg8::bf16x8 uf[8][2];
#pragma unroll
            for (int q = 0; q < 8; ++q) { const int blk = w * 16 + hb * 8 + q; const bf16* src = P + (size_t)(b * SL + 16 * blk + l15) * NIN + 768 + 64 * g + 8 * lq;
                uf[q][0] = *(const GAS pg8::bf16x8*)src; uf[q][1] = *(const GAS pg8::bf16x8*)(src + 32); }
#pragma unroll
            for (int q = 0; q < 8; ++q) { const int blk = w * 16 + hb * 8 + q;
                f32x4 d = (f32x4){0.f, 0.f, 0.f, 0.f};
                d = __builtin_amdgcn_mfma_f32_16x16x32_bf16(ct0, uf[q][0], d, 0, 0, 0); d = __builtin_amdgcn_mfma_f32_16x16x32_bf16(ct1, uf[q][1], d, 0, 0, 0);
                const int r = 16 * (blk & 1) + l15, s = blk >> 1;
                LAS unsigned char* dst = B1 + (32 * 4 * (lq & 1) + r) * 272 + (64 * (lq >> 1) + s) * 2;
                const unsigned p01 = pk2(d[0], d[1]), p23 = pk2(d[2], d[3]);
                *(LAS unsigned short*)(dst + 0 * 8704) = (unsigned short)(p01 & 0xffffu); *(LAS unsigned short*)(dst + 1 * 8704) = (unsigned short)(p01 >> 16);
                *(LAS unsigned short*)(dst + 2 * 8704) = (unsigned short)(p23 & 0xffffu); *(LAS unsigned short*)(dst + 3 * 8704) = (unsigned short)(p23 >> 16); } } }
    pg8::bf16x8 w2[2][2];
#pragma unroll
    for (int ab = 0; ab < 2; ++ab)
#pragma unroll
        for (int ks = 0; ks < 2; ++ks) w2[ab][ks] = *(const GAS pg8::bf16x8*)(W2g + (ab * 16 + l15) * 64 + ks * 32 + 8 * lq);
    __syncthreads();
    f32x4 acc[8][2];
#pragma unroll
    for (int mb = 0; mb < 8; ++mb) { acc[mb][0] = (f32x4){0.f, 0.f, 0.f, 0.f}; acc[mb][1] = (f32x4){0.f, 0.f, 0.f, 0.f}; }
#pragma unroll
    for (int ks = 0; ks < 4; ++ks) {
        const pg8::bf16x8 b0 = *(const LAS pg8::bf16x8*)(B1 + ((2 * w + 0) * 16 + l15) * 272 + ks * 64 + lq * 16);
        const pg8::bf16x8 b1 = *(const LAS pg8::bf16x8*)(B1 + ((2 * w + 1) * 16 + l15) * 272 + ks * 64 + lq * 16);
#pragma unroll
        for (int mb = 0; mb < 8; ++mb) { const pg8::bf16x8 af = *(const LAS pg8::bf16x8*)(A1 + (mb * 16 + l15) * 272 + ks * 64 + lq * 16);
            acc[mb][0] = __builtin_amdgcn_mfma_f32_16x16x32_bf16(af, b0, acc[mb][0], 0, 0, 0);
            acc[mb][1] = __builtin_amdgcn_mfma_f32_16x16x32_bf16(af, b1, acc[mb][1], 0, 0, 0); } }
    __syncthreads();
    LAS unsigned char* B2 = F.lds;
    {
#pragma unroll
      for (int mbp = 0; mbp < 4; ++mbp)
#pragma unroll
        for (int nbl = 0; nbl < 2; ++nbl) { const int r = 16 * nbl + l15;
#pragma unroll
            for (int i = 0; i < 4; ++i) { const int c = mbp * 16 + 4 * lq + i;
                const pg8::f32x2 t = *(const LAS pg8::f32x2*)(TW + (c * 32 + r) * 8);
                const float ar = acc[mbp][nbl][i], ai = acc[mbp + 4][nbl][i];
                const unsigned pk = pk2(ar * t.x - ai * t.y, ar * t.y + ai * t.x);
                LAS unsigned char* d = B2 + (c * 8 + w) * 144 + 2 * (l15 & 7);
                *(LAS unsigned short*)(d + (((r >> 3) ^ (2 * lq)) * 16)) = (unsigned short)(pk & 0xffffu); *(LAS unsigned short*)(d + (((4 + (r >> 3)) ^ (2 * lq)) * 16)) = (unsigned short)(pk >> 16); } } }
    __syncthreads();
    f32x4 y[4][2];
#pragma unroll
    for (int nbp = 0; nbp < 4; ++nbp) { y[nbp][0] = (f32x4){0.f, 0.f, 0.f, 0.f}; y[nbp][1] = (f32x4){0.f, 0.f, 0.f, 0.f}; }
#pragma unroll
    for (int nbp = 0; nbp < 4; ++nbp) { const int sw = 2 * ((2 * w + (nbp >> 1)) & 3);
#pragma unroll
        for (int ks = 0; ks < 2; ++ks) { const pg8::bf16x8 af = *(const LAS pg8::bf16x8*)(B2 + ((4 * w + nbp) * 16 + l15) * 144 + (((ks * 4 + lq) ^ sw) * 16));
            y[nbp][0] = __builtin_amdgcn_mfma_f32_16x16x32_bf16(af, w2[0][ks], y[nbp][0], 0, 0, 0);
            y[nbp][1] = __builtin_amdgcn_mfma_f32_16x16x32_bf16(af, w2[1][ks], y[nbp][1], 0, 0, 0); } }
    constexpr float SC = 0.0027621358640099515f;
#pragma unroll
    for (int nbp = 0; nbp < 4; ++nbp)
#pragma unroll
        for (int ab = 0; ab < 2; ++ab) { const int c = (4 * w + nbp) * 2 + (lq >> 1), a = ab * 16 + l15, p = 64 * a + c;
            v2u o; o.x = pk2(y[nbp][ab][0] * SC, y[nbp][ab][1] * SC); o.y = pk2(y[nbp][ab][2] * SC, y[nbp][ab][3] * SC);
            *(GAS v2u*)(YF + (size_t)(b * SL + p) * 256 + jb * 8 + 4 * (lq & 1)) = o; }
    __syncthreads();
}
__device__ __forceinline__ void zt_phase(Frame& F, int l) {
    const bf16* P = (const bf16*)(F.ws + WS_P);
    LAS bf16* T = (LAS bf16*)(F.lds + F.wave * 16384);
    const int gw = F.vcu * NWAVES + F.wave, NGW = F.G * NWAVES;
    const int nitems = (l == 0 ? 256 : 0);
    for (int it = gw; it < nitems; it += NGW) {
        const bool lat = false; const int r = it;
        const int pb = r >> 3, cb = r & 7;
        const int row0 = (lat ? 0 : MLAT) + 64 * pb; const int L = lat ? SL : CL;
        const int b = lat ? (pb >> 5) : (pb >> 2); const int n0 = (64 * pb) & (L - 1);
        bf16* ZT = lat ? (bf16*)(F.ws + WS_ZT) : (bf16*)(F.ws + WS_ZTC);
#pragma unroll
        for (int i = 0; i < 8; ++i) { const int pos = 8 * i + (F.lane >> 3), ch = F.lane & 7;
            const v4u v = *(const GAS v4u*)(P + (size_t)(row0 + pos) * NIN + 768 + 64 * cb + 8 * ch);
            LAS unsigned* d = (LAS unsigned*)(T + pos * 66 + 8 * ch); d[0] = v.x; d[1] = v.y; d[2] = v.z; d[3] = v.w; }
        LDS_WAIT(); asm volatile("" ::: "memory");
        const int sn = cb >> 2;
#pragma unroll
        for (int j = 0; j < 8; ++j) { const int chl = 8 * j + (F.lane >> 3), pc = F.lane & 7;
            unsigned e[8];
#pragma unroll
            for (int q = 0; q < 8; ++q) e[q] = T[(8 * pc + q) * 66 + chl];
            v4u o; o.x = e[0] | (e[1] << 16); o.y = e[2] | (e[3] << 16); o.z = e[4] | (e[5] << 16); o.w = e[6] | (e[7] << 16);
            const int chg = 64 * (cb & 3) + chl;
            *(GAS v4u*)(ZT + ((size_t)(b * 256 + chg) * 2 + sn) * L + n0 + 8 * pc) = o; }
        LDS_WAIT(); asm volatile("" ::: "memory");
    }
}
__device__ __forceinline__ void ycat_norm_phase(Frame& F, int nrows) {
    bf16* Y = (bf16*)(F.ws + WS_YCAT); const bf16* YC = (const bf16*)F.out + (size_t)MT * 768; const bf16* YF = (const bf16*)(F.ws + WS_YF); const bf16* AT = (const bf16*)((const char*)F.out + OUT_ATT);
    const int gw = F.vcu * NWAVES + F.wave, NGW = F.G * NWAVES;
    constexpr int R = 2;
    for (int row0 = gw; row0 < nrows; row0 += R * NGW) {
        v4u a[R]; v2u c[R]; v2u f[R];
#pragma unroll
        for (int q = 0; q < R; ++q) { const int row = row0 + q * NGW; if (row < nrows) { a[q] = __builtin_nontemporal_load((const GAS v4u*)(AT + (size_t)row * 512 + 8 * F.lane)); c[q] = __builtin_nontemporal_load((const GAS v2u*)(YC + (size_t)row * 256 + 4 * F.lane));
            f[q] = __builtin_nontemporal_load((const GAS v2u*)(YF + (size_t)row * 256 + 4 * F.lane)); } }
#pragma unroll
        for (int q = 0; q < R; ++q) { const int row = row0 + q * NGW; if (row < nrows) { bf16* yr = Y + (size_t)row * 1024;
            float av[8], fv[4], cv[4];
            fv[0] = bf2f(f[q].x & 0xffffu); fv[1] = bf2f(f[q].x >> 16); fv[2] = bf2f(f[q].y & 0xffffu); fv[3] = bf2f(f[q].y >> 16);
            av[0] = bf2f(a[q].x & 0xffffu); av[1] = bf2f(a[q].x >> 16); av[2] = bf2f(a[q].y & 0xffffu); av[3] = bf2f(a[q].y >> 16); av[4] = bf2f(a[q].z & 0xffffu); av[5] = bf2f(a[q].z >> 16); av[6] = bf2f(a[q].w & 0xffffu); av[7] = bf2f(a[q].w >> 16);
            cv[0] = bf2f(c[q].x & 0xffffu); cv[1] = bf2f(c[q].x >> 16); cv[2] = bf2f(c[q].y & 0xffffu); cv[3] = bf2f(c[q].y >> 16);
            float sa = 0.f, sf = 0.f, sc = 0.f;
#pragma unroll
            for (int e = 0; e < 8; ++e) sa += av[e] * av[e];
#pragma unroll
            for (int e = 0; e < 4; ++e) { sf += fv[e] * fv[e]; sc += cv[e] * cv[e]; }
            const float ra = 1.0f / sqrtf(wave_sum(sa) * (1.0f / 512.0f) + EPS), rf = 1.0f / sqrtf(wave_sum(sf) * (1.0f / 256.0f) + EPS), rc = 1.0f / sqrtf(wave_sum(sc) * (1.0f / 256.0f) + EPS);
            v4u oa; oa.x = pk2(av[0] * ra, av[1] * ra); oa.y = pk2(av[2] * ra, av[3] * ra); oa.z = pk2(av[4] * ra, av[5] * ra); oa.w = pk2(av[6] * ra, av[7] * ra);
            v2u of; of.x = pk2(fv[0] * rf, fv[1] * rf); of.y = pk2(fv[2] * rf, fv[3] * rf);
            v2u oc; oc.x = pk2(cv[0] * rc, cv[1] * rc); oc.y = pk2(cv[2] * rc, cv[3] * rc);
            *(GAS v4u*)(yr + 8 * F.lane) = oa; *(GAS v2u*)(yr + 512 + 4 * F.lane) = of; *(GAS v2u*)(yr + 768 + 4 * F.lane) = oc; } }
    }
}
__device__ __forceinline__ void ctx_combine_phase(Frame& F, const float* base, const float* gp_g, int gp_ofs, int gate_ofs, const float* gn_g, const float* gn_mod, int gn_ofs, int nsl) {
    const bf16* PART = (const bf16*)(F.ws + WS_CPART); bf16* XNp = (bf16*)(F.ws + WS_XN); float* SSXp = (float*)(F.ws + WS_SSX);
    const float* mod0 = (const float*)(F.ws + WS_MOD) + 8 * 6144;
    const int gw = F.vcu * NWAVES + F.wave, NGW = F.G * NWAVES;
    for (int row = gw; row < MCTX; row += NGW) {
        float ss = 0.f; bf16* xr = XNp + (size_t)(MLAT + row) * DM;
#pragma unroll
        for (int j = 0; j < 4; ++j) { const int c = 256 * j + 4 * F.lane; f32x4 x;
            if (base != nullptr) x = *(const f32x4*)(base + (size_t)row * DM + c);
            else { const v2u xw = *(const GAS v2u*)(xr + c); x[0] = bf2f(xw.x & 0xffffu); x[1] = bf2f(xw.x >> 16); x[2] = bf2f(xw.y & 0xffffu); x[3] = bf2f(xw.y >> 16);
                const f32x4 gp = *(const f32x4*)(gp_g + c) * (*(const f32x4*)(mod0 + gp_ofs + c) + 1.0f);
                x[0] = x[0] / gp[0]; x[1] = x[1] / gp[1]; x[2] = x[2] / gp[2]; x[3] = x[3] / gp[3]; }
            f32x4 s = {0.f, 0.f, 0.f, 0.f};
            for (int k = 0; k < nsl; ++k) { const v2u pw = __builtin_nontemporal_load((const GAS v2u*)(PART + ((size_t)k * MCTX + row) * DM + c)); s[0] += bf2f(pw.x & 0xffffu); s[1] += bf2f(pw.x >> 16); s[2] += bf2f(pw.y & 0xffffu); s[3] += bf2f(pw.y >> 16); }
            x = x + *(const f32x4*)(mod0 + gate_ofs + c) * s;
            ss += (x[0] * x[0] + x[1] * x[1]) + (x[2] * x[2] + x[3] * x[3]);
            const f32x4 h = x * (*(const f32x4*)(gn_g + c)) * (*(const f32x4*)(gn_mod + gn_ofs + c) + 1.0f);
            v2u ho; ho.x = pk2(h[0], h[1]); ho.y = pk2(h[2], h[3]); *(GAS v2u*)(xr + c) = ho; }
        ss = wave_sum(ss);
        if (F.lane < 16) SSXp[(size_t)(MLAT + row) * 16 + F.lane] = F.lane == 0 ? ss : 0.f;
    }
}
__device__ __forceinline__ void final_norm_phase(Frame& F, const bf16* xf, const float* g) {
    const int gw = F.vcu * NWAVES + F.wave, NGW = F.G * NWAVES;
    constexpr int R = 2;
    v2u w[R][4], wn[R][4];
#define FN_LOAD(W_, r0_) do { _Pragma("unroll") for (int q = 0; q < R; ++q) { const int row = (r0_) + q * NGW; if (row < MLAT) { \
        _Pragma("unroll") for (int j = 0; j < 4; ++j) W_[q][j] = __builtin_nontemporal_load((const GAS v2u*)(xf + (size_t)row * DM + 256 * j + 4 * F.lane)); } } } while (0)
    FN_LOAD(w, gw);
    for (int row0 = gw; row0 < MLAT; row0 += R * NGW) {
        FN_LOAD(wn, row0 + R * NGW);
#pragma unroll
        for (int q = 0; q < R; ++q) { const int row = row0 + q * NGW; if (row < MLAT) { float* orow = F.out + (size_t)row * DM;
            f32x4 v[4]; float ss = 0.f;
#pragma unroll
            for (int j = 0; j < 4; ++j) { v[j][0] = bf2f(w[q][j].x & 0xffffu); v[j][1] = bf2f(w[q][j].x >> 16); v[j][2] = bf2f(w[q][j].y & 0xffffu); v[j][3] = bf2f(w[q][j].y >> 16);
                ss += (v[j][0] * v[j][0] + v[j][1] * v[j][1]) + (v[j][2] * v[j][2] + v[j][3] * v[j][3]); }
            const float rstd = 1.0f / sqrtf(wave_sum(ss) * (1.0f / DM) + EPS);
#pragma unroll
            for (int j = 0; j < 4; ++j) { const int c = 256 * j + 4 * F.lane; const f32x4 gg = *(const f32x4*)(g + c); __builtin_nontemporal_store((v[j] * rstd) * gg, (f32x4*)(orow + c)); } } }
#pragma unroll
        for (int q = 0; q < R; ++q)
#pragma unroll
            for (int j = 0; j < 4; ++j) w[q][j] = wn[q][j];
    }
#undef FN_LOAD
}
#ifndef PHMASK
#define PHMASK 0xFFFF
#endif
#define PHON(x) (((PHMASK) >> (x)) & 1)
#ifndef SUBMASK
#define SUBMASK 0xFF
#endif
#define SUBON(x) (rep_ == 0 || (((SUBMASK) >> (x)) & 1))
struct UpOrder : pg8::StaticOrder {
    typedef pg8::UnitUp UnitT; int nrows;
    __device__ __forceinline__ bool next(int i, pg8::UnitUp& u) const {
        if (!next_mn(i, u.pm, u.pn)) return false;
        u.kofs = 0; u.kofb = 0; u.nt = ntk; u.arow = 254 * u.pm - 1; u.nrows = nrows;
        return true;
    }
};

struct SliceOrder0 : pg8::StaticOrder {
    typedef pg8::Unit UnitT; int nsl;
    __device__ __forceinline__ bool next(int i, pg8::Unit& u) const {
        if (i == 0) { if (!next_mn(0, u.pm, u.pn)) return false; u.arow = u.pm * 256; u.kofs = 0; u.kofb = 0; u.nt = ntk; u.aux = 0; return true; }
        const int L = (i - 1) * G + c; if (L >= 32 * nsl) return false;
        const int t = L / nsl, s = L % nsl; u.pm = 64 + (t >> 2); u.pn = t & 3; u.arow = u.pm * 256; u.aux = s;
        if (nsl == 8) { u.kofs = (s < 6 ? 6 * s : 36 + 4 * (s - 6)) * 64; u.nt = s < 6 ? 6 : 4; } else { u.kofs = s * 256; u.nt = 4; }
        u.kofb = u.kofs; return true;
    }
};

struct QkvOrder {
    typedef pg8::Unit UnitT; int G, c, nq;
    __device__ __forceinline__ bool next(int i, pg8::Unit& u) const { const int L = i * G + c; if (L >= 288 + nq) return false;
        if (L < 288) { u.pm = L >> 2; u.pn = 3 + (L & 3); u.kofs = 384; u.nt = 4; } else { const int j = L - 288; u.pm = j / 3; u.pn = j % 3; u.kofs = 0; u.nt = 6; }
        u.kofb = 0; u.arow = u.pm * 256; return true; }
};

struct WinOrder {
    typedef pg8::Unit UnitT; pg8::StaticOrder S; int G, c, l;
    __device__ __forceinline__ void init(int G_, int c_, int l_) { S.init(64, 7, G_, c_, 1024); G = G_; c = c_; l = l_; }
    __device__ __forceinline__ bool next(int i, pg8::Unit& u) const {
        int pm, pn;
        if (S.next_mn(i, pm, pn)) { u.pm = pm; u.pn = pn < 3 ? pn : (pn == 3 ? 8 : pn + 1); }
        else { const long L = (long)i * G + c - 448; const int nctx = (l == 0) ? 64 : 16; if (L < 0 || L >= nctx) return false;
            if (l == 0) { u.pm = 64 + (int)(L >> 3); u.pn = (int)(L & 7); } else { u.pm = 64 + (int)(L >> 1); u.pn = 1 + (int)(L & 1); } }
        u.arow = u.pm * 256; u.kofs = 0; u.kofb = 0; u.nt = 16; u.aux = 0; return true; }
};
struct FnetOrder {
    typedef pg8::Unit UnitT; int G, c;
    __device__ __forceinline__ bool next(int i, pg8::Unit& u) const { const int L = i * G + c; if (L >= 256) return false;
        u.pm = (L >> 3) & 7; u.pn = L & 7; u.arow = u.pm * 256; u.kofs = (L >> 6) * 1024; u.kofb = u.kofs; u.nt = 16; return true; }
};

__global__ void __launch_bounds__(NWAVES * 64, 2) mk_fwd(Args args) {
    extern __shared__ __attribute__((aligned(16))) unsigned char lds[];
    Frame F;
    F.lds = (LAS unsigned char*)lds; F.ldsg = (char*)lds;
    F.MISC = (volatile LAS unsigned*)(F.lds + MISC_OFF);
    F.tid = threadIdx.x; F.lane = F.tid & 63; F.wave = __builtin_amdgcn_readfirstlane(F.tid >> 6);
    F.G = gridDim.x; F.bx = blockIdx.x; F.vcu = (F.G % 8 == 0) ? (F.bx % 8) * (F.G / 8) + F.bx / 8 : F.bx;
    F.ws = args.ws; F.out = args.out;
    for (int u = F.tid; u < (LDS_BYTES - LDSCTL_OFF) / 4; u += NWAVES * 64) ((LAS unsigned*)(F.lds + LDSCTL_OFF))[u] = 0u;
    __syncthreads();
    if (F.tid == 0) { LAS unsigned long long* T = (LAS unsigned long long*)(F.lds + PTR_OFF);
#pragma unroll
        for (int i = 0; i < 22; ++i) T[i] = (unsigned long long)args.in[i]; }
    __syncthreads();
    XcdBarrier bar; bar.bar = (unsigned*)(F.ws + WS_CTL) + CW_BAR; bar.x = 0; bar.st = nullptr;
    if (!MK_SPLIT) bar = xcd_barrier_post((unsigned*)(F.ws + WS_CTL) + CW_BAR, F.MISC + 8);

#define MOD ((float*)(ws + WS_MOD))
#define SSQ ((float*)(ws + WS_SSQ))
#define XN ((bf16*)(ws + WS_XN))
#define P ((bf16*)(ws + WS_P))
#define Qb ((bf16*)F.out)
#define Kb ((bf16*)(ws + WS_K))
#define Vb ((bf16*)(ws + WS_V))
#define YCAT ((bf16*)(ws + WS_YCAT))
#define ATTO ((bf16*)((char*)F.out + OUT_ATT))
#define ACT ((bf16*)(ws + WS_ACT))
#define XCTX ((bf16*)(ws + WS_XCTX))
#define XBL ((bf16*)F.out + (size_t)MLAT * DM)
#define XFIN ((bf16*)(ws + WS_XN))
    LAS unsigned char* ring = F.lds + RING_OFF;

    const int ph_lo = args.ph_lo, ph_hi = args.ph_hi;
#ifndef FFT_RPT
#define FFT_RPT 1
#endif
#ifndef FILL2_RPT
#define FILL2_RPT 1
#endif
#ifndef FILL_RPT
#define FILL_RPT 1
#endif
#define PHASE(k) (ph_lo <= (k) && (k) < ph_hi)
#define SEAM(k) do { if (PHASE(k) && PHASE((k) + 1)) xcd_barrier(bar); } while (0)
#ifndef P0SUB
#define P0SUB 0xFF
#endif
#ifndef UPPROBE
#define UPPROBE 0
#endif
#ifndef RPT_PH
#define RPT_PH -1
#endif
#define RELANE() do { int t_ = threadIdx.x; asm volatile("" : "+v"(t_)); F.tid = t_; F.lane = t_ & 63; F.wave = __builtin_amdgcn_readfirstlane(t_ >> 6); } while (0)
    unsigned char* ws = F.ws;
    if (PHASE(0)) for (int rep_ = 0; rep_ < (((0) == RPT_PH) ? 2 : 1); ++rep_) { if (rep_) xcd_barrier(bar); RELANE(); if (PHON(0)) p0_prologue(F, rep_ ? P0SUB : 0xFF, 0, F.vcu * NWAVES + F.wave, F.G * NWAVES); }
    SEAM(0);
    for (int l = 0; l < 2; ++l) {
        const int pb = 1 + 9 * l;
        const int nMall = (l == 0) ? 72 : 64;
        if (PHASE(pb + 0)) for (int rep_ = 0; rep_ < (((pb + 0) == RPT_PH) ? 2 : 1); ++rep_) { if (rep_) xcd_barrier(bar); RELANE();
            if (l == 0 && (rep_ == 0 || (SUBMASK & 1))) { pg8::Gemm g{(const bf16*)(ws + WS_CST), (const bf16*)(ws + WS_WF), 2, 8, 256, 256}; pg8::StaticOrder S; S.init(2, 8, F.G, F.bx, 256);
                pg8::EpiFold E{(bf16*)(ws + WS_WIN), (unsigned)(WIN_STRIDE / 2)};
                pg8::gemm_phase(ring, g, S, E); RELANE(); }
            if (PHON(1) && l == 0 && (rep_ == 0 || (SUBMASK & 2))) norm_mod_phase(F, inptr(F, I_X), inptr(F, I_CTX), MT, inptr(F, I_N1G), MOD, 0, 1024, 16); }
        if (l == 0) SEAM(pb + 0);
        if (PHASE(pb + 1)) for (int rep_ = 0; rep_ < (((pb + 1) == RPT_PH) ? 2 : 1); ++rep_) { if (rep_) xcd_barrier(bar); RELANE();
            if (PHON(2)) { pg8::Gemm g{XN, (const bf16*)(ws + WS_WIN + l * WIN_STRIDE), 72, 9, 1024, 1024}; WinOrder S; S.init(F.G, F.bx, l);
                pg8::EpiWin E{P, NIN, SSQ, l == 1 ? (const float*)(ws + WS_SSX) : nullptr, (const float*)(ws + WS_PB) + 9 * NWIN, (LAS float*)(F.lds + EPIX_OFF)};
                pg8::gemm_phase(ring, g, S, E);
                if (rep_ == 0 && l == 1) {
                    RELANE(); int nb = 464 - F.G; nb = nb < 0 ? 0 : (nb > F.G ? F.G : nb);
                    const bool all = (nb == F.G); if (all || F.bx >= nb) { const int rk = all ? F.bx : F.bx - nb, n = all ? F.G : F.G - nb;
                        bias_phase(F, 4, rk * NWAVES + F.wave, n * NWAVES); } } } }
        SEAM(pb + 1);
        if (PHASE(pb + 2)) for (int rep_ = 0; rep_ < (((pb + 2) == RPT_PH) ? 2 : 1); ++rep_) { if (rep_) xcd_barrier(bar); RELANE();
            if (PHON(3)) {
                if (SUBON(0)) { pg8::Gemm g{P, (const bf16*)(ws + WS_WQKV + l * WQKV_STRIDE), 72, 7, 384, NIN}; QkvOrder S; S.G = F.G; S.c = F.vcu; S.nq = 3 * nMall;
                  pg8::EpiQKV E{Qb, Kb, Vb, SSQ, (const float*)(ws + WS_ROPE), (const float*)(ws + WS_ROPE) + 1024, (LAS float*)(F.lds + EPIX_OFF)};
                  pg8::gemm_phase(ring, g, S, E); }
                if (SUBON(2)) qkv_rows_phase(F, l);
                if (SUBON(3)) zt_phase(F, l);
                } }
        SEAM(pb + 2);
        if (PHASE(pb + 3)) for (int rep_ = 0; rep_ < (((pb + 3) == RPT_PH) ? 2 : 1); ++rep_) { if (rep_) xcd_barrier(bar); RELANE();
            if (PHON(4)) {
                const int NU = 256 + (l == 0 ? 32 : 0);
                for (int u = F.vcu; u < NU; u += F.G) {
                    if (u < 256) { const int bh = u >> 3, qb = u & 7, b = bh >> 2, h = bh & 3; const long q0 = (long)b * SL + qb * 256;
                        att::attn_unit(Qb + q0 * 768 + 192 * h, Kb + 192 * h, Vb + 128 * h, ATTO + q0 * 512 + 128 * h, MLAT + CL * b, 4, SL * b, 36, F.ldsg);
                    } else { const int cu = u - 256, b = cu >> 2, h = cu & 3; const long q0 = MLAT + (long)CL * b;
                        att::attn_unit(Qb + q0 * 768 + 192 * h, Kb + 192 * h, Vb + 128 * h, ATTO + q0 * 512 + 128 * h, (int)q0, 4, 0, 4, F.ldsg); }
                }
                RELANE(); for (int rp_ = 0; rp_ < FFT_RPT; ++rp_) for (int u = F.vcu; u < 256; u += F.G) fnet_fft_unit(F, u >> 5, u & 31);
                RELANE();
                if (l == 0) { pg8::Gemm g{(const bf16*)(ws + WS_DFTC), (const bf16*)(ws + WS_ZTC), 1, 8, 512, 512}; pg8::StaticOrder S; S.init(1, 8, F.G, (F.bx + 128) % F.G, 512);
                  pg8::EpiFnet E{(bf16*)(ws + WS_YF), MLAT, CL, 0.0078125f, (unsigned)(MT * 256)};
                  pg8::gemm_phase(ring, g, S, E); }
                if (l == 0 && rep_ == 0) {
                    RELANE(); const bool all = F.G <= 32; if (all || F.vcu >= 32) { const int rk = all ? F.vcu : F.vcu - 32, n = all ? F.G : F.G - 32;
                        for (int fr_ = 0; fr_ < FILL_RPT; ++fr_) { p0_prologue(F, 0xFF, 1, rk * NWAVES + F.wave, n * NWAVES); bias_phase(F, 1, rk * NWAVES + F.wave, n * NWAVES); } } } } }
        SEAM(pb + 3);
        if (PHASE(pb + 4)) for (int rep_ = 0; rep_ < (((pb + 4) == RPT_PH) ? 2 : 1); ++rep_) { if (rep_) xcd_barrier(bar); RELANE();
            if (PHON(5)) ycat_norm_phase(F, nMall * 256); }
        SEAM(pb + 4);
        if (PHASE(pb + 5)) for (int rep_ = 0; rep_ < (((pb + 5) == RPT_PH) ? 2 : 1); ++rep_) { if (rep_) xcd_barrier(bar); RELANE();
            if (PHON(6)) { pg8::Gemm g{YCAT, (const bf16*)(ws + WS_WOUT + l * WOUT_STRIDE), nMall, 4, 1024, 1024}; pg8::StaticOrder S; S.init(nMall, 4, F.G, F.bx, 1024);
                if (l == 0) { SliceOrder0 S0; S0.init(64, 4, F.G, F.bx, 1024); S0.nsl = 4; pg8::Gemm g0{YCAT, (const bf16*)(ws + WS_WOUT), 64, 4, 1024, 1024};
                    pg8::EpiRes<true> E{inptr(F, I_X), inptr(F, I_CTX), XN, MOD, 2048, nullptr, nullptr, 0, inptr(F, I_N2G), MOD, 4096, (float*)(ws + WS_SSX), rep_ ? 0.f : 1.f, (bf16*)(ws + WS_CPART)};
                    pg8::gemm_phase(ring, g0, S0, E);
                    RELANE(); { int nb = 128; nb = nb > F.G ? F.G : nb; const bool all = (nb == F.G); if (rep_ == 0 && (all || F.bx >= nb)) { const int rk = all ? F.bx : F.bx - nb, n = all ? F.G : F.G - nb; bias_phase(F, 2, rk * NWAVES + F.wave, n * NWAVES); } }
                    xcd_barrier(bar); RELANE();
                    ctx_combine_phase(F, inptr(F, I_CTX), nullptr, 0, 2048, inptr(F, I_N2G), MOD + 8 * 6144, 4096, 4); }
                else { pg8::EpiRes<false> E{nullptr, nullptr, XN, MOD + (size_t)9 * 6144, 2048, inptr(F, I_N1G) + DM, MOD + (size_t)9 * 6144, 1024, inptr(F, I_N2G) + DM, MOD + (size_t)9 * 6144, 4096, (float*)(ws + WS_SSX), rep_ ? 0.f : 1.f, nullptr};
                    pg8::gemm_phase(ring, g, S, E); } } }
        SEAM(pb + 5);
        if (PHASE(pb + 6)) for (int rep_ = 0; rep_ < (((pb + 6) == RPT_PH) ? 2 : 1); ++rep_) { if (rep_) xcd_barrier(bar); RELANE();
            }
        if (PHASE(pb + 7)) for (int rep_ = 0; rep_ < (((pb + 7) == RPT_PH) ? 2 : 1); ++rep_) { if (rep_) xcd_barrier(bar); RELANE();
            if (PHON(8)) { const int nrows = (l == 0) ? MT : MLAT; const int nM = (nrows + 253) / 254;
                pg8::Gemm g{XN, (const bf16*)(ws + WS_WUP + l * WUP_STRIDE), nM, 22, 1024, 1024}; UpOrder S; S.init(nM, 22, F.G, F.bx, 1024); S.nrows = nrows;
                pg8::EpiUp E{ACT, inptr(F, I_FCW) + (size_t)l * 3 * FF, inptr(F, I_FCB) + (size_t)l * FF, (LAS float*)(F.lds + EPIX_OFF), (const float*)(ws + WS_SSX), (const float*)(ws + WS_UB) + (size_t)l * 9 * 5632};
                pg8::gemm_phase(ring, g, S, E);
                if (l == 0 && rep_ == 0) {
                    RELANE(); int nb = nM * 22 - 6 * F.G; nb = nb < 0 ? 0 : (nb > F.G ? F.G : nb);
                    const bool all = (nb == F.G); if (all || F.bx >= nb) { const int rk = all ? F.bx : F.bx - nb, n = all ? F.G : F.G - nb; for (int fr_ = 0; fr_ < FILL2_RPT; ++fr_) p0_prologue(F, 0xFF, 2, rk * NWAVES + F.wave, n * NWAVES); } } } }
        SEAM(pb + 7);
        if (PHASE(pb + 8)) for (int rep_ = 0; rep_ < (((pb + 8) == RPT_PH) ? 2 : 1); ++rep_) { if (rep_) xcd_barrier(bar); RELANE();
            if (PHON(6)) {
                if (l == 0) { pg8::Gemm g{ACT, (const bf16*)(ws + WS_WDOWN), 64, 4, FF, FF}; SliceOrder0 S; S.init(64, 4, F.G, F.bx, FF); S.nsl = 8;
                    pg8::EpiRes<false> E{nullptr, nullptr, XN, MOD, 5120, inptr(F, I_N2G), MOD, 4096, inptr(F, I_N1G) + DM, MOD + (size_t)9 * 6144, 1024, (float*)(ws + WS_SSX), rep_ ? 0.f : 1.f, (bf16*)(ws + WS_CPART)};
                    pg8::gemm_phase(ring, g, S, E);
                    xcd_barrier(bar); RELANE();
                    ctx_combine_phase(F, nullptr, inptr(F, I_N2G), 4096, 5120, inptr(F, I_N1G) + DM, MOD + (size_t)9 * 6144 + 8 * 6144, 1024, 8);
                } else { pg8::Gemm g{ACT, (const bf16*)(ws + WS_WDOWN + WDOWN_STRIDE), 64, 4, FF, FF}; pg8::StaticOrder S; S.init(64, 4, F.G, F.bx, FF);
                    pg8::EpiRes<false> E{nullptr, nullptr, XN, MOD + (size_t)9 * 6144, 5120, inptr(F, I_N2G) + DM, MOD + (size_t)9 * 6144, 4096, nullptr, nullptr, 0, nullptr, 1.f, nullptr};
                    pg8::gemm_phase(ring, g, S, E); } } }
        SEAM(pb + 8);
    }
    if (PHASE(NPH - 1)) for (int rep_ = 0; rep_ < (((NPH - 1) == RPT_PH) ? 2 : 1); ++rep_) { if (rep_) xcd_barrier(bar); RELANE(); if (PHON(10)) final_norm_phase(F, XN, inptr(F, I_FING)); }
#undef PHASE
#undef SEAM
#undef RELANE
#undef MOD
#undef SSQ
#undef XN
#undef P
#undef Qb
#undef Kb
#undef Vb
#undef YCAT
#undef ATTO
#undef ACT
#undef XCTX
#undef XBL
#undef XFIN
}

extern "C" void kernel_launch(void* const* d_in, const int* in_sizes, int n_in, void* d_out, int out_size, void* d_ws, size_t ws_size, hipStream_t stream) {
    static int grid = 0;
    if (grid == 0) {
        if (n_in != 22 || out_size != MLAT * DM || ws_size < WS_END) { fprintf(stderr, "kernel_launch: unexpected shapes (n_in %d out %d ws %zu)\n", n_in, out_size, ws_size); grid = -1; return; }
        int dev = 0, cus = 0;
        if (hipGetDevice(&dev) != hipSuccess || hipDeviceGetAttribute(&cus, hipDeviceAttributeMultiprocessorCount, dev) != hipSuccess) { grid = -1; return; }
        if (hipFuncSetAttribute((const void*)mk_fwd, hipFuncAttributeMaxDynamicSharedMemorySize, LDS_BYTES) != hipSuccess) { fprintf(stderr, "kernel_launch: hipFuncSetAttribute failed\n"); grid = -1; return; }
        int per_cu = 0;
        if (hipOccupancyMaxActiveBlocksPerMultiprocessor(&per_cu, (const void*)mk_fwd, NWAVES * 64, LDS_BYTES) != hipSuccess || per_cu < 1) fprintf(stderr, "kernel_launch: occupancy query says %d\n", per_cu);
        (void)hipGetLastError();
        grid = cus;
    }
    if (grid < 0) return;
    if (hipMemsetAsync((char*)d_ws + WS_CTL, 0, CTL_ZERO_BYTES, stream) != hipSuccess) return;
    Args a{};
    for (int i = 0; i < 22; ++i) a.in[i] = (const float*)d_in[i];
    a.out = (float*)d_out; a.ws = (unsigned char*)d_ws;
#if MK_SPLIT
    for (int ph = 0; ph < NPH; ++ph) { a.ph_lo = ph; a.ph_hi = ph + 1; hipLaunchKernelGGL(mk_fwd, dim3(grid), dim3(NWAVES * 64), LDS_BYTES, stream, a); }
#else
    a.ph_lo = 0; a.ph_hi = NPH;
    hipLaunchKernelGGL(mk_fwd, dim3(grid), dim3(NWAVES * 64), LDS_BYTES, stream, a);
#endif
    const hipError_t le = hipPeekAtLastError();
    if (le != hipSuccess) fprintf(stderr, "kernel_launch: launch failed: %s\n", hipGetErrorName(le));
}
```
